# Optimizing an MI355X kernel written in HIP

```python
import math
import jax, jax.numpy as jnp
from jax import lax
import numpy as np

D_MODEL = 1024
BATCH = 16
SEQ = 2048
DEPTH = 1
DEC_BATCH = 128
DEC_SEQ = 8
PAST_LEN = 8192
PAGE_SIZE = 128

ATT_HEADS = 8
N_KV_HEADS = 2
HEAD_DIM = 64
ATT_WIDTH = ATT_HEADS * HEAD_DIM
ROPE_THETA = 500000.0
IDX_HEADS = 8
IDX_DIM = 64
TOPK_MAX = 256
Q_BLOCK = 128
GDN_HEADS = 4
GDN_DK = 128
GDN_DV = 128
GDN_WIDTH = GDN_HEADS * GDN_DV
GDN_CONV_DIM = 2 * GDN_HEADS * GDN_DK + GDN_WIDTH
CONV_K = 4
GDN_CHUNK = 64
MIX_WIDTH = ATT_WIDTH + GDN_WIDTH
D_FF = 2816
LN_EPS = 1e-5
NORM_EPS = 1e-6
DEEP_ALPHA = (2 * DEPTH) ** 0.25
DEEP_BETA = (8 * DEPTH) ** -0.25
SPLITS = (ATT_WIDTH, N_KV_HEADS * HEAD_DIM, N_KV_HEADS * HEAD_DIM, IDX_HEADS * IDX_DIM, IDX_DIM, IDX_HEADS,
          GDN_CONV_DIM, GDN_WIDTH, GDN_HEADS, GDN_HEADS)
IN_WIDTH = sum(SPLITS)
SPLIT_POINTS = tuple(int(s) for s in np.cumsum(SPLITS)[:-1])

kernel_name = 'dsa_gdn_macaron_deepnorm_step'


def layer_norm(x, g, b):
    xf = x.astype(jnp.float32)
    mu = jnp.mean(xf, -1, keepdims=True)
    var = jnp.mean(jnp.square(xf - mu), -1, keepdims=True)
    return ((xf - mu) * lax.rsqrt(var + LN_EPS) * g.astype(jnp.float32) + b.astype(jnp.float32)).astype(x.dtype)


def swiglu(x, w_gate, w_up, w_down):
    return (jax.nn.silu(x @ w_gate) * (x @ w_up)) @ w_down


def ffn_half_step(x, w_gate, w_up, w_down, g, b):
    return layer_norm(DEEP_ALPHA * x + 0.5 * swiglu(x, w_gate, w_up, w_down), g, b)


def mixer_residual(x, att, gdn, w_o, g, b):
    return layer_norm(DEEP_ALPHA * x + jnp.concatenate([att, gdn], -1) @ w_o, g, b)


def rope_partial(x, pos):
    d_rot = x.shape[-1] // 4
    half = d_rot // 2
    inv_freq = ROPE_THETA ** (-jnp.arange(half, dtype=jnp.float32) / half)
    ang = pos.astype(jnp.float32)[:, None] * inv_freq[None, :]
    cos = jnp.cos(ang)[None, :, None, :]
    sin = jnp.sin(ang)[None, :, None, :]
    xr = x[..., :d_rot].astype(jnp.float32)
    x1, x2 = xr[..., :half], xr[..., half:]
    rot = jnp.concatenate([x1 * cos - x2 * sin, x2 * cos + x1 * sin], -1).astype(x.dtype)
    return jnp.concatenate([rot, x[..., d_rot:]], -1)


def mix_projection(h, w_in, pos):
    B, T, _ = h.shape
    q, k, v, qi, ki, wi, qkv, z, b_g, a_g = jnp.split(h @ w_in, SPLIT_POINTS, axis=-1)
    q = rope_partial(q.reshape(B, T, ATT_HEADS, HEAD_DIM), pos)
    k = rope_partial(k.reshape(B, T, N_KV_HEADS, HEAD_DIM), pos)
    v = v.reshape(B, T, N_KV_HEADS, HEAD_DIM)
    qi = rope_partial(qi.reshape(B, T, IDX_HEADS, IDX_DIM), pos)
    ki = rope_partial(ki.reshape(B, T, 1, IDX_DIM), pos)[:, :, 0]
    wi = wi * IDX_HEADS ** -0.5
    return q, k, v, qi, ki, wi, qkv, z, b_g, a_g


def indexer_scores(qi, wi, ki):
    s = jnp.einsum('bqhd,bld->bqhl', qi.astype(jnp.float32), ki.astype(jnp.float32)) * IDX_DIM ** -0.5
    return jnp.einsum('bqhl,bqh->bql', jax.nn.relu(s), wi.astype(jnp.float32))


def sparse_attend(q, ks, vs, valid):
    B, Q, H, d = q.shape
    G = H // N_KV_HEADS
    qg = q.reshape(B, Q, N_KV_HEADS, G, d).astype(jnp.float32)
    s = jnp.einsum('bqkgd,bqnkd->bqkgn', qg, ks.astype(jnp.float32)) * d ** -0.5
    p = jax.nn.softmax(jnp.where(valid[:, :, None, None, :], s, -jnp.inf), axis=-1)
    o = jnp.einsum('bqkgn,bqnkd->bqkgd', p, vs.astype(jnp.float32))
    return o.reshape(B, Q, H * d).astype(q.dtype)


def dsa_prompt(q, k, v, qi, ki, wi):
    B, S = q.shape[:2]
    nblk = S // Q_BLOCK
    ksel = min(TOPK_MAX, S // 4)
    key_pos = jnp.arange(S)
    bidx = jnp.arange(B)[:, None, None]

    def blocks(a):
        return jnp.swapaxes(a.reshape((B, nblk, Q_BLOCK) + a.shape[2:]), 0, 1)

    def attend_block(args):
        q_b, qi_b, wi_b, pos_b = args
        score = indexer_scores(qi_b, wi_b, ki)
        score = jnp.where(key_pos[None, None, :] <= pos_b[None, :, None], score, -jnp.inf)
        _, idx = lax.top_k(score, ksel)
        return sparse_attend(q_b, k[bidx, idx], v[bidx, idx], idx <= pos_b[None, :, None])

    out = lax.map(attend_block, (blocks(q), blocks(qi), blocks(wi), key_pos.reshape(nblk, Q_BLOCK)))
    return jnp.swapaxes(out, 0, 1).reshape(B, S, ATT_WIDTH)


def dsa_sample(q, k, v, qi, ki, wi, cache_k, cache_v, cache_kidx, page_table, layer):
    B, T = q.shape[:2]
    page = cache_k.shape[2]
    past = page_table.shape[1] * page
    L = past + T
    ksel = min(TOPK_MAX, L // 4)
    ki_past = cache_kidx[layer, page_table].reshape(B, past, IDX_DIM)
    ki_all = jnp.concatenate([ki_past, ki.astype(ki_past.dtype)], 1)
    pos_q = past + jnp.arange(T)
    score = indexer_scores(qi, wi, ki_all)
    score = jnp.where(jnp.arange(L)[None, None, :] <= pos_q[None, :, None], score, -jnp.inf)
    _, idx = lax.top_k(score, ksel)
    bidx = jnp.arange(B)[:, None, None]
    from_past = (idx < past)[..., None, None]
    pidx = jnp.minimum(idx, past - 1)
    phys = page_table[bidx, pidx // page]
    off = pidx % page
    nidx = jnp.clip(idx - past, 0, T - 1)
    ks = jnp.where(from_past, cache_k[layer, phys, off], k[bidx, nidx].astype(cache_k.dtype))
    vs = jnp.where(from_past, cache_v[layer, phys, off], v[bidx, nidx].astype(cache_v.dtype))
    return sparse_attend(q, ks, vs, idx <= pos_q[None, :, None])


def l2norm(x):
    xf = x.astype(jnp.float32)
    return xf * lax.rsqrt(jnp.sum(jnp.square(xf), -1, keepdims=True) + NORM_EPS)


def gated_delta_chunked(q, k, v, g, beta, s0):
    B, T, H, dk = q.shape
    dv = v.shape[-1]
    C = GDN_CHUNK
    n = -(-T // C)
    pad = n * C - T

    def to_chunks(a):
        a = jnp.pad(a.astype(jnp.float32), [(0, 0), (0, pad)] + [(0, 0)] * (a.ndim - 2))
        return jnp.swapaxes(jnp.moveaxis(a.reshape((B, n, C) + a.shape[2:]), 1, 0), 2, 3)

    qc = to_chunks(q) * dk ** -0.5
    kc, vc, gc, bc = to_chunks(k), to_chunks(v), to_chunks(g), to_chunks(beta)
    gc = jnp.cumsum(gc, -1)
    causal = jnp.tril(jnp.ones((C, C), bool))
    strict = jnp.tril(jnp.ones((C, C), bool), -1)
    decay = jnp.exp(jnp.where(causal, gc[..., :, None] - gc[..., None, :], -jnp.inf))
    kb = kc * bc[..., None]
    m = jnp.where(strict, jnp.einsum('nbhid,nbhjd->nbhij', kb, kc) * decay, 0.0)
    rhs = jnp.concatenate([vc * bc[..., None], kb * jnp.exp(gc)[..., None]], -1)
    sol = lax.linalg.triangular_solve(m + jnp.eye(C, dtype=jnp.float32), rhs,
                                      left_side=True, lower=True, unit_diagonal=True)
    u, w = sol[..., :dv], sol[..., dv:]
    qk = jnp.where(causal, jnp.einsum('nbhid,nbhjd->nbhij', qc, kc) * decay, 0.0)

    def step(S, xs):
        q_i, k_i, u_i, w_i, g_i, qk_i = xs
        v_new = u_i - jnp.einsum('bhck,bhkv->bhcv', w_i, S)
        o_i = (jnp.einsum('bhck,bhkv->bhcv', q_i * jnp.exp(g_i)[..., None], S)
               + jnp.einsum('bhij,bhjv->bhiv', qk_i, v_new))
        g_last = g_i[..., -1]
        S = (S * jnp.exp(g_last)[..., None, None]
             + jnp.einsum('bhck,bhcv->bhkv', k_i * jnp.exp(g_last[..., None] - g_i)[..., None], v_new))
        return S, o_i

    S, o = lax.scan(step, s0.astype(jnp.float32), (qc, kc, u, w, gc, qk))
    o = jnp.moveaxis(jnp.swapaxes(o, 2, 3), 0, 1).reshape(B, n * C, H, dv)[:, :T]
    return o, S


def gdn_branch(qkv, z, b_g, a_g, conv_buf, s0, conv_w, a_log, dt_bias, norm_w):
    B, T, _ = qkv.shape
    xin = jnp.concatenate([conv_buf.astype(qkv.dtype), qkv], 1)
    y = lax.conv_general_dilated(xin, conv_w[:, None, :].astype(qkv.dtype), window_strides=(1,), padding='VALID',
                                 dimension_numbers=('NWC', 'WIO', 'NWC'), feature_group_count=GDN_CONV_DIM)
    y = jax.nn.silu(y)
    nq = GDN_HEADS * GDN_DK
    q = l2norm(y[..., :nq].reshape(B, T, GDN_HEADS, GDN_DK))
    k = l2norm(y[..., nq:2 * nq].reshape(B, T, GDN_HEADS, GDN_DK))
    v = y[..., 2 * nq:].reshape(B, T, GDN_HEADS, GDN_DV)
    beta = jax.nn.sigmoid(b_g.astype(jnp.float32))
    g = -jnp.exp(a_log.astype(jnp.float32)) * jax.nn.softplus(a_g.astype(jnp.float32) + dt_bias.astype(jnp.float32))
    o, s = gated_delta_chunked(q, k, v, g, beta, s0)
    o = o * lax.rsqrt(jnp.mean(jnp.square(o), -1, keepdims=True) + NORM_EPS) * norm_w.astype(jnp.float32)
    o = o * jax.nn.silu(z.reshape(B, T, GDN_HEADS, GDN_DV).astype(jnp.float32))
    return o.reshape(B, T, GDN_WIDTH).astype(qkv.dtype), s.astype(s0.dtype), xin[:, T:]


def setup_inputs(seed: int = 0) -> dict:
    key = jax.random.key(seed)
    ks = jax.random.split(key, 32)
    f32 = jnp.float32
    n_pages = PAST_LEN // PAGE_SIZE
    n_pool = (DEC_BATCH * n_pages * 5) // 4

    def nrm(k, shape, scale):
        return jax.random.normal(k, shape, f32) * scale

    def gain(k, n):
        return 1.0 + 0.02 * jax.random.normal(k, (DEPTH, n), f32)

    def bias(k, n):
        return 0.02 * jax.random.normal(k, (DEPTH, n), f32)

    dt = jnp.exp(jax.random.uniform(ks[14], (DEPTH, GDN_HEADS), f32, math.log(1e-3), math.log(1e-1)))
    page_table = jax.random.permutation(ks[7], n_pool)[:DEC_BATCH * n_pages].reshape(DEC_BATCH, n_pages).astype(jnp.int32)
    return {
        'x_prompt': nrm(ks[0], (BATCH, SEQ, D_MODEL), 1.0),
        'x_sample': nrm(ks[1], (DEC_BATCH, DEC_SEQ, D_MODEL), 1.0),
        'cache_k': nrm(ks[2], (DEPTH, n_pool, PAGE_SIZE, N_KV_HEADS, HEAD_DIM), 1.0),
        'cache_v': nrm(ks[3], (DEPTH, n_pool, PAGE_SIZE, N_KV_HEADS, HEAD_DIM), 1.0),
        'cache_kidx': nrm(ks[4], (DEPTH, n_pool, PAGE_SIZE, IDX_DIM), 1.0),
        'state_gdn': nrm(ks[5], (DEPTH, DEC_BATCH, GDN_HEADS, GDN_DK, GDN_DV), 0.1),
        'state_conv': nrm(ks[6], (DEPTH, DEC_BATCH, CONV_K - 1, GDN_CONV_DIM), 1.0),
        'page_table': page_table,
        'ffn1_w_gate': nrm(ks[8], (DEPTH, D_MODEL, D_FF), D_MODEL ** -0.5),
        'ffn1_w_up': nrm(ks[9], (DEPTH, D_MODEL, D_FF), D_MODEL ** -0.5),
        'ffn1_w_down': nrm(ks[10], (DEPTH, D_FF, D_MODEL), DEEP_BETA * D_FF ** -0.5),
        'ln1_g': gain(ks[11], D_MODEL),
        'ln1_b': bias(ks[12], D_MODEL),
        'w_in': nrm(ks[13], (DEPTH, D_MODEL, IN_WIDTH), D_MODEL ** -0.5),
        'conv_w': nrm(ks[15], (DEPTH, CONV_K, GDN_CONV_DIM), CONV_K ** -0.5),
        'a_log': jnp.log(jax.random.uniform(ks[16], (DEPTH, GDN_HEADS), f32, 1.0, 16.0)),
        'dt_bias': dt + jnp.log(-jnp.expm1(-dt)),
        'gdn_norm_w': gain(ks[17], GDN_DV),
        'w_o': nrm(ks[18], (DEPTH, MIX_WIDTH, D_MODEL), DEEP_BETA * MIX_WIDTH ** -0.5),
        'ln2_g': gain(ks[19], D_MODEL),
        'ln2_b': bias(ks[20], D_MODEL),
        'ffn2_w_gate': nrm(ks[21], (DEPTH, D_MODEL, D_FF), D_MODEL ** -0.5),
        'ffn2_w_up': nrm(ks[22], (DEPTH, D_MODEL, D_FF), D_MODEL ** -0.5),
        'ffn2_w_down': nrm(ks[23], (DEPTH, D_FF, D_MODEL), DEEP_BETA * D_FF ** -0.5),
        'ln3_g': gain(ks[24], D_MODEL),
        'ln3_b': bias(ks[25], D_MODEL),
    }


def reference(x_prompt, x_sample, cache_k, cache_v, cache_kidx, state_gdn, state_conv, page_table,
              ffn1_w_gate, ffn1_w_up, ffn1_w_down, ln1_g, ln1_b, w_in, conv_w, a_log, dt_bias, gdn_norm_w,
              w_o, ln2_g, ln2_b, ffn2_w_gate, ffn2_w_up, ffn2_w_down, ln3_g, ln3_b):
    B, S, _ = x_prompt.shape
    T = x_sample.shape[1]
    past = page_table.shape[1] * cache_k.shape[2]
    pos_p = jnp.arange(S)
    pos_s = past + jnp.arange(T)
    xp, xs = x_prompt, x_sample
    kp_l, vp_l, ip_l, sp_l, cp_l = [], [], [], [], []
    ks_l, vs_l, is_l, ss_l, cs_l = [], [], [], [], []
    for l in range(DEPTH):
        xp = ffn_half_step(xp, ffn1_w_gate[l], ffn1_w_up[l], ffn1_w_down[l], ln1_g[l], ln1_b[l])
        xs = ffn_half_step(xs, ffn1_w_gate[l], ffn1_w_up[l], ffn1_w_down[l], ln1_g[l], ln1_b[l])
        q, k, v, qi, ki, wi, qkv, z, b_g, a_g = mix_projection(xp, w_in[l], pos_p)
        att = dsa_prompt(q, k, v, qi, ki, wi)
        gdn, s_new, c_new = gdn_branch(qkv, z, b_g, a_g, jnp.zeros((B, CONV_K - 1, GDN_CONV_DIM), xp.dtype),
                                       jnp.zeros((B, GDN_HEADS, GDN_DK, GDN_DV), jnp.float32),
                                       conv_w[l], a_log[l], dt_bias[l], gdn_norm_w[l])
        xp = mixer_residual(xp, att, gdn, w_o[l], ln2_g[l], ln2_b[l])
        kp_l.append(k); vp_l.append(v); ip_l.append(ki); sp_l.append(s_new); cp_l.append(c_new)
        q, k, v, qi, ki, wi, qkv, z, b_g, a_g = mix_projection(xs, w_in[l], pos_s)
        att = dsa_sample(q, k, v, qi, ki, wi, cache_k, cache_v, cache_kidx, page_table, l)
        gdn, s_new, c_new = gdn_branch(qkv, z, b_g, a_g, state_conv[l], state_gdn[l],
                                       conv_w[l], a_log[l], dt_bias[l], gdn_norm_w[l])
        xs = mixer_residual(xs, att, gdn, w_o[l], ln2_g[l], ln2_b[l])
        ks_l.append(k); vs_l.append(v); is_l.append(ki); ss_l.append(s_new); cs_l.append(c_new)
        xp = ffn_half_step(xp, ffn2_w_gate[l], ffn2_w_up[l], ffn2_w_down[l], ln3_g[l], ln3_b[l])
        xs = ffn_half_step(xs, ffn2_w_gate[l], ffn2_w_up[l], ffn2_w_down[l], ln3_g[l], ln3_b[l])
    return (xp, xs,
            jnp.stack(kp_l), jnp.stack(vp_l), jnp.stack(ip_l), jnp.stack(sp_l), jnp.stack(cp_l),
            jnp.stack(ks_l), jnp.stack(vs_l), jnp.stack(is_l), jnp.stack(ss_l), jnp.stack(cs_l))
```

```cpp
#define MK_DIAG 0
#define MK_ONE_LAUNCH 1
#include <hip/hip_runtime.h>
#include <cstdio>
#include <cstdint>
namespace pg8 {
#define PG8_LAS __attribute__((address_space(3)))
typedef unsigned short bf16_t;
typedef short bf16x8 __attribute__((ext_vector_type(8)));
typedef float f32x4 __attribute__((ext_vector_type(4)));
typedef unsigned u32x4 __attribute__((ext_vector_type(4)));
constexpr int BM = 256, BK = 64, HALF = 128, HTB = HALF * BK * 2  , STAGE_BYTES = 8 * HTB, NXCD = 8, WGM = 8;

__host__ __device__ __forceinline__ int lds_byte(int r, int c) { const int st = (r >> 4) * 2 + (c >> 5), rr = r & 15, cc = c & 31, ob = rr * 64 + cc * 2; return st * 1024 + (ob ^ (((ob >> 9) & 1) << 5)); }
__host__ __device__ __forceinline__ void stage_rc(int b, int& R, int& C) { const int st = b / 1024, sb = b % 1024, swz = sb ^ (((sb >> 9) & 1) << 5); R = (st >> 1) * 16 + swz / 64; C = (st & 1) * 32 + (swz % 64) / 2; }
__host__ __device__ __forceinline__ int perm32(int rho) { const int n = rho >> 4, i = rho & 15; return 8 * (i >> 2) + 4 * n + (i & 3); }

struct Unit { int pm, pn; };
struct Gemm { const bf16_t* A; const bf16_t* Bt; int M, N, K; };

struct StaticOrder {
    int nM, nN, nwg, G, c;
    __host__ __device__ void init(int M, int N, int G_, int c_) { nM = M / BM; nN = N / BM; nwg = nM * nN; G = G_; c = c_; }
    __host__ __device__ bool next(int i, Unit& u) const {
        const long L = (long)i * G + c; if (L >= nwg) return false;
        int wgid = (int)L; { const int q = nwg / NXCD, r = nwg % NXCD, xcd = wgid % NXCD, off = wgid / NXCD; wgid = (xcd < r ? xcd * (q + 1) : r * (q + 1) + (xcd - r) * q) + off; }
        const int nig = WGM * nN, gid = wgid / nig, fm = gid * WGM, gsz = (nM - fm) < WGM ? (nM - fm) : WGM;
        u.pm = fm + ((wgid % nig) % gsz); u.pn = (wgid % nig) / gsz; return true;
    }
    __device__ __forceinline__ void a_ready(const Unit&) const {}
    __device__ __forceinline__ void done(const Unit&) const {}
};

__device__ __forceinline__ unsigned cvt_pk_bf16(float lo, float hi) { unsigned r; asm volatile("v_cvt_pk_bf16_f32 %0, %1, %2" : "=v"(r) : "v"(lo), "v"(hi)); return r; }
typedef float f32x2 __attribute__((ext_vector_type(2)));
__device__ __forceinline__ float silu_f(float x) { return x * __builtin_amdgcn_rcpf(1.0f + __builtin_amdgcn_exp2f(-1.4426950408889634f * x)); }
struct EpiSwiGLU {
    static constexpr bool PERM = true, AFTER_DRAIN = false;
    bf16_t* O; int ldc;
    __device__ __forceinline__ void operator()(const f32x4 (&acc)[2][2][4][2], const Unit& u, int wr, int wc, int fr, int fq) const {
        const int row0 = u.pm * BM + wr * 64 + fr, col0 = u.pn * HALF + wc * 32 + 8 * fq;
#pragma unroll
        for (int ai = 0; ai < 2; ++ai)
#pragma unroll
            for (int m = 0; m < 4; ++m) { bf16_t* p = O + (size_t)(row0 + ai * HALF + m * 16) * ldc + col0;
                const f32x4 g0 = acc[ai][0][m][0], g1 = acc[ai][0][m][1], u0 = acc[ai][1][m][0], u1 = acc[ai][1][m][1];
                u32x4 w; w.x = cvt_pk_bf16(silu_f(g0[0]) * u0[0], silu_f(g0[1]) * u0[1]); w.y = cvt_pk_bf16(silu_f(g0[2]) * u0[2], silu_f(g0[3]) * u0[3]);
                w.z = cvt_pk_bf16(silu_f(g1[0]) * u1[0], silu_f(g1[1]) * u1[1]); w.w = cvt_pk_bf16(silu_f(g1[2]) * u1[2], silu_f(g1[3]) * u1[3]);
                *(u32x4*)p = w; }
    }
};
struct EpiResF32 {
    static constexpr bool PERM = false, AFTER_DRAIN = false;
    const float* res0; const float* res1; int split; float* out; int ldc; float alpha, s;
    __device__ __forceinline__ void operator()(const f32x4 (&acc)[2][2][4][2], const Unit& u, int wr, int wc, int fr, int fq) const {
        const int col0 = u.pn * BM + wc * 32 + 4 * fq;
#pragma unroll
        for (int ai = 0; ai < 2; ++ai)
#pragma unroll
            for (int m = 0; m < 4; ++m) { const int r = u.pm * BM + ai * HALF + wr * 64 + m * 16 + fr;
                const float* rp = (r < split) ? res0 + (size_t)r * ldc : res1 + (size_t)(r - split) * ldc; float* op = out + (size_t)r * ldc;
#pragma unroll
                for (int bj = 0; bj < 2; ++bj)
#pragma unroll
                    for (int n = 0; n < 2; ++n) { const int c = col0 + bj * HALF + n * 16; const f32x4 x = *(const f32x4*)(rp + c); *(f32x4*)(op + c) = x * alpha + acc[ai][bj][m][n] * s; }
                if (m & 1) asm volatile("" ::: "memory"); }
    }
};
struct EpiPlainBf16 {
    static constexpr bool PERM = true, AFTER_DRAIN = false;
    bf16_t* O; int ldc;
    __device__ __forceinline__ void operator()(const f32x4 (&acc)[2][2][4][2], const Unit& u, int wr, int wc, int fr, int fq) const {
        const int row0 = u.pm * BM + wr * 64 + fr, col0 = u.pn * BM + wc * 32 + 8 * fq;
#pragma unroll
        for (int ai = 0; ai < 2; ++ai)
#pragma unroll
            for (int m = 0; m < 4; ++m) { bf16_t* rowp = O + (size_t)(row0 + ai * HALF + m * 16) * ldc + col0;
#pragma unroll
                for (int bj = 0; bj < 2; ++bj) { const f32x4 v0 = acc[ai][bj][m][0], v1 = acc[ai][bj][m][1];
                    u32x4 w; w.x = cvt_pk_bf16(v0[0], v0[1]); w.y = cvt_pk_bf16(v0[2], v0[3]); w.z = cvt_pk_bf16(v1[0], v1[1]); w.w = cvt_pk_bf16(v1[2], v1[3]);
                    *(u32x4*)(rowp + bj * HALF) = w; } }
    }
};
template <class Epi, class Sched, bool ALIGN_EPI = false, bool SP2 = false>
__device__ __forceinline__ void gemm_phase(PG8_LAS unsigned char* lds, const Gemm g, const Sched& S, const Epi& E, const int wid) {
    int lane_; asm volatile("v_mbcnt_lo_u32_b32 %0, -1, 0\n\tv_mbcnt_hi_u32_b32 %0, -1, %0" : "=v"(lane_));
    const int lane = lane_, tid = wid * 64 + lane, wr = wid >> 2, wc = wid & 3, fr = lane & 15, fq = lane >> 4;
    const int K = g.K, nt = K / BK;
    unsigned voffA[2], voffB[2];
#pragma unroll
    for (int i = 0; i < 2; ++i) { int R, C; stage_rc(tid * 16 + i * 8192, R, C); const int Rb = Epi::PERM ? ((R & ~31) + perm32(R & 31)) : R;
        voffA[i] = (unsigned)(R * K + C) * 2u; voffB[i] = (unsigned)(Rb * K + C) * 2u; }
    const size_t kstep = (size_t)(BK * 2);
    const size_t hstep = (size_t)HALF * K * 2;
    const size_t tstep = 2 * hstep;
    const unsigned ldsw = (unsigned)wid * 1024u;
    const int aoff = lds_byte(wr * 64 + fr, fq * 8), boff = lds_byte(wc * 32 + fr, fq * 8);
#define PG8_SA(b, h) (((b) * 2 + (h)) * HTB)
#define PG8_SB(b, h) ((4 + (b) * 2 + (h)) * HTB)
#define PG8_STAGE(bufoff, gbase, voff) do { _Pragma("unroll") for (int _i = 0; _i < 2; ++_i) \
        __builtin_amdgcn_global_load_lds((const unsigned*)((const char*)(gbase) + (voff)[_i]), (PG8_LAS unsigned*)(lds + (bufoff) + ldsw + _i * 8192), 16, 0, 0); } while (0)
#define PG8_LDA(dst, b, h) do { _Pragma("unroll") for (int m = 0; m < 4; ++m) _Pragma("unroll") for (int k = 0; k < 2; ++k) dst[m][k] = *(const PG8_LAS bf16x8*)(lds + PG8_SA(b, h) + aoff + m * 2048 + k * 1024); } while (0)
#define PG8_LDB(dst, b, h) do { _Pragma("unroll") for (int n = 0; n < 2; ++n) _Pragma("unroll") for (int k = 0; k < 2; ++k) dst[n][k] = *(const PG8_LAS bf16x8*)(lds + PG8_SB(b, h) + boff + n * 2048 + k * 1024); } while (0)
#define PG8_MMA(ai, bj, At, Bt) do { __builtin_amdgcn_s_setprio(1); _Pragma("unroll") for (int m = 0; m < 4; ++m) _Pragma("unroll") for (int n = 0; n < 2; ++n) _Pragma("unroll") for (int k = 0; k < 2; ++k) \
        acc[ai][bj][m][n] = __builtin_amdgcn_mfma_f32_16x16x32_bf16(Bt[n][k], At[m][k], acc[ai][bj][m][n], 0, 0, 0); __builtin_amdgcn_s_setprio(0); } while (0)
#define PG8_WAIT_V(n) asm volatile("s_waitcnt vmcnt(" #n ")" ::: "memory")
#define PG8_WAIT_L(n) asm volatile("s_waitcnt lgkmcnt(" #n ")" ::: "memory")
#define PG8_BAR __builtin_amdgcn_s_barrier()
#define PG8_SCHED __builtin_amdgcn_sched_barrier(0)
    Unit cur, nxt; int ui = 0;
    if (!S.next(0, cur)) return;
    f32x4 acc[2][2][4][2];
#pragma unroll
    for (int a = 0; a < 2; ++a)
#pragma unroll
        for (int b = 0; b < 2; ++b)
#pragma unroll
            for (int m = 0; m < 4; ++m)
#pragma unroll
                for (int n = 0; n < 2; ++n) acc[a][b][m][n] = (f32x4){0.f, 0.f, 0.f, 0.f};
    bf16x8 At[4][2], B0[2][2], B1[2][2];
    const char* cA = (const char*)g.A + (size_t)cur.pm * tstep; const char* cB = (const char*)g.Bt + (size_t)cur.pn * tstep;
    S.a_ready(cur);
    if constexpr (SP2) {
        PG8_STAGE(PG8_SB(0, 0), cB, voffB); PG8_STAGE(PG8_SB(0, 1), cB + hstep, voffB); PG8_STAGE(PG8_SA(0, 0), cA, voffA); PG8_STAGE(PG8_SA(0, 1), cA + hstep, voffA);
        if (wr == 1) PG8_BAR;
        PG8_WAIT_V(2); PG8_BAR;
        PG8_STAGE(PG8_SB(1, 0), cB + kstep, voffB); PG8_STAGE(PG8_SA(1, 0), cA + kstep, voffA); PG8_STAGE(PG8_SB(1, 1), cB + hstep + kstep, voffB);
        PG8_WAIT_V(6); PG8_BAR;
    } else {
        PG8_STAGE(PG8_SB(0, 0), cB, voffB); PG8_STAGE(PG8_SA(0, 0), cA, voffA); PG8_STAGE(PG8_SB(0, 1), cB + hstep, voffB); PG8_STAGE(PG8_SA(0, 1), cA + hstep, voffA);
        if (wr == 1) PG8_BAR;
        PG8_WAIT_V(4); PG8_BAR;
        PG8_STAGE(PG8_SB(1, 0), cB + kstep, voffB); PG8_STAGE(PG8_SA(1, 0), cA + kstep, voffA); PG8_STAGE(PG8_SB(1, 1), cB + hstep + kstep, voffB);
        PG8_WAIT_V(6); PG8_BAR;
    }
    for (;;) {
        const bool has_next = S.next(ui + 1, nxt);
        const char* nA = has_next ? (const char*)g.A + (size_t)nxt.pm * tstep : cA; const char* nB = has_next ? (const char*)g.Bt + (size_t)nxt.pn * tstep : cB;
        for (int t = 0; t < nt; t += 2) {
            const bool last = (t == nt - 2);
            const char* a1 = cA + (size_t)(t + 1) * kstep;
            const char* a2 = last ? nA : cA + (size_t)(t + 2) * kstep; const char* b2 = last ? nB : cB + (size_t)(t + 2) * kstep;
            const char* a3 = a2 + kstep; const char* b3 = b2 + kstep;
            if (last && has_next) S.a_ready(nxt);
            if constexpr (SP2) {
            PG8_LDB(B0, 0, 0); PG8_LDB(B1, 0, 1); PG8_SCHED; PG8_LDA(At, 0, 0); PG8_STAGE(PG8_SA(1, 1), a1 + hstep, voffA);
            PG8_WAIT_V(8); PG8_WAIT_L(0); PG8_BAR; PG8_MMA(0, 0, At, B0); PG8_MMA(0, 1, At, B1); PG8_BAR; PG8_SCHED;
            PG8_LDA(At, 0, 1); PG8_STAGE(PG8_SB(0, 0), b2, voffB); PG8_STAGE(PG8_SB(0, 1), b2 + hstep, voffB); PG8_STAGE(PG8_SA(0, 0), a2, voffA);
            PG8_WAIT_V(8); PG8_WAIT_L(0); PG8_BAR; PG8_MMA(1, 0, At, B0); PG8_MMA(1, 1, At, B1); PG8_BAR; PG8_SCHED;
            PG8_LDB(B0, 1, 0); PG8_LDB(B1, 1, 1); PG8_SCHED; PG8_LDA(At, 1, 0); PG8_STAGE(PG8_SA(0, 1), a2 + hstep, voffA);
            PG8_WAIT_V(8); PG8_WAIT_L(0); PG8_BAR; PG8_MMA(0, 0, At, B0); PG8_MMA(0, 1, At, B1); PG8_BAR; PG8_SCHED;
            PG8_LDA(At, 1, 1); PG8_STAGE(PG8_SB(1, 0), b3, voffB); PG8_STAGE(PG8_SB(1, 1), b3 + hstep, voffB); PG8_STAGE(PG8_SA(1, 0), a3, voffA);
            PG8_WAIT_V(8); PG8_WAIT_L(0); PG8_BAR; PG8_MMA(1, 0, At, B0); PG8_MMA(1, 1, At, B1); PG8_BAR; PG8_SCHED;
            } else {
            PG8_LDB(B0, 0, 0); PG8_SCHED; PG8_LDA(At, 0, 0); PG8_STAGE(PG8_SA(1, 1), a1 + hstep, voffA);
            PG8_WAIT_L(8); PG8_BAR; PG8_WAIT_L(0); PG8_MMA(0, 0, At, B0); PG8_BAR; PG8_SCHED;
            PG8_LDB(B1, 0, 1); PG8_STAGE(PG8_SB(0, 0), b2, voffB);
            PG8_BAR; PG8_WAIT_L(0); PG8_MMA(0, 1, At, B1); PG8_BAR;
            PG8_LDA(At, 0, 1); PG8_STAGE(PG8_SA(0, 0), a2, voffA);
            PG8_BAR; PG8_WAIT_L(0); PG8_MMA(1, 0, At, B0); PG8_BAR; PG8_SCHED;
            PG8_STAGE(PG8_SB(0, 1), b2 + hstep, voffB);
            PG8_WAIT_V(6); PG8_BAR; PG8_MMA(1, 1, At, B1); PG8_BAR;
            PG8_LDB(B0, 1, 0); PG8_SCHED; PG8_LDA(At, 1, 0); PG8_STAGE(PG8_SA(0, 1), a2 + hstep, voffA);
            PG8_WAIT_L(8); PG8_BAR; PG8_WAIT_L(0); PG8_MMA(0, 0, At, B0); PG8_BAR; PG8_SCHED;
            PG8_LDB(B1, 1, 1); PG8_STAGE(PG8_SB(1, 0), b3, voffB);
            PG8_BAR; PG8_WAIT_L(0); PG8_MMA(0, 1, At, B1); PG8_BAR;
            PG8_LDA(At, 1, 1); PG8_STAGE(PG8_SA(1, 0), a3, voffA);
            PG8_BAR; PG8_WAIT_L(0); PG8_MMA(1, 0, At, B0); PG8_BAR; PG8_SCHED;
            PG8_STAGE(PG8_SB(1, 1), b3 + hstep, voffB);
            PG8_WAIT_V(6); PG8_BAR; PG8_MMA(1, 1, At, B1); PG8_BAR;
            }
        }
        if constexpr (ALIGN_EPI) { if (wr == 0) PG8_BAR; }
        if constexpr (!Epi::AFTER_DRAIN) { E(acc, cur, wr, wc, fr, fq); S.done(cur); }
        if (!has_next) break;
#pragma unroll
        for (int a = 0; a < 2; ++a)
#pragma unroll
            for (int b = 0; b < 2; ++b)
#pragma unroll
                for (int m = 0; m < 4; ++m)
#pragma unroll
                    for (int n = 0; n < 2; ++n) acc[a][b][m][n] = (f32x4){0.f, 0.f, 0.f, 0.f};
        cur = nxt; cA = nA; cB = nB; ++ui;
        if constexpr (ALIGN_EPI) { if (wr == 1) PG8_BAR; }
    }
    PG8_WAIT_V(0);
    if constexpr (!ALIGN_EPI) { if (wr == 0) PG8_BAR; }
    PG8_BAR;
    if constexpr (Epi::AFTER_DRAIN) { E.fused(acc, cur, wr, wc, fr, fq, lds, wid, lane); S.done(cur); }
#undef PG8_SA
#undef PG8_SB
#undef PG8_STAGE
#undef PG8_LDA
#undef PG8_LDB
#undef PG8_MMA
#undef PG8_WAIT_V
#undef PG8_WAIT_L
#undef PG8_BAR
#undef PG8_SCHED
}
}
constexpr int NWAVES = 8, NTHR = 512;
constexpr int D = 1024, BATCH = 16, SEQ = 2048, DECB = 128, DECT = 8, PAST = 8192, PAGE = 128, NPAGES = 64;
constexpr int MP = BATCH * SEQ, MS = DECB * DECT, M = MP + MS;
constexpr int FF = 2816, NGU = 2 * FF, INW = 3408, INWP = 3584;
constexpr int C_Q = 0, C_K = 512, C_V = 640, C_QI = 768, C_KI = 1280, C_WI = 1344, C_QKV = 1352, C_Z = 2888, C_BG = 3400, C_AG = 3404;
constexpr int GH = 4, GDK = 128, GDV = 128, CONVC = 1536, NCHUNK = SEQ / 64, GDN_UNITS = 2048 + DECB * GH;
constexpr int KSEL = 256, LS = PAST + DECT, SCS_LD = 8208;
constexpr float LN_EPS = 1e-5f, NORM_EPS = 1e-6f, ALPHA = 1.189207115002721f;
constexpr size_t O_YP = 0, O_YS = 33554432, O_KP = 34603008, O_VP = 38797312, O_IP = 42991616, O_GP = 45088768, O_CP = 46137344, O_KS = 46211072, O_VS = 46342144, O_IS = 46473216, O_GS = 46538752, O_CS = 54927360, O_END = 55517184;
constexpr size_t MiB = 1u << 20;
constexpr size_t WS_CTL = 0, CTL_ZERO_BYTES = 1 * MiB, WS_ROPE = 1 * MiB;
constexpr size_t WS_WGU1 = 2 * MiB, WS_WD1 = 13 * MiB, WS_WIN = 19 * MiB, WS_WO = 26 * MiB, WS_WGU2 = 28 * MiB, WS_WD2 = 39 * MiB;
constexpr size_t WS_XB = 48 * MiB, WS_X1 = 116 * MiB, WS_X2 = 248 * MiB, WS_R = 380 * MiB, WS_H = 512 * MiB, WS_P = 696 * MiB;
constexpr size_t WS_QB = 928 * MiB, WS_QI = 961 * MiB, WS_KB = 994 * MiB, WS_VT = 1003 * MiB, WS_KI = 1011 * MiB, WS_WI = 1016 * MiB, WS_BG = 1018 * MiB;
constexpr size_t WS_CAT = 1020 * MiB, WS_OG = 1086 * MiB, WS_GSC = 1152 * MiB, WS_GL = 1334 * MiB, WS_SCS = 1336 * MiB, WS_END = 1370 * MiB;
constexpr size_t GSC_UNIT = 73728;
static_assert(WS_WGU1 + (size_t)NGU * D * 2 <= WS_WD1 && WS_WD1 + (size_t)D * FF * 2 <= WS_WIN && WS_WIN + (size_t)INWP * D * 2 <= WS_WO && WS_WO + (size_t)D * D * 2 <= WS_WGU2, "ws map 1");
static_assert(WS_XB + (size_t)M * D * 2 <= WS_X1 && WS_X1 + (size_t)M * D * 4 <= WS_X2 && WS_X2 + (size_t)M * D * 4 <= WS_R && WS_R + (size_t)M * D * 4 <= WS_H && WS_H + (size_t)M * FF * 2 <= WS_P && WS_P + (size_t)M * INWP * 2 <= WS_QB, "ws map 2");
static_assert(WS_QB + (size_t)M * 512 * 2 <= WS_QI && WS_QI + (size_t)M * 512 * 2 <= WS_KB && WS_KB + (size_t)M * 128 * 2 <= WS_VT && WS_VT + (size_t)MP * 128 * 2 <= WS_KI && WS_KI + (size_t)M * 64 * 2 <= WS_WI && WS_WI + (size_t)M * 8 * 4 <= WS_BG && WS_BG + (size_t)M * 8 * 4 <= WS_CAT, "ws map 3");
static_assert(WS_CAT + (size_t)M * D * 2 <= WS_OG && WS_OG + (size_t)M * 512 * 4 <= WS_GSC && WS_GSC + (size_t)GDN_UNITS * GSC_UNIT <= WS_GL && WS_SCS + (size_t)MS * SCS_LD * 4 <= WS_END, "ws map 4");
constexpr int CW_TMO = 0, CW_CODE = 1, CW_BAR = 4096;
constexpr int RING_OFF = 0, RING_BYTES = 151552;
constexpr int LDSCTL_OFF = RING_BYTES, MISC_OFF = LDSCTL_OFF + 320;
constexpr int LDS_BYTES = 152576;
static_assert(MISC_OFF + 128 <= LDS_BYTES, "LDS map");

#define GAS __attribute__((address_space(1)))
#define LAS __attribute__((address_space(3)))
typedef unsigned short bf16;
typedef _Float16 f16;
typedef unsigned v4u __attribute__((ext_vector_type(4)));
typedef unsigned v2u __attribute__((ext_vector_type(2)));
typedef float f32x4 __attribute__((ext_vector_type(4)));
typedef float f32x2 __attribute__((ext_vector_type(2)));
typedef float f32x16 __attribute__((ext_vector_type(16)));
typedef short bf16x8 __attribute__((ext_vector_type(8)));
typedef short s16x4 __attribute__((ext_vector_type(4)));
typedef _Float16 f16x8 __attribute__((ext_vector_type(8)));
typedef GAS unsigned gu32;
#define RLX_AGENT __ATOMIC_RELAXED, __HIP_MEMORY_SCOPE_AGENT
#define LDS_WAIT() asm volatile("s_waitcnt lgkmcnt(0)" ::: "memory")
#define VM_WAIT() asm volatile("s_waitcnt vmcnt(0)" ::: "memory")
__device__ __forceinline__ unsigned f2bf(float f) { unsigned u = __builtin_bit_cast(unsigned, f); return (u + 0x7fffu + ((u >> 16) & 1u)) >> 16; }
__device__ __forceinline__ unsigned pk2(float lo, float hi) { return f2bf(lo) | (f2bf(hi) << 16); }
__device__ __forceinline__ float bf2f(unsigned short b) { return __builtin_bit_cast(float, (unsigned)b << 16); }
__device__ __forceinline__ float bflo(unsigned w) { return __builtin_bit_cast(float, w << 16); }
__device__ __forceinline__ float bfhi(unsigned w) { return __builtin_bit_cast(float, w & 0xffff0000u); }
__device__ __forceinline__ float wave_sum(float v) {
#pragma unroll
    for (int o = 1; o < 64; o <<= 1) v += __shfl_xor(v, o);
    return v;
}
__device__ __forceinline__ float wave_max(float v) {
#pragma unroll
    for (int o = 1; o < 64; o <<= 1) v = fmaxf(v, __shfl_xor(v, o));
    return v;
}
__device__ __forceinline__ int lane_fresh() { int l; asm volatile("v_mbcnt_lo_u32_b32 %0, -1, 0\n\tv_mbcnt_hi_u32_b32 %0, -1, %0" : "=v"(l)); return l; }
__device__ __forceinline__ int lane_dep(int dep) { int l; asm volatile("v_mbcnt_lo_u32_b32 %0, -1, 0\n\tv_mbcnt_hi_u32_b32 %0, -1, %0" : "=v"(l) : "s"(dep)); return l; }
#define XB_TMO      128
#define XB_XCNT(j)  (256  + 64 * (j))
#define XB_XSUB(j)  (1280 + 64 * (j))
#define XB_XGEN(j)  (2304 + 64 * (j))
#define XB_TOP      3328
#define XB_TOPGEN   3392
#define XCD_BAR_WORDS 3456
#define XB_SPIN_CAP (1u << 18)

__device__ __forceinline__ unsigned xb_ld(unsigned* p)              { return __hip_atomic_load(p, __ATOMIC_RELAXED, __HIP_MEMORY_SCOPE_AGENT); }
__device__ __forceinline__ unsigned xb_add(unsigned* p, unsigned v) { return __hip_atomic_fetch_add(p, v, __ATOMIC_RELAXED, __HIP_MEMORY_SCOPE_AGENT); }
__device__ __forceinline__ unsigned xb_xcc_id() { return (unsigned)__builtin_amdgcn_s_getreg((3 << 11) | 20) & 0xFu; }
#define XB_SPIN(cond, bar) do { unsigned _sp = 0; while (cond) { __builtin_amdgcn_s_sleep(1); \
    if ((++_sp & 255u) == 0u) { if (xb_ld(&(bar)[XB_TMO])) break; if (_sp > XB_SPIN_CAP) { atomicAdd(&(bar)[XB_TMO], 1u); break; } } } } while (0)

struct XcdBarrier {
    int wave; unsigned* bar; unsigned x;
    volatile LAS unsigned* st;
};

__device__ __forceinline__ XcdBarrier xcd_barrier_post(unsigned* bar, volatile LAS unsigned* st, int wave) {
    XcdBarrier b; b.wave = wave; b.bar = bar; b.x = xb_xcc_id(); b.st = st;
    if (wave == 0 && lane_fresh() == 0) (void)xb_add(&bar[XB_XCNT(b.x)], 1u);
    return b;
}
__device__ __forceinline__ void xcd_barrier_complete(unsigned* bar, unsigned x, unsigned& nloc, unsigned& nx) {
    const unsigned G = gridDim.x * gridDim.y * gridDim.z;
    unsigned sum, cnt, mine, sp = 0u;
    for (;;) {
        sum = 0u; cnt = 0u; mine = 0u;
#pragma unroll
        for (unsigned j = 0; j < 16; ++j) { const unsigned c = xb_ld(&bar[XB_XCNT(j)]); sum += c; cnt += (c > 0u) ? 1u : 0u; mine = (j == x) ? c : mine; }
        if (sum == G) break;
        __builtin_amdgcn_s_sleep(1);
        if ((++sp & 255u) == 0u) { if (xb_ld(&bar[XB_TMO])) break; if (sp > XB_SPIN_CAP) { atomicAdd(&bar[XB_TMO], 1u); break; } }
    }
    nloc = mine > 0u ? mine : 1u; nx = cnt > 0u ? cnt : 1u;
}

__device__ __forceinline__ void xcd_barrier(const XcdBarrier& b) {
    asm volatile("s_waitcnt vmcnt(0)" ::: "memory");
    __syncthreads();
    if (b.wave == 0 && lane_fresh() == 0) {
        unsigned* bar = b.bar;
        __builtin_amdgcn_s_waitcnt(0);
        unsigned nloc = b.st[0], nx = b.st[1];
        if (nloc == 0u) { xcd_barrier_complete(bar, b.x, nloc, nx); b.st[0] = nloc; b.st[1] = nx; }
        const unsigned old = xb_add(&bar[XB_XSUB(b.x)], 1u);
        const unsigned gen = old / nloc;
        if (old + 1u == (gen + 1u) * nloc) {
            __builtin_amdgcn_fence(__ATOMIC_RELEASE, "agent");
            asm volatile("s_waitcnt vmcnt(0)" ::: "memory");
            const unsigned og = xb_add(&bar[XB_TOP], 1u);
            const unsigned tg = og / nx;
            if (og + 1u == (tg + 1u) * nx) xb_add(&bar[XB_TOPGEN], 1u);
            else XB_SPIN(xb_ld(&bar[XB_TOPGEN]) == tg, bar);
            __builtin_amdgcn_fence(__ATOMIC_ACQUIRE, "agent");
            xb_add(&bar[XB_XGEN(b.x)], 1u);
            asm volatile("s_waitcnt vmcnt(0)" ::: "memory");
        } else {
            XB_SPIN(xb_ld(&bar[XB_XGEN(b.x)]) == gen, bar);
            __builtin_amdgcn_fence(__ATOMIC_ACQUIRE, "agent");
            asm volatile("s_waitcnt vmcnt(0)" ::: "memory");
        }
    }
    __syncthreads();
}
struct Frame {
    LAS unsigned char* lds;
    volatile LAS unsigned* MISC;
    gu32* ctl;
    int wave, G, bx;
    float* out; unsigned char* ws;
};
struct Args { const float* in[26]; float* out; unsigned char* ws; int ph_lo, ph_hi; };
#define WSP(T, off) ((T*)(F.ws + (off)))

__device__ __forceinline__ void p0_transpose_item(const float* W, int K, int N, bf16* WT, int drow0, int k0, int n0, LAS float* scr, int lane) {
    const int nc = n0 + (lane & 31); const bool ok = nc < N;
#pragma unroll 8
    for (int i = 0; i < 32; ++i) { const int kk = 2 * i + (lane >> 5); scr[kk * 33 + (lane & 31)] = ok ? W[(size_t)(k0 + kk) * N + nc] : 0.f; }
    LDS_WAIT(); asm volatile("" ::: "memory");
    const int c = lane & 7;
#pragma unroll
    for (int j = 0; j < 4; ++j) { const int n = (lane >> 3) + 8 * j; const LAS float* s = scr + (8 * c) * 33 + n;
        v4u o; o.x = pk2(s[0 * 33], s[1 * 33]); o.y = pk2(s[2 * 33], s[3 * 33]); o.z = pk2(s[4 * 33], s[5 * 33]); o.w = pk2(s[6 * 33], s[7 * 33]);
        *(GAS v4u*)(WT + (size_t)(drow0 + n) * K + k0 + 8 * c) = o; }
    LDS_WAIT(); asm volatile("" ::: "memory");
}
__device__ __forceinline__ void p0_prologue(Frame& F, const Args& A) {
    LAS float* scr = (LAS float*)(F.lds + RING_OFF + F.wave * 16384);
    const int lane = lane_fresh();
    const int gw = F.bx * NWAVES + F.wave, NGW = F.G * NWAVES;
    constexpr int I_GU = (D / 64) * (FF / 32), I_D = (FF / 64) * (D / 32), I_IN = (D / 64) * (INWP / 32), I_O = (D / 64) * (D / 32);
    constexpr int NITEMS = 4 * I_GU + 2 * I_D + I_IN + I_O;
    for (int it = gw; it < NITEMS; it += NGW) {
        int r = it;
        if (r < 4 * I_GU) {
            const int which = r / I_GU; r -= which * I_GU; const int nblk = FF / 32, kb = r / nblk, nb = r % nblk, n0 = 32 * nb;
            const float* W = which == 0 ? A.in[8] : which == 1 ? A.in[9] : which == 2 ? A.in[21] : A.in[22];
            bf16* WT = WSP(bf16, (which < 2) ? WS_WGU1 : WS_WGU2);
            const int drow0 = 256 * (n0 >> 7) + (n0 & 127) + ((which & 1) ? 128 : 0);
            p0_transpose_item(W, D, FF, WT, drow0, 64 * kb, n0, scr, lane); continue; }
        r -= 4 * I_GU;
        if (r < 2 * I_D) { const int which = r / I_D; r -= which * I_D; const int nblk = D / 32, kb = r / nblk, nb = r % nblk;
            p0_transpose_item(which ? A.in[23] : A.in[10], FF, D, WSP(bf16, which ? WS_WD2 : WS_WD1), 32 * nb, 64 * kb, 32 * nb, scr, lane); continue; }
        r -= 2 * I_D;
        if (r < I_IN) { const int nblk = INWP / 32, kb = r / nblk, nb = r % nblk;
            p0_transpose_item(A.in[13], D, INW, WSP(bf16, WS_WIN), 32 * nb, 64 * kb, 32 * nb, scr, lane); continue; }
        r -= I_IN;
        { const int nblk = D / 32, kb = r / nblk, nb = r % nblk; p0_transpose_item(A.in[18], D, D, WSP(bf16, WS_WO), 32 * nb, 64 * kb, 32 * nb, scr, lane); }
    }
    bf16* XB = WSP(bf16, WS_XB);
    for (int m = gw; m < M; m += NGW) {
        const float* xr = (m < MP) ? A.in[0] + (size_t)m * D : A.in[1] + (size_t)(m - MP) * D;
        const GAS f32x4* x4 = (const GAS f32x4*)xr + lane; GAS unsigned long long* o8 = (GAS unsigned long long*)(XB + (size_t)m * D) + lane;
#pragma unroll
        for (int j = 0; j < 4; ++j) { const f32x4 v = x4[64 * j]; o8[64 * j] = (unsigned long long)pk2(v.x, v.y) | ((unsigned long long)pk2(v.z, v.w) << 32); }
    }
    float* rope = WSP(float, WS_ROPE);
    for (int i = gw * 64 + lane; i < (SEQ + DECT) * 8; i += NGW * 64) {
        const int pi = i >> 3, f = i & 7; const float pos = (float)(pi < SEQ ? pi : PAST + pi - SEQ);
        const float invf = powf(500000.0f, -(float)f / 8.0f); const float ang = pos * invf;
        rope[pi * 16 + f] = cosf(ang); rope[pi * 16 + 8 + f] = sinf(ang);
    }
}
__device__ __forceinline__ void ln_phase(Frame& F, const float* src, const float* g, const float* b, float* dstf, bf16* dstb) {
    const int lane = lane_fresh();
    const int gw = F.bx * NWAVES + F.wave, NGW = F.G * NWAVES;
    f32x4 gv[4], bv[4];
#pragma unroll
    for (int j = 0; j < 4; ++j) { gv[j] = ((const GAS f32x4*)g)[lane + 64 * j]; bv[j] = ((const GAS f32x4*)b)[lane + 64 * j]; }
    for (int m = gw; m < M; m += NGW) {
        const GAS f32x4* xr = (const GAS f32x4*)(src + (size_t)m * D) + lane;
        f32x4 v[4]; float s = 0.f;
#pragma unroll
        for (int j = 0; j < 4; ++j) { v[j] = xr[64 * j]; s += (v[j].x + v[j].y) + (v[j].z + v[j].w); }
        const float mean = wave_sum(s) * (1.f / D); float s2 = 0.f;
#pragma unroll
        for (int j = 0; j < 4; ++j) { v[j] = v[j] - mean; s2 += (v[j].x * v[j].x + v[j].y * v[j].y) + (v[j].z * v[j].z + v[j].w * v[j].w); }
        const float rstd = 1.f / sqrtf(wave_sum(s2) * (1.f / D) + LN_EPS);
#pragma unroll
        for (int j = 0; j < 4; ++j) { v[j] = v[j] * rstd * gv[j] + bv[j]; }
        if (dstf) { GAS f32x4* o = (GAS f32x4*)(dstf + (size_t)m * D) + lane;
#pragma unroll
            for (int j = 0; j < 4; ++j) o[64 * j] = v[j]; }
        if (dstb) { GAS unsigned long long* o8 = (GAS unsigned long long*)(dstb + (size_t)m * D) + lane;
#pragma unroll
            for (int j = 0; j < 4; ++j) o8[64 * j] = (unsigned long long)pk2(v[j].x, v[j].y) | ((unsigned long long)pk2(v[j].z, v[j].w) << 32); }
    }
}
__device__ __forceinline__ void post_phase(Frame& F, const Args& A) {
    const int lane = lane_fresh();
    const int gw = F.bx * NWAVES + F.wave, NGW = F.G * NWAVES;
    const bf16* P = WSP(bf16, WS_P); const float* rope = WSP(float, WS_ROPE);
    bf16* Qb = WSP(bf16, WS_QB); f16* QIh = WSP(f16, WS_QI); bf16* Kb = WSP(bf16, WS_KB); f16* KIh = WSP(f16, WS_KI); float* WI = WSP(float, WS_WI); float* BG = WSP(float, WS_BG);
    const float a_exp = (lane < 4) ? expf(A.in[15][lane]) : 0.f, dtb = (lane < 4) ? A.in[16][lane] : 0.f;
    for (int m = gw; m < M; m += NGW) {
        const bool prm = m < MP; const int ms = m - MP; const int b = prm ? (m >> 11) : (ms >> 3), t = prm ? (m & 2047) : (ms & 7), pi = prm ? t : SEQ + t;
        const bf16* p = P + (size_t)m * INWP;
        const float cs = (lane < 16) ? rope[pi * 16 + (lane & 7)] : 1.f; float sn = (lane < 16) ? rope[pi * 16 + 8 + (lane & 7)] : 0.f; if (lane < 8) sn = -sn;
        float* kout = F.out + (prm ? O_KP + (size_t)m * 128 : O_KS + (size_t)ms * 128);
        float* vout = F.out + (prm ? O_VP + (size_t)m * 128 : O_VS + (size_t)ms * 128);
        float* iout = F.out + (prm ? O_IP + (size_t)m * 64 : O_IS + (size_t)ms * 64);
#pragma unroll
        for (int h = 0; h < 8; ++h) { const float v = bf2f(p[C_Q + h * 64 + lane]); const float pr = __shfl_xor(v, 8); Qb[(size_t)m * 512 + h * 64 + lane] = (bf16)f2bf(v * cs + pr * sn); }
#pragma unroll
        for (int h = 0; h < 8; ++h) { const float v = bf2f(p[C_QI + h * 64 + lane]); const float pr = __shfl_xor(v, 8); QIh[(size_t)m * 512 + h * 64 + lane] = (f16)(v * cs + pr * sn); }
#pragma unroll
        for (int h = 0; h < 2; ++h) { const float v = bf2f(p[C_K + h * 64 + lane]); const float pr = __shfl_xor(v, 8); const float o = v * cs + pr * sn;
            Kb[(size_t)m * 128 + h * 64 + lane] = (bf16)f2bf(o); kout[h * 64 + lane] = o; vout[h * 64 + lane] = bf2f(p[C_V + h * 64 + lane]); }
        { const float v = bf2f(p[C_KI + lane]); const float pr = __shfl_xor(v, 8); const float o = v * cs + pr * sn; KIh[(size_t)m * 64 + lane] = (f16)o; iout[lane] = o; }
        if (lane < 8) WI[(size_t)m * 8 + lane] = bf2f(p[C_WI + lane]) * (0.35355339059327373f * 0.125f);
        if (lane < 4) { const float bg = bf2f(p[C_BG + lane]), ag = bf2f(p[C_AG + lane]) + dtb;
            const float sp = ag > 20.f ? ag : log1pf(expf(ag));
            BG[(size_t)m * 8 + lane] = 1.f / (1.f + expf(-bg)); BG[(size_t)m * 8 + 4 + lane] = -a_exp * sp; }
        const int trow = prm ? t - (SEQ - 3) : t - (DECT - 3);
        if (trow >= 0) { float* co = F.out + (prm ? O_CP : O_CS) + ((size_t)b * 3 + trow) * CONVC;
            for (int c = lane; c < CONVC; c += 64) co[c] = bf2f(p[C_QKV + c]); }
    }
    LAS bf16* tile = (LAS bf16*)(F.lds + RING_OFF + F.wave * 16384);
    bf16* VT = WSP(bf16, WS_VT);
    for (int it = gw; it < BATCH * 2 * (SEQ / 64); it += NGW) {
        const int tb = it % (SEQ / 64), g = (it / (SEQ / 64)) & 1, b = it / (2 * (SEQ / 64));
        for (int tt = 0; tt < 64; ++tt) tile[tt * 66 + lane] = P[(size_t)(b * SEQ + tb * 64 + tt) * INWP + C_V + g * 64 + lane];
        LDS_WAIT(); asm volatile("" ::: "memory");
        for (int d = 0; d < 64; ++d) VT[((size_t)(b * 2 + g) * 64 + d) * SEQ + tb * 64 + lane] = tile[lane * 66 + d];
        LDS_WAIT(); asm volatile("" ::: "memory");
    }
}
#define MFMA32 __builtin_amdgcn_mfma_f32_32x32x16_bf16
__device__ __forceinline__ int crow(int r, int hh) { return (r & 3) + 8 * (r >> 2) + 4 * hh; }
__device__ __forceinline__ f32x16 zero16() { f32x16 z; for (int i = 0; i < 16; ++i) z[i] = 0.f; return z; }
constexpr int GT_LD = 272;
constexpr int GP_HALF = 72704;
constexpr int GP_Q = 0, GP_K = 17408, GP_V = 34816, GP_A = 52224, GP_G = 69632, GP_B = 69888, GP_EG = 70144;
__device__ __forceinline__ void gdn_prep_phase(Frame& F, const Args& A) {
    const int half = F.wave >> 2, hw = F.wave & 3;
    LAS unsigned char* L = F.lds + RING_OFF + half * GP_HALF;
    const bf16* P = WSP(bf16, WS_P); const float* BG = WSP(float, WS_BG); const float* cw = A.in[14];
    const float* sconv = A.in[6];
    const int nit = (GDN_UNITS + 2 * F.G - 1) / (2 * F.G);
    for (int it = 0; it < nit; ++it) {
        const int lane = lane_fresh();
        const int ht = (hw << 6) | lane;
        const int u = (it * F.G + F.bx) * 2 + half; const bool live = u < GDN_UNITS;
        const bool smp = u >= 2048; const int us = u - 2048;
        const int c = smp ? 0 : (u & 31), h = smp ? (us & 3) : ((u >> 5) & 3), b = smp ? (us >> 2) : (u >> 7);
        const size_t mrow0 = smp ? (size_t)MP + (size_t)b * DECT : (size_t)b * SEQ;
        const int nreal = smp ? DECT : 64;
        unsigned char* gs = F.ws + WS_GSC + (size_t)u * GSC_UNIT;
        if (live) {
            float w[3][4][2];
#pragma unroll
            for (int p = 0; p < 3; ++p)
#pragma unroll
                for (int j = 0; j < 4; ++j) { const f32x2 t = *(const GAS f32x2*)(cw + j * CONVC + p * 512 + h * 128 + 2 * lane); w[p][j][0] = t.x; w[p][j][1] = t.y; }
            unsigned xr[3][3];
            const int t0 = c * 64 + hw * 16;
#pragma unroll
            for (int j = 0; j < 3; ++j) { const int tt = t0 - 3 + j;
#pragma unroll
                for (int p = 0; p < 3; ++p) { unsigned xv = 0u;
                    if (tt >= 0) { if (!smp || tt < nreal) xv = *(const GAS unsigned*)(P + (mrow0 + tt) * INWP + C_QKV + p * 512 + h * 128 + 2 * lane); }
                    else if (smp) { const f32x2 sv = *(const GAS f32x2*)(sconv + ((size_t)b * 3 + (3 + tt)) * CONVC + p * 512 + h * 128 + 2 * lane); xv = pk2(sv.x, sv.y); }
                    xr[p][j] = xv; } }
            for (int i = 0; i < 16; ++i) {
                const int tt = t0 + i; float y[3][2]; const bool real = (hw * 16 + i) < nreal;
#pragma unroll
                for (int p = 0; p < 3; ++p) { const unsigned x3 = real ? *(const GAS unsigned*)(P + (mrow0 + tt) * INWP + C_QKV + p * 512 + h * 128 + 2 * lane) : 0u;
                    float a0 = w[p][0][0] * bflo(xr[p][0]) + w[p][1][0] * bflo(xr[p][1]) + w[p][2][0] * bflo(xr[p][2]) + w[p][3][0] * bflo(x3);
                    float a1 = w[p][0][1] * bfhi(xr[p][0]) + w[p][1][1] * bfhi(xr[p][1]) + w[p][2][1] * bfhi(xr[p][2]) + w[p][3][1] * bfhi(x3);
                    y[p][0] = a0 / (1.f + __expf(-a0)); y[p][1] = a1 / (1.f + __expf(-a1));
                    xr[p][0] = xr[p][1]; xr[p][1] = xr[p][2]; xr[p][2] = x3; }
                const float rq = 1.f / sqrtf(wave_sum(y[0][0] * y[0][0] + y[0][1] * y[0][1]) + NORM_EPS), rk = 1.f / sqrtf(wave_sum(y[1][0] * y[1][0] + y[1][1] * y[1][1]) + NORM_EPS);
                const int row = hw * 16 + i;
                *(LAS unsigned*)(L + GP_Q + row * GT_LD + 4 * lane) = real ? pk2(y[0][0] * rq, y[0][1] * rq) : 0u;
                *(LAS unsigned*)(L + GP_K + row * GT_LD + 4 * lane) = real ? pk2(y[1][0] * rk, y[1][1] * rk) : 0u;
                *(LAS unsigned*)(L + GP_V + row * GT_LD + 4 * lane) = real ? pk2(y[2][0], y[2][1]) : 0u;
            }
            if (hw == 0) { const size_t m = mrow0 + c * 64 + lane; const bool rl = lane < nreal; float g = rl ? BG[m * 8 + 4 + h] : 0.f; const float be = rl ? BG[m * 8 + h] : 0.f;
#pragma unroll
                for (int o = 1; o < 64; o <<= 1) { const float t = __shfl_up(g, o); if (lane >= o) g += t; }
                ((LAS float*)(L + GP_G))[lane] = g; ((LAS float*)(L + GP_B))[lane] = be; }
        }
        LDS_WAIT(); __syncthreads();
        if (live) {
            const LAS float* Gs = (const LAS float*)(L + GP_G); const LAS float* Bs = (const LAS float*)(L + GP_B);
            bf16* QKg = (bf16*)(gs + 65536);
            const int r = lane & 31, hh = lane >> 5;
            if (hw < 3) {
                const int ti = hw > 0 ? 1 : 0, tj = hw > 1 ? 1 : 0;
                f32x16 akk = zero16(), aqk = zero16();
#pragma unroll
                for (int s = 0; s < 8; ++s) {
                    const bf16x8 bk = *(const LAS bf16x8*)(L + GP_K + (32 * tj + r) * GT_LD + (16 * s + 8 * hh) * 2);
                    const bf16x8 ak = *(const LAS bf16x8*)(L + GP_K + (32 * ti + r) * GT_LD + (16 * s + 8 * hh) * 2);
                    const bf16x8 aq = *(const LAS bf16x8*)(L + GP_Q + (32 * ti + r) * GT_LD + (16 * s + 8 * hh) * 2);
                    akk = MFMA32(ak, bk, akk, 0, 0, 0); aqk = MFMA32(aq, bk, aqk, 0, 0, 0);
                }
                const int j = 32 * tj + r; const float Gj = Gs[j];
#pragma unroll
                for (int q = 0; q < 16; ++q) { const int i = 32 * ti + crow(q, hh); const float dec = __expf(Gs[i] - Gj);
                    ((LAS float*)(L + GP_A))[i * 68 + j] = (i > j) ? Bs[i] * akk[q] * dec : 0.f;
                    QKg[i * 64 + j] = (bf16)f2bf((i >= j) ? aqk[q] * dec * 0.08838834764831845f : 0.f); }
            } else {
#pragma unroll
                for (int q = 0; q < 16; ++q) QKg[crow(q, hh) * 64 + 32 + r] = 0;
            }
        }
        LDS_WAIT(); __syncthreads();
        if (live) {
            const LAS float* Gs = (const LAS float*)(L + GP_G); const LAS float* Bs = (const LAS float*)(L + GP_B); const LAS float* As = (const LAS float*)(L + GP_A);
            const bool isu = ht < 128; const int cc = ht & 127;
            const LAS unsigned char* src = L + (isu ? GP_V : GP_K) + cc * 2;
            float X[64];
#pragma unroll
            for (int i = 0; i < 64; ++i) X[i] = 0.f;
#pragma unroll
            for (int i = 0; i < 64; ++i) {
                float acc = bf2f(*(const LAS bf16*)(src + i * GT_LD)) * Bs[i] * (isu ? 1.f : __expf(Gs[i]));
#pragma unroll
                for (int j4 = 0; j4 < (i + 3) / 4; ++j4) { const f32x4 a = *(const LAS f32x4*)(As + i * 68 + 4 * j4);
                    acc -= a.x * X[4 * j4]; acc -= a.y * X[4 * j4 + 1]; acc -= a.z * X[4 * j4 + 2]; acc -= a.w * X[4 * j4 + 3]; }
                X[i] = acc; asm volatile("" : "+v"(X[i]) :: "memory"); __builtin_amdgcn_sched_barrier(0);
            }
            if (isu) { GAS v4u* o = (GAS v4u*)(gs + (size_t)cc * 128);
#pragma unroll
                for (int q = 0; q < 8; ++q) { v4u w4; w4.x = pk2(X[8 * q], X[8 * q + 1]); w4.y = pk2(X[8 * q + 2], X[8 * q + 3]); w4.z = pk2(X[8 * q + 4], X[8 * q + 5]); w4.w = pk2(X[8 * q + 6], X[8 * q + 7]); o[q] = w4; }
            } else { bf16* wg = (bf16*)(gs + 16384);
#pragma unroll
                for (int i = 0; i < 64; ++i) wg[i * 128 + cc] = (bf16)f2bf(X[i]); }
            { bf16* qt = (bf16*)(gs + 32768);
#pragma unroll
              for (int e = 0; e < 16; ++e) { const int idx = e * 256 + ht, i = idx >> 6, cp = idx & 63; const unsigned qv = *(const LAS unsigned*)(L + GP_Q + i * GT_LD + 4 * cp); const float sc = __expf(Gs[i]) * 0.08838834764831845f;
                  *(GAS unsigned*)(qt + i * 128 + 2 * cp) = pk2(bflo(qv) * sc, bfhi(qv) * sc); } }
            if (!isu) { const float G63 = Gs[63]; GAS v4u* o = (GAS v4u*)(gs + 49152 + (size_t)cc * 128);
#pragma unroll
                for (int q = 0; q < 8; ++q) { float kv[8];
#pragma unroll
                    for (int e = 0; e < 8; ++e) { const int i = 8 * q + e; kv[e] = bf2f(*(const LAS bf16*)(L + GP_K + i * GT_LD + cc * 2)) * __expf(G63 - Gs[i]); }
                    v4u w4; w4.x = pk2(kv[0], kv[1]); w4.y = pk2(kv[2], kv[3]); w4.z = pk2(kv[4], kv[5]); w4.w = pk2(kv[6], kv[7]); o[q] = w4; } }
            if (ht == 0) WSP(float, WS_GL)[u] = __expf(Gs[63]);
        }
        LDS_WAIT(); __syncthreads();
    }
}
constexpr int GS_SB = 0, GS_SB_LD = 272, GS_VN = 8704, GS_VN_LD = 144;
__device__ __forceinline__ void gdn_scan_phase(Frame& F, const Args& A) {
    const int wave = F.wave;
    LAS unsigned char* L = F.lds + RING_OFF;
    float* OG = WSP(float, WS_OG); const float* GL = WSP(float, WS_GL);
    for (int uu = F.bx; uu < BATCH * GH * 4 + DECB * GH * 4; uu += F.G) {
        const int lane = lane_fresh(); const int r = lane & 31, hh = lane >> 5;
        const bool smp = uu >= BATCH * GH * 4; const int u = smp ? uu - BATCH * GH * 4 : uu;
        const int sl = u & 3, h = (u >> 2) & 3, b = u >> 4, dv0 = sl * 32;
        const int role = wave < 2 ? 0 : (wave < 4 ? 1 : 2), rt = wave < 2 ? wave : (wave < 4 ? wave - 2 : wave - 4);
        const int nch = smp ? 1 : NCHUNK, un0 = smp ? 2048 + b * GH + h : (b * GH + h) * NCHUNK;
        const size_t mrow0 = smp ? (size_t)MP + (size_t)b * DECT : (size_t)b * SEQ;
        f32x16 Sacc = zero16();
        __syncthreads();
        if (!smp) { for (int i = wave * 64 + lane; i < (GS_VN + 32 * GS_VN_LD) / 4; i += NTHR) ((LAS unsigned*)L)[i] = 0u; }
        else if (role == 2) {
            const GAS float* sp = (const GAS float*)(A.in[5] + ((size_t)(b * GH + h) * GDK + 32 * rt) * GDV + dv0 + r);
#pragma unroll
            for (int q = 0; q < 16; ++q) Sacc[q] = sp[(size_t)crow(q, hh) * GDV];
#pragma unroll
            for (int g = 0; g < 4; ++g) { v2u w2; w2.x = pk2(Sacc[4 * g], Sacc[4 * g + 1]); w2.y = pk2(Sacc[4 * g + 2], Sacc[4 * g + 3]); *(LAS v2u*)(L + GS_SB + r * GS_SB_LD + (32 * rt + 8 * g + 4 * hh) * 2) = w2; }
        }
        LDS_WAIT(); __syncthreads();
        for (int c = 0; c < nch; ++c) {
            const int un = un0 + c;
            const unsigned char* gs = F.ws + WS_GSC + (size_t)un * GSC_UNIT;
            bf16x8 fa[8]; s16x4 uv[4]; bf16x8 fb[4]; float gl = 1.f;
            if (role == 0) {
#pragma unroll
                for (int s = 0; s < 8; ++s) fa[s] = *(const GAS bf16x8*)(gs + 16384 + (size_t)(32 * rt + r) * 256 + (16 * s + 8 * hh) * 2);
#pragma unroll
                for (int g = 0; g < 4; ++g) uv[g] = *(const GAS s16x4*)(gs + (size_t)(dv0 + r) * 128 + (32 * rt + 8 * g + 4 * hh) * 2);
            } else if (role == 1) {
#pragma unroll
                for (int s = 0; s < 8; ++s) fa[s] = *(const GAS bf16x8*)(gs + 32768 + (size_t)(32 * rt + r) * 256 + (16 * s + 8 * hh) * 2);
#pragma unroll
                for (int s = 0; s < 4; ++s) fb[s] = *(const GAS bf16x8*)(gs + 65536 + (size_t)(32 * rt + r) * 128 + (16 * s + 8 * hh) * 2);
            } else {
#pragma unroll
                for (int s = 0; s < 4; ++s) fb[s] = *(const GAS bf16x8*)(gs + 49152 + (size_t)(32 * rt + r) * 128 + (16 * s + 8 * hh) * 2);
                gl = GL[un];
            }
            f32x16 acc = zero16();
            if (role < 2) {
#pragma unroll
                for (int s = 0; s < 8; ++s) { const bf16x8 sb = *(const LAS bf16x8*)(L + GS_SB + r * GS_SB_LD + (16 * s + 8 * hh) * 2); acc = MFMA32(fa[s], sb, acc, 0, 0, 0); }
            }
            if (role == 0) {
#pragma unroll
                for (int g = 0; g < 4; ++g) { const float v0 = bf2f((unsigned short)uv[g][0]) - acc[4 * g], v1 = bf2f((unsigned short)uv[g][1]) - acc[4 * g + 1], v2 = bf2f((unsigned short)uv[g][2]) - acc[4 * g + 2], v3 = bf2f((unsigned short)uv[g][3]) - acc[4 * g + 3];
                    v2u w2; w2.x = pk2(v0, v1); w2.y = pk2(v2, v3); *(LAS v2u*)(L + GS_VN + r * GS_VN_LD + (32 * rt + 8 * g + 4 * hh) * 2) = w2; }
            }
            LDS_WAIT(); __syncthreads();
            if (role == 1) {
#pragma unroll
                for (int s = 0; s < 4; ++s) { const bf16x8 vn = *(const LAS bf16x8*)(L + GS_VN + r * GS_VN_LD + (16 * s + 8 * hh) * 2); acc = MFMA32(fb[s], vn, acc, 0, 0, 0); }
                float* op = OG + (mrow0 + c * 64 + 32 * rt) * 512 + h * 128 + dv0 + r;
                const int nreal = smp ? DECT : 64;
#pragma unroll
                for (int q = 0; q < 16; ++q) if (32 * rt + crow(q, hh) < nreal) op[(size_t)crow(q, hh) * 512] = acc[q];
            } else if (role == 2) {
#pragma unroll
                for (int q = 0; q < 16; ++q) Sacc[q] *= gl;
#pragma unroll
                for (int s = 0; s < 4; ++s) { const bf16x8 vn = *(const LAS bf16x8*)(L + GS_VN + r * GS_VN_LD + (16 * s + 8 * hh) * 2); Sacc = MFMA32(fb[s], vn, Sacc, 0, 0, 0); }
#pragma unroll
                for (int g = 0; g < 4; ++g) { v2u w2; w2.x = pk2(Sacc[4 * g], Sacc[4 * g + 1]); w2.y = pk2(Sacc[4 * g + 2], Sacc[4 * g + 3]); *(LAS v2u*)(L + GS_SB + r * GS_SB_LD + (32 * rt + 8 * g + 4 * hh) * 2) = w2; }
            }
            LDS_WAIT(); __syncthreads();
        }
        if (role == 2) { float* so = F.out + (smp ? O_GS : O_GP) + ((size_t)(b * GH + h) * GDK + 32 * rt) * GDV + dv0 + r;
#pragma unroll
            for (int q = 0; q < 16; ++q) so[(size_t)crow(q, hh) * GDV] = Sacc[q]; }
    }
}
__device__ __forceinline__ void gdn_out_phase(Frame& F, const Args& A) {
    const int lane = lane_fresh(); const bf16* P = WSP(bf16, WS_P); const float* OG = WSP(float, WS_OG); bf16* CAT = WSP(bf16, WS_CAT);
    const f32x2 nw = *(const GAS f32x2*)(A.in[17] + 2 * lane);
    for (int it = F.bx * NWAVES + F.wave; it < M * GH; it += F.G * NWAVES) {
        const int m = it >> 2, h = it & 3;
        const f32x2 o = *(const GAS f32x2*)(OG + (size_t)m * 512 + h * 128 + 2 * lane);
        const float rs = 1.f / sqrtf(wave_sum(o.x * o.x + o.y * o.y) * (1.f / 128.f) + NORM_EPS);
        const unsigned zz = *(const GAS unsigned*)(P + (size_t)m * INWP + C_Z + h * 128 + 2 * lane); const float z0 = bflo(zz), z1 = bfhi(zz);
        *(GAS unsigned*)(CAT + (size_t)m * D + 512 + h * 128 + 2 * lane) = pk2(o.x * rs * nw.x * (z0 / (1.f + __expf(-z0))), o.y * rs * nw.y * (z1 / (1.f + __expf(-z1))));
    }
}
#define MFMA32H __builtin_amdgcn_mfma_f32_32x32x16_f16
__device__ __forceinline__ unsigned f2key(float x) { unsigned b = __builtin_bit_cast(unsigned, x); if ((b << 1) == 0u) b = 0u; return (b & 0x80000000u) ? ~b : (b | 0x80000000u); }
__device__ __forceinline__ float key2f(unsigned k) { const unsigned b = (k & 0x80000000u) ? (k & 0x7fffffffu) : ~k; return __builtin_bit_cast(float, b); }
template <class Get>
__device__ __forceinline__ void wave_topk_threshold(const Get& get, int n, int lane, LAS unsigned* hist, unsigned& thr_key, int& tie_cut) {
    const int niter = (n + 63) >> 6;
    unsigned prefix = 0u, mask = 0u; int kk = KSEL; unsigned cnt_eq = 0u;
#pragma unroll 1
    for (int pass = 0; pass < 4; ++pass) {
        const int shift = 24 - 8 * pass;
        *(LAS v4u*)(hist + 4 * lane) = (v4u){0u, 0u, 0u, 0u};
        LDS_WAIT(); asm volatile("" ::: "memory");
#pragma unroll 1
        for (int it = 0; it < niter; ++it) { const int idx = 64 * it + lane;
            if (idx < n) { const unsigned uk = f2key(get(idx)); if ((uk & mask) == prefix) __hip_atomic_fetch_add(hist + ((uk >> shift) & 255u), 1u, __ATOMIC_RELAXED, __HIP_MEMORY_SCOPE_WORKGROUP); } }
        LDS_WAIT(); asm volatile("" ::: "memory");
        const v4u h4 = *(const LAS v4u*)(hist + 4 * lane);
        const unsigned tot = h4.x + h4.y + h4.z + h4.w; unsigned incl = tot;
#pragma unroll
        for (int o = 1; o < 64; o <<= 1) { const unsigned t = __shfl_down(incl, o); if (lane + o < 64) incl += t; }
        const unsigned excl = incl - tot, c3 = excl + h4.w, c2 = c3 + h4.z, c1 = c2 + h4.y, c0 = c1 + h4.x; const unsigned k_ = (unsigned)kk;
        int dj = -1; unsigned above = 0u, cnt = 0u;
        if (excl < k_ && k_ <= c3) { dj = 3; above = excl; cnt = h4.w; } else if (c3 < k_ && k_ <= c2) { dj = 2; above = c3; cnt = h4.z; } else if (c2 < k_ && k_ <= c1) { dj = 1; above = c2; cnt = h4.y; } else if (c1 < k_ && k_ <= c0) { dj = 0; above = c1; cnt = h4.x; }
        const unsigned long long bm = __ballot(dj >= 0); const int src = bm ? __builtin_ctzll(bm) : 0;
        const unsigned digit = (unsigned)__shfl(4 * lane + dj, src); above = (unsigned)__shfl((int)above, src); cnt = (unsigned)__shfl((int)cnt, src);
        prefix |= digit << shift; mask |= 255u << shift; kk -= (int)above; cnt_eq = cnt;
    }
    thr_key = prefix; tie_cut = 0x7fffffff;
    if ((int)cnt_eq > kk) {
        int run = 0;
#pragma unroll 1
        for (int it = 0; it < niter; ++it) { const int idx = 64 * it + lane; const bool eq = idx < n && f2key(get(idx)) == prefix;
            unsigned long long bm = __ballot(eq); const int c = __builtin_popcountll(bm);
            if (run + c >= kk) { int skip = kk - run - 1; while (skip-- > 0) bm &= bm - 1; tie_cut = 64 * it + __builtin_ctzll(bm); break; }
            run += c; }
    }
}
__device__ __forceinline__ int idx_row_q(int i) { return 2 * ((i >> 2) & 1) + (i >> 4); }
__device__ __forceinline__ int idx_row_h(int i) { return 4 * ((i >> 3) & 1) + (i & 3); }

constexpr int SC_LD = 2052;
constexpr int DP_SC = 0, DP_WI = 131328, DP_THR = 131840, DP_TIE = 131904, DP_HIST = 132096, DP_END = 140288;
static_assert(DP_END <= RING_BYTES, "DSA prompt LDS");
constexpr float QK_SCALE = 0.125f * 1.4426950408889634f;
__device__ __forceinline__ void dsa_prompt_unit(Frame& F, int b, int qt) {
    const int wave = F.wave; const int lane = lane_dep(qt); const int c = lane & 31, hh = lane >> 5;
    LAS unsigned char* L = F.lds + RING_OFF;
    LAS float* SC = (LAS float*)(L + DP_SC); LAS float* WIs = (LAS float*)(L + DP_WI); LAS float* THR = (LAS float*)(L + DP_THR); LAS int* TIE = (LAS int*)(L + DP_TIE);
    const f16* QIh = WSP(f16, WS_QI); const f16* KIh = WSP(f16, WS_KI); const float* WI = WSP(float, WS_WI);
    const bf16* Qb = WSP(bf16, WS_QB); const bf16* Kb = WSP(bf16, WS_KB); const bf16* VT = WSP(bf16, WS_VT); bf16* CAT = WSP(bf16, WS_CAT);
    const int q0 = 16 * qt; const size_t mb = (size_t)b * SEQ; const int Lk = q0 + 16, nkt = (Lk + 31) >> 5;
    if (wave == 0 && lane < 32) *(LAS f32x4*)(WIs + 4 * lane) = *(const GAS f32x4*)(WI + (mb + q0) * 8 + 4 * lane);
    {
        f16x8 aq[4][4];
#pragma unroll
        for (int rt4 = 0; rt4 < 4; ++rt4)
#pragma unroll
            for (int s = 0; s < 4; ++s) aq[rt4][s] = *(const GAS f16x8*)(QIh + (mb + q0 + 4 * rt4 + idx_row_q(c)) * 512 + idx_row_h(c) * 64 + 16 * s + 8 * hh);
        LDS_WAIT(); __syncthreads();
#pragma unroll 1
        for (int kt = wave; kt < nkt; kt += NWAVES) {
            f16x8 bk[4]; const int key = 32 * kt + c;
#pragma unroll
            for (int s = 0; s < 4; ++s) bk[s] = *(const GAS f16x8*)(KIh + (mb + key) * 64 + 16 * s + 8 * hh);
#pragma unroll
            for (int rt4 = 0; rt4 < 4; ++rt4) {
                f32x16 acc = zero16();
#pragma unroll
                for (int s = 0; s < 4; ++s) acc = MFMA32H(aq[rt4][s], bk[s], acc, 0, 0, 0);
                const int ql0 = 4 * rt4 + 2 * hh;
                const f32x4 w0 = *(const LAS f32x4*)(WIs + ql0 * 8), w1 = *(const LAS f32x4*)(WIs + ql0 * 8 + 4), w2 = *(const LAS f32x4*)(WIs + ql0 * 8 + 8), w3 = *(const LAS f32x4*)(WIs + ql0 * 8 + 12);
                float s0 = w0.x * fmaxf(acc[0], 0.f) + w0.y * fmaxf(acc[1], 0.f) + w0.z * fmaxf(acc[2], 0.f) + w0.w * fmaxf(acc[3], 0.f) + w1.x * fmaxf(acc[4], 0.f) + w1.y * fmaxf(acc[5], 0.f) + w1.z * fmaxf(acc[6], 0.f) + w1.w * fmaxf(acc[7], 0.f);
                float s1 = w2.x * fmaxf(acc[8], 0.f) + w2.y * fmaxf(acc[9], 0.f) + w2.z * fmaxf(acc[10], 0.f) + w2.w * fmaxf(acc[11], 0.f) + w3.x * fmaxf(acc[12], 0.f) + w3.y * fmaxf(acc[13], 0.f) + w3.z * fmaxf(acc[14], 0.f) + w3.w * fmaxf(acc[15], 0.f);
                SC[ql0 * SC_LD + key] = (key <= q0 + ql0) ? s0 : -INFINITY; SC[(ql0 + 1) * SC_LD + key] = (key <= q0 + ql0 + 1) ? s1 : -INFINITY;
            }
        }
    }
    LDS_WAIT(); __syncthreads();
#pragma unroll 1
    for (int e = 0; e < 2; ++e) { const int ql = 2 * wave + e, n = q0 + ql + 1; unsigned tk = 0u; int tc = 0x7fffffff; float thr = -INFINITY;
        if (n > KSEL) { const LAS float* row = SC + ql * SC_LD; auto get = [&](int i) { return row[i]; };
            wave_topk_threshold(get, n, lane, (LAS unsigned*)(L + DP_HIST) + wave * 256, tk, tc); thr = key2f(tk); }
        if (lane == 0) { THR[ql] = thr; TIE[ql] = tc; } }
    LDS_WAIT(); __syncthreads();
    const int rt = wave & 3, kh = wave >> 2, g = rt >> 1, ql = 8 * (rt & 1) + (c >> 2), head = 4 * g + (c & 3), qpos = q0 + ql;
    bf16x8 bq[4];
#pragma unroll
    for (int s = 0; s < 4; ++s) bq[s] = *(const GAS bf16x8*)(Qb + (mb + qpos) * 512 + head * 64 + 16 * s + 8 * hh);
    const float thr = THR[ql]; const int tie = TIE[ql];
    float m_run = -INFINITY, l_run = 0.f; f32x16 O0 = zero16(), O1 = zero16();
    const bf16* vtb = VT + ((size_t)(b * 2 + g) * 64 + c) * SEQ + 4 * hh;
#pragma unroll 1
    for (int kt = kh; kt < nkt; kt += 2) {
        bf16x8 ak[4];
#pragma unroll
        for (int s = 0; s < 4; ++s) ak[s] = *(const GAS bf16x8*)(Kb + (mb + 32 * kt + c) * 128 + g * 64 + 16 * s + 8 * hh);
        s16x4 v8[2][2][2];
#pragma unroll
        for (int dt = 0; dt < 2; ++dt)
#pragma unroll
            for (int s2 = 0; s2 < 2; ++s2)
#pragma unroll
                for (int e = 0; e < 2; ++e) v8[dt][s2][e] = *(const GAS s16x4*)(vtb + (size_t)(32 * dt) * SEQ + 32 * kt + 16 * s2 + 8 * e);
        f32x16 acc = zero16();
#pragma unroll
        for (int s = 0; s < 4; ++s) acc = MFMA32(ak[s], bq[s], acc, 0, 0, 0);
        float p[16]; float mx = -INFINITY;
#pragma unroll
        for (int g4 = 0; g4 < 4; ++g4) { const f32x4 scv = *(const LAS f32x4*)(SC + ql * SC_LD + 32 * kt + 8 * g4 + 4 * hh);
#pragma unroll
            for (int e = 0; e < 4; ++e) { const int key = 32 * kt + 8 * g4 + 4 * hh + e; const float sv = scv[e];
                const bool sel = key <= qpos && (sv > thr || (sv == thr && key <= tie));
                const float s = sel ? acc[4 * g4 + e] * QK_SCALE : -INFINITY; p[4 * g4 + e] = s; mx = fmaxf(mx, s); } }
        mx = fmaxf(mx, __shfl_xor(mx, 32));
        const float m_new = fmaxf(m_run, mx), m_safe = (m_new == -INFINITY) ? 0.f : m_new, alpha = __builtin_amdgcn_exp2f(m_run - m_safe);
        float ps = 0.f;
#pragma unroll
        for (int r = 0; r < 16; ++r) { p[r] = __builtin_amdgcn_exp2f(p[r] - m_safe); ps += p[r]; }
        l_run = l_run * alpha + ps; m_run = m_new;
#pragma unroll
        for (int r = 0; r < 16; ++r) { O0[r] *= alpha; O1[r] *= alpha; }
#pragma unroll
        for (int s2 = 0; s2 < 2; ++s2) {
            v4u pw; pw.x = pk2(p[8 * s2], p[8 * s2 + 1]); pw.y = pk2(p[8 * s2 + 2], p[8 * s2 + 3]); pw.z = pk2(p[8 * s2 + 4], p[8 * s2 + 5]); pw.w = pk2(p[8 * s2 + 6], p[8 * s2 + 7]);
            const bf16x8 pb = __builtin_bit_cast(bf16x8, pw);
            bf16x8 a0, a1;
#pragma unroll
            for (int j = 0; j < 4; ++j) { a0[j] = v8[0][s2][0][j]; a0[4 + j] = v8[0][s2][1][j]; a1[j] = v8[1][s2][0][j]; a1[4 + j] = v8[1][s2][1][j]; }
            O0 = MFMA32(a0, pb, O0, 0, 0, 0); O1 = MFMA32(a1, pb, O1, 0, 0, 0);
        }
    }
    l_run += __shfl_xor(l_run, 32);
    __syncthreads();
    LAS float* CB = (LAS float*)(L + DP_SC) + rt * (34 * 64);
    if (kh == 1) { CB[lane] = m_run; CB[64 + lane] = l_run;
#pragma unroll
        for (int r = 0; r < 16; ++r) { CB[(2 + r) * 64 + lane] = O0[r]; CB[(18 + r) * 64 + lane] = O1[r]; } }
    LDS_WAIT(); __syncthreads();
    if (kh == 0) {
        const float m1 = CB[lane], l1 = CB[64 + lane]; const float m = fmaxf(m_run, m1), ms = (m == -INFINITY) ? 0.f : m;
        const float a0 = __builtin_amdgcn_exp2f(m_run - ms), a1 = __builtin_amdgcn_exp2f(m1 - ms); const float inv = 1.f / (l_run * a0 + l1 * a1);
        bf16* op = CAT + (mb + qpos) * D + head * 64 + 4 * hh;
#pragma unroll
        for (int g4 = 0; g4 < 4; ++g4) { float o[8];
#pragma unroll
            for (int e = 0; e < 4; ++e) { o[e] = (O0[4 * g4 + e] * a0 + CB[(2 + 4 * g4 + e) * 64 + lane] * a1) * inv; o[4 + e] = (O1[4 * g4 + e] * a0 + CB[(18 + 4 * g4 + e) * 64 + lane] * a1) * inv; }
            v2u w0; w0.x = pk2(o[0], o[1]); w0.y = pk2(o[2], o[3]); *(GAS v2u*)(op + 8 * g4) = w0;
            v2u w1; w1.x = pk2(o[4], o[5]); w1.y = pk2(o[6], o[7]); *(GAS v2u*)(op + 32 + 8 * g4) = w1; }
    }
    LDS_WAIT(); __syncthreads();
}
__device__ __forceinline__ void dsa_prompt_phase(Frame& F) {
    for (int w = F.bx; w < 256; w += F.G) { const int b = w >> 4, sub = w & 15;
#pragma unroll 1
        for (int j = 0; j < 8; ++j) { const int qt = 32 * (j >> 1) + ((j & 1) ? 31 - sub : sub); dsa_prompt_unit(F, b, qt); } }
}
__device__ __forceinline__ void dsa_sample_scores_phase(Frame& F, const Args& A) {
    const int wave = F.wave;
    const f16* QIh = WSP(f16, WS_QI); const f16* KIh = WSP(f16, WS_KI); const float* WI = WSP(float, WS_WI); float* SCS = WSP(float, WS_SCS);
    const float* ckidx = A.in[4]; const int* ptab = (const int*)A.in[7];
    const int kt4 = wave & 3, rt2 = wave >> 2;
#pragma unroll 1
    for (int u = F.bx; u < DECB * NPAGES; u += F.G) {
        const int lane = lane_dep(u); const int c = lane & 31, hh = lane >> 5;
        const int bs = u >> 6, j = u & 63; const size_t ms = (size_t)MP + (size_t)bs * DECT;
        const int phys = ptab[bs * NPAGES + j];
        f16x8 aq[4], bk[4];
        const float* kp = ckidx + ((size_t)phys * PAGE + 32 * kt4 + c) * 64 + 8 * hh;
#pragma unroll
        for (int s = 0; s < 4; ++s) { const f32x4 x0 = *(const GAS f32x4*)(kp + 16 * s), x1 = *(const GAS f32x4*)(kp + 16 * s + 4);
            f16x8 t; t[0] = (f16)x0.x; t[1] = (f16)x0.y; t[2] = (f16)x0.z; t[3] = (f16)x0.w; t[4] = (f16)x1.x; t[5] = (f16)x1.y; t[6] = (f16)x1.z; t[7] = (f16)x1.w; bk[s] = t; }
#pragma unroll
        for (int s = 0; s < 4; ++s) aq[s] = *(const GAS f16x8*)(QIh + (ms + 4 * rt2 + idx_row_q(c)) * 512 + idx_row_h(c) * 64 + 16 * s + 8 * hh);
        f32x16 acc = zero16();
#pragma unroll
        for (int s = 0; s < 4; ++s) acc = MFMA32H(aq[s], bk[s], acc, 0, 0, 0);
        const int ql0 = 4 * rt2 + 2 * hh;
        const GAS f32x4* wp = (const GAS f32x4*)(WI + (ms + ql0) * 8);
        const f32x4 w0 = wp[0], w1 = wp[1], w2 = wp[2], w3 = wp[3];
        const float s0 = w0.x * fmaxf(acc[0], 0.f) + w0.y * fmaxf(acc[1], 0.f) + w0.z * fmaxf(acc[2], 0.f) + w0.w * fmaxf(acc[3], 0.f) + w1.x * fmaxf(acc[4], 0.f) + w1.y * fmaxf(acc[5], 0.f) + w1.z * fmaxf(acc[6], 0.f) + w1.w * fmaxf(acc[7], 0.f);
        const float s1 = w2.x * fmaxf(acc[8], 0.f) + w2.y * fmaxf(acc[9], 0.f) + w2.z * fmaxf(acc[10], 0.f) + w2.w * fmaxf(acc[11], 0.f) + w3.x * fmaxf(acc[12], 0.f) + w3.y * fmaxf(acc[13], 0.f) + w3.z * fmaxf(acc[14], 0.f) + w3.w * fmaxf(acc[15], 0.f);
        const int key = PAGE * j + 32 * kt4 + c;
        SCS[((size_t)bs * DECT + ql0) * SCS_LD + key] = s0; SCS[((size_t)bs * DECT + ql0 + 1) * SCS_LD + key] = s1;
    }
#pragma unroll 1
    for (int bs = F.bx * NWAVES + wave; bs < DECB; bs += F.G * NWAVES) {
        const int lane = lane_dep(bs); const int t = lane >> 3, t2 = lane & 7; const size_t ms = (size_t)MP + (size_t)bs * DECT;
        float sc = 0.f;
#pragma unroll 1
        for (int h = 0; h < 8; ++h) { float d = 0.f;
#pragma unroll 8
            for (int e = 0; e < 64; ++e) d += (float)QIh[(ms + t) * 512 + h * 64 + e] * (float)KIh[(ms + t2) * 64 + e];
            sc += WI[(ms + t) * 8 + h] * fmaxf(d, 0.f); }
        SCS[((size_t)bs * DECT + t) * SCS_LD + PAST + t2] = (t2 <= t) ? sc : -INFINITY;
    }
}
constexpr int DS_WAVE = 13312;
__device__ __forceinline__ void dsa_sample_attend_phase(Frame& F, const Args& A) {
    const int wave = F.wave;
    LAS unsigned char* L = F.lds + RING_OFF + wave * DS_WAVE;
    LAS unsigned* hist = (LAS unsigned*)L; LAS int* list = (LAS int*)(L + 1024); LAS int* rowid = (LAS int*)(L + 2048); LAS float* qv = (LAS float*)(L + 3072); LAS float* sc = (LAS float*)(L + 5120);
    const float* SCS = WSP(float, WS_SCS); const bf16* Qb = WSP(bf16, WS_QB); bf16* CAT = WSP(bf16, WS_CAT);
    const float* ck = A.in[2]; const float* cv = A.in[3]; const int* ptab = (const int*)A.in[7];
#pragma unroll 1
    for (int qi = wave * F.G + F.bx; qi < MS; qi += NWAVES * F.G) {
        const int lane = lane_dep(qi);
        const int bs = qi >> 3, t = qi & 7, n = PAST + t + 1; const size_t m = (size_t)MP + qi;
        const GAS float* row = (const GAS float*)(SCS + (size_t)qi * SCS_LD);
        unsigned tk; int tc; auto get = [&](int i) { return row[i]; };
        wave_topk_threshold(get, n, lane, hist, tk, tc);
        int cnt = 0;
#pragma unroll 1
        for (int it = 0; it < (n + 63) / 64; ++it) { const int idx = 64 * it + lane; bool sel = false;
            if (idx < n) { const unsigned uk = f2key(row[idx]); sel = uk > tk || (uk == tk && idx <= tc); }
            const unsigned long long bm = __ballot(sel); const int pos = cnt + __builtin_popcountll(bm & ((1ull << lane) - 1ull));
            if (sel && pos < KSEL) list[pos] = idx;
            cnt += __builtin_popcountll(bm); }
#pragma unroll
        for (int e = 0; e < 4; ++e) { const unsigned qq = *(const GAS unsigned*)(Qb + m * 512 + 128 * e + 2 * lane); qv[128 * e + 2 * lane] = bflo(qq); qv[128 * e + 2 * lane + 1] = bfhi(qq); }
        LDS_WAIT(); asm volatile("" ::: "memory");
        float mxh[8];
#pragma unroll
        for (int h = 0; h < 8; ++h) mxh[h] = -INFINITY;
#pragma unroll 1
        for (int p = 0; p < 4; ++p) { const int jj = 64 * p + lane; const int idx = list[jj];
            const float* kp; int rid;
            if (idx < PAST) { rid = ptab[bs * NPAGES + (idx >> 7)] * PAGE + (idx & 127); kp = ck + (size_t)rid * 128; }
            else { rid = -(idx - PAST) - 1; kp = F.out + O_KS + ((size_t)bs * DECT + (idx - PAST)) * 128; }
            rowid[jj] = rid;
            float s[8];
#pragma unroll
            for (int h = 0; h < 8; ++h) s[h] = 0.f;
#pragma unroll 1
            for (int g = 0; g < 2; ++g) {
#pragma unroll 4
                for (int d4 = 0; d4 < 16; ++d4) { const f32x4 kv = *(const GAS f32x4*)(kp + 64 * g + 4 * d4);
#pragma unroll
                    for (int hl = 0; hl < 4; ++hl) { const f32x4 q4 = *(const LAS f32x4*)(qv + (4 * g + hl) * 64 + 4 * d4); const float dd = kv.x * q4.x + kv.y * q4.y + kv.z * q4.z + kv.w * q4.w;
                        if (g == 0) s[hl] += dd; else s[4 + hl] += dd; } } }
#pragma unroll
            for (int h = 0; h < 8; ++h) { const float v = s[h] * QK_SCALE; sc[h * 256 + jj] = v; mxh[h] = fmaxf(mxh[h], v); } }
        LDS_WAIT(); asm volatile("" ::: "memory");
        float invl[8];
#pragma unroll
        for (int h = 0; h < 8; ++h) { const float mm = wave_max(mxh[h]); float ps = 0.f;
#pragma unroll
            for (int p = 0; p < 4; ++p) { const float e = __builtin_amdgcn_exp2f(sc[h * 256 + 64 * p + lane] - mm); sc[h * 256 + 64 * p + lane] = e; ps += e; }
            invl[h] = 1.f / wave_sum(ps); }
        LDS_WAIT(); asm volatile("" ::: "memory");
        const int g = lane >> 5, dp = lane & 31; float o[4][2];
#pragma unroll
        for (int hl = 0; hl < 4; ++hl) { o[hl][0] = 0.f; o[hl][1] = 0.f; }
#pragma unroll 4
        for (int jj = 0; jj < KSEL; ++jj) { const int rid = __builtin_amdgcn_readfirstlane(rowid[jj]);
            const float* vp = (rid >= 0) ? cv + (size_t)rid * 128 : F.out + O_VS + ((size_t)bs * DECT + (-rid - 1)) * 128;
            const f32x2 vv = *(const GAS f32x2*)(vp + 64 * g + 2 * dp);
#pragma unroll
            for (int hl = 0; hl < 4; ++hl) { const float pp = sc[(4 * g + hl) * 256 + jj]; o[hl][0] += pp * vv.x; o[hl][1] += pp * vv.y; } }
#pragma unroll
        for (int hl = 0; hl < 4; ++hl) { const float il = (g == 0) ? invl[hl] : invl[4 + hl];
            *(GAS unsigned*)(CAT + m * D + (4 * g + hl) * 64 + 2 * dp) = pk2(o[hl][0] * il, o[hl][1] * il); }
        LDS_WAIT(); asm volatile("" ::: "memory");
    }
}
#if MK_DIAG
constexpr int CW_DG = 2048;
__device__ __forceinline__ void dg_add(Frame& F, int k, float num, float den) {
    LAS float* red = (LAS float*)(F.lds + RING_OFF + 140000);
    __syncthreads(); if ((int)threadIdx.x < 2) red[(int)threadIdx.x] = 0.f; __syncthreads();
    atomicAdd((float*)&red[0], num); atomicAdd((float*)&red[1], den); __syncthreads();
    if ((int)threadIdx.x == 0) { atomicAdd((float*)(F.ctl + CW_DG + 2 * k), red[0]); atomicAdd((float*)(F.ctl + CW_DG + 2 * k + 1), red[1]); }
    __syncthreads();
}
__device__ __forceinline__ int dg_row(int i) { const int rows[8] = {0, 777, 2047, 2048, 20000, 32767, 32768, 33791}; int r = 0;
#pragma unroll
    for (int j = 0; j < 8; ++j) r = (i == j) ? rows[j] : r; return r; }
__device__ __forceinline__ void chk_ffn(Frame& F, const float* x0, const float* x1, int split, const float* Wg, const float* Wu, const float* Wd, const float* lg, const float* lb, const float* Xout, int ch) {
    if (F.bx >= 8) return;
    const int row = dg_row(F.bx), tid = (int)threadIdx.x;
    LAS float* xs = (LAS float*)(F.lds + RING_OFF); LAS float* hs = xs + 1024; LAS float* rs = hs + 2816;
    const float* xr = row < split ? x0 + (size_t)row * D : x1 + (size_t)(row - split) * D;
    for (int c = tid; c < D; c += NTHR) xs[c] = xr[c];
    __syncthreads();
    for (int j = tid; j < FF; j += NTHR) { float g = 0.f, u = 0.f; for (int k = 0; k < D; ++k) { g += xs[k] * Wg[(size_t)k * FF + j]; u += xs[k] * Wu[(size_t)k * FF + j]; } hs[j] = g / (1.f + expf(-g)) * u; }
    __syncthreads();
    for (int c = tid; c < D; c += NTHR) { float y = 0.f; for (int j = 0; j < FF; ++j) y += hs[j] * Wd[(size_t)j * D + c]; rs[c] = ALPHA * xs[c] + 0.5f * y; }
    __syncthreads();
    float mean = 0.f; for (int c = 0; c < D; ++c) mean += rs[c]; mean *= (1.f / D);
    float var = 0.f; for (int c = 0; c < D; ++c) { const float d = rs[c] - mean; var += d * d; } var *= (1.f / D);
    const float rstd = 1.f / sqrtf(var + LN_EPS);
    float num = 0.f, den = 0.f;
    for (int c = tid; c < D; c += NTHR) { const float ref = (rs[c] - mean) * rstd * lg[c] + lb[c]; const float d = Xout[(size_t)row * D + c] - ref; num += d * d; den += ref * ref; }
    dg_add(F, ch, num, den);
}
__device__ __forceinline__ void chk_proj(Frame& F, const float* X1, const float* Win, const bf16* P, int ch) {
    if (F.bx >= 8) return;
    const int row = dg_row(F.bx), tid = (int)threadIdx.x;
    LAS float* xs = (LAS float*)(F.lds + RING_OFF);
    for (int c = tid; c < D; c += NTHR) xs[c] = X1[(size_t)row * D + c];
    __syncthreads();
    float num = 0.f, den = 0.f;
    for (int c = tid; c < INW; c += NTHR) { float p = 0.f; for (int k = 0; k < D; ++k) p += xs[k] * Win[(size_t)k * INW + c]; const float d = bf2f(P[(size_t)row * INWP + c]) - p; num += d * d; den += p * p; }
    dg_add(F, ch, num, den);
}

__device__ __forceinline__ void chk_gdn(Frame& F, const Args& A, bool sample, int b, int h, int ch_o, int ch_s) {
    const int tid = (int)threadIdx.x;
    LAS float* S = (LAS float*)(F.lds + RING_OFF); LAS float* y = S + 16384; LAS float* qn = y + 384; LAS float* kn = qn + 128; LAS float* rv = kn + 128;
    const bf16* P = WSP(bf16, WS_P); const float* BG = WSP(float, WS_BG); const float* OG = WSP(float, WS_OG); const float* cw = A.in[14];
    const int T = sample ? DECT : SEQ; const size_t m0 = sample ? (size_t)MP + b * DECT : (size_t)b * SEQ;
    const float* st_in = A.in[5] + (size_t)(b * GH + h) * GDK * GDV; const float* st_out = F.out + (sample ? O_GS : O_GP) + (size_t)(b * GH + h) * GDK * GDV;
    for (int e = tid; e < 16384; e += NTHR) S[e] = sample ? st_in[e] : 0.f;
    float no = 0.f, dn = 0.f;
    __syncthreads();
    for (int t = 0; t < T; ++t) {
        const size_t m = m0 + t;
        if (tid < 384) { const int col = (tid < 128) ? h * 128 + tid : (tid < 256) ? 512 + h * 128 + (tid - 128) : 1024 + h * 128 + (tid - 256); float a = 0.f;
            for (int j = 0; j < 4; ++j) { const int rr = t + j; float x;
                if (rr < 3) x = sample ? A.in[6][((size_t)b * 3 + rr) * CONVC + col] : 0.f; else x = bf2f(P[(m0 + rr - 3) * INWP + C_QKV + col]);
                a += cw[j * CONVC + col] * x; }
            y[tid] = a / (1.f + expf(-a)); }
        __syncthreads();
        float sq = 0.f, sk = 0.f; for (int i = 0; i < 128; ++i) { sq += y[i] * y[i]; sk += y[128 + i] * y[128 + i]; }
        const float rq = 1.f / sqrtf(sq + NORM_EPS), rk = 1.f / sqrtf(sk + NORM_EPS);
        if (tid < 128) { qn[tid] = y[tid] * rq; kn[tid] = y[128 + tid] * rk; }
        __syncthreads();
        const float be = BG[m * 8 + h], a = expf(BG[m * 8 + 4 + h]);
        if (tid < 128) { float part = 0.f; for (int dk = 0; dk < 128; ++dk) part += a * S[dk * 128 + tid] * kn[dk]; rv[tid] = (y[256 + tid] - part) * be; }
        __syncthreads();
        for (int e = tid; e < 16384; e += NTHR) S[e] = a * S[e] + kn[e >> 7] * rv[e & 127];
        __syncthreads();
        if (tid < 128) { float o = 0.f; for (int dk = 0; dk < 128; ++dk) o += S[dk * 128 + tid] * qn[dk]; o *= 0.08838834764831845f;
            const float d = OG[m * 512 + h * 128 + tid] - o; no += d * d; dn += o * o; }
        __syncthreads();
    }
    float ns = 0.f, ds = 0.f;
    for (int e = tid; e < 16384; e += NTHR) { const float d = st_out[e] - S[e]; ns += d * d; ds += S[e] * S[e]; }
    dg_add(F, ch_o, no, dn); dg_add(F, ch_s, ns, ds);
}

__device__ __forceinline__ void chk_dsa(Frame& F, const Args& A, bool sample, int b, int t, int ch) {
    const int tid = (int)threadIdx.x;
    LAS float* sc = (LAS float*)(F.lds + RING_OFF); LAS unsigned char* sel = (LAS unsigned char*)(sc + 8208); LAS float* qs = (LAS float*)(sel + 8208);
    const f16* QIh = WSP(f16, WS_QI); const f16* KIh = WSP(f16, WS_KI); const float* WI = WSP(float, WS_WI); const bf16* Qb = WSP(bf16, WS_QB); const bf16* Kb = WSP(bf16, WS_KB); const bf16* P = WSP(bf16, WS_P); const bf16* CAT = WSP(bf16, WS_CAT);
    const int* ptab = (const int*)A.in[7];
    const size_t m = sample ? (size_t)MP + b * DECT + t : (size_t)b * SEQ + t; const int n = sample ? PAST + t + 1 : t + 1;
    for (int l = tid; l < n; l += NTHR) { float s = 0.f;
        for (int h = 0; h < 8; ++h) { float d = 0.f;
            for (int e = 0; e < 64; ++e) { float kv;
                if (sample) { if (l < PAST) kv = (float)(f16)A.in[4][((size_t)ptab[b * NPAGES + (l >> 7)] * PAGE + (l & 127)) * 64 + e]; else kv = (float)KIh[((size_t)MP + b * DECT + (l - PAST)) * 64 + e]; }
                else kv = (float)KIh[((size_t)b * SEQ + l) * 64 + e];
                d += (float)QIh[m * 512 + h * 64 + e] * kv; }
            s += WI[m * 8 + h] * fmaxf(d, 0.f); }
        if (s == 0.f) s = 0.f;
        sc[l] = s; }
    for (int e = tid; e < 512; e += NTHR) qs[e] = bf2f(Qb[m * 512 + e]);
    __syncthreads();
    for (int l = tid; l < n; l += NTHR) { const float x = sc[l]; int rank = 0; for (int l2 = 0; l2 < n; ++l2) { const float y = sc[l2]; rank += (y > x || (y == x && l2 < l)) ? 1 : 0; } sel[l] = rank < KSEL ? 1 : 0; }
    __syncthreads();
    const int h = tid >> 6, d = tid & 63, g = h >> 2; float mx = -INFINITY;
    for (int pass = 0; pass < 2; ++pass) { float lsum = 0.f, o = 0.f;
        for (int l = 0; l < n; ++l) { if (!sel[l]) continue; float dot = 0.f; float vv;
            if (sample) { const float* kp; const float* vp;
                if (l < PAST) { const size_t rid = (size_t)ptab[b * NPAGES + (l >> 7)] * PAGE + (l & 127); kp = A.in[2] + rid * 128; vp = A.in[3] + rid * 128; }
                else { kp = F.out + O_KS + ((size_t)b * DECT + (l - PAST)) * 128; vp = F.out + O_VS + ((size_t)b * DECT + (l - PAST)) * 128; }
                for (int e = 0; e < 64; ++e) dot += qs[h * 64 + e] * kp[g * 64 + e]; vv = vp[g * 64 + d];
            } else { const size_t mk = (size_t)b * SEQ + l; for (int e = 0; e < 64; ++e) dot += qs[h * 64 + e] * bf2f(Kb[mk * 128 + g * 64 + e]); vv = bf2f(P[mk * INWP + C_V + g * 64 + d]); }
            dot *= 0.125f;
            if (pass == 0) mx = fmaxf(mx, dot); else { const float p = expf(dot - mx); lsum += p; o += p * vv; } }
        if (pass == 1) { const float ref = o / lsum; const float dd = bf2f(CAT[m * D + h * 64 + d]) - ref; dg_add(F, ch, dd * dd, ref * ref); } }
}
__device__ __forceinline__ void dg_report(Frame& F) {
    if (F.bx != 0 || (int)threadIdx.x >= 12) return;
    const size_t offs[12] = {O_YP, O_YS, O_KP, O_VP, O_IP, O_GP, O_CP, O_KS, O_VS, O_IS, O_GS, O_CS};
    size_t off = 0;
#pragma unroll
    for (int j = 0; j < 12; ++j) off = ((int)threadIdx.x == j) ? offs[j] : off;
    const float num = __hip_atomic_load((float*)(F.ctl + CW_DG + 2 * (int)threadIdx.x), RLX_AGENT), den = __hip_atomic_load((float*)(F.ctl + CW_DG + 2 * (int)threadIdx.x + 1), RLX_AGENT);
    int n = 99;
    if (den > 0.f) { const float e = sqrtf(num / den); const float L = -log10f(fmaxf(e, 1e-9f)); n = 1 + (int)(10.f * fmaxf(L, 0.f) + 0.5f); n = n > 98 ? 98 : n; if (!(e == e)) n = 1; }
    for (int i = 0; i < n; ++i) ((unsigned*)F.out)[off + i] = 0xAAAAAAAAu;
}
#endif
#ifndef MK_ONE_LAUNCH
#define MK_ONE_LAUNCH 0
#endif
constexpr int NPH = 14 + 2 * MK_DIAG;
__global__ void __launch_bounds__(NTHR, 2) mk_fwd(Args args) {
    extern __shared__ __attribute__((aligned(16))) unsigned char lds[];
    Frame F;
    F.lds = (LAS unsigned char*)lds; F.MISC = (volatile LAS unsigned*)(F.lds + MISC_OFF);
    F.wave = __builtin_amdgcn_readfirstlane(threadIdx.x >> 6); F.G = gridDim.x; F.bx = blockIdx.x;
    F.out = args.out; F.ws = args.ws; F.ctl = (gu32*)(args.ws + WS_CTL);
    for (int u = F.wave * 64 + lane_fresh(); u < (LDS_BYTES - LDSCTL_OFF) / 4; u += NTHR) ((LAS unsigned*)(F.lds + LDSCTL_OFF))[u] = 0u;
    __syncthreads();
    XcdBarrier bar; bar.wave = F.wave; bar.bar = (unsigned*)(F.ctl + CW_BAR); bar.x = 0; bar.st = nullptr;
    if (MK_ONE_LAUNCH) bar = xcd_barrier_post((unsigned*)(F.ctl + CW_BAR), F.MISC + 8, F.wave);
    const int lo = args.ph_lo, hi = args.ph_hi;
#define IN(k) (lo <= (k) && (k) < hi)
#define SEAM(k) do { if (IN(k) && IN((k) + 1)) xcd_barrier(bar); } while (0)
    const float* xp = args.in[0]; const float* xs = args.in[1];
    bf16* XB = WSP(bf16, WS_XB); float* X1 = WSP(float, WS_X1); float* X2 = WSP(float, WS_X2); float* R = WSP(float, WS_R); bf16* H = WSP(bf16, WS_H); bf16* P = WSP(bf16, WS_P); bf16* CAT = WSP(bf16, WS_CAT);

    if (IN(0)) { p0_prologue(F, args); } SEAM(0);
    if (IN(1)) {
        pg8::Gemm g{XB, WSP(bf16, WS_WGU1), M, NGU, D}; pg8::StaticOrder S; S.init(M, NGU, F.G, F.bx);
        pg8::EpiSwiGLU E{H, FF};
        pg8::gemm_phase<pg8::EpiSwiGLU, pg8::StaticOrder, true, true>(F.lds + RING_OFF, g, S, E, F.wave);
    } SEAM(1);
    if (IN(2)) {
        pg8::Gemm g{H, WSP(bf16, WS_WD1), M, D, FF}; pg8::StaticOrder S; S.init(M, D, F.G, F.bx);
        pg8::EpiResF32 E{xp, xs, MP, R, D, ALPHA, 0.5f};
        pg8::gemm_phase<pg8::EpiResF32, pg8::StaticOrder, true, true>(F.lds + RING_OFF, g, S, E, F.wave);
    } SEAM(2);
    if (IN(3)) { ln_phase(F, R, args.in[11], args.in[12], X1, XB); } SEAM(3);
    if (IN(4)) {
        pg8::Gemm g{XB, WSP(bf16, WS_WIN), M, INWP, D}; pg8::StaticOrder S; S.init(M, INWP, F.G, F.bx);
        pg8::EpiPlainBf16 E{P, INWP};
        pg8::gemm_phase<pg8::EpiPlainBf16, pg8::StaticOrder, true, true>(F.lds + RING_OFF, g, S, E, F.wave);
    } SEAM(4);
    if (IN(5)) { post_phase(F, args); } SEAM(5);
    if (IN(6)) { gdn_prep_phase(F, args); dsa_sample_scores_phase(F, args); } SEAM(6);
    if (IN(7)) { gdn_scan_phase(F, args); dsa_sample_attend_phase(F, args); dsa_prompt_phase(F); } SEAM(7);
    if (IN(8)) { gdn_out_phase(F, args); } SEAM(8);
    if (IN(9)) {
        pg8::Gemm g{CAT, WSP(bf16, WS_WO), M, D, D}; pg8::StaticOrder S; S.init(M, D, F.G, F.bx);
        pg8::EpiResF32 E{X1, X1, M, R, D, ALPHA, 1.0f};
        pg8::gemm_phase<pg8::EpiResF32, pg8::StaticOrder, true, true>(F.lds + RING_OFF, g, S, E, F.wave);
    } SEAM(9);
    if (IN(10)) { ln_phase(F, R, args.in[19], args.in[20], X2, XB); } SEAM(10);
    if (IN(11)) {
        pg8::Gemm g{XB, WSP(bf16, WS_WGU2), M, NGU, D}; pg8::StaticOrder S; S.init(M, NGU, F.G, F.bx);
        pg8::EpiSwiGLU E{H, FF};
        pg8::gemm_phase<pg8::EpiSwiGLU, pg8::StaticOrder, true, true>(F.lds + RING_OFF, g, S, E, F.wave);
    } SEAM(11);
    if (IN(12)) {
        pg8::Gemm g{H, WSP(bf16, WS_WD2), M, D, FF}; pg8::StaticOrder S; S.init(M, D, F.G, F.bx);
        pg8::EpiResF32 E{X2, X2, M, R, D, ALPHA, 0.5f};
        pg8::gemm_phase<pg8::EpiResF32, pg8::StaticOrder, true, true>(F.lds + RING_OFF, g, S, E, F.wave);
    } SEAM(12);
    if (IN(13)) { ln_phase(F, R, args.in[24], args.in[25], F.out + O_YP, nullptr); }
#if MK_DIAG
    if (IN(14)) {
        chk_ffn(F, xp, xs, MP, args.in[8], args.in[9], args.in[10], args.in[11], args.in[12], X1, 0);
        chk_proj(F, X1, args.in[13], P, 1);
        if (F.bx >= 8 && F.bx < 12) { const int i = F.bx - 8; chk_gdn(F, args, false, 5 * i, i, 2, 3); }
        if (F.bx >= 16 && F.bx < 24) { const int i = F.bx - 16; chk_dsa(F, args, false, (3 * i + 1) & 15, i == 0 ? 5 : i == 1 ? 255 : i == 2 ? 256 : i == 3 ? 300 : i == 4 ? 777 : i == 5 ? 1500 : i == 6 ? 2046 : 2047, 6); }
        if (F.bx >= 24 && F.bx < 28) { const int i = F.bx - 24; chk_dsa(F, args, true, i == 0 ? 0 : i == 1 ? 50 : i == 2 ? 99 : 127, i == 0 ? 0 : i == 1 ? 3 : i == 2 ? 6 : 7, 7); }
        if (F.bx >= 12 && F.bx < 16) { const int i = F.bx - 12; chk_gdn(F, args, true, i == 0 ? 0 : i == 1 ? 37 : i == 2 ? 100 : 127, i, 4, 5); }
    }
#endif
#if MK_DIAG
    if (IN(15)) dg_report(F);
#endif
#undef IN
#undef SEAM
}

extern "C" void kernel_launch(void* const* d_in, const int* in_sizes, int n_in, void* d_out, int out_size, void* d_ws, size_t ws_size, hipStream_t stream) {
    static int grid = 0;
    if (grid == 0) {
        if (n_in != 26 || out_size != (int)O_END || ws_size < WS_END) { fprintf(stderr, "kernel_launch: unexpected shapes (n_in %d out %d ws %zu)\n", n_in, out_size, ws_size); grid = -1; return; }
        int dev = 0, cus = 0, per_cu = 0;
        if (hipGetDevice(&dev) != hipSuccess || hipDeviceGetAttribute(&cus, hipDeviceAttributeMultiprocessorCount, dev) != hipSuccess) { grid = -1; return; }
        if (hipFuncSetAttribute((const void*)mk_fwd, hipFuncAttributeMaxDynamicSharedMemorySize, LDS_BYTES) != hipSuccess) { fprintf(stderr, "kernel_launch: hipFuncSetAttribute failed\n"); grid = -1; return; }
        if (hipOccupancyMaxActiveBlocksPerMultiprocessor(&per_cu, (const void*)mk_fwd, NTHR, LDS_BYTES) != hipSuccess || per_cu < 1) fprintf(stderr, "kernel_launch: occupancy query reports %d\n", per_cu);
        (void)hipGetLastError();
        grid = cus;
    }
    if (grid < 0) return;
    if (hipMemsetAsync((char*)d_ws + WS_CTL, 0, CTL_ZERO_BYTES, stream) != hipSuccess) return;
    Args a{};
    for (int i = 0; i < 26; ++i) a.in[i] = (const float*)d_in[i];
    a.out = (float*)d_out; a.ws = (unsigned char*)d_ws;
#if MK_ONE_LAUNCH
    a.ph_lo = 0; a.ph_hi = NPH;
    hipLaunchKernelGGL(mk_fwd, dim3(grid), dim3(NTHR), LDS_BYTES, stream, a);
#else
    for (int k = 0; k < NPH; ++k) { a.ph_lo = k; a.ph_hi = k + 1; hipLaunchKernelGGL(mk_fwd, dim3(grid), dim3(NTHR), LDS_BYTES, stream, a); }
#endif
}
```

```cpp
#define MK_DIAG 0
#define TS_LO {0,1,2,3,4,5,6,7,8,9,10,11}
#define TS_HI {1,2,3,4,5,6,7,8,9,10,11,14}
#define MK_ONE_LAUNCH 1
#define MK_DUP -1
#define MK_X 0
#include <hip/hip_runtime.h>
#include <cstdio>
#include <cstdint>
namespace pg8 {
#define PG8_LAS __attribute__((address_space(3)))
typedef unsigned short bf16_t;
typedef short bf16x8 __attribute__((ext_vector_type(8)));
typedef float f32x4 __attribute__((ext_vector_type(4)));
typedef unsigned u32x4 __attribute__((ext_vector_type(4)));
constexpr int BM = 256, BK = 64, HALF = 128, HTB = HALF * BK * 2  , STAGE_BYTES = 8 * HTB, NXCD = 8, WGM = 8;

__host__ __device__ __forceinline__ int lds_byte(int r, int c) { const int st = (r >> 4) * 2 + (c >> 5), rr = r & 15, cc = c & 31, ob = rr * 64 + cc * 2; return st * 1024 + (ob ^ (((ob >> 9) & 1) << 5)); }
__host__ __device__ __forceinline__ void stage_rc(int b, int& R, int& C) { const int st = b / 1024, sb = b % 1024, swz = sb ^ (((sb >> 9) & 1) << 5); R = (st >> 1) * 16 + swz / 64; C = (st & 1) * 32 + (swz % 64) / 2; }
__host__ __device__ __forceinline__ int perm32(int rho) { const int n = rho >> 4, i = rho & 15; return 8 * (i >> 2) + 4 * n + (i & 3); }

struct Unit { int pm, pn; };
struct Gemm { const bf16_t* A; const bf16_t* Bt; int M, N, K; };

struct StaticOrder {
    int nM, nN, nwg, G, c;
    __host__ __device__ void init(int M, int N, int G_, int c_) { nM = M / BM; nN = N / BM; nwg = nM * nN; G = G_; c = c_; }
    __host__ __device__ bool next(int i, Unit& u) const {
        const long L = (long)i * G + c; if (L >= nwg) return false;
        int wgid = (int)L; { const int q = nwg / NXCD, r = nwg % NXCD, xcd = wgid % NXCD, off = wgid / NXCD; wgid = (xcd < r ? xcd * (q + 1) : r * (q + 1) + (xcd - r) * q) + off; }
        const int nig = WGM * nN, gid = wgid / nig, fm = gid * WGM, gsz = (nM - fm) < WGM ? (nM - fm) : WGM;
        u.pm = fm + ((wgid % nig) % gsz); u.pn = (wgid % nig) / gsz; return true;
    }
    __device__ __forceinline__ void a_ready(const Unit&) const {}
    __device__ __forceinline__ void done(const Unit&) const {}
};

__device__ __forceinline__ unsigned cvt_pk_bf16(float lo, float hi) { unsigned r; asm volatile("v_cvt_pk_bf16_f32 %0, %1, %2" : "=v"(r) : "v"(lo), "v"(hi)); return r; }
typedef float f32x2 __attribute__((ext_vector_type(2)));
__device__ __forceinline__ float silu_f(float x) { return x * __builtin_amdgcn_rcpf(1.0f + __builtin_amdgcn_exp2f(-1.4426950408889634f * x)); }
struct EpiSwiGLU {
    static constexpr bool PERM = true, AFTER_DRAIN = false;
    bf16_t* O; int ldc;
    __device__ __forceinline__ void operator()(const f32x4 (&acc)[2][2][4][2], const Unit& u, int wr, int wc, int fr, int fq) const {
        const int row0 = u.pm * BM + wr * 64 + fr, col0 = u.pn * HALF + wc * 32 + 8 * fq;
#pragma unroll
        for (int ai = 0; ai < 2; ++ai)
#pragma unroll
            for (int m = 0; m < 4; ++m) { bf16_t* p = O + (size_t)(row0 + ai * HALF + m * 16) * ldc + col0;
                const f32x4 g0 = acc[ai][0][m][0], g1 = acc[ai][0][m][1], u0 = acc[ai][1][m][0], u1 = acc[ai][1][m][1];
                u32x4 w; w.x = cvt_pk_bf16(silu_f(g0[0]) * u0[0], silu_f(g0[1]) * u0[1]); w.y = cvt_pk_bf16(silu_f(g0[2]) * u0[2], silu_f(g0[3]) * u0[3]);
                w.z = cvt_pk_bf16(silu_f(g1[0]) * u1[0], silu_f(g1[1]) * u1[1]); w.w = cvt_pk_bf16(silu_f(g1[2]) * u1[2], silu_f(g1[3]) * u1[3]);
                *(u32x4*)p = w; }
    }
};
struct EpiResF32 {
    static constexpr bool PERM = false, AFTER_DRAIN = false;
    const float* res0; const float* res1; int split; float* out; int ldc; float alpha, s;
    __device__ __forceinline__ void operator()(const f32x4 (&acc)[2][2][4][2], const Unit& u, int wr, int wc, int fr, int fq) const {
        const int col0 = u.pn * BM + wc * 32 + 4 * fq;
#pragma unroll
        for (int ai = 0; ai < 2; ++ai)
#pragma unroll
            for (int m = 0; m < 4; ++m) { const int r = u.pm * BM + ai * HALF + wr * 64 + m * 16 + fr;
                const float* rp = (r < split) ? res0 + (size_t)r * ldc : res1 + (size_t)(r - split) * ldc; float* op = out + (size_t)r * ldc;
#pragma unroll
                for (int bj = 0; bj < 2; ++bj)
#pragma unroll
                    for (int n = 0; n < 2; ++n) { const int c = col0 + bj * HALF + n * 16; const f32x4 x = *(const f32x4*)(rp + c); *(f32x4*)(op + c) = x * alpha + acc[ai][bj][m][n] * s; }
                if (m & 1) asm volatile("" ::: "memory"); }
    }
};
struct EpiPlainBf16 {
    static constexpr bool PERM = true, AFTER_DRAIN = false;
    bf16_t* O; int ldc;
    __device__ __forceinline__ void operator()(const f32x4 (&acc)[2][2][4][2], const Unit& u, int wr, int wc, int fr, int fq) const {
        const int row0 = u.pm * BM + wr * 64 + fr, col0 = u.pn * BM + wc * 32 + 8 * fq;
#pragma unroll
        for (int ai = 0; ai < 2; ++ai)
#pragma unroll
            for (int m = 0; m < 4; ++m) { bf16_t* rowp = O + (size_t)(row0 + ai * HALF + m * 16) * ldc + col0;
#pragma unroll
                for (int bj = 0; bj < 2; ++bj) { const f32x4 v0 = acc[ai][bj][m][0], v1 = acc[ai][bj][m][1];
                    u32x4 w; w.x = cvt_pk_bf16(v0[0], v0[1]); w.y = cvt_pk_bf16(v0[2], v0[3]); w.z = cvt_pk_bf16(v1[0], v1[1]); w.w = cvt_pk_bf16(v1[2], v1[3]);
                    *(u32x4*)(rowp + bj * HALF) = w; } }
    }
};
template <class Epi, class Sched, bool ALIGN_EPI = false, bool SP2 = false>
__device__ __forceinline__ void gemm_phase(PG8_LAS unsigned char* lds, const Gemm g, const Sched& S, const Epi& E, const int wid) {
    int lane_; asm volatile("v_mbcnt_lo_u32_b32 %0, -1, 0\n\tv_mbcnt_hi_u32_b32 %0, -1, %0" : "=v"(lane_));
    const int lane = lane_, tid = wid * 64 + lane, wr = wid >> 2, wc = wid & 3, fr = lane & 15, fq = lane >> 4;
    const int K = g.K, nt = K / BK;
    unsigned voffA[2], voffB[2];
#pragma unroll
    for (int i = 0; i < 2; ++i) { int R, C; stage_rc(tid * 16 + i * 8192, R, C); const int Rb = Epi::PERM ? ((R & ~31) + perm32(R & 31)) : R;
        voffA[i] = (unsigned)(R * K + C) * 2u; voffB[i] = (unsigned)(Rb * K + C) * 2u; }
    const size_t kstep = (size_t)(BK * 2);
    const size_t hstep = (size_t)HALF * K * 2;
    const size_t tstep = 2 * hstep;
    const unsigned ldsw = (unsigned)wid * 1024u;
    const int aoff = lds_byte(wr * 64 + fr, fq * 8), boff = lds_byte(wc * 32 + fr, fq * 8);
#define PG8_SA(b, h) (((b) * 2 + (h)) * HTB)
#define PG8_SB(b, h) ((4 + (b) * 2 + (h)) * HTB)
#define PG8_STAGE(bufoff, gbase, voff) do { _Pragma("unroll") for (int _i = 0; _i < 2; ++_i) \
        __builtin_amdgcn_global_load_lds((const unsigned*)((const char*)(gbase) + (voff)[_i]), (PG8_LAS unsigned*)(lds + (bufoff) + ldsw + _i * 8192), 16, 0, 0); } while (0)
#define PG8_LDA(dst, b, h) do { _Pragma("unroll") for (int m = 0; m < 4; ++m) _Pragma("unroll") for (int k = 0; k < 2; ++k) dst[m][k] = *(const PG8_LAS bf16x8*)(lds + PG8_SA(b, h) + aoff + m * 2048 + k * 1024); } while (0)
#define PG8_LDB(dst, b, h) do { _Pragma("unroll") for (int n = 0; n < 2; ++n) _Pragma("unroll") for (int k = 0; k < 2; ++k) dst[n][k] = *(const PG8_LAS bf16x8*)(lds + PG8_SB(b, h) + boff + n * 2048 + k * 1024); } while (0)
#define PG8_MMA(ai, bj, At, Bt) do { __builtin_amdgcn_s_setprio(1); _Pragma("unroll") for (int m = 0; m < 4; ++m) _Pragma("unroll") for (int n = 0; n < 2; ++n) _Pragma("unroll") for (int k = 0; k < 2; ++k) \
        acc[ai][bj][m][n] = __builtin_amdgcn_mfma_f32_16x16x32_bf16(Bt[n][k], At[m][k], acc[ai][bj][m][n], 0, 0, 0); __builtin_amdgcn_s_setprio(0); } while (0)
#define PG8_WAIT_V(n) asm volatile("s_waitcnt vmcnt(" #n ")" ::: "memory")
#define PG8_WAIT_L(n) asm volatile("s_waitcnt lgkmcnt(" #n ")" ::: "memory")
#define PG8_BAR __builtin_amdgcn_s_barrier()
#define PG8_SCHED __builtin_amdgcn_sched_barrier(0)
    Unit cur, nxt; int ui = 0;
    if (!S.next(0, cur)) return;
    f32x4 acc[2][2][4][2];
#pragma unroll
    for (int a = 0; a < 2; ++a)
#pragma unroll
        for (int b = 0; b < 2; ++b)
#pragma unroll
            for (int m = 0; m < 4; ++m)
#pragma unroll
                for (int n = 0; n < 2; ++n) acc[a][b][m][n] = (f32x4){0.f, 0.f, 0.f, 0.f};
    bf16x8 At[4][2], B0[2][2], B1[2][2];
    const char* cA = (const char*)g.A + (size_t)cur.pm * tstep; const char* cB = (const char*)g.Bt + (size_t)cur.pn * tstep;
    S.a_ready(cur);
    if constexpr (SP2) {
        PG8_STAGE(PG8_SB(0, 0), cB, voffB); PG8_STAGE(PG8_SB(0, 1), cB + hstep, voffB); PG8_STAGE(PG8_SA(0, 0), cA, voffA); PG8_STAGE(PG8_SA(0, 1), cA + hstep, voffA);
        if (wr == 1) PG8_BAR;
        PG8_WAIT_V(2); PG8_BAR;
        PG8_STAGE(PG8_SB(1, 0), cB + kstep, voffB); PG8_STAGE(PG8_SA(1, 0), cA + kstep, voffA); PG8_STAGE(PG8_SB(1, 1), cB + hstep + kstep, voffB);
        PG8_WAIT_V(6); PG8_BAR;
    } else {
        PG8_STAGE(PG8_SB(0, 0), cB, voffB); PG8_STAGE(PG8_SA(0, 0), cA, voffA); PG8_STAGE(PG8_SB(0, 1), cB + hstep, voffB); PG8_STAGE(PG8_SA(0, 1), cA + hstep, voffA);
        if (wr == 1) PG8_BAR;
        PG8_WAIT_V(4); PG8_BAR;
        PG8_STAGE(PG8_SB(1, 0), cB + kstep, voffB); PG8_STAGE(PG8_SA(1, 0), cA + kstep, voffA); PG8_STAGE(PG8_SB(1, 1), cB + hstep + kstep, voffB);
        PG8_WAIT_V(6); PG8_BAR;
    }
    for (;;) {
        const bool has_next = S.next(ui + 1, nxt);
        const char* nA = has_next ? (const char*)g.A + (size_t)nxt.pm * tstep : cA; const char* nB = has_next ? (const char*)g.Bt + (size_t)nxt.pn * tstep : cB;
        for (int t = 0; t < nt; t += 2) {
            const bool last = (t == nt - 2);
            const char* a1 = cA + (size_t)(t + 1) * kstep;
            const char* a2 = last ? nA : cA + (size_t)(t + 2) * kstep; const char* b2 = last ? nB : cB + (size_t)(t + 2) * kstep;
            const char* a3 = a2 + kstep; const char* b3 = b2 + kstep;
            if (last && has_next) S.a_ready(nxt);
            if constexpr (SP2) {
            PG8_LDB(B0, 0, 0); PG8_LDB(B1, 0, 1); PG8_SCHED; PG8_LDA(At, 0, 0); PG8_STAGE(PG8_SA(1, 1), a1 + hstep, voffA);
            PG8_WAIT_V(8); PG8_WAIT_L(0); PG8_BAR; PG8_MMA(0, 0, At, B0); PG8_MMA(0, 1, At, B1); PG8_BAR; PG8_SCHED;
            PG8_LDA(At, 0, 1); PG8_STAGE(PG8_SB(0, 0), b2, voffB); PG8_STAGE(PG8_SB(0, 1), b2 + hstep, voffB); PG8_STAGE(PG8_SA(0, 0), a2, voffA);
            PG8_WAIT_V(8); PG8_WAIT_L(0); PG8_BAR; PG8_MMA(1, 0, At, B0); PG8_MMA(1, 1, At, B1); PG8_BAR; PG8_SCHED;
            PG8_LDB(B0, 1, 0); PG8_LDB(B1, 1, 1); PG8_SCHED; PG8_LDA(At, 1, 0); PG8_STAGE(PG8_SA(0, 1), a2 + hstep, voffA);
            PG8_WAIT_V(8); PG8_WAIT_L(0); PG8_BAR; PG8_MMA(0, 0, At, B0); PG8_MMA(0, 1, At, B1); PG8_BAR; PG8_SCHED;
            PG8_LDA(At, 1, 1); PG8_STAGE(PG8_SB(1, 0), b3, voffB); PG8_STAGE(PG8_SB(1, 1), b3 + hstep, voffB); PG8_STAGE(PG8_SA(1, 0), a3, voffA);
            PG8_WAIT_V(8); PG8_WAIT_L(0); PG8_BAR; PG8_MMA(1, 0, At, B0); PG8_MMA(1, 1, At, B1); PG8_BAR; PG8_SCHED;
            } else {
            PG8_LDB(B0, 0, 0); PG8_SCHED; PG8_LDA(At, 0, 0); PG8_STAGE(PG8_SA(1, 1), a1 + hstep, voffA);
            PG8_WAIT_L(8); PG8_BAR; PG8_WAIT_L(0); PG8_MMA(0, 0, At, B0); PG8_BAR; PG8_SCHED;
            PG8_LDB(B1, 0, 1); PG8_STAGE(PG8_SB(0, 0), b2, voffB);
            PG8_BAR; PG8_WAIT_L(0); PG8_MMA(0, 1, At, B1); PG8_BAR;
            PG8_LDA(At, 0, 1); PG8_STAGE(PG8_SA(0, 0), a2, voffA);
            PG8_BAR; PG8_WAIT_L(0); PG8_MMA(1, 0, At, B0); PG8_BAR; PG8_SCHED;
            PG8_STAGE(PG8_SB(0, 1), b2 + hstep, voffB);
            PG8_WAIT_V(6); PG8_BAR; PG8_MMA(1, 1, At, B1); PG8_BAR;
            PG8_LDB(B0, 1, 0); PG8_SCHED; PG8_LDA(At, 1, 0); PG8_STAGE(PG8_SA(0, 1), a2 + hstep, voffA);
            PG8_WAIT_L(8); PG8_BAR; PG8_WAIT_L(0); PG8_MMA(0, 0, At, B0); PG8_BAR; PG8_SCHED;
            PG8_LDB(B1, 1, 1); PG8_STAGE(PG8_SB(1, 0), b3, voffB);
            PG8_BAR; PG8_WAIT_L(0); PG8_MMA(0, 1, At, B1); PG8_BAR;
            PG8_LDA(At, 1, 1); PG8_STAGE(PG8_SA(1, 0), a3, voffA);
            PG8_BAR; PG8_WAIT_L(0); PG8_MMA(1, 0, At, B0); PG8_BAR; PG8_SCHED;
            PG8_STAGE(PG8_SB(1, 1), b3 + hstep, voffB);
            PG8_WAIT_V(6); PG8_BAR; PG8_MMA(1, 1, At, B1); PG8_BAR;
            }
        }
        if constexpr (ALIGN_EPI) { if (wr == 0) PG8_BAR; }
        if constexpr (!Epi::AFTER_DRAIN) { E(acc, cur, wr, wc, fr, fq); S.done(cur); }
        if (!has_next) break;
#pragma unroll
        for (int a = 0; a < 2; ++a)
#pragma unroll
            for (int b = 0; b < 2; ++b)
#pragma unroll
                for (int m = 0; m < 4; ++m)
#pragma unroll
                    for (int n = 0; n < 2; ++n) acc[a][b][m][n] = (f32x4){0.f, 0.f, 0.f, 0.f};
        cur = nxt; cA = nA; cB = nB; ++ui;
        if constexpr (ALIGN_EPI) { if (wr == 1) PG8_BAR; }
    }
    PG8_WAIT_V(0);
    if constexpr (!ALIGN_EPI) { if (wr == 0) PG8_BAR; }
    PG8_BAR;
    if constexpr (Epi::AFTER_DRAIN) { E.fused(acc, cur, wr, wc, fr, fq, lds, wid, lane); S.done(cur); }
#undef PG8_SA
#undef PG8_SB
#undef PG8_STAGE
#undef PG8_LDA
#undef PG8_LDB
#undef PG8_MMA
#undef PG8_WAIT_V
#undef PG8_WAIT_L
#undef PG8_BAR
#undef PG8_SCHED
}
}
constexpr int NWAVES = 8, NTHR = 512;
constexpr int D = 1024, BATCH = 16, SEQ = 2048, DECB = 128, DECT = 8, PAST = 8192, PAGE = 128, NPAGES = 64;
constexpr int MP = BATCH * SEQ, MS = DECB * DECT, M = MP + MS;
constexpr int FF = 2816, NGU = 2 * FF, INW = 3408, INWP = 3584;
constexpr int C_Q = 0, C_K = 512, C_V = 640, C_QI = 768, C_KI = 1280, C_WI = 1344, C_QKV = 1352, C_Z = 2888, C_BG = 3400, C_AG = 3404;
constexpr int GH = 4, GDK = 128, GDV = 128, CONVC = 1536, NCHUNK = SEQ / 64, GDN_UNITS = 2048 + DECB * GH;
constexpr int KSEL = 256, LS = PAST + DECT, SCS_LD = 8208;
constexpr float LN_EPS = 1e-5f, NORM_EPS = 1e-6f, ALPHA = 1.189207115002721f;
constexpr size_t O_YP = 0, O_YS = 33554432, O_KP = 34603008, O_VP = 38797312, O_IP = 42991616, O_GP = 45088768, O_CP = 46137344, O_KS = 46211072, O_VS = 46342144, O_IS = 46473216, O_GS = 46538752, O_CS = 54927360, O_END = 55517184;
constexpr size_t MiB = 1u << 20;
constexpr size_t WS_CTL = 0, CTL_ZERO_BYTES = 1 * MiB, WS_ROPE = 1 * MiB;
constexpr size_t WS_WGU1 = 2 * MiB, WS_WD1 = 13 * MiB, WS_WIN = 19 * MiB, WS_WO = 26 * MiB, WS_WGU2 = 28 * MiB, WS_WD2 = 39 * MiB;
constexpr size_t WS_XB = 48 * MiB, WS_X1 = 116 * MiB, WS_X2 = 248 * MiB, WS_R = 380 * MiB, WS_H = 512 * MiB, WS_P = 696 * MiB;
constexpr size_t WS_QB = 928 * MiB, WS_QI = 961 * MiB, WS_KB = 994 * MiB, WS_VT = 1003 * MiB, WS_KI = 1011 * MiB, WS_WI = 1016 * MiB, WS_BG = 1018 * MiB;
constexpr size_t WS_CAT = 1020 * MiB, WS_OG = 1086 * MiB, WS_GSC = 1152 * MiB, WS_GL = 1334 * MiB, WS_SCS = 1336 * MiB, WS_END = 1370 * MiB;
constexpr size_t GSC_UNIT = 73728;
static_assert(WS_WGU1 + (size_t)NGU * D * 2 <= WS_WD1 && WS_WD1 + (size_t)D * FF * 2 <= WS_WIN && WS_WIN + (size_t)INWP * D * 2 <= WS_WO && WS_WO + (size_t)D * D * 2 <= WS_WGU2, "ws map 1");
static_assert(WS_XB + (size_t)M * D * 2 <= WS_X1 && WS_X1 + (size_t)M * D * 4 <= WS_X2 && WS_X2 + (size_t)M * D * 4 <= WS_R && WS_R + (size_t)M * D * 4 <= WS_H && WS_H + (size_t)M * FF * 2 <= WS_P && WS_P + (size_t)M * INWP * 2 <= WS_QB, "ws map 2");
static_assert(WS_QB + (size_t)M * 512 * 2 <= WS_QI && WS_QI + (size_t)M * 512 * 2 <= WS_KB && WS_KB + (size_t)M * 128 * 2 <= WS_VT && WS_VT + (size_t)MP * 128 * 2 <= WS_KI && WS_KI + (size_t)M * 64 * 2 <= WS_WI && WS_WI + (size_t)M * 8 * 4 <= WS_BG && WS_BG + (size_t)M * 8 * 4 <= WS_CAT, "ws map 3");
static_assert(WS_CAT + (size_t)M * D * 2 <= WS_OG && WS_OG + (size_t)M * 512 * 4 <= WS_GSC && WS_GSC + (size_t)GDN_UNITS * GSC_UNIT <= WS_GL && WS_SCS + (size_t)MS * SCS_LD * 4 <= WS_END, "ws map 4");
constexpr int CW_TMO = 0, CW_CODE = 1, CW_BAR = 4096;
constexpr int RING_OFF = 0, RING_BYTES = 151552;
constexpr int LDSCTL_OFF = RING_BYTES, MISC_OFF = LDSCTL_OFF + 320;
constexpr int LDS_BYTES = 152576;
static_assert(MISC_OFF + 128 <= LDS_BYTES, "LDS map");

#define GAS __attribute__((address_space(1)))
#define LAS __attribute__((address_space(3)))
typedef unsigned short bf16;
typedef _Float16 f16;
typedef unsigned v4u __attribute__((ext_vector_type(4)));
typedef unsigned v2u __attribute__((ext_vector_type(2)));
typedef float f32x4 __attribute__((ext_vector_type(4)));
typedef float f32x2 __attribute__((ext_vector_type(2)));
typedef float f32x16 __attribute__((ext_vector_type(16)));
typedef short bf16x8 __attribute__((ext_vector_type(8)));
typedef short s16x4 __attribute__((ext_vector_type(4)));
typedef _Float16 f16x8 __attribute__((ext_vector_type(8)));
typedef GAS unsigned gu32;
#define RLX_AGENT __ATOMIC_RELAXED, __HIP_MEMORY_SCOPE_AGENT
#define LDS_WAIT() asm volatile("s_waitcnt lgkmcnt(0)" ::: "memory")
#define VM_WAIT() asm volatile("s_waitcnt vmcnt(0)" ::: "memory")
__device__ __forceinline__ unsigned f2bf(float f) { unsigned u = __builtin_bit_cast(unsigned, f); return (u + 0x7fffu + ((u >> 16) & 1u)) >> 16; }
__device__ __forceinline__ unsigned pk2(float lo, float hi) { return f2bf(lo) | (f2bf(hi) << 16); }
__device__ __forceinline__ float bf2f(unsigned short b) { return __builtin_bit_cast(float, (unsigned)b << 16); }
__device__ __forceinline__ float bflo(unsigned w) { return __builtin_bit_cast(float, w << 16); }
__device__ __forceinline__ float bfhi(unsigned w) { return __builtin_bit_cast(float, w & 0xffff0000u); }
__device__ __forceinline__ float wave_sum(float v) {
#pragma unroll
    for (int o = 1; o < 64; o <<= 1) v += __shfl_xor(v, o);
    return v;
}
__device__ __forceinline__ float wave_max(float v) {
#pragma unroll
    for (int o = 1; o < 64; o <<= 1) v = fmaxf(v, __shfl_xor(v, o));
    return v;
}
__device__ __forceinline__ int lane_fresh() { int l; asm volatile("v_mbcnt_lo_u32_b32 %0, -1, 0\n\tv_mbcnt_hi_u32_b32 %0, -1, %0" : "=v"(l)); return l; }
__device__ __forceinline__ int lane_dep(int dep) { int l; asm volatile("v_mbcnt_lo_u32_b32 %0, -1, 0\n\tv_mbcnt_hi_u32_b32 %0, -1, %0" : "=v"(l) : "s"(dep)); return l; }
#define XB_TMO      128
#define XB_XCNT(j)  (256  + 64 * (j))
#define XB_XSUB(j)  (1280 + 64 * (j))
#define XB_XGEN(j)  (2304 + 64 * (j))
#define XB_TOP      3328
#define XB_TOPGEN   3392
#define XCD_BAR_WORDS 3456
#define XB_SPIN_CAP (1u << 18)

__device__ __forceinline__ unsigned xb_ld(unsigned* p)              { return __hip_atomic_load(p, __ATOMIC_RELAXED, __HIP_MEMORY_SCOPE_AGENT); }
__device__ __forceinline__ unsigned xb_add(unsigned* p, unsigned v) { return __hip_atomic_fetch_add(p, v, __ATOMIC_RELAXED, __HIP_MEMORY_SCOPE_AGENT); }
__device__ __forceinline__ unsigned xb_xcc_id() { return (unsigned)__builtin_amdgcn_s_getreg((3 << 11) | 20) & 0xFu; }
#define XB_SPIN(cond, bar) do { unsigned _sp = 0; while (cond) { __builtin_amdgcn_s_sleep(1); \
    if ((++_sp & 255u) == 0u) { if (xb_ld(&(bar)[XB_TMO])) break; if (_sp > XB_SPIN_CAP) { atomicAdd(&(bar)[XB_TMO], 1u); break; } } } } while (0)

struct XcdBarrier {
    int wave; unsigned* bar; unsigned x;
    volatile LAS unsigned* st;
};

__device__ __forceinline__ XcdBarrier xcd_barrier_post(unsigned* bar, volatile LAS unsigned* st, int wave) {
    XcdBarrier b; b.wave = wave; b.bar = bar; b.x = xb_xcc_id(); b.st = st;
    if (wave == 0 && lane_fresh() == 0) (void)xb_add(&bar[XB_XCNT(b.x)], 1u);
    return b;
}
__device__ __forceinline__ void xcd_barrier_complete(unsigned* bar, unsigned x, unsigned& nloc, unsigned& nx) {
    const unsigned G = gridDim.x * gridDim.y * gridDim.z;
    unsigned sum, cnt, mine, sp = 0u;
    for (;;) {
        sum = 0u; cnt = 0u; mine = 0u;
#pragma unroll
        for (unsigned j = 0; j < 16; ++j) { const unsigned c = xb_ld(&bar[XB_XCNT(j)]); sum += c; cnt += (c > 0u) ? 1u : 0u; mine = (j == x) ? c : mine; }
        if (sum == G) break;
        __builtin_amdgcn_s_sleep(1);
        if ((++sp & 255u) == 0u) { if (xb_ld(&bar[XB_TMO])) break; if (sp > XB_SPIN_CAP) { atomicAdd(&bar[XB_TMO], 1u); break; } }
    }
    nloc = mine > 0u ? mine : 1u; nx = cnt > 0u ? cnt : 1u;
}

__device__ __forceinline__ void xcd_barrier(const XcdBarrier& b) {
    asm volatile("s_waitcnt vmcnt(0)" ::: "memory");
    __syncthreads();
    if (b.wave == 0 && lane_fresh() == 0) {
        unsigned* bar = b.bar;
        __builtin_amdgcn_s_waitcnt(0);
        unsigned nloc = b.st[0], nx = b.st[1];
        if (nloc == 0u) { xcd_barrier_complete(bar, b.x, nloc, nx); b.st[0] = nloc; b.st[1] = nx; }
        const unsigned old = xb_add(&bar[XB_XSUB(b.x)], 1u);
        const unsigned gen = old / nloc;
        if (old + 1u == (gen + 1u) * nloc) {
            __builtin_amdgcn_fence(__ATOMIC_RELEASE, "agent");
            asm volatile("s_waitcnt vmcnt(0)" ::: "memory");
            const unsigned og = xb_add(&bar[XB_TOP], 1u);
            const unsigned tg = og / nx;
            if (og + 1u == (tg + 1u) * nx) xb_add(&bar[XB_TOPGEN], 1u);
            else XB_SPIN(xb_ld(&bar[XB_TOPGEN]) == tg, bar);
            __builtin_amdgcn_fence(__ATOMIC_ACQUIRE, "agent");
            xb_add(&bar[XB_XGEN(b.x)], 1u);
            asm volatile("s_waitcnt vmcnt(0)" ::: "memory");
        } else {
            XB_SPIN(xb_ld(&bar[XB_XGEN(b.x)]) == gen, bar);
            __builtin_amdgcn_fence(__ATOMIC_ACQUIRE, "agent");
            asm volatile("s_waitcnt vmcnt(0)" ::: "memory");
        }
    }
    __syncthreads();
}
struct Frame {
    LAS unsigned char* lds;
    volatile LAS unsigned* MISC;
    gu32* ctl;
    int wave, G, bx;
    float* out; unsigned char* ws;
};
struct Args { const float* in[26]; float* out; unsigned char* ws; int ph_lo, ph_hi; };
#define WSP(T, off) ((T*)(F.ws + (off)))

__device__ __forceinline__ void p0_transpose_item(const float* W, int K, int N, bf16* WT, int drow0, int k0, int n0, LAS float* scr, int lane) {
    const int nc = n0 + (lane & 31); const bool ok = nc < N;
#pragma unroll 8
    for (int i = 0; i < 32; ++i) { const int kk = 2 * i + (lane >> 5); scr[kk * 33 + (lane & 31)] = ok ? W[(size_t)(k0 + kk) * N + nc] : 0.f; }
    LDS_WAIT(); asm volatile("" ::: "memory");
    const int c = lane & 7;
#pragma unroll
    for (int j = 0; j < 4; ++j) { const int n = (lane >> 3) + 8 * j; const LAS float* s = scr + (8 * c) * 33 + n;
        v4u o; o.x = pk2(s[0 * 33], s[1 * 33]); o.y = pk2(s[2 * 33], s[3 * 33]); o.z = pk2(s[4 * 33], s[5 * 33]); o.w = pk2(s[6 * 33], s[7 * 33]);
        *(GAS v4u*)(WT + (size_t)(drow0 + n) * K + k0 + 8 * c) = o; }
    LDS_WAIT(); asm volatile("" ::: "memory");
}
__device__ __forceinline__ void p0_prologue(Frame& F, const Args& A) {
    LAS float* scr = (LAS float*)(F.lds + RING_OFF + F.wave * 16384);
    const int lane = lane_fresh();
    const int gw = F.bx * NWAVES + F.wave, NGW = F.G * NWAVES;
    constexpr int I_GU = (D / 64) * (FF / 32), I_D = (FF / 64) * (D / 32), I_IN = (D / 64) * (INWP / 32), I_O = (D / 64) * (D / 32);
    constexpr int NITEMS = 4 * I_GU + 2 * I_D + I_IN + I_O;
    for (int it = gw; it < NITEMS; it += NGW) {
        int r = it;
        if (r < 4 * I_GU) {
            const int which = r / I_GU; r -= which * I_GU; const int nblk = FF / 32, kb = r / nblk, nb = r % nblk, n0 = 32 * nb;
            const float* W = which == 0 ? A.in[8] : which == 1 ? A.in[9] : which == 2 ? A.in[21] : A.in[22];
            bf16* WT = WSP(bf16, (which < 2) ? WS_WGU1 : WS_WGU2);
            const int drow0 = 256 * (n0 >> 7) + (n0 & 127) + ((which & 1) ? 128 : 0);
            p0_transpose_item(W, D, FF, WT, drow0, 64 * kb, n0, scr, lane); continue; }
        r -= 4 * I_GU;
        if (r < 2 * I_D) { const int which = r / I_D; r -= which * I_D; const int nblk = D / 32, kb = r / nblk, nb = r % nblk;
            p0_transpose_item(which ? A.in[23] : A.in[10], FF, D, WSP(bf16, which ? WS_WD2 : WS_WD1), 32 * nb, 64 * kb, 32 * nb, scr, lane); continue; }
        r -= 2 * I_D;
        if (r < I_IN) { const int nblk = INWP / 32, kb = r / nblk, nb = r % nblk;
            p0_transpose_item(A.in[13], D, INW, WSP(bf16, WS_WIN), 32 * nb, 64 * kb, 32 * nb, scr, lane); continue; }
        r -= I_IN;
        { const int nblk = D / 32, kb = r / nblk, nb = r % nblk; p0_transpose_item(A.in[18], D, D, WSP(bf16, WS_WO), 32 * nb, 64 * kb, 32 * nb, scr, lane); }
    }
    bf16* XB = WSP(bf16, WS_XB);
    for (int m = gw; m < M; m += NGW) {
        const float* xr = (m < MP) ? A.in[0] + (size_t)m * D : A.in[1] + (size_t)(m - MP) * D;
        const GAS f32x4* x4 = (const GAS f32x4*)xr + lane; GAS unsigned long long* o8 = (GAS unsigned long long*)(XB + (size_t)m * D) + lane;
#pragma unroll
        for (int j = 0; j < 4; ++j) { const f32x4 v = x4[64 * j]; o8[64 * j] = (unsigned long long)pk2(v.x, v.y) | ((unsigned long long)pk2(v.z, v.w) << 32); }
    }
    float* rope = WSP(float, WS_ROPE);
    for (int i = gw * 64 + lane; i < (SEQ + DECT) * 8; i += NGW * 64) {
        const int pi = i >> 3, f = i & 7; const float pos = (float)(pi < SEQ ? pi : PAST + pi - SEQ);
        const float invf = powf(500000.0f, -(float)f / 8.0f); const float ang = pos * invf;
        rope[pi * 16 + f] = cosf(ang); rope[pi * 16 + 8 + f] = sinf(ang);
    }
}
__device__ __forceinline__ void ln_phase(Frame& F, const float* src, const float* g, const float* b, float* dstf, bf16* dstb) {
    const int lane = lane_fresh();
    const int gw = F.bx * NWAVES + F.wave, NGW = F.G * NWAVES;
    f32x4 gv[4], bv[4];
#pragma unroll
    for (int j = 0; j < 4; ++j) { gv[j] = ((const GAS f32x4*)g)[lane + 64 * j]; bv[j] = ((const GAS f32x4*)b)[lane + 64 * j]; }
    for (int m = gw; m < M; m += NGW) {
        const GAS f32x4* xr = (const GAS f32x4*)(src + (size_t)m * D) + lane;
        f32x4 v[4]; float s = 0.f;
#pragma unroll
        for (int j = 0; j < 4; ++j) { v[j] = xr[64 * j]; s += (v[j].x + v[j].y) + (v[j].z + v[j].w); }
        const float mean = wave_sum(s) * (1.f / D); float s2 = 0.f;
#pragma unroll
        for (int j = 0; j < 4; ++j) { v[j] = v[j] - mean; s2 += (v[j].x * v[j].x + v[j].y * v[j].y) + (v[j].z * v[j].z + v[j].w * v[j].w); }
        const float rstd = 1.f / sqrtf(wave_sum(s2) * (1.f / D) + LN_EPS);
#pragma unroll
        for (int j = 0; j < 4; ++j) { v[j] = v[j] * rstd * gv[j] + bv[j]; }
        if (dstf) { GAS f32x4* o = (GAS f32x4*)(dstf + (size_t)m * D) + lane;
#pragma unroll
            for (int j = 0; j < 4; ++j) o[64 * j] = v[j]; }
        if (dstb) { GAS unsigned long long* o8 = (GAS unsigned long long*)(dstb + (size_t)m * D) + lane;
#pragma unroll
            for (int j = 0; j < 4; ++j) o8[64 * j] = (unsigned long long)pk2(v[j].x, v[j].y) | ((unsigned long long)pk2(v[j].z, v[j].w) << 32); }
    }
}
__device__ __forceinline__ void post_phase(Frame& F, const Args& A) {
    const int lane = lane_fresh();
    const int gw = F.bx * NWAVES + F.wave, NGW = F.G * NWAVES;
    const bf16* P = WSP(bf16, WS_P); const float* rope = WSP(float, WS_ROPE);
    bf16* Qb = WSP(bf16, WS_QB); f16* QIh = WSP(f16, WS_QI); bf16* Kb = WSP(bf16, WS_KB); f16* KIh = WSP(f16, WS_KI); float* WI = WSP(float, WS_WI); float* BG = WSP(float, WS_BG);
    const f32x4 alog = *(const GAS f32x4*)A.in[15], dtb4 = *(const GAS f32x4*)A.in[16];
    const float a_exp[4] = {expf(alog.x), expf(alog.y), expf(alog.z), expf(alog.w)}; const float dtb[4] = {dtb4.x, dtb4.y, dtb4.z, dtb4.w};
    const int j8 = lane & 7; const bool rot = j8 < 2; const float sgn = (j8 == 0) ? -1.f : 1.f;
    for (int m = gw; m < M; m += NGW) {
        const bool prm = m < MP; const int ms = m - MP; const int b = prm ? (m >> 11) : (ms >> 3), t = prm ? (m & 2047) : (ms & 7), pi = prm ? t : SEQ + t;
        const bf16* p = P + (size_t)m * INWP;
        const int c3 = lane < 32 ? C_K + 8 * lane : (lane < 41 ? C_KI + 8 * (lane - 32) : C_BG);
        const v4u rq = *(const GAS v4u*)(p + C_Q + 8 * lane), ri = *(const GAS v4u*)(p + C_QI + 8 * lane);
        v4u r3 = (v4u){0u, 0u, 0u, 0u}; if (lane < 42) r3 = *(const GAS v4u*)(p + c3);
        const f32x4 c0 = *(const GAS f32x4*)(rope + pi * 16), c1 = *(const GAS f32x4*)(rope + pi * 16 + 4), s0 = *(const GAS f32x4*)(rope + pi * 16 + 8), s1 = *(const GAS f32x4*)(rope + pi * 16 + 12);
        const float cs[8] = {c0.x, c0.y, c0.z, c0.w, c1.x, c1.y, c1.z, c1.w}; const float sn[8] = {s0.x, s0.y, s0.z, s0.w, s1.x, s1.y, s1.z, s1.w};
        float xq[8], xi[8], x3[8];
#pragma unroll
        for (int e = 0; e < 4; ++e) { xq[2 * e] = bflo(rq[e]); xq[2 * e + 1] = bfhi(rq[e]); xi[2 * e] = bflo(ri[e]); xi[2 * e + 1] = bfhi(ri[e]); x3[2 * e] = bflo(r3[e]); x3[2 * e + 1] = bfhi(r3[e]); }
        const bool rot3 = rot && (lane < 16 || (lane >= 32 && lane < 40));
#pragma unroll
        for (int e = 0; e < 8; ++e) { const float pq = __shfl_xor(xq[e], 1), pi_ = __shfl_xor(xi[e], 1), p3 = __shfl_xor(x3[e], 1);
            if (rot) { xq[e] = xq[e] * cs[e] + sgn * pq * sn[e]; xi[e] = xi[e] * cs[e] + sgn * pi_ * sn[e]; }
            if (rot3) x3[e] = x3[e] * cs[e] + sgn * p3 * sn[e]; }
        { v4u w; const float qs = 0.125f * 1.4426950408889634f;
#pragma unroll
          for (int e = 0; e < 4; ++e) w[e] = pk2(xq[2 * e] * qs, xq[2 * e + 1] * qs);
          *(GAS v4u*)(Qb + (size_t)m * 512 + 8 * lane) = w;
          f16x8 h;
#pragma unroll
          for (int e = 0; e < 8; ++e) h[e] = (f16)xi[e];
          *(GAS f16x8*)(QIh + (size_t)m * 512 + 8 * lane) = h; }
        if (lane < 32) {
            float* o = F.out + (lane < 16 ? (prm ? O_KP + (size_t)m * 128 : O_KS + (size_t)ms * 128) + 8 * lane : (prm ? O_VP + (size_t)m * 128 : O_VS + (size_t)ms * 128) + 8 * (lane - 16));
            *(GAS f32x4*)o = (f32x4){x3[0], x3[1], x3[2], x3[3]}; *(GAS f32x4*)(o + 4) = (f32x4){x3[4], x3[5], x3[6], x3[7]};
            if (lane < 16) { v4u w;
#pragma unroll
                for (int e = 0; e < 4; ++e) w[e] = pk2(x3[2 * e], x3[2 * e + 1]);
                *(GAS v4u*)(Kb + (size_t)m * 128 + 8 * lane) = w; }
        } else if (lane < 40) {
            float* o = F.out + (prm ? O_IP + (size_t)m * 64 : O_IS + (size_t)ms * 64) + 8 * (lane - 32);
            *(GAS f32x4*)o = (f32x4){x3[0], x3[1], x3[2], x3[3]}; *(GAS f32x4*)(o + 4) = (f32x4){x3[4], x3[5], x3[6], x3[7]};
            f16x8 h;
#pragma unroll
            for (int e = 0; e < 8; ++e) h[e] = (f16)x3[e];
            *(GAS f16x8*)(KIh + (size_t)m * 64 + 8 * (lane - 32)) = h;
        } else if (lane == 40) {
            const float ws = 0.35355339059327373f * 0.125f;
            *(GAS f32x4*)(WI + (size_t)m * 8) = (f32x4){x3[0] * ws, x3[1] * ws, x3[2] * ws, x3[3] * ws}; *(GAS f32x4*)(WI + (size_t)m * 8 + 4) = (f32x4){x3[4] * ws, x3[5] * ws, x3[6] * ws, x3[7] * ws};
        } else if (lane == 41) {
            float be[4], gg[4];
#pragma unroll
            for (int e = 0; e < 4; ++e) { be[e] = 1.f / (1.f + expf(-x3[e])); const float ag = x3[4 + e] + dtb[e]; gg[e] = -a_exp[e] * (ag > 20.f ? ag : log1pf(expf(ag))); }
            *(GAS f32x4*)(BG + (size_t)m * 8) = (f32x4){be[0], be[1], be[2], be[3]}; *(GAS f32x4*)(BG + (size_t)m * 8 + 4) = (f32x4){gg[0], gg[1], gg[2], gg[3]};
        }
        const int trow = prm ? t - (SEQ - 3) : t - (DECT - 3);
        if (trow >= 0) { float* co = F.out + (prm ? O_CP : O_CS) + ((size_t)b * 3 + trow) * CONVC;
#pragma unroll
            for (int k = 0; k < 3; ++k) { const v4u rc = *(const GAS v4u*)(p + C_QKV + 512 * k + 8 * lane);
                *(GAS f32x4*)(co + 512 * k + 8 * lane) = (f32x4){bflo(rc[0]), bfhi(rc[0]), bflo(rc[1]), bfhi(rc[1])}; *(GAS f32x4*)(co + 512 * k + 8 * lane + 4) = (f32x4){bflo(rc[2]), bfhi(rc[2]), bflo(rc[3]), bfhi(rc[3])}; } }
    }
    LAS bf16* tile = (LAS bf16*)(F.lds + RING_OFF + F.wave * 16384);
    bf16* VT = WSP(bf16, WS_VT);
    for (int it = gw; it < BATCH * 2 * (SEQ / 64); it += NGW) {
        const int tb = it % (SEQ / 64), g = (it / (SEQ / 64)) & 1, b = it / (2 * (SEQ / 64));
        for (int tt = 0; tt < 64; ++tt) tile[tt * 66 + lane] = P[(size_t)(b * SEQ + tb * 64 + tt) * INWP + C_V + g * 64 + lane];
        LDS_WAIT(); asm volatile("" ::: "memory");
        { const int kk = lane & 31, pos = ((kk >> 2) & 1) * 16 + ((kk >> 4) * 2 + ((kk >> 3) & 1)) * 4 + (kk & 3); bf16* vt = VT + (((size_t)(b * 2 + g) * (SEQ / 32) + 2 * tb + (lane >> 5)) * 64) * 32 + pos;
          for (int d = 0; d < 64; ++d) vt[d * 32] = tile[lane * 66 + d]; }
        LDS_WAIT(); asm volatile("" ::: "memory");
    }
}
#define MFMA32 __builtin_amdgcn_mfma_f32_32x32x16_bf16
__device__ __forceinline__ int crow(int r, int hh) { return (r & 3) + 8 * (r >> 2) + 4 * hh; }
__device__ __forceinline__ f32x16 zero16() { f32x16 z; for (int i = 0; i < 16; ++i) z[i] = 0.f; return z; }
constexpr int GT_LD = 272;
constexpr int GP_HALF = 72704;
constexpr int GP_Q = 0, GP_K = 17408, GP_V = 34816, GP_A = 52224, GP_G = 69632, GP_B = 69888, GP_EG = 70144;
__device__ __forceinline__ void gdn_prep_phase(Frame& F, const Args& A) {
    const int half = F.wave >> 2, hw = F.wave & 3;
    LAS unsigned char* L = F.lds + RING_OFF + half * GP_HALF;
    const bf16* P = WSP(bf16, WS_P); const float* BG = WSP(float, WS_BG); const float* cw = A.in[14];
    const float* sconv = A.in[6];
    const int nit = (GDN_UNITS + 2 * F.G - 1) / (2 * F.G);
    for (int it = 0; it < nit; ++it) {
        const int lane = lane_fresh();
        const int ht = (hw << 6) | lane;
        const int u = (it * F.G + F.bx) * 2 + half; const bool live = u < GDN_UNITS;
        const bool smp = u >= 2048; const int us = u - 2048;
        const int c = smp ? 0 : (u & 31), h = smp ? (us & 3) : ((u >> 5) & 3), b = smp ? (us >> 2) : (u >> 7);
        const size_t mrow0 = smp ? (size_t)MP + (size_t)b * DECT : (size_t)b * SEQ;
        const int nreal = smp ? DECT : 64;
        unsigned char* gs = F.ws + WS_GSC + (size_t)u * GSC_UNIT;
        if (live) {
            float w[3][4][2];
#pragma unroll
            for (int p = 0; p < 3; ++p)
#pragma unroll
                for (int j = 0; j < 4; ++j) { const f32x2 t = *(const GAS f32x2*)(cw + j * CONVC + p * 512 + h * 128 + 2 * lane); w[p][j][0] = t.x; w[p][j][1] = t.y; }
            unsigned xr[3][3];
            const int t0 = c * 64 + hw * 16;
#pragma unroll
            for (int j = 0; j < 3; ++j) { const int tt = t0 - 3 + j;
#pragma unroll
                for (int p = 0; p < 3; ++p) { unsigned xv = 0u;
                    if (tt >= 0) { if (!smp || tt < nreal) xv = *(const GAS unsigned*)(P + (mrow0 + tt) * INWP + C_QKV + p * 512 + h * 128 + 2 * lane); }
                    else if (smp) { const f32x2 sv = *(const GAS f32x2*)(sconv + ((size_t)b * 3 + (3 + tt)) * CONVC + p * 512 + h * 128 + 2 * lane); xv = pk2(sv.x, sv.y); }
                    xr[p][j] = xv; } }
            for (int i = 0; i < 16; ++i) {
                const int tt = t0 + i; float y[3][2]; const bool real = (hw * 16 + i) < nreal;
#pragma unroll
                for (int p = 0; p < 3; ++p) { const unsigned x3 = real ? *(const GAS unsigned*)(P + (mrow0 + tt) * INWP + C_QKV + p * 512 + h * 128 + 2 * lane) : 0u;
                    float a0 = w[p][0][0] * bflo(xr[p][0]) + w[p][1][0] * bflo(xr[p][1]) + w[p][2][0] * bflo(xr[p][2]) + w[p][3][0] * bflo(x3);
                    float a1 = w[p][0][1] * bfhi(xr[p][0]) + w[p][1][1] * bfhi(xr[p][1]) + w[p][2][1] * bfhi(xr[p][2]) + w[p][3][1] * bfhi(x3);
                    y[p][0] = a0 / (1.f + __expf(-a0)); y[p][1] = a1 / (1.f + __expf(-a1));
                    xr[p][0] = xr[p][1]; xr[p][1] = xr[p][2]; xr[p][2] = x3; }
                const float rq = 1.f / sqrtf(wave_sum(y[0][0] * y[0][0] + y[0][1] * y[0][1]) + NORM_EPS), rk = 1.f / sqrtf(wave_sum(y[1][0] * y[1][0] + y[1][1] * y[1][1]) + NORM_EPS);
                const int row = hw * 16 + i;
                *(LAS unsigned*)(L + GP_Q + row * GT_LD + 4 * lane) = real ? pk2(y[0][0] * rq, y[0][1] * rq) : 0u;
                *(LAS unsigned*)(L + GP_K + row * GT_LD + 4 * lane) = real ? pk2(y[1][0] * rk, y[1][1] * rk) : 0u;
                *(LAS unsigned*)(L + GP_V + row * GT_LD + 4 * lane) = real ? pk2(y[2][0], y[2][1]) : 0u;
            }
            if (hw == 0) { const size_t m = mrow0 + c * 64 + lane; const bool rl = lane < nreal; float g = rl ? BG[m * 8 + 4 + h] : 0.f; const float be = rl ? BG[m * 8 + h] : 0.f;
#pragma unroll
                for (int o = 1; o < 64; o <<= 1) { const float t = __shfl_up(g, o); if (lane >= o) g += t; }
                ((LAS float*)(L + GP_G))[lane] = g; ((LAS float*)(L + GP_B))[lane] = be; }
        }
        LDS_WAIT(); __syncthreads();
        if (live) {
            const LAS float* Gs = (const LAS float*)(L + GP_G); const LAS float* Bs = (const LAS float*)(L + GP_B);
            bf16* QKg = (bf16*)(gs + 65536);
            const int r = lane & 31, hh = lane >> 5;
            if (hw < 3) {
                const int ti = hw > 0 ? 1 : 0, tj = hw > 1 ? 1 : 0;
                f32x16 akk = zero16(), aqk = zero16();
#pragma unroll
                for (int s = 0; s < 8; ++s) {
                    const bf16x8 bk = *(const LAS bf16x8*)(L + GP_K + (32 * tj + r) * GT_LD + (16 * s + 8 * hh) * 2);
                    const bf16x8 ak = *(const LAS bf16x8*)(L + GP_K + (32 * ti + r) * GT_LD + (16 * s + 8 * hh) * 2);
                    const bf16x8 aq = *(const LAS bf16x8*)(L + GP_Q + (32 * ti + r) * GT_LD + (16 * s + 8 * hh) * 2);
                    akk = MFMA32(ak, bk, akk, 0, 0, 0); aqk = MFMA32(aq, bk, aqk, 0, 0, 0);
                }
                const int j = 32 * tj + r; const float Gj = Gs[j];
#pragma unroll
                for (int q = 0; q < 16; ++q) { const int i = 32 * ti + crow(q, hh); const float dec = __expf(Gs[i] - Gj);
                    ((LAS float*)(L + GP_A))[i * 68 + j] = (i > j) ? Bs[i] * akk[q] * dec : 0.f;
                    QKg[(((i >> 5) * 4 + (j >> 4)) * 64 + ((j >> 3) & 1) * 32 + (i & 31)) * 8 + (j & 7)] = (bf16)f2bf((i >= j) ? aqk[q] * dec * 0.08838834764831845f : 0.f); }
            } else {
#pragma unroll
                for (int q = 0; q < 16; ++q) { const int i = crow(q, hh), j = 32 + r; QKg[(((i >> 5) * 4 + (j >> 4)) * 64 + ((j >> 3) & 1) * 32 + (i & 31)) * 8 + (j & 7)] = 0; }
            }
        }
        LDS_WAIT(); __syncthreads();
        if (live) {
            const LAS float* Gs = (const LAS float*)(L + GP_G); const LAS float* Bs = (const LAS float*)(L + GP_B); const LAS float* As = (const LAS float*)(L + GP_A);
            const bool isu = ht < 128; const int cc = ht & 127;
            const LAS unsigned char* src = L + (isu ? GP_V : GP_K) + cc * 2;
            float X[64];
#pragma unroll
            for (int i = 0; i < 64; ++i) X[i] = 0.f;
#pragma unroll
            for (int i = 0; i < 64; ++i) {
                float acc = bf2f(*(const LAS bf16*)(src + i * GT_LD)) * Bs[i] * (isu ? 1.f : __expf(Gs[i]));
#pragma unroll
                for (int j4 = 0; j4 < (i + 3) / 4; ++j4) { const f32x4 a = *(const LAS f32x4*)(As + i * 68 + 4 * j4);
                    acc -= a.x * X[4 * j4]; acc -= a.y * X[4 * j4 + 1]; acc -= a.z * X[4 * j4 + 2]; acc -= a.w * X[4 * j4 + 3]; }
                X[i] = acc; asm volatile("" : "+v"(X[i]) :: "memory"); __builtin_amdgcn_sched_barrier(0);
            }
            if (isu) {
#pragma unroll
                for (int q = 0; q < 16; ++q) { const int rt_ = q >> 3, g_ = (q >> 1) & 3, hh_ = q & 1, i0 = 32 * rt_ + 8 * g_ + 4 * hh_;
                    v2u w2; w2.x = pk2(X[i0], X[i0 + 1]); w2.y = pk2(X[i0 + 2], X[i0 + 3]);
                    *(GAS v2u*)(gs + (size_t)((((cc >> 5) * 2 + rt_) * 4 + g_) * 64 + hh_ * 32 + (cc & 31)) * 8) = w2; }
            } else {
                bf16* wg = (bf16*)(gs + 16384) + (size_t)(((cc >> 4) * 64 + ((cc >> 3) & 1) * 32) * 8 + (cc & 7));
#pragma unroll
                for (int i = 0; i < 64; ++i) wg[(size_t)(((i >> 5) * 8) * 64 + (i & 31)) * 8] = (bf16)f2bf(X[i]); }
            { bf16* qt = (bf16*)(gs + 32768);
#pragma unroll
              for (int e = 0; e < 16; ++e) { const int idx = e * 256 + ht, i = idx >> 6, cp = idx & 63, dk = 2 * cp; const unsigned qv = *(const LAS unsigned*)(L + GP_Q + i * GT_LD + 4 * cp); const float sc = __expf(Gs[i]) * 0.08838834764831845f;
                  *(GAS unsigned*)(qt + (size_t)((((i >> 5) * 8 + (dk >> 4)) * 64 + ((dk >> 3) & 1) * 32 + (i & 31)) * 8 + (dk & 7))) = pk2(bflo(qv) * sc, bfhi(qv) * sc); } }
            if (!isu) { const float G63 = Gs[63];
#pragma unroll
                for (int q = 0; q < 8; ++q) { float kv[8];
#pragma unroll
                    for (int e = 0; e < 8; ++e) { const int i = 8 * q + e; kv[e] = bf2f(*(const LAS bf16*)(L + GP_K + i * GT_LD + cc * 2)) * __expf(G63 - Gs[i]); }
                    v4u w4; w4.x = pk2(kv[0], kv[1]); w4.y = pk2(kv[2], kv[3]); w4.z = pk2(kv[4], kv[5]); w4.w = pk2(kv[6], kv[7]);
                    *(GAS v4u*)(gs + 49152 + (size_t)((((cc >> 5) * 4 + (q >> 1)) * 64 + (q & 1) * 32 + (cc & 31)) * 16)) = w4; } }
            if (ht == 0) WSP(float, WS_GL)[u] = __expf(Gs[63]);
        }
        LDS_WAIT(); __syncthreads();
    }
}
constexpr int GS_SB = 0, GS_SB_LD = 272, GS_VN = 8704, GS_VN_LD = 144;
__device__ __forceinline__ void gdn_scan_phase(Frame& F, const Args& A) {
    const int wave = F.wave;
    LAS unsigned char* L = F.lds + RING_OFF;
    float* OG = WSP(float, WS_OG); const float* GL = WSP(float, WS_GL);
    for (int uu0 = F.bx; uu0 < (BATCH * GH * 4 + DECB * GH * 4) * (MK_X == 3 || MK_X == 4 ? 2 : 1); uu0 += F.G) {
        int uu = uu0; if (MK_X == 3 && uu0 >= BATCH * GH * 4 + DECB * GH * 4) { uu = uu0 - (BATCH * GH * 4 + DECB * GH * 4); if (uu >= BATCH * GH * 4) continue; }
        if (MK_X == 4 && uu0 >= BATCH * GH * 4 + DECB * GH * 4) { uu = uu0 - (BATCH * GH * 4 + DECB * GH * 4); if (uu < BATCH * GH * 4) continue; }
        const int lane = lane_fresh(); const int r = lane & 31, hh = lane >> 5;
        const bool smp = uu >= BATCH * GH * 4; const int u = smp ? uu - BATCH * GH * 4 : uu;
        const int sl = u & 3, h = (u >> 2) & 3, b = u >> 4, dv0 = sl * 32;
        const int role = wave < 2 ? 0 : (wave < 4 ? 1 : 2), rt = wave < 2 ? wave : (wave < 4 ? wave - 2 : wave - 4);
        const int nch = smp ? 1 : NCHUNK, un0 = smp ? 2048 + b * GH + h : (b * GH + h) * NCHUNK;
        const size_t mrow0 = smp ? (size_t)MP + (size_t)b * DECT : (size_t)b * SEQ;
        f32x16 Sacc = zero16();
        __syncthreads();
        if (!smp) { for (int i = wave * 64 + lane; i < (GS_VN + 32 * GS_VN_LD) / 4; i += NTHR) ((LAS unsigned*)L)[i] = 0u; }
        else if (role == 2) {
            const GAS float* sp = (const GAS float*)(A.in[5] + ((size_t)(b * GH + h) * GDK + 32 * rt) * GDV + dv0 + r);
#pragma unroll
            for (int q = 0; q < 16; ++q) Sacc[q] = sp[(size_t)crow(q, hh) * GDV];
#pragma unroll
            for (int g = 0; g < 4; ++g) { v2u w2; w2.x = pk2(Sacc[4 * g], Sacc[4 * g + 1]); w2.y = pk2(Sacc[4 * g + 2], Sacc[4 * g + 3]); *(LAS v2u*)(L + GS_SB + r * GS_SB_LD + (32 * rt + 8 * g + 4 * hh) * 2) = w2; }
        }
        LDS_WAIT(); __syncthreads();
        const size_t offA = (role == 1 ? 32768 : 16384) + (size_t)(((role == 2 ? 0 : rt) * 8) * 64 + lane) * 16;
        const size_t offB = (role == 2 ? 49152 : 65536) + (size_t)(((role == 0 ? 0 : rt) * 4) * 64 + lane) * 16;
        const size_t offU = (size_t)(((sl * 2 + (role == 0 ? rt : 0)) * 4) * 64 + lane) * 8;
#define GS_LOAD(FA, UV, FB, GLV, cc) do { const int un_ = un0 + (cc); const unsigned char* gs = F.ws + WS_GSC + (size_t)un_ * GSC_UNIT; \
            _Pragma("unroll") for (int s = 0; s < 8; ++s) FA[s] = *(const GAS bf16x8*)(gs + offA + (size_t)s * 1024); \
            _Pragma("unroll") for (int s = 0; s < 4; ++s) FB[s] = *(const GAS bf16x8*)(gs + offB + (size_t)s * 1024); \
            _Pragma("unroll") for (int g = 0; g < 4; ++g) UV[g] = *(const GAS s16x4*)(gs + offU + (size_t)g * 512); \
            GLV = GL[un_]; } while (0)
#define GS_STEP(FA, UV, FB, GLV, cc) do { asm volatile("; SCAN_STEP_BEGIN"); \
            f32x16 acc = zero16(); \
            if (role < 2) { \
                _Pragma("unroll") for (int s = 0; s < 8; ++s) { const bf16x8 sb = *(const LAS bf16x8*)(L + GS_SB + r * GS_SB_LD + (16 * s + 8 * hh) * 2); acc = MFMA32(FA[s], sb, acc, 0, 0, 0); } } \
            if (role == 0) { \
                _Pragma("unroll") for (int g = 0; g < 4; ++g) { const float v0 = bf2f((unsigned short)UV[g][0]) - acc[4 * g], v1 = bf2f((unsigned short)UV[g][1]) - acc[4 * g + 1], v2 = bf2f((unsigned short)UV[g][2]) - acc[4 * g + 2], v3 = bf2f((unsigned short)UV[g][3]) - acc[4 * g + 3]; \
                    v2u w2; w2.x = pk2(v0, v1); w2.y = pk2(v2, v3); *(LAS v2u*)(L + GS_VN + r * GS_VN_LD + (32 * rt + 8 * g + 4 * hh) * 2) = w2; } } \
            LDS_WAIT(); __builtin_amdgcn_s_barrier(); asm volatile("" ::: "memory"); \
            if (role == 1) { \
                _Pragma("unroll") for (int s = 0; s < 4; ++s) { const bf16x8 vn = *(const LAS bf16x8*)(L + GS_VN + r * GS_VN_LD + (16 * s + 8 * hh) * 2); acc = MFMA32(FB[s], vn, acc, 0, 0, 0); } \
                float* op = OG + (mrow0 + (cc) * 64 + 32 * rt) * 512 + h * 128 + dv0 + r; \
                const int nreal = smp ? DECT : 64; \
                _Pragma("unroll") for (int q = 0; q < 16; ++q) if (32 * rt + crow(q, hh) < nreal) op[(size_t)crow(q, hh) * 512] = acc[q]; \
            } else if (role == 2) { \
                _Pragma("unroll") for (int q = 0; q < 16; ++q) Sacc[q] *= GLV; \
                _Pragma("unroll") for (int s = 0; s < 4; ++s) { const bf16x8 vn = *(const LAS bf16x8*)(L + GS_VN + r * GS_VN_LD + (16 * s + 8 * hh) * 2); Sacc = MFMA32(FB[s], vn, Sacc, 0, 0, 0); } \
                _Pragma("unroll") for (int g = 0; g < 4; ++g) { v2u w2; w2.x = pk2(Sacc[4 * g], Sacc[4 * g + 1]); w2.y = pk2(Sacc[4 * g + 2], Sacc[4 * g + 3]); *(LAS v2u*)(L + GS_SB + r * GS_SB_LD + (32 * rt + 8 * g + 4 * hh) * 2) = w2; } } \
            LDS_WAIT(); __builtin_amdgcn_s_barrier(); asm volatile("" ::: "memory"); } while (0)
        bf16x8 fa0[8], fa1[8], fb0[4], fb1[4]; s16x4 uv0[4], uv1[4]; float gl0 = 1.f, gl1 = 1.f;
        GS_LOAD(fa0, uv0, fb0, gl0, 0);
#pragma unroll 1
        for (int c = 0; c < nch; c += 2) {
            { const int cn = (c + 1 < nch) ? c + 1 : nch - 1; GS_LOAD(fa1, uv1, fb1, gl1, cn); }
            GS_STEP(fa0, uv0, fb0, gl0, c);
            if (c + 1 < nch) {
                { const int cn = (c + 2 < nch) ? c + 2 : nch - 1; GS_LOAD(fa0, uv0, fb0, gl0, cn); }
                GS_STEP(fa1, uv1, fb1, gl1, c + 1);
            }
        }
#undef GS_LOAD
#undef GS_STEP
        if (role == 2) { float* so = F.out + (smp ? O_GS : O_GP) + ((size_t)(b * GH + h) * GDK + 32 * rt) * GDV + dv0 + r;
#pragma unroll
            for (int q = 0; q < 16; ++q) so[(size_t)crow(q, hh) * GDV] = Sacc[q]; }
    }
}
__device__ __forceinline__ void gdn_out_phase(Frame& F, const Args& A) {
    const int lane = lane_fresh(); const bf16* P = WSP(bf16, WS_P); const float* OG = WSP(float, WS_OG); bf16* CAT = WSP(bf16, WS_CAT);
    const f32x2 nw = *(const GAS f32x2*)(A.in[17] + 2 * lane);
    for (int it = F.bx * NWAVES + F.wave; it < M * GH; it += F.G * NWAVES) {
        const int m = it >> 2, h = it & 3;
        const f32x2 o = *(const GAS f32x2*)(OG + (size_t)m * 512 + h * 128 + 2 * lane);
        const float rs = 1.f / sqrtf(wave_sum(o.x * o.x + o.y * o.y) * (1.f / 128.f) + NORM_EPS);
        const unsigned zz = *(const GAS unsigned*)(P + (size_t)m * INWP + C_Z + h * 128 + 2 * lane); const float z0 = bflo(zz), z1 = bfhi(zz);
        *(GAS unsigned*)(CAT + (size_t)m * D + 512 + h * 128 + 2 * lane) = pk2(o.x * rs * nw.x * (z0 / (1.f + __expf(-z0))), o.y * rs * nw.y * (z1 / (1.f + __expf(-z1))));
    }
}
#define MFMA32H __builtin_amdgcn_mfma_f32_32x32x16_f16
__device__ __forceinline__ unsigned f2key(float x) { unsigned b = __builtin_bit_cast(unsigned, x); if ((b << 1) == 0u) b = 0u; return (b & 0x80000000u) ? ~b : (b | 0x80000000u); }
__device__ __forceinline__ float key2f(unsigned k) { const unsigned b = (k & 0x80000000u) ? (k & 0x7fffffffu) : ~k; return __builtin_bit_cast(float, b); }
template <class Get>
__device__ __forceinline__ void wave_topk_threshold(const Get& get, int n, int lane, LAS unsigned* hist, unsigned& thr_key, int& tie_cut) {
    const int niter = (n + 63) >> 6;
    unsigned kmin = 0xffffffffu, kmax = 0u;
#pragma unroll 4
    for (int it = 0; it < niter; ++it) { const int idx = 64 * it + lane; if (idx < n) { const unsigned uk = f2key(get(idx)); kmin = uk < kmin ? uk : kmin; kmax = uk > kmax ? uk : kmax; } }
#pragma unroll
    for (int o = 1; o < 64; o <<= 1) { const unsigned a = (unsigned)__shfl_xor((int)kmin, o), b = (unsigned)__shfl_xor((int)kmax, o); kmin = a < kmin ? a : kmin; kmax = b > kmax ? b : kmax; }
    thr_key = kmax; tie_cut = KSEL - 1;
    if (kmax == kmin) return;
    unsigned base = kmin; int bits = 32 - __builtin_clz(kmax - kmin), kk = KSEL; unsigned cnt = (unsigned)n;
#pragma unroll 1
    while (bits > 0 && cnt > 64u) {
        const int shift = bits > 8 ? bits - 8 : 0;
        *(LAS v4u*)(hist + 4 * lane) = (v4u){0u, 0u, 0u, 0u};
        LDS_WAIT(); asm volatile("" ::: "memory");
#pragma unroll 4
        for (int it = 0; it < niter; ++it) { const int idx = 64 * it + lane;
            if (idx < n) { const unsigned uk = f2key(get(idx)); const unsigned rel = uk - base; if (uk >= base && (bits >= 32 || (rel >> bits) == 0u)) __hip_atomic_fetch_add(hist + (rel >> shift), 1u, __ATOMIC_RELAXED, __HIP_MEMORY_SCOPE_WORKGROUP); } }
        LDS_WAIT(); asm volatile("" ::: "memory");
        const v4u h4 = *(const LAS v4u*)(hist + 4 * lane);
        const unsigned tot = h4.x + h4.y + h4.z + h4.w; unsigned incl = tot;
#pragma unroll
        for (int o = 1; o < 64; o <<= 1) { const unsigned t = __shfl_down(incl, o); if (lane + o < 64) incl += t; }
        const unsigned excl = incl - tot, c3 = excl + h4.w, c2 = c3 + h4.z, c1 = c2 + h4.y, c0 = c1 + h4.x; const unsigned k_ = (unsigned)kk;
        int dj = -1; unsigned above = 0u, cn = 0u;
        if (excl < k_ && k_ <= c3) { dj = 3; above = excl; cn = h4.w; } else if (c3 < k_ && k_ <= c2) { dj = 2; above = c3; cn = h4.z; } else if (c2 < k_ && k_ <= c1) { dj = 1; above = c2; cn = h4.y; } else if (c1 < k_ && k_ <= c0) { dj = 0; above = c1; cn = h4.x; }
        const unsigned long long bm = __ballot(dj >= 0); const int src = bm ? __builtin_ctzll(bm) : 0;
        const unsigned digit = (unsigned)__shfl(4 * lane + dj, src); above = (unsigned)__shfl((int)above, src); cn = (unsigned)__shfl((int)cn, src);
        base += digit << shift; kk -= (int)above; cnt = cn; bits = shift;
    }
    if (bits == 0) {
        thr_key = base; tie_cut = 0x7fffffff;
        if ((int)cnt > kk) { int run = 0;
#pragma unroll 1
            for (int it = 0; it < niter; ++it) { const int idx = 64 * it + lane; const bool eq = idx < n && f2key(get(idx)) == base;
                unsigned long long bm = __ballot(eq); const int c = __builtin_popcountll(bm);
                if (run + c >= kk) { int skip = kk - run - 1; while (skip-- > 0) bm &= bm - 1; tie_cut = 64 * it + __builtin_ctzll(bm); break; }
                run += c; } }
        return;
    }
    { int run = 0;
#pragma unroll 4
      for (int it = 0; it < niter; ++it) { const int idx = 64 * it + lane; bool in = false; unsigned uk = 0u;
          if (idx < n) { uk = f2key(get(idx)); in = uk >= base && ((uk - base) >> bits) == 0u; }
          const unsigned long long bm = __ballot(in);
          if (in) { const int pos = run + __builtin_popcountll(bm & ((1ull << lane) - 1ull)); hist[pos] = uk; hist[64 + pos] = (unsigned)idx; }
          run += __builtin_popcountll(bm); } }
    LDS_WAIT(); asm volatile("" ::: "memory");
    const bool have = lane < (int)cnt; const unsigned my = have ? hist[lane] : 0u; const int myi = have ? (int)hist[64 + lane] : 0x7fffffff;
    int rank = 0; bool later_tie = false;
#pragma unroll 1
    for (int j = 0; j < (int)cnt; ++j) { const unsigned kj = hist[j]; const int ij = (int)hist[64 + j]; rank += (kj > my || (kj == my && ij < myi)) ? 1 : 0; later_tie = later_tie || (kj == my && ij > myi); }
    const unsigned long long hit = __ballot(have && rank == kk - 1); const int src = hit ? __builtin_ctzll(hit) : 0;
    thr_key = (unsigned)__shfl((int)my, src); const int cut = __shfl(myi, src); const int lt = __shfl(later_tie ? 1 : 0, src);
    tie_cut = lt ? cut : 0x7fffffff;
}
template <int NIT>
__device__ __forceinline__ void wave_topk_reg(const LAS float* row, int n, int lane, LAS unsigned* hist, unsigned& thr_key, int& tie_cut) {
    unsigned key[NIT]; unsigned kmin = 0xffffffffu, kmax = 0u;
#pragma unroll
    for (int i = 0; i < NIT; ++i) { const float x = row[64 * i + lane]; const unsigned uk = f2key(x); const bool ok = 64 * i + lane < n; key[i] = ok ? uk : 0u;
        kmin = (ok && uk < kmin) ? uk : kmin; kmax = (ok && uk > kmax) ? uk : kmax; }
#pragma unroll
    for (int o = 1; o < 64; o <<= 1) { const unsigned a = (unsigned)__shfl_xor((int)kmin, o), b = (unsigned)__shfl_xor((int)kmax, o); kmin = a < kmin ? a : kmin; kmax = b > kmax ? b : kmax; }
    thr_key = kmax; tie_cut = KSEL - 1;
    if (kmax == kmin) return;
    unsigned base = kmin, kcap = kmax; int kk = KSEL; unsigned cnt = (unsigned)n;
#define TK_SCAN(DIGIT, ABOVE, CN) do { \
        const v4u h4 = *(const LAS v4u*)(hist + 4 * lane); \
        const unsigned tot = h4.x + h4.y + h4.z + h4.w; unsigned incl = tot; \
        _Pragma("unroll") for (int o = 1; o < 64; o <<= 1) { const unsigned t = __shfl_down(incl, o); if (lane + o < 64) incl += t; } \
        const unsigned excl = incl - tot, c3 = excl + h4.w, c2 = c3 + h4.z, c1 = c2 + h4.y, c0 = c1 + h4.x; const unsigned k_ = (unsigned)kk; \
        int dj = -1; unsigned ab_ = 0u, cn_ = 0u; \
        if (excl < k_ && k_ <= c3) { dj = 3; ab_ = excl; cn_ = h4.w; } else if (c3 < k_ && k_ <= c2) { dj = 2; ab_ = c3; cn_ = h4.z; } else if (c2 < k_ && k_ <= c1) { dj = 1; ab_ = c2; cn_ = h4.y; } else if (c1 < k_ && k_ <= c0) { dj = 0; ab_ = c1; cn_ = h4.x; } \
        const unsigned long long bm_ = __ballot(dj >= 0); const int src_ = bm_ ? __builtin_ctzll(bm_) : 0; \
        DIGIT = (unsigned)__shfl(4 * lane + dj, src_); ABOVE = (unsigned)__shfl((int)ab_, src_); CN = (unsigned)__shfl((int)cn_, src_); } while (0)
    { const float xmin = key2f(kmin), range = key2f(kmax) - xmin;
      if (range > 1e-30f && range < 1e30f) {
          const float scale = 255.99f / range;
          *(LAS v4u*)(hist + 4 * lane) = (v4u){0u, 0u, 0u, 0u};
          LDS_WAIT(); asm volatile("" ::: "memory");
#pragma unroll
          for (int i = 0; i < NIT; ++i) { int d = (int)((key2f(key[i]) - xmin) * scale); d = d > 255 ? 255 : d; if (key[i] != 0u) __hip_atomic_fetch_add(hist + d, 1u, __ATOMIC_RELAXED, __HIP_MEMORY_SCOPE_WORKGROUP); }
          LDS_WAIT(); asm volatile("" ::: "memory");
          unsigned digit, above, cn; TK_SCAN(digit, above, cn);
          kk -= (int)above; cnt = cn;
          unsigned k2min = 0xffffffffu, k2max = 0u;
#pragma unroll
          for (int i = 0; i < NIT; ++i) { int d = (int)((key2f(key[i]) - xmin) * scale); d = d > 255 ? 255 : d; const bool in = key[i] != 0u && d == (int)digit; k2min = (in && key[i] < k2min) ? key[i] : k2min; k2max = (in && key[i] > k2max) ? key[i] : k2max; }
#pragma unroll
          for (int o = 1; o < 64; o <<= 1) { const unsigned a = (unsigned)__shfl_xor((int)k2min, o), b = (unsigned)__shfl_xor((int)k2max, o); k2min = a < k2min ? a : k2min; k2max = b > k2max ? b : k2max; }
          base = k2min; kcap = k2max;
      } }
    int bits = (kcap == base) ? 0 : 32 - __builtin_clz(kcap - base);
#pragma unroll 1
    while (bits > 0 && cnt > 64u) {
        const int shift = bits > 8 ? bits - 8 : 0; const unsigned lim = bits >= 32 ? 0xffffffffu : ((1u << bits) - 1u);
        *(LAS v4u*)(hist + 4 * lane) = (v4u){0u, 0u, 0u, 0u};
        LDS_WAIT(); asm volatile("" ::: "memory");
#pragma unroll
        for (int i = 0; i < NIT; ++i) { const unsigned rel = key[i] - base; if (key[i] >= base && key[i] <= kcap && rel <= lim) __hip_atomic_fetch_add(hist + (rel >> shift), 1u, __ATOMIC_RELAXED, __HIP_MEMORY_SCOPE_WORKGROUP); }
        LDS_WAIT(); asm volatile("" ::: "memory");
        unsigned digit, above, cn; TK_SCAN(digit, above, cn);
        base += digit << shift; kk -= (int)above; cnt = cn; bits = shift;
    }
#undef TK_SCAN
    if (bits == 0) {
        thr_key = base; tie_cut = 0x7fffffff;
        if ((int)cnt > kk) { int run = 0; bool done = false;
#pragma unroll
            for (int i = 0; i < NIT; ++i) { unsigned long long bm = __ballot(key[i] == base); const int c = __builtin_popcountll(bm);
                if (!done && run + c >= kk) { int skip = kk - run - 1; while (skip-- > 0) bm &= bm - 1; tie_cut = 64 * i + __builtin_ctzll(bm); done = true; }
                run += c; } }
        return;
    }
    const unsigned lim = bits >= 32 ? 0xffffffffu : ((1u << bits) - 1u);
    { int run = 0;
#pragma unroll
      for (int i = 0; i < NIT; ++i) { const unsigned rel = key[i] - base; const bool in = key[i] >= base && key[i] <= kcap && rel <= lim;
          const unsigned long long bm = __ballot(in);
          if (in) { const int pos = run + __builtin_popcountll(bm & ((1ull << lane) - 1ull)); hist[pos] = key[i]; hist[64 + pos] = (unsigned)(64 * i + lane); }
          run += __builtin_popcountll(bm); } }
    LDS_WAIT(); asm volatile("" ::: "memory");
    const bool have = lane < (int)cnt; const unsigned my = have ? hist[lane] : 0u; const int myi = have ? (int)hist[64 + lane] : 0x7fffffff;
    int rank = 0; bool later_tie = false;
#pragma unroll 1
    for (int j = 0; j < (int)cnt; ++j) { const unsigned kj = hist[j]; const int ij = (int)hist[64 + j]; rank += (kj > my || (kj == my && ij < myi)) ? 1 : 0; later_tie = later_tie || (kj == my && ij > myi); }
    const unsigned long long hit = __ballot(have && rank == kk - 1); const int src = hit ? __builtin_ctzll(hit) : 0;
    thr_key = (unsigned)__shfl((int)my, src); const int cut = __shfl(myi, src); const int lt = __shfl(later_tie ? 1 : 0, src);
    tie_cut = lt ? cut : 0x7fffffff;
}
__device__ __forceinline__ int idx_row_q(int i) { return 2 * ((i >> 2) & 1) + (i >> 4); }
__device__ __forceinline__ int idx_row_h(int i) { return 4 * ((i >> 3) & 1) + (i & 3); }

constexpr int SC_LD = 2052;
constexpr int DP_SC = 0, DP_WI = 131328, DP_THR = 131840, DP_TIE = 131904, DP_HIST = 132096, DP_END = 140288;
static_assert(DP_END <= RING_BYTES, "DSA prompt LDS");
constexpr float QK_SCALE = 0.125f * 1.4426950408889634f;
__device__ __forceinline__ void dsa_prompt_unit(Frame& F, int b, int qt) {
    const int wave = F.wave; const int lane = lane_dep(qt); const int c = lane & 31, hh = lane >> 5;
    LAS unsigned char* L = F.lds + RING_OFF;
    LAS float* SC = (LAS float*)(L + DP_SC); LAS float* WIs = (LAS float*)(L + DP_WI); LAS float* THR = (LAS float*)(L + DP_THR); LAS int* TIE = (LAS int*)(L + DP_TIE);
    const f16* QIh = WSP(f16, WS_QI); const f16* KIh = WSP(f16, WS_KI); const float* WI = WSP(float, WS_WI);
    const bf16* Qb = WSP(bf16, WS_QB); const bf16* Kb = WSP(bf16, WS_KB); const bf16* VT = WSP(bf16, WS_VT); bf16* CAT = WSP(bf16, WS_CAT);
    const int q0 = 16 * qt; const size_t mb = (size_t)b * SEQ; const int Lk = q0 + 16, nkt = (Lk + 31) >> 5;
#pragma unroll 1
    for (int rep_a = 0; rep_a < (MK_X == 1 ? 2 : 1); ++rep_a) {
    if (wave == 0 && lane < 32) *(LAS f32x4*)(WIs + 4 * lane) = *(const GAS f32x4*)(WI + (mb + q0) * 8 + 4 * lane);
    {
        f16x8 aq[4][4];
#pragma unroll
        for (int rt4 = 0; rt4 < 4; ++rt4)
#pragma unroll
            for (int s = 0; s < 4; ++s) aq[rt4][s] = *(const GAS f16x8*)(QIh + (mb + q0 + 4 * rt4 + idx_row_q(c)) * 512 + idx_row_h(c) * 64 + 16 * s + 8 * hh);
        LDS_WAIT(); __syncthreads();
#define DA_LOAD(BK, kt_) do { _Pragma("unroll") for (int s = 0; s < 4; ++s) BK[s] = *(const GAS f16x8*)(KIh + (mb + 32 * (kt_) + c) * 64 + 16 * s + 8 * hh); } while (0)
#define DA_STEP(BK, kt_) do { const int key = 32 * (kt_) + c; \
            _Pragma("unroll") for (int rt4 = 0; rt4 < 4; ++rt4) { \
                f32x16 acc = zero16(); \
                _Pragma("unroll") for (int s = 0; s < 4; ++s) acc = MFMA32H(aq[rt4][s], BK[s], acc, 0, 0, 0); \
                const int ql0 = 4 * rt4 + 2 * hh; \
                const f32x4 w0 = *(const LAS f32x4*)(WIs + ql0 * 8), w1 = *(const LAS f32x4*)(WIs + ql0 * 8 + 4), w2 = *(const LAS f32x4*)(WIs + ql0 * 8 + 8), w3 = *(const LAS f32x4*)(WIs + ql0 * 8 + 12); \
                float s0 = w0.x * fmaxf(acc[0], 0.f) + w0.y * fmaxf(acc[1], 0.f) + w0.z * fmaxf(acc[2], 0.f) + w0.w * fmaxf(acc[3], 0.f) + w1.x * fmaxf(acc[4], 0.f) + w1.y * fmaxf(acc[5], 0.f) + w1.z * fmaxf(acc[6], 0.f) + w1.w * fmaxf(acc[7], 0.f); \
                float s1 = w2.x * fmaxf(acc[8], 0.f) + w2.y * fmaxf(acc[9], 0.f) + w2.z * fmaxf(acc[10], 0.f) + w2.w * fmaxf(acc[11], 0.f) + w3.x * fmaxf(acc[12], 0.f) + w3.y * fmaxf(acc[13], 0.f) + w3.z * fmaxf(acc[14], 0.f) + w3.w * fmaxf(acc[15], 0.f); \
                SC[ql0 * SC_LD + key] = (key <= q0 + ql0) ? s0 : -INFINITY; SC[(ql0 + 1) * SC_LD + key] = (key <= q0 + ql0 + 1) ? s1 : -INFINITY; } } while (0)
        { f16x8 bkA[4], bkB[4];
          if (wave < nkt) DA_LOAD(bkA, wave);
#pragma unroll 1
          for (int kt = wave; kt < nkt; kt += 2 * NWAVES) {
              if (kt + NWAVES < nkt) DA_LOAD(bkB, kt + NWAVES);
              DA_STEP(bkA, kt);
              if (kt + NWAVES < nkt) {
                  if (kt + 2 * NWAVES < nkt) DA_LOAD(bkA, kt + 2 * NWAVES);
                  DA_STEP(bkB, kt + NWAVES);
              }
          } }
#undef DA_LOAD
#undef DA_STEP
    }
    LDS_WAIT(); __syncthreads();
    }
#pragma unroll 1
    for (int rep_b = 0; rep_b < (MK_X == 2 ? 2 : 1); ++rep_b)
#pragma unroll 1
    for (int e = 0; e < 2; ++e) { const int ql = 2 * wave + e, n = q0 + ql + 1; unsigned tk = 0u; int tc = 0x7fffffff; float thr = -3.0e38f;
        if (n > KSEL) { const LAS float* row = SC + ql * SC_LD; LAS unsigned* hist = (LAS unsigned*)(L + DP_HIST) + wave * 256;
            if (n <= 1024) wave_topk_reg<16>(row, n, lane, hist, tk, tc); else wave_topk_reg<32>(row, n, lane, hist, tk, tc);
            thr = key2f(tk); }
        if (lane == 0) { THR[ql] = thr; TIE[ql] = tc; } }
    LDS_WAIT(); __syncthreads();
    const int rt = wave & 3, kh = wave >> 2, g = rt >> 1, ql = 8 * (rt & 1) + (c >> 2), head = 4 * g + (c & 3), qpos = q0 + ql;
    bf16x8 bq[4];
#pragma unroll
    for (int s = 0; s < 4; ++s) bq[s] = *(const GAS bf16x8*)(Qb + (mb + qpos) * 512 + head * 64 + 16 * s + 8 * hh);
    const float thr = THR[ql]; const int tie = TIE[ql];
    float m_run = -INFINITY, l_run = 0.f; f32x16 O0 = zero16(), O1 = zero16();
    const bf16* vtb = VT + (((size_t)(b * 2 + g) * (SEQ / 32)) * 64 + c) * 32 + 16 * hh;
#define DP_LOAD(AK, V8, kt_) do { \
        _Pragma("unroll") for (int s = 0; s < 4; ++s) AK[s] = *(const GAS bf16x8*)(Kb + (mb + 32 * (kt_) + c) * 128 + g * 64 + 16 * s + 8 * hh); \
        _Pragma("unroll") for (int dt = 0; dt < 2; ++dt) _Pragma("unroll") for (int s2 = 0; s2 < 2; ++s2) \
            V8[dt][s2] = *(const GAS bf16x8*)(vtb + ((size_t)(kt_) * 64 + 32 * dt) * 32 + 8 * s2); } while (0)
#define DP_STEP(AK, V8, kt_) do { \
        f32x16 acc = zero16(); \
        _Pragma("unroll") for (int s = 0; s < 4; ++s) acc = MFMA32(AK[s], bq[s], acc, 0, 0, 0); \
        float p[16]; float mx = -INFINITY; \
        if (notie) { \
            _Pragma("unroll") for (int g4 = 0; g4 < 4; ++g4) { const f32x4 scv = *(const LAS f32x4*)(SC + ql * SC_LD + 32 * (kt_) + 8 * g4 + 4 * hh); \
                _Pragma("unroll") for (int e = 0; e < 4; ++e) { const float s = (scv[e] >= thr) ? acc[4 * g4 + e] : -INFINITY; p[4 * g4 + e] = s; mx = fmaxf(mx, s); } } \
        } else { \
            _Pragma("unroll") for (int g4 = 0; g4 < 4; ++g4) { const f32x4 scv = *(const LAS f32x4*)(SC + ql * SC_LD + 32 * (kt_) + 8 * g4 + 4 * hh); \
                _Pragma("unroll") for (int e = 0; e < 4; ++e) { const int key = 32 * (kt_) + 8 * g4 + 4 * hh + e; const float sv = scv[e]; \
                    const bool sel = sv > thr || (sv == thr && key <= tie); \
                    const float s = sel ? acc[4 * g4 + e] : -INFINITY; p[4 * g4 + e] = s; mx = fmaxf(mx, s); } } } \
        mx = fmaxf(mx, __shfl_xor(mx, 32)); \
        const float m_new = fmaxf(m_run, mx), m_safe = (m_new == -INFINITY) ? 0.f : m_new; \
        float ps = 0.f; \
        _Pragma("unroll") for (int r = 0; r < 16; ++r) { p[r] = __builtin_amdgcn_exp2f(p[r] - m_safe); ps += p[r]; } \
        if (__any(m_new != m_run)) { const float alpha = __builtin_amdgcn_exp2f(m_run - m_safe); l_run *= alpha; \
            _Pragma("unroll") for (int r = 0; r < 16; ++r) { O0[r] *= alpha; O1[r] *= alpha; } } \
        l_run += ps; m_run = m_new; \
        _Pragma("unroll") for (int s2 = 0; s2 < 2; ++s2) { \
            v4u pw; pw.x = pg8::cvt_pk_bf16(p[8 * s2], p[8 * s2 + 1]); pw.y = pg8::cvt_pk_bf16(p[8 * s2 + 2], p[8 * s2 + 3]); pw.z = pg8::cvt_pk_bf16(p[8 * s2 + 4], p[8 * s2 + 5]); pw.w = pg8::cvt_pk_bf16(p[8 * s2 + 6], p[8 * s2 + 7]); \
            const bf16x8 pb = __builtin_bit_cast(bf16x8, pw); \
            O0 = MFMA32(V8[0][s2], pb, O0, 0, 0, 0); O1 = MFMA32(V8[1][s2], pb, O1, 0, 0, 0); } } while (0)
    { bf16x8 akA[4], akB[4], akC[4]; bf16x8 v8A[2][2], v8B[2][2], v8C[2][2];
      const bool notie = __all(tie == 0x7fffffff);
      if (kh < nkt) DP_LOAD(akA, v8A, kh);
      if (kh + 2 < nkt) DP_LOAD(akB, v8B, kh + 2);
#pragma unroll 1
      for (int kt = kh; kt < nkt; kt += 6) {
          if (kt + 4 < nkt) DP_LOAD(akC, v8C, kt + 4);
          DP_STEP(akA, v8A, kt);
          if (kt + 2 < nkt) {
              if (kt + 6 < nkt) DP_LOAD(akA, v8A, kt + 6);
              DP_STEP(akB, v8B, kt + 2);
              if (kt + 4 < nkt) {
                  if (kt + 8 < nkt) DP_LOAD(akB, v8B, kt + 8);
                  DP_STEP(akC, v8C, kt + 4);
              }
          }
      } }
#undef DP_LOAD
#undef DP_STEP
    l_run += __shfl_xor(l_run, 32);
    __syncthreads();
    LAS float* CB = (LAS float*)(L + DP_SC) + rt * (34 * 64);
    if (kh == 1) { CB[lane] = m_run; CB[64 + lane] = l_run;
#pragma unroll
        for (int r = 0; r < 16; ++r) { CB[(2 + r) * 64 + lane] = O0[r]; CB[(18 + r) * 64 + lane] = O1[r]; } }
    LDS_WAIT(); __syncthreads();
    if (kh == 0) {
        const float m1 = CB[lane], l1 = CB[64 + lane]; const float m = fmaxf(m_run, m1), ms = (m == -INFINITY) ? 0.f : m;
        const float a0 = __builtin_amdgcn_exp2f(m_run - ms), a1 = __builtin_amdgcn_exp2f(m1 - ms); const float inv = 1.f / (l_run * a0 + l1 * a1);
        bf16* op = CAT + (mb + qpos) * D + head * 64 + 4 * hh;
#pragma unroll
        for (int g4 = 0; g4 < 4; ++g4) { float o[8];
#pragma unroll
            for (int e = 0; e < 4; ++e) { o[e] = (O0[4 * g4 + e] * a0 + CB[(2 + 4 * g4 + e) * 64 + lane] * a1) * inv; o[4 + e] = (O1[4 * g4 + e] * a0 + CB[(18 + 4 * g4 + e) * 64 + lane] * a1) * inv; }
            v2u w0; w0.x = pk2(o[0], o[1]); w0.y = pk2(o[2], o[3]); *(GAS v2u*)(op + 8 * g4) = w0;
            v2u w1; w1.x = pk2(o[4], o[5]); w1.y = pk2(o[6], o[7]); *(GAS v2u*)(op + 32 + 8 * g4) = w1; }
    }
    LDS_WAIT(); __syncthreads();
}
__device__ __forceinline__ void dsa_prompt_phase(Frame& F) {
    for (int w0 = F.bx; w0 < 256; w0 += F.G) { const int w = ((w0 & 7) << 5) | (w0 >> 3);
        const int b = w >> 4, sub = w & 15;
#pragma unroll 1
        for (int j = 0; j < 8; ++j) { const int qt = 32 * (j >> 1) + ((j & 1) ? 31 - sub : sub); dsa_prompt_unit(F, b, qt); } }
}
__device__ __forceinline__ void dsa_sample_scores_phase(Frame& F, const Args& A) {
    const int wave = F.wave;
    const f16* QIh = WSP(f16, WS_QI); const f16* KIh = WSP(f16, WS_KI); const float* WI = WSP(float, WS_WI); float* SCS = WSP(float, WS_SCS);
    const float* ckidx = A.in[4]; const int* ptab = (const int*)A.in[7];
    const int kt4 = wave & 3, rt2 = wave >> 2;
#define D1_LOAD(XB, u_) do { const int bs_ = (u_) >> 6, j_ = (u_) & 63; const int phys = ptab[bs_ * NPAGES + j_]; \
        const float* kp = ckidx + ((size_t)phys * PAGE + 32 * kt4 + c) * 64 + 8 * hh; \
        _Pragma("unroll") for (int s = 0; s < 4; ++s) { XB[2 * s] = *(const GAS f32x4*)(kp + 16 * s); XB[2 * s + 1] = *(const GAS f32x4*)(kp + 16 * s + 4); } } while (0)
#define D1_STEP(XB, u_) do { const int bs = (u_) >> 6, j = (u_) & 63; const size_t ms = (size_t)MP + (size_t)bs * DECT; \
        f16x8 aq[4], bk[4]; \
        _Pragma("unroll") for (int s = 0; s < 4; ++s) { const f32x4 x0 = XB[2 * s], x1 = XB[2 * s + 1]; \
            f16x8 t; t[0] = (f16)x0.x; t[1] = (f16)x0.y; t[2] = (f16)x0.z; t[3] = (f16)x0.w; t[4] = (f16)x1.x; t[5] = (f16)x1.y; t[6] = (f16)x1.z; t[7] = (f16)x1.w; bk[s] = t; } \
        _Pragma("unroll") for (int s = 0; s < 4; ++s) aq[s] = *(const GAS f16x8*)(QIh + (ms + 4 * rt2 + idx_row_q(c)) * 512 + idx_row_h(c) * 64 + 16 * s + 8 * hh); \
        f32x16 acc = zero16(); \
        _Pragma("unroll") for (int s = 0; s < 4; ++s) acc = MFMA32H(aq[s], bk[s], acc, 0, 0, 0); \
        const int ql0 = 4 * rt2 + 2 * hh; \
        const GAS f32x4* wp = (const GAS f32x4*)(WI + (ms + ql0) * 8); \
        const f32x4 w0 = wp[0], w1 = wp[1], w2 = wp[2], w3 = wp[3]; \
        const float s0 = w0.x * fmaxf(acc[0], 0.f) + w0.y * fmaxf(acc[1], 0.f) + w0.z * fmaxf(acc[2], 0.f) + w0.w * fmaxf(acc[3], 0.f) + w1.x * fmaxf(acc[4], 0.f) + w1.y * fmaxf(acc[5], 0.f) + w1.z * fmaxf(acc[6], 0.f) + w1.w * fmaxf(acc[7], 0.f); \
        const float s1 = w2.x * fmaxf(acc[8], 0.f) + w2.y * fmaxf(acc[9], 0.f) + w2.z * fmaxf(acc[10], 0.f) + w2.w * fmaxf(acc[11], 0.f) + w3.x * fmaxf(acc[12], 0.f) + w3.y * fmaxf(acc[13], 0.f) + w3.z * fmaxf(acc[14], 0.f) + w3.w * fmaxf(acc[15], 0.f); \
        const int key = PAGE * j + 32 * kt4 + c; \
        SCS[((size_t)bs * DECT + ql0) * SCS_LD + key] = s0; SCS[((size_t)bs * DECT + ql0 + 1) * SCS_LD + key] = s1; } while (0)
    { const int lane = lane_fresh(); const int c = lane & 31, hh = lane >> 5; const int NU = DECB * NPAGES;
      f32x4 xbA[8], xbB[8];
      if (F.bx < NU) D1_LOAD(xbA, F.bx);
#pragma unroll 1
      for (int u = F.bx; u < NU; u += 2 * F.G) {
          if (u + F.G < NU) D1_LOAD(xbB, u + F.G);
          D1_STEP(xbA, u);
          if (u + F.G < NU) {
              if (u + 2 * F.G < NU) D1_LOAD(xbA, u + 2 * F.G);
              D1_STEP(xbB, u + F.G);
          }
      } }
#undef D1_LOAD
#undef D1_STEP
#pragma unroll 1
    for (int bs = F.bx * NWAVES + wave; bs < DECB; bs += F.G * NWAVES) {
        const int lane = lane_dep(bs); const int t = lane >> 3, t2 = lane & 7; const size_t ms = (size_t)MP + (size_t)bs * DECT;
        float sc = 0.f;
#pragma unroll 1
        for (int h = 0; h < 8; ++h) { float d = 0.f;
#pragma unroll 8
            for (int e = 0; e < 64; ++e) d += (float)QIh[(ms + t) * 512 + h * 64 + e] * (float)KIh[(ms + t2) * 64 + e];
            sc += WI[(ms + t) * 8 + h] * fmaxf(d, 0.f); }
        SCS[((size_t)bs * DECT + t) * SCS_LD + PAST + t2] = (t2 <= t) ? sc : -INFINITY;
    }
}
constexpr int DS_ROW = 0, DS_HIST = 32832, DS_LIST = 33856, DS_RID = 34880, DS_WAVE = 35904;
static_assert(4 * DS_WAVE <= RING_BYTES, "DSA sample LDS");
__device__ __forceinline__ void dsa_sample_attend_phase(Frame& F, const Args& A) {
    const int wave = F.wave;
    if (wave >= 4) return;
    LAS unsigned char* L = F.lds + RING_OFF + wave * DS_WAVE;
    LAS float* rowl = (LAS float*)(L + DS_ROW); LAS unsigned* hist = (LAS unsigned*)(L + DS_HIST); LAS int* list = (LAS int*)(L + DS_LIST); LAS int* rowid = (LAS int*)(L + DS_RID);
    LAS float* qv = rowl; LAS float* sc = rowl + 512;
    const float* SCS = WSP(float, WS_SCS); const bf16* Qb = WSP(bf16, WS_QB); bf16* CAT = WSP(bf16, WS_CAT);
    const float* ck = A.in[2]; const float* cv = A.in[3]; const int* ptab = (const int*)A.in[7];
#pragma unroll 1
    for (int qi = wave * F.G + F.bx; qi < MS; qi += 4 * F.G) {
        const int lane = lane_dep(qi);
        const int bs = qi >> 3, t = qi & 7, n = PAST + t + 1; const size_t m = (size_t)MP + qi;
        { const GAS f32x4* src = (const GAS f32x4*)(SCS + (size_t)qi * SCS_LD);
#pragma unroll 1
          for (int k0 = 0; k0 < 33; k0 += 11) { f32x4 tmp[11];
#pragma unroll
              for (int k = 0; k < 11; ++k) { const int i4 = lane + 64 * (k0 + k); tmp[k] = (i4 < SCS_LD / 4) ? src[i4] : (f32x4){0.f, 0.f, 0.f, 0.f}; }
#pragma unroll
              for (int k = 0; k < 11; ++k) { const int i4 = lane + 64 * (k0 + k); if (i4 < SCS_LD / 4) *(LAS f32x4*)(rowl + 4 * i4) = tmp[k]; } } }
        LDS_WAIT(); asm volatile("" ::: "memory");
        unsigned tk; int tc; auto get = [&](int i) { return rowl[i]; };
        wave_topk_threshold(get, n, lane, hist, tk, tc);
        int cnt = 0;
#pragma unroll 1
        for (int it = 0; it < (n + 63) / 64; ++it) { const int idx = 64 * it + lane; bool sel = false;
            if (idx < n) { const unsigned uk = f2key(rowl[idx]); sel = uk > tk || (uk == tk && idx <= tc); }
            const unsigned long long bm = __ballot(sel); const int pos = cnt + __builtin_popcountll(bm & ((1ull << lane) - 1ull));
            if (sel && pos < KSEL) list[pos] = idx;
            cnt += __builtin_popcountll(bm); }
        LDS_WAIT(); asm volatile("" ::: "memory");
#pragma unroll
        for (int e = 0; e < 4; ++e) { const unsigned qq = *(const GAS unsigned*)(Qb + m * 512 + 128 * e + 2 * lane); qv[128 * e + 2 * lane] = bflo(qq); qv[128 * e + 2 * lane + 1] = bfhi(qq); }
        LDS_WAIT(); asm volatile("" ::: "memory");
        float mxh[8];
#pragma unroll
        for (int h = 0; h < 8; ++h) mxh[h] = -INFINITY;
#pragma unroll 1
        for (int p = 0; p < 4; ++p) { const int jj = 64 * p + lane; const int idx = list[jj];
            const float* kp; int rid;
            if (idx < PAST) { rid = ptab[bs * NPAGES + (idx >> 7)] * PAGE + (idx & 127); kp = ck + (size_t)rid * 128; }
            else { rid = -(idx - PAST) - 1; kp = F.out + O_KS + ((size_t)bs * DECT + (idx - PAST)) * 128; }
            rowid[jj] = rid;
            f32x4 kr[32];
#pragma unroll
            for (int e = 0; e < 32; ++e) kr[e] = *(const GAS f32x4*)(kp + 4 * e);
            float s[8];
#pragma unroll
            for (int h = 0; h < 8; ++h) s[h] = 0.f;
#pragma unroll
            for (int g = 0; g < 2; ++g)
#pragma unroll
                for (int d4 = 0; d4 < 16; ++d4) { const f32x4 kv = kr[16 * g + d4];
#pragma unroll
                    for (int hl = 0; hl < 4; ++hl) { const f32x4 q4 = *(const LAS f32x4*)(qv + (4 * g + hl) * 64 + 4 * d4); s[4 * g + hl] += kv.x * q4.x + kv.y * q4.y + kv.z * q4.z + kv.w * q4.w; } }
#pragma unroll
            for (int h = 0; h < 8; ++h) { const float v = s[h];   sc[h * 256 + jj] = v; mxh[h] = fmaxf(mxh[h], v); } }
        LDS_WAIT(); asm volatile("" ::: "memory");
        float invl[8];
#pragma unroll
        for (int h = 0; h < 8; ++h) { const float mm = wave_max(mxh[h]); float ps = 0.f;
#pragma unroll
            for (int p = 0; p < 4; ++p) { const float e = __builtin_amdgcn_exp2f(sc[h * 256 + 64 * p + lane] - mm); sc[h * 256 + 64 * p + lane] = e; ps += e; }
            invl[h] = 1.f / wave_sum(ps); }
        LDS_WAIT(); asm volatile("" ::: "memory");
        const int g = lane >> 5, dp = lane & 31; float o[4][2];
#pragma unroll
        for (int hl = 0; hl < 4; ++hl) { o[hl][0] = 0.f; o[hl][1] = 0.f; }
#pragma unroll 1
        for (int j0 = 0; j0 < KSEL; j0 += 16) { f32x2 vv[16];
#pragma unroll
            for (int e = 0; e < 16; ++e) { const int rid = __builtin_amdgcn_readfirstlane(rowid[j0 + e]);
                const float* vp = (rid >= 0) ? cv + (size_t)rid * 128 : F.out + O_VS + ((size_t)bs * DECT + (-rid - 1)) * 128;
                vv[e] = *(const GAS f32x2*)(vp + 64 * g + 2 * dp); }
#pragma unroll
            for (int e = 0; e < 16; ++e)
#pragma unroll
                for (int hl = 0; hl < 4; ++hl) { const float pp = sc[(4 * g + hl) * 256 + j0 + e]; o[hl][0] += pp * vv[e].x; o[hl][1] += pp * vv[e].y; } }
#pragma unroll
        for (int hl = 0; hl < 4; ++hl) { const float il = (g == 0) ? invl[hl] : invl[4 + hl];
            *(GAS unsigned*)(CAT + m * D + (4 * g + hl) * 64 + 2 * dp) = pk2(o[hl][0] * il, o[hl][1] * il); }
        LDS_WAIT(); asm volatile("" ::: "memory");
    }
}
#if MK_DIAG
constexpr int CW_DG = 2048;
__device__ __forceinline__ void dg_add(Frame& F, int k, float num, float den) {
    LAS float* red = (LAS float*)(F.lds + RING_OFF + 140000);
    __syncthreads(); if ((int)threadIdx.x < 2) red[(int)threadIdx.x] = 0.f; __syncthreads();
    atomicAdd((float*)&red[0], num); atomicAdd((float*)&red[1], den); __syncthreads();
    if ((int)threadIdx.x == 0) { atomicAdd((float*)(F.ctl + CW_DG + 2 * k), red[0]); atomicAdd((float*)(F.ctl + CW_DG + 2 * k + 1), red[1]); }
    __syncthreads();
}
__device__ __forceinline__ int dg_row(int i) { const int rows[8] = {0, 777, 2047, 2048, 20000, 32767, 32768, 33791}; int r = 0;
#pragma unroll
    for (int j = 0; j < 8; ++j) r = (i == j) ? rows[j] : r; return r; }
__device__ __forceinline__ void chk_ffn(Frame& F, const float* x0, const float* x1, int split, const float* Wg, const float* Wu, const float* Wd, const float* lg, const float* lb, const float* Xout, int ch) {
    if (F.bx >= 8) return;
    const int row = dg_row(F.bx), tid = (int)threadIdx.x;
    LAS float* xs = (LAS float*)(F.lds + RING_OFF); LAS float* hs = xs + 1024; LAS float* rs = hs + 2816;
    const float* xr = row < split ? x0 + (size_t)row * D : x1 + (size_t)(row - split) * D;
    for (int c = tid; c < D; c += NTHR) xs[c] = xr[c];
    __syncthreads();
    for (int j = tid; j < FF; j += NTHR) { float g = 0.f, u = 0.f; for (int k = 0; k < D; ++k) { g += xs[k] * Wg[(size_t)k * FF + j]; u += xs[k] * Wu[(size_t)k * FF + j]; } hs[j] = g / (1.f + expf(-g)) * u; }
    __syncthreads();
    for (int c = tid; c < D; c += NTHR) { float y = 0.f; for (int j = 0; j < FF; ++j) y += hs[j] * Wd[(size_t)j * D + c]; rs[c] = ALPHA * xs[c] + 0.5f * y; }
    __syncthreads();
    float mean = 0.f; for (int c = 0; c < D; ++c) mean += rs[c]; mean *= (1.f / D);
    float var = 0.f; for (int c = 0; c < D; ++c) { const float d = rs[c] - mean; var += d * d; } var *= (1.f / D);
    const float rstd = 1.f / sqrtf(var + LN_EPS);
    float num = 0.f, den = 0.f;
    for (int c = tid; c < D; c += NTHR) { const float ref = (rs[c] - mean) * rstd * lg[c] + lb[c]; const float d = Xout[(size_t)row * D + c] - ref; num += d * d; den += ref * ref; }
    dg_add(F, ch, num, den);
}
__device__ __forceinline__ void chk_proj(Frame& F, const float* X1, const float* Win, const bf16* P, int ch) {
    if (F.bx >= 8) return;
    const int row = dg_row(F.bx), tid = (int)threadIdx.x;
    LAS float* xs = (LAS float*)(F.lds + RING_OFF);
    for (int c = tid; c < D; c += NTHR) xs[c] = X1[(size_t)row * D + c];
    __syncthreads();
    float num = 0.f, den = 0.f;
    for (int c = tid; c < INW; c += NTHR) { float p = 0.f; for (int k = 0; k < D; ++k) p += xs[k] * Win[(size_t)k * INW + c]; const float d = bf2f(P[(size_t)row * INWP + c]) - p; num += d * d; den += p * p; }
    dg_add(F, ch, num, den);
}

__device__ __forceinline__ void chk_gdn(Frame& F, const Args& A, bool sample, int b, int h, int ch_o, int ch_s) {
    const int tid = (int)threadIdx.x;
    LAS float* S = (LAS float*)(F.lds + RING_OFF); LAS float* y = S + 16384; LAS float* qn = y + 384; LAS float* kn = qn + 128; LAS float* rv = kn + 128;
    const bf16* P = WSP(bf16, WS_P); const float* BG = WSP(float, WS_BG); const float* OG = WSP(float, WS_OG); const float* cw = A.in[14];
    const int T = sample ? DECT : SEQ; const size_t m0 = sample ? (size_t)MP + b * DECT : (size_t)b * SEQ;
    const float* st_in = A.in[5] + (size_t)(b * GH + h) * GDK * GDV; const float* st_out = F.out + (sample ? O_GS : O_GP) + (size_t)(b * GH + h) * GDK * GDV;
    for (int e = tid; e < 16384; e += NTHR) S[e] = sample ? st_in[e] : 0.f;
    float no = 0.f, dn = 0.f;
    __syncthreads();
    for (int t = 0; t < T; ++t) {
        const size_t m = m0 + t;
        if (tid < 384) { const int col = (tid < 128) ? h * 128 + tid : (tid < 256) ? 512 + h * 128 + (tid - 128) : 1024 + h * 128 + (tid - 256); float a = 0.f;
            for (int j = 0; j < 4; ++j) { const int rr = t + j; float x;
                if (rr < 3) x = sample ? A.in[6][((size_t)b * 3 + rr) * CONVC + col] : 0.f; else x = bf2f(P[(m0 + rr - 3) * INWP + C_QKV + col]);
                a += cw[j * CONVC + col] * x; }
            y[tid] = a / (1.f + expf(-a)); }
        __syncthreads();
        float sq = 0.f, sk = 0.f; for (int i = 0; i < 128; ++i) { sq += y[i] * y[i]; sk += y[128 + i] * y[128 + i]; }
        const float rq = 1.f / sqrtf(sq + NORM_EPS), rk = 1.f / sqrtf(sk + NORM_EPS);
        if (tid < 128) { qn[tid] = y[tid] * rq; kn[tid] = y[128 + tid] * rk; }
        __syncthreads();
        const float be = BG[m * 8 + h], a = expf(BG[m * 8 + 4 + h]);
        if (tid < 128) { float part = 0.f; for (int dk = 0; dk < 128; ++dk) part += a * S[dk * 128 + tid] * kn[dk]; rv[tid] = (y[256 + tid] - part) * be; }
        __syncthreads();
        for (int e = tid; e < 16384; e += NTHR) S[e] = a * S[e] + kn[e >> 7] * rv[e & 127];
        __syncthreads();
        if (tid < 128) { float o = 0.f; for (int dk = 0; dk < 128; ++dk) o += S[dk * 128 + tid] * qn[dk]; o *= 0.08838834764831845f;
            const float d = OG[m * 512 + h * 128 + tid] - o; no += d * d; dn += o * o; }
        __syncthreads();
    }
    float ns = 0.f, ds = 0.f;
    for (int e = tid; e < 16384; e += NTHR) { const float d = st_out[e] - S[e]; ns += d * d; ds += S[e] * S[e]; }
    dg_add(F, ch_o, no, dn); dg_add(F, ch_s, ns, ds);
}

__device__ __forceinline__ void chk_dsa(Frame& F, const Args& A, bool sample, int b, int t, int ch) {
    const int tid = (int)threadIdx.x;
    LAS float* sc = (LAS float*)(F.lds + RING_OFF); LAS unsigned char* sel = (LAS unsigned char*)(sc + 8208); LAS float* qs = (LAS float*)(sel + 8208);
    const f16* QIh = WSP(f16, WS_QI); const f16* KIh = WSP(f16, WS_KI); const float* WI = WSP(float, WS_WI); const bf16* Qb = WSP(bf16, WS_QB); const bf16* Kb = WSP(bf16, WS_KB); const bf16* P = WSP(bf16, WS_P); const bf16* CAT = WSP(bf16, WS_CAT);
    const int* ptab = (const int*)A.in[7];
    const size_t m = sample ? (size_t)MP + b * DECT + t : (size_t)b * SEQ + t; const int n = sample ? PAST + t + 1 : t + 1;
    for (int l = tid; l < n; l += NTHR) { float s = 0.f;
        for (int h = 0; h < 8; ++h) { float d = 0.f;
            for (int e = 0; e < 64; ++e) { float kv;
                if (sample) { if (l < PAST) kv = (float)(f16)A.in[4][((size_t)ptab[b * NPAGES + (l >> 7)] * PAGE + (l & 127)) * 64 + e]; else kv = (float)KIh[((size_t)MP + b * DECT + (l - PAST)) * 64 + e]; }
                else kv = (float)KIh[((size_t)b * SEQ + l) * 64 + e];
                d += (float)QIh[m * 512 + h * 64 + e] * kv; }
            s += WI[m * 8 + h] * fmaxf(d, 0.f); }
        if (s == 0.f) s = 0.f;
        sc[l] = s; }
    for (int e = tid; e < 512; e += NTHR) qs[e] = bf2f(Qb[m * 512 + e]);
    __syncthreads();
    for (int l = tid; l < n; l += NTHR) { const float x = sc[l]; int rank = 0; for (int l2 = 0; l2 < n; ++l2) { const float y = sc[l2]; rank += (y > x || (y == x && l2 < l)) ? 1 : 0; } sel[l] = rank < KSEL ? 1 : 0; }
    __syncthreads();
    const int h = tid >> 6, d = tid & 63, g = h >> 2; float mx = -INFINITY;
    for (int pass = 0; pass < 2; ++pass) { float lsum = 0.f, o = 0.f;
        for (int l = 0; l < n; ++l) { if (!sel[l]) continue; float dot = 0.f; float vv;
            if (sample) { const float* kp; const float* vp;
                if (l < PAST) { const size_t rid = (size_t)ptab[b * NPAGES + (l >> 7)] * PAGE + (l & 127); kp = A.in[2] + rid * 128; vp = A.in[3] + rid * 128; }
                else { kp = F.out + O_KS + ((size_t)b * DECT + (l - PAST)) * 128; vp = F.out + O_VS + ((size_t)b * DECT + (l - PAST)) * 128; }
                for (int e = 0; e < 64; ++e) dot += qs[h * 64 + e] * kp[g * 64 + e]; vv = vp[g * 64 + d];
            } else { const size_t mk = (size_t)b * SEQ + l; for (int e = 0; e < 64; ++e) dot += qs[h * 64 + e] * bf2f(Kb[mk * 128 + g * 64 + e]); vv = bf2f(P[mk * INWP + C_V + g * 64 + d]); }
            dot *= 0.6931471805599453f;
            if (pass == 0) mx = fmaxf(mx, dot); else { const float p = expf(dot - mx); lsum += p; o += p * vv; } }
        if (pass == 1) { const float ref = o / lsum; const float dd = bf2f(CAT[m * D + h * 64 + d]) - ref; dg_add(F, ch, dd * dd, ref * ref); } }
}
__device__ __forceinline__ void dg_report(Frame& F) {
    if (F.bx != 0 || (int)threadIdx.x >= 12) return;
    const size_t offs[12] = {O_YP, O_YS, O_KP, O_VP, O_IP, O_GP, O_CP, O_KS, O_VS, O_IS, O_GS, O_CS};
    size_t off = 0;
#pragma unroll
    for (int j = 0; j < 12; ++j) off = ((int)threadIdx.x == j) ? offs[j] : off;
    const float num = __hip_atomic_load((float*)(F.ctl + CW_DG + 2 * (int)threadIdx.x), RLX_AGENT), den = __hip_atomic_load((float*)(F.ctl + CW_DG + 2 * (int)threadIdx.x + 1), RLX_AGENT);
    int n = 99;
    if (den > 0.f) { const float e = sqrtf(num / den); const float L = -log10f(fmaxf(e, 1e-9f)); n = 1 + (int)(10.f * fmaxf(L, 0.f) + 0.5f); n = n > 98 ? 98 : n; if (!(e == e)) n = 1; }
    for (int i = 0; i < n; ++i) ((unsigned*)F.out)[off + i] = 0xAAAAAAAAu;
}
#endif

#if MK_DIAG == 2
constexpr int CW_TS = 3072;
__device__ __forceinline__ void ts_stamp(Frame& F, int k) { if (F.bx == 0 && F.wave == 0 && lane_fresh() == 0) { const unsigned long long t = __builtin_amdgcn_s_memrealtime(); F.ctl[CW_TS + 2 * k] = (unsigned)t; F.ctl[CW_TS + 2 * k + 1] = (unsigned)(t >> 32); } }
__device__ __forceinline__ void ts_report(Frame& F) {
    if (F.bx != 0 || F.wave != 0) return; const int lane = lane_fresh(); if (lane >= 12) return;
    const size_t offs[12] = {O_YP, O_YS, O_KP, O_VP, O_IP, O_GP, O_CP, O_KS, O_VS, O_IS, O_GS, O_CS};
    const int lo[12] = TS_LO; const int hi[12] = TS_HI;
    size_t off = 0; int a = 0, b = 0;
#pragma unroll
    for (int j = 0; j < 12; ++j) { off = (lane == j) ? offs[j] : off; a = (lane == j) ? lo[j] : a; b = (lane == j) ? hi[j] : b; }
    const unsigned long long t0 = (unsigned long long)F.ctl[CW_TS + 2 * a] | ((unsigned long long)F.ctl[CW_TS + 2 * a + 1] << 32), t1 = (unsigned long long)F.ctl[CW_TS + 2 * b] | ((unsigned long long)F.ctl[CW_TS + 2 * b + 1] << 32);
    int n = (int)((t1 - t0) / 100ull); n = n < 1 ? 1 : (n > 60000 ? 60000 : n);
    for (int i = 0; i < n; ++i) ((unsigned*)F.out)[off + i] = 0xAAAAAAAAu;
}
#endif
#ifndef MK_ONE_LAUNCH
#define MK_ONE_LAUNCH 0
#endif
constexpr int NPH = 14 + (MK_DIAG == 1 ? 2 : MK_DIAG == 2 ? 1 : 0);
__global__ void __launch_bounds__(NTHR, 2) mk_fwd(Args args) {
    extern __shared__ __attribute__((aligned(16))) unsigned char lds[];
    Frame F;
    F.lds = (LAS unsigned char*)lds; F.MISC = (volatile LAS unsigned*)(F.lds + MISC_OFF);
    F.wave = __builtin_amdgcn_readfirstlane(threadIdx.x >> 6); F.G = gridDim.x; F.bx = blockIdx.x;
    F.out = args.out; F.ws = args.ws; F.ctl = (gu32*)(args.ws + WS_CTL);
    for (int u = F.wave * 64 + lane_fresh(); u < (LDS_BYTES - LDSCTL_OFF) / 4; u += NTHR) ((LAS unsigned*)(F.lds + LDSCTL_OFF))[u] = 0u;
    __syncthreads();
    XcdBarrier bar; bar.wave = F.wave; bar.bar = (unsigned*)(F.ctl + CW_BAR); bar.x = 0; bar.st = nullptr;
    if (MK_ONE_LAUNCH) bar = xcd_barrier_post((unsigned*)(F.ctl + CW_BAR), F.MISC + 8, F.wave);
    const int lo = args.ph_lo, hi = args.ph_hi;
#define IN(k) (lo <= (k) && (k) < hi)
#define PHASE(k, ...) do { if (IN(k)) { __VA_ARGS__ } if (MK_DUP == (k)) { xcd_barrier(bar); __VA_ARGS__ } SEAM(k); } while (0)
#if MK_DIAG == 2
#define SEAM(k) do { if (IN(k) && IN((k) + 1)) xcd_barrier(bar); ts_stamp(F, (k) + 1); } while (0)
#else
#define SEAM(k) do { if (IN(k) && IN((k) + 1)) xcd_barrier(bar); } while (0)
#endif
    const float* xp = args.in[0]; const float* xs = args.in[1];
    bf16* XB = WSP(bf16, WS_XB); float* X1 = WSP(float, WS_X1); float* X2 = WSP(float, WS_X2); float* R = WSP(float, WS_R); bf16* H = WSP(bf16, WS_H); bf16* P = WSP(bf16, WS_P); bf16* CAT = WSP(bf16, WS_CAT);

#if MK_DIAG == 2
    ts_stamp(F, 0);
#endif
    PHASE(0,  p0_prologue(F, args); );
    PHASE(1,
        pg8::Gemm g{XB, WSP(bf16, WS_WGU1), M, NGU, D}; pg8::StaticOrder S; S.init(M, NGU, F.G, F.bx);
        pg8::EpiSwiGLU E{H, FF};
        pg8::gemm_phase<pg8::EpiSwiGLU, pg8::StaticOrder, true, true>(F.lds + RING_OFF, g, S, E, F.wave);
    );
    PHASE(2,
        pg8::Gemm g{H, WSP(bf16, WS_WD1), M, D, FF}; pg8::StaticOrder S; S.init(M, D, F.G, F.bx);
        pg8::EpiResF32 E{xp, xs, MP, R, D, ALPHA, 0.5f};
        pg8::gemm_phase<pg8::EpiResF32, pg8::StaticOrder, true, true>(F.lds + RING_OFF, g, S, E, F.wave);
    );
    PHASE(3,  ln_phase(F, R, args.in[11], args.in[12], X1, XB); );
    PHASE(4,
        pg8::Gemm g{XB, WSP(bf16, WS_WIN), M, INWP, D}; pg8::StaticOrder S; S.init(M, INWP, F.G, F.bx);
        pg8::EpiPlainBf16 E{P, INWP};
        pg8::gemm_phase<pg8::EpiPlainBf16, pg8::StaticOrder, true, true>(F.lds + RING_OFF, g, S, E, F.wave);
    );
    PHASE(5,  post_phase(F, args); );
    PHASE(6,  gdn_prep_phase(F, args); if (MK_DUP == 60) gdn_prep_phase(F, args); dsa_sample_scores_phase(F, args); if (MK_DUP == 61) dsa_sample_scores_phase(F, args); );
    PHASE(7,  gdn_scan_phase(F, args); if (MK_DUP == 70) gdn_scan_phase(F, args); dsa_sample_attend_phase(F, args); if (MK_DUP == 71) dsa_sample_attend_phase(F, args); dsa_prompt_phase(F); if (MK_DUP == 72) dsa_prompt_phase(F); );
    PHASE(8,  gdn_out_phase(F, args); );
    PHASE(9,
        pg8::Gemm g{CAT, WSP(bf16, WS_WO), M, D, D}; pg8::StaticOrder S; S.init(M, D, F.G, F.bx);
        pg8::EpiResF32 E{X1, X1, M, R, D, ALPHA, 1.0f};
        pg8::gemm_phase<pg8::EpiResF32, pg8::StaticOrder, true, true>(F.lds + RING_OFF, g, S, E, F.wave);
    );
    PHASE(10,  ln_phase(F, R, args.in[19], args.in[20], X2, XB); );
    PHASE(11,
        pg8::Gemm g{XB, WSP(bf16, WS_WGU2), M, NGU, D}; pg8::StaticOrder S; S.init(M, NGU, F.G, F.bx);
        pg8::EpiSwiGLU E{H, FF};
        pg8::gemm_phase<pg8::EpiSwiGLU, pg8::StaticOrder, true, true>(F.lds + RING_OFF, g, S, E, F.wave);
    );
    PHASE(12,
        pg8::Gemm g{H, WSP(bf16, WS_WD2), M, D, FF}; pg8::StaticOrder S; S.init(M, D, F.G, F.bx);
        pg8::EpiResF32 E{X2, X2, M, R, D, ALPHA, 0.5f};
        pg8::gemm_phase<pg8::EpiResF32, pg8::StaticOrder, true, true>(F.lds + RING_OFF, g, S, E, F.wave);
    );
    PHASE(13,  ln_phase(F, R, args.in[24], args.in[25], F.out + O_YP, nullptr); );
#if MK_DIAG == 1
    if (IN(14)) {
        chk_ffn(F, xp, xs, MP, args.in[8], args.in[9], args.in[10], args.in[11], args.in[12], X1, 0);
        chk_proj(F, X1, args.in[13], P, 1);
        if (F.bx >= 8 && F.bx < 12) { const int i = F.bx - 8; chk_gdn(F, args, false, 5 * i, i, 2, 3); }
        if (F.bx >= 16 && F.bx < 24) { const int i = F.bx - 16; chk_dsa(F, args, false, (3 * i + 1) & 15, i == 0 ? 5 : i == 1 ? 255 : i == 2 ? 256 : i == 3 ? 300 : i == 4 ? 777 : i == 5 ? 1500 : i == 6 ? 2046 : 2047, 6); }
        if (F.bx >= 24 && F.bx < 28) { const int i = F.bx - 24; chk_dsa(F, args, true, i == 0 ? 0 : i == 1 ? 50 : i == 2 ? 99 : 127, i == 0 ? 0 : i == 1 ? 3 : i == 2 ? 6 : 7, 7); }
        if (F.bx >= 12 && F.bx < 16) { const int i = F.bx - 12; chk_gdn(F, args, true, i == 0 ? 0 : i == 1 ? 37 : i == 2 ? 100 : 127, i, 4, 5); }
    }
#endif
#if MK_DIAG == 1
    if (IN(15)) dg_report(F);
#endif
#if MK_DIAG == 2
    if (IN(14)) ts_report(F);
#endif
#undef IN
#undef SEAM
}

extern "C" void kernel_launch(void* const* d_in, const int* in_sizes, int n_in, void* d_out, int out_size, void* d_ws, size_t ws_size, hipStream_t stream) {
    static int grid = 0;
    if (grid == 0) {
        if (n_in != 26 || out_size != (int)O_END || ws_size < WS_END) { fprintf(stderr, "kernel_launch: unexpected shapes (n_in %d out %d ws %zu)\n", n_in, out_size, ws_size); grid = -1; return; }
        int dev = 0, cus = 0, per_cu = 0;
        if (hipGetDevice(&dev) != hipSuccess || hipDeviceGetAttribute(&cus, hipDeviceAttributeMultiprocessorCount, dev) != hipSuccess) { grid = -1; return; }
        if (hipFuncSetAttribute((const void*)mk_fwd, hipFuncAttributeMaxDynamicSharedMemorySize, LDS_BYTES) != hipSuccess) { fprintf(stderr, "kernel_launch: hipFuncSetAttribute failed\n"); grid = -1; return; }
        if (hipOccupancyMaxActiveBlocksPerMultiprocessor(&per_cu, (const void*)mk_fwd, NTHR, LDS_BYTES) != hipSuccess || per_cu < 1) fprintf(stderr, "kernel_launch: occupancy query reports %d\n", per_cu);
        (void)hipGetLastError();
        grid = cus;
    }
    if (grid < 0) return;
    if (hipMemsetAsync((char*)d_ws + WS_CTL, 0, CTL_ZERO_BYTES, stream) != hipSuccess) return;
    Args a{};
    for (int i = 0; i < 26; ++i) a.in[i] = (const float*)d_in[i];
    a.out = (float*)d_out; a.ws = (unsigned char*)d_ws;
#if MK_ONE_LAUNCH
    a.ph_lo = 0; a.ph_hi = NPH;
    hipLaunchKernelGGL(mk_fwd, dim3(grid), dim3(NTHR), LDS_BYTES, stream, a);
#else
    for (int k = 0; k < NPH; ++k) { a.ph_lo = k; a.ph_hi = k + 1; hipLaunchKernelGGL(mk_fwd, dim3(grid), dim3(NTHR), LDS_BYTES, stream, a); }
#endif
}
```

```cpp
#define MK_DIAG 0
#define MK_DIAG_ALL 0
#define TS_LO {0,1,2,3,4,5,6,7,8,9,10,11}
#define TS_HI {1,2,3,4,5,6,7,8,9,10,11,14}
#define MK_ONE_LAUNCH 1
#define MK_DUP -1
#define MK_X 0
#include <hip/hip_runtime.h>
#include <cstdio>
#include <cstdint>
namespace pg8 {
#define PG8_LAS __attribute__((address_space(3)))
typedef unsigned short bf16_t;
typedef short bf16x8 __attribute__((ext_vector_type(8)));
typedef float f32x4 __attribute__((ext_vector_type(4)));
typedef unsigned u32x4 __attribute__((ext_vector_type(4)));
constexpr int BM = 256, BK = 64, HALF = 128, HTB = HALF * BK * 2  , STAGE_BYTES = 8 * HTB, NXCD = 8, WGM = 8;

__host__ __device__ __forceinline__ int lds_byte(int r, int c) { const int st = (r >> 4) * 2 + (c >> 5), rr = r & 15, cc = c & 31, ob = rr * 64 + cc * 2; return st * 1024 + (ob ^ (((ob >> 9) & 1) << 5)); }
__host__ __device__ __forceinline__ void stage_rc(int b, int& R, int& C) { const int st = b / 1024, sb = b % 1024, swz = sb ^ (((sb >> 9) & 1) << 5); R = (st >> 1) * 16 + swz / 64; C = (st & 1) * 32 + (swz % 64) / 2; }
__host__ __device__ __forceinline__ int perm32(int rho) { const int n = rho >> 4, i = rho & 15; return 8 * (i >> 2) + 4 * n + (i & 3); }

struct Unit { int pm, pn, kc; };
struct Gemm { const bf16_t* A; const bf16_t* Bt; int M, N, K; int klen = 0; };

struct StaticOrder {
    int nM, nN, nwg, G, c;
    __host__ __device__ void init(int M, int N, int G_, int c_) { nM = M / BM; nN = N / BM; nwg = nM * nN; G = G_; c = c_; }
    __host__ __device__ bool next(int i, Unit& u) const {
        const long L = (long)i * G + c; if (L >= nwg) return false;
        int wgid = (int)L; { const int q = nwg / NXCD, r = nwg % NXCD, xcd = wgid % NXCD, off = wgid / NXCD; wgid = (xcd < r ? xcd * (q + 1) : r * (q + 1) + (xcd - r) * q) + off; }
        const int nig = WGM * nN, gid = wgid / nig, fm = gid * WGM, gsz = (nM - fm) < WGM ? (nM - fm) : WGM;
        u.pm = fm + ((wgid % nig) % gsz); u.pn = (wgid % nig) / gsz; u.kc = 0; return true;
    }
    __device__ __forceinline__ void a_ready(const Unit&) const {}
    __device__ __forceinline__ void done(const Unit&) const {}
};

__device__ __forceinline__ unsigned cvt_pk_bf16(float lo, float hi) { unsigned r; asm volatile("v_cvt_pk_bf16_f32 %0, %1, %2" : "=v"(r) : "v"(lo), "v"(hi)); return r; }
typedef float f32x2 __attribute__((ext_vector_type(2)));
__device__ __forceinline__ float silu_f(float x) { return x * __builtin_amdgcn_rcpf(1.0f + __builtin_amdgcn_exp2f(-1.4426950408889634f * x)); }
struct EpiSwiGLU {
    static constexpr bool PERM = true, AFTER_DRAIN = false;
    bf16_t* O; int ldc;
    __device__ __forceinline__ void operator()(const f32x4 (&acc)[2][2][4][2], const Unit& u, int wr, int wc, int fr, int fq) const {
        const int row0 = u.pm * BM + wr * 64 + fr, col0 = u.pn * HALF + wc * 32 + 8 * fq;
#pragma unroll
        for (int ai = 0; ai < 2; ++ai)
#pragma unroll
            for (int m = 0; m < 4; ++m) { bf16_t* p = O + (size_t)(row0 + ai * HALF + m * 16) * ldc + col0;
                const f32x4 g0 = acc[ai][0][m][0], g1 = acc[ai][0][m][1], u0 = acc[ai][1][m][0], u1 = acc[ai][1][m][1];
                u32x4 w; w.x = cvt_pk_bf16(silu_f(g0[0]) * u0[0], silu_f(g0[1]) * u0[1]); w.y = cvt_pk_bf16(silu_f(g0[2]) * u0[2], silu_f(g0[3]) * u0[3]);
                w.z = cvt_pk_bf16(silu_f(g1[0]) * u1[0], silu_f(g1[1]) * u1[1]); w.w = cvt_pk_bf16(silu_f(g1[2]) * u1[2], silu_f(g1[3]) * u1[3]);
                *(u32x4*)p = w; }
    }
};
struct EpiResF32 {
    static constexpr bool PERM = false, AFTER_DRAIN = false;
    const float* res0; const float* res1; int split; float* out; int ldc; float alpha, s;
    __device__ __forceinline__ void operator()(const f32x4 (&acc)[2][2][4][2], const Unit& u, int wr, int wc, int fr, int fq) const {
        const int col0 = u.pn * BM + wc * 32 + 4 * fq;
#pragma unroll
        for (int ai = 0; ai < 2; ++ai)
#pragma unroll
            for (int m = 0; m < 4; ++m) { const int r = u.pm * BM + ai * HALF + wr * 64 + m * 16 + fr;
                const float* rp = (r < split) ? res0 + (size_t)r * ldc : res1 + (size_t)(r - split) * ldc; float* op = out + (size_t)r * ldc;
#pragma unroll
                for (int bj = 0; bj < 2; ++bj)
#pragma unroll
                    for (int n = 0; n < 2; ++n) { const int c = col0 + bj * HALF + n * 16; const f32x4 x = *(const f32x4*)(rp + c); *(f32x4*)(op + c) = x * alpha + acc[ai][bj][m][n] * s; }
                if (m & 1) asm volatile("" ::: "memory"); }
    }
};
struct EpiPlainBf16 {
    static constexpr bool PERM = true, AFTER_DRAIN = false;
    bf16_t* O; int ldc;
    __device__ __forceinline__ void operator()(const f32x4 (&acc)[2][2][4][2], const Unit& u, int wr, int wc, int fr, int fq) const {
        const int row0 = u.pm * BM + wr * 64 + fr, col0 = u.pn * BM + wc * 32 + 8 * fq;
#pragma unroll
        for (int ai = 0; ai < 2; ++ai)
#pragma unroll
            for (int m = 0; m < 4; ++m) { bf16_t* rowp = O + (size_t)(row0 + ai * HALF + m * 16) * ldc + col0;
#pragma unroll
                for (int bj = 0; bj < 2; ++bj) { const f32x4 v0 = acc[ai][bj][m][0], v1 = acc[ai][bj][m][1];
                    u32x4 w; w.x = cvt_pk_bf16(v0[0], v0[1]); w.y = cvt_pk_bf16(v0[2], v0[3]); w.z = cvt_pk_bf16(v1[0], v1[1]); w.w = cvt_pk_bf16(v1[2], v1[3]);
                    *(u32x4*)(rowp + bj * HALF) = w; } }
    }
};
struct SplitOrder {
    int nM, nN, ns, nwg, G, c;
    __host__ __device__ void init(int M, int N, int ns_, int G_, int c_) { nM = M / BM; nN = N / BM; ns = ns_; nwg = nM * nN * ns; G = G_; c = c_; }
    __host__ __device__ bool next(int i, Unit& u) const { const long L = (long)i * G + c; if (L >= nwg) return false; const int l = (int)L; u.kc = l % ns; u.pn = (l / ns) % nN; u.pm = l / (ns * nN); return true; }
    __device__ __forceinline__ void a_ready(const Unit&) const {}
    __device__ __forceinline__ void done(const Unit&) const {}
};
struct EpiPartialF32 {
    static constexpr bool PERM = false, AFTER_DRAIN = false;
    float* part; int ldc; size_t slice;
    __device__ __forceinline__ void operator()(const f32x4 (&acc)[2][2][4][2], const Unit& u, int wr, int wc, int fr, int fq) const {
        const int col0 = u.pn * BM + wc * 32 + 4 * fq; float* base = part + (size_t)u.kc * slice;
#pragma unroll
        for (int ai = 0; ai < 2; ++ai)
#pragma unroll
            for (int m = 0; m < 4; ++m) { const int r = u.pm * BM + ai * HALF + wr * 64 + m * 16 + fr; float* op = base + (size_t)r * ldc;
#pragma unroll
                for (int bj = 0; bj < 2; ++bj)
#pragma unroll
                    for (int n = 0; n < 2; ++n) *(f32x4*)(op + col0 + bj * HALF + n * 16) = acc[ai][bj][m][n]; }
    }
};
template <bool RESF32> struct EpiResBf16 {
    static constexpr bool PERM = true, AFTER_DRAIN = false;
    const void* res; bf16_t* out; int ldc; float alpha, s;
    __device__ __forceinline__ void operator()(const f32x4 (&acc)[2][2][4][2], const Unit& u, int wr, int wc, int fr, int fq) const {
        const int row0 = u.pm * BM + wr * 64 + fr, col0 = u.pn * BM + wc * 32 + 8 * fq;
#pragma unroll
        for (int ai = 0; ai < 2; ++ai)
#pragma unroll
            for (int m = 0; m < 4; ++m) { const size_t ro = (size_t)(row0 + ai * HALF + m * 16) * ldc + col0;
#pragma unroll
                for (int bj = 0; bj < 2; ++bj) { f32x4 r0, r1;
                    if (RESF32) { const float* rp = (const float*)res + ro + bj * HALF; r0 = *(const f32x4*)rp; r1 = *(const f32x4*)(rp + 4); }
                    else { const u32x4 rw = *(const u32x4*)((const bf16_t*)res + ro + bj * HALF);
                        r0 = (f32x4){__builtin_bit_cast(float, rw.x << 16), __builtin_bit_cast(float, rw.x & 0xffff0000u), __builtin_bit_cast(float, rw.y << 16), __builtin_bit_cast(float, rw.y & 0xffff0000u)};
                        r1 = (f32x4){__builtin_bit_cast(float, rw.z << 16), __builtin_bit_cast(float, rw.z & 0xffff0000u), __builtin_bit_cast(float, rw.w << 16), __builtin_bit_cast(float, rw.w & 0xffff0000u)}; }
                    const f32x4 v0 = r0 * alpha + acc[ai][bj][m][0] * s, v1 = r1 * alpha + acc[ai][bj][m][1] * s;
                    u32x4 w; w.x = cvt_pk_bf16(v0[0], v0[1]); w.y = cvt_pk_bf16(v0[2], v0[3]); w.z = cvt_pk_bf16(v1[0], v1[1]); w.w = cvt_pk_bf16(v1[2], v1[3]);
                    *(u32x4*)(out + ro + bj * HALF) = w; }
                if (m & 1) asm volatile("" ::: "memory"); }
    }
};
template <class Epi, class Sched, bool ALIGN_EPI = false, bool SP2 = false>
__device__ __forceinline__ void gemm_phase(PG8_LAS unsigned char* lds, const Gemm g, const Sched& S, const Epi& E, const int wid) {
    int lane_; asm volatile("v_mbcnt_lo_u32_b32 %0, -1, 0\n\tv_mbcnt_hi_u32_b32 %0, -1, %0" : "=v"(lane_));
    const int lane = lane_, tid = wid * 64 + lane, wr = wid >> 2, wc = wid & 3, fr = lane & 15, fq = lane >> 4;
    const int K = g.K, nt = (g.klen ? g.klen : K) / BK;
    const size_t kcstep = (size_t)g.klen * 2;
    unsigned voffA[2], voffB[2];
#pragma unroll
    for (int i = 0; i < 2; ++i) { int R, C; stage_rc(tid * 16 + i * 8192, R, C); const int Rb = Epi::PERM ? ((R & ~31) + perm32(R & 31)) : R;
        voffA[i] = (unsigned)(R * K + C) * 2u; voffB[i] = (unsigned)(Rb * K + C) * 2u; }
    const size_t kstep = (size_t)(BK * 2);
    const size_t hstep = (size_t)HALF * K * 2;
    const size_t tstep = 2 * hstep;
    const unsigned ldsw = (unsigned)wid * 1024u;
    const int aoff = lds_byte(wr * 64 + fr, fq * 8), boff = lds_byte(wc * 32 + fr, fq * 8);
#define PG8_SA(b, h) (((b) * 2 + (h)) * HTB)
#define PG8_SB(b, h) ((4 + (b) * 2 + (h)) * HTB)
#define PG8_STAGE(bufoff, gbase, voff) do { _Pragma("unroll") for (int _i = 0; _i < 2; ++_i) \
        __builtin_amdgcn_global_load_lds((const unsigned*)((const char*)(gbase) + (voff)[_i]), (PG8_LAS unsigned*)(lds + (bufoff) + ldsw + _i * 8192), 16, 0, 0); } while (0)
#define PG8_LDA(dst, b, h) do { _Pragma("unroll") for (int m = 0; m < 4; ++m) _Pragma("unroll") for (int k = 0; k < 2; ++k) dst[m][k] = *(const PG8_LAS bf16x8*)(lds + PG8_SA(b, h) + aoff + m * 2048 + k * 1024); } while (0)
#define PG8_LDB(dst, b, h) do { _Pragma("unroll") for (int n = 0; n < 2; ++n) _Pragma("unroll") for (int k = 0; k < 2; ++k) dst[n][k] = *(const PG8_LAS bf16x8*)(lds + PG8_SB(b, h) + boff + n * 2048 + k * 1024); } while (0)
#define PG8_MMA(ai, bj, At, Bt) do { __builtin_amdgcn_s_setprio(1); _Pragma("unroll") for (int m = 0; m < 4; ++m) _Pragma("unroll") for (int n = 0; n < 2; ++n) _Pragma("unroll") for (int k = 0; k < 2; ++k) \
        acc[ai][bj][m][n] = __builtin_amdgcn_mfma_f32_16x16x32_bf16(Bt[n][k], At[m][k], acc[ai][bj][m][n], 0, 0, 0); __builtin_amdgcn_s_setprio(0); } while (0)
#define PG8_WAIT_V(n) asm volatile("s_waitcnt vmcnt(" #n ")" ::: "memory")
#define PG8_WAIT_L(n) asm volatile("s_waitcnt lgkmcnt(" #n ")" ::: "memory")
#define PG8_BAR __builtin_amdgcn_s_barrier()
#define PG8_SCHED __builtin_amdgcn_sched_barrier(0)
    Unit cur, nxt; int ui = 0;
    if (!S.next(0, cur)) return;
    f32x4 acc[2][2][4][2];
#pragma unroll
    for (int a = 0; a < 2; ++a)
#pragma unroll
        for (int b = 0; b < 2; ++b)
#pragma unroll
            for (int m = 0; m < 4; ++m)
#pragma unroll
                for (int n = 0; n < 2; ++n) acc[a][b][m][n] = (f32x4){0.f, 0.f, 0.f, 0.f};
    bf16x8 At[4][2], B0[2][2], B1[2][2];
    const char* cA = (const char*)g.A + (size_t)cur.pm * tstep + (size_t)cur.kc * kcstep; const char* cB = (const char*)g.Bt + (size_t)cur.pn * tstep + (size_t)cur.kc * kcstep;
    S.a_ready(cur);
    if constexpr (SP2) {
        PG8_STAGE(PG8_SB(0, 0), cB, voffB); PG8_STAGE(PG8_SB(0, 1), cB + hstep, voffB); PG8_STAGE(PG8_SA(0, 0), cA, voffA); PG8_STAGE(PG8_SA(0, 1), cA + hstep, voffA);
        if (wr == 1) PG8_BAR;
        PG8_WAIT_V(2); PG8_BAR;
        PG8_STAGE(PG8_SB(1, 0), cB + kstep, voffB); PG8_STAGE(PG8_SA(1, 0), cA + kstep, voffA); PG8_STAGE(PG8_SB(1, 1), cB + hstep + kstep, voffB);
        PG8_WAIT_V(6); PG8_BAR;
    } else {
        PG8_STAGE(PG8_SB(0, 0), cB, voffB); PG8_STAGE(PG8_SA(0, 0), cA, voffA); PG8_STAGE(PG8_SB(0, 1), cB + hstep, voffB); PG8_STAGE(PG8_SA(0, 1), cA + hstep, voffA);
        if (wr == 1) PG8_BAR;
        PG8_WAIT_V(4); PG8_BAR;
        PG8_STAGE(PG8_SB(1, 0), cB + kstep, voffB); PG8_STAGE(PG8_SA(1, 0), cA + kstep, voffA); PG8_STAGE(PG8_SB(1, 1), cB + hstep + kstep, voffB);
        PG8_WAIT_V(6); PG8_BAR;
    }
    for (;;) {
        const bool has_next = S.next(ui + 1, nxt);
        const char* nA = has_next ? (const char*)g.A + (size_t)nxt.pm * tstep + (size_t)nxt.kc * kcstep : cA; const char* nB = has_next ? (const char*)g.Bt + (size_t)nxt.pn * tstep + (size_t)nxt.kc * kcstep : cB;
        for (int t = 0; t < nt; t += 2) {
            const bool last = (t == nt - 2);
            const char* a1 = cA + (size_t)(t + 1) * kstep;
            const char* a2 = last ? nA : cA + (size_t)(t + 2) * kstep; const char* b2 = last ? nB : cB + (size_t)(t + 2) * kstep;
            const char* a3 = a2 + kstep; const char* b3 = b2 + kstep;
            if (last && has_next) S.a_ready(nxt);
            if constexpr (SP2) {
            PG8_LDB(B0, 0, 0); PG8_LDB(B1, 0, 1); PG8_SCHED; PG8_LDA(At, 0, 0); PG8_STAGE(PG8_SA(1, 1), a1 + hstep, voffA);
            PG8_WAIT_V(8); PG8_WAIT_L(0); PG8_BAR; PG8_MMA(0, 0, At, B0); PG8_MMA(0, 1, At, B1); PG8_BAR; PG8_SCHED;
            PG8_LDA(At, 0, 1); PG8_STAGE(PG8_SB(0, 0), b2, voffB); PG8_STAGE(PG8_SB(0, 1), b2 + hstep, voffB); PG8_STAGE(PG8_SA(0, 0), a2, voffA);
            PG8_WAIT_V(8); PG8_WAIT_L(0); PG8_BAR; PG8_MMA(1, 0, At, B0); PG8_MMA(1, 1, At, B1); PG8_BAR; PG8_SCHED;
            PG8_LDB(B0, 1, 0); PG8_LDB(B1, 1, 1); PG8_SCHED; PG8_LDA(At, 1, 0); PG8_STAGE(PG8_SA(0, 1), a2 + hstep, voffA);
            PG8_WAIT_V(8); PG8_WAIT_L(0); PG8_BAR; PG8_MMA(0, 0, At, B0); PG8_MMA(0, 1, At, B1); PG8_BAR; PG8_SCHED;
            PG8_LDA(At, 1, 1); PG8_STAGE(PG8_SB(1, 0), b3, voffB); PG8_STAGE(PG8_SB(1, 1), b3 + hstep, voffB); PG8_STAGE(PG8_SA(1, 0), a3, voffA);
            PG8_WAIT_V(8); PG8_WAIT_L(0); PG8_BAR; PG8_MMA(1, 0, At, B0); PG8_MMA(1, 1, At, B1); PG8_BAR; PG8_SCHED;
            } else {
            PG8_LDB(B0, 0, 0); PG8_SCHED; PG8_LDA(At, 0, 0); PG8_STAGE(PG8_SA(1, 1), a1 + hstep, voffA);
            PG8_WAIT_L(8); PG8_BAR; PG8_WAIT_L(0); PG8_MMA(0, 0, At, B0); PG8_BAR; PG8_SCHED;
            PG8_LDB(B1, 0, 1); PG8_STAGE(PG8_SB(0, 0), b2, voffB);
            PG8_BAR; PG8_WAIT_L(0); PG8_MMA(0, 1, At, B1); PG8_BAR;
            PG8_LDA(At, 0, 1); PG8_STAGE(PG8_SA(0, 0), a2, voffA);
            PG8_BAR; PG8_WAIT_L(0); PG8_MMA(1, 0, At, B0); PG8_BAR; PG8_SCHED;
            PG8_STAGE(PG8_SB(0, 1), b2 + hstep, voffB);
            PG8_WAIT_V(6); PG8_BAR; PG8_MMA(1, 1, At, B1); PG8_BAR;
            PG8_LDB(B0, 1, 0); PG8_SCHED; PG8_LDA(At, 1, 0); PG8_STAGE(PG8_SA(0, 1), a2 + hstep, voffA);
            PG8_WAIT_L(8); PG8_BAR; PG8_WAIT_L(0); PG8_MMA(0, 0, At, B0); PG8_BAR; PG8_SCHED;
            PG8_LDB(B1, 1, 1); PG8_STAGE(PG8_SB(1, 0), b3, voffB);
            PG8_BAR; PG8_WAIT_L(0); PG8_MMA(0, 1, At, B1); PG8_BAR;
            PG8_LDA(At, 1, 1); PG8_STAGE(PG8_SA(1, 0), a3, voffA);
            PG8_BAR; PG8_WAIT_L(0); PG8_MMA(1, 0, At, B0); PG8_BAR; PG8_SCHED;
            PG8_STAGE(PG8_SB(1, 1), b3 + hstep, voffB);
            PG8_WAIT_V(6); PG8_BAR; PG8_MMA(1, 1, At, B1); PG8_BAR;
            }
        }
        if constexpr (ALIGN_EPI) { if (wr == 0) PG8_BAR; }
        if constexpr (!Epi::AFTER_DRAIN) { E(acc, cur, wr, wc, fr, fq); S.done(cur); }
        if (!has_next) break;
#pragma unroll
        for (int a = 0; a < 2; ++a)
#pragma unroll
            for (int b = 0; b < 2; ++b)
#pragma unroll
                for (int m = 0; m < 4; ++m)
#pragma unroll
                    for (int n = 0; n < 2; ++n) acc[a][b][m][n] = (f32x4){0.f, 0.f, 0.f, 0.f};
        cur = nxt; cA = nA; cB = nB; ++ui;
        if constexpr (ALIGN_EPI) { if (wr == 1) PG8_BAR; }
    }
    PG8_WAIT_V(0);
    if constexpr (!ALIGN_EPI) { if (wr == 0) PG8_BAR; }
    PG8_BAR;
    if constexpr (Epi::AFTER_DRAIN) { E.fused(acc, cur, wr, wc, fr, fq, lds, wid, lane); S.done(cur); }
#undef PG8_SA
#undef PG8_SB
#undef PG8_STAGE
#undef PG8_LDA
#undef PG8_LDB
#undef PG8_MMA
#undef PG8_WAIT_V
#undef PG8_WAIT_L
#undef PG8_BAR
#undef PG8_SCHED
}
}
constexpr int NWAVES = 8, NTHR = 512;
constexpr int D = 1024, BATCH = 16, SEQ = 2048, DECB = 128, DECT = 8, PAST = 8192, PAGE = 128, NPAGES = 64;
constexpr int MP = BATCH * SEQ, MS = DECB * DECT, M = MP + MS;
constexpr int FF = 2816, NGU = 2 * FF, INW = 3408, INWP = 3584;
constexpr int C_Q = 0, C_K = 512, C_V = 640, C_QI = 768, C_KI = 1280, C_WI = 1344, C_QKV = 1352, C_Z = 2888, C_BG = 3400, C_AG = 3404;
constexpr int GH = 4, GDK = 128, GDV = 128, CONVC = 1536, NCHUNK = SEQ / 64, GDN_UNITS = 2048 + DECB * GH;
constexpr int KSEL = 256, LS = PAST + DECT, SCS_LD = 8208;
constexpr float LN_EPS = 1e-5f, NORM_EPS = 1e-6f, ALPHA = 1.189207115002721f;
constexpr size_t O_YP = 0, O_YS = 33554432, O_KP = 34603008, O_VP = 38797312, O_IP = 42991616, O_GP = 45088768, O_CP = 46137344, O_KS = 46211072, O_VS = 46342144, O_IS = 46473216, O_GS = 46538752, O_CS = 54927360, O_END = 55517184;
constexpr size_t MiB = 1u << 20;
constexpr size_t WS_CTL = 0, CTL_ZERO_BYTES = 1 * MiB, WS_ROPE = 1 * MiB;
constexpr size_t WS_WGU1 = 2 * MiB, WS_WD1 = 13 * MiB, WS_WIN = 19 * MiB, WS_WO = 26 * MiB, WS_WGU2 = 28 * MiB, WS_WD2 = 39 * MiB;
constexpr size_t WS_XB = 48 * MiB, WS_X1 = 116 * MiB, WS_X2 = 248 * MiB, WS_R = 380 * MiB, WS_H = 512 * MiB, WS_P = 696 * MiB;
constexpr size_t WS_QB = 928 * MiB, WS_QI = 961 * MiB, WS_KB = 994 * MiB, WS_VT = 1003 * MiB, WS_KI = 1011 * MiB, WS_WI = 1016 * MiB, WS_BG = 1018 * MiB;
constexpr size_t WS_CAT = 1020 * MiB, WS_OG = 1086 * MiB, WS_GSC = 1152 * MiB, WS_GL = 1334 * MiB, WS_SCS = 1336 * MiB, WS_PART = 1370 * MiB, WS_END = 1418 * MiB;
constexpr size_t GSC_UNIT = 73728;
static_assert(WS_WGU1 + (size_t)NGU * D * 2 <= WS_WD1 && WS_WD1 + (size_t)D * FF * 2 <= WS_WIN && WS_WIN + (size_t)INWP * D * 2 <= WS_WO && WS_WO + (size_t)D * D * 2 <= WS_WGU2, "ws map 1");
static_assert(WS_XB + (size_t)M * D * 2 <= WS_X1 && WS_X1 + (size_t)M * D * 4 <= WS_X2 && WS_X2 + (size_t)M * D * 4 <= WS_R && WS_R + (size_t)M * D * 4 <= WS_H && WS_H + (size_t)M * FF * 2 <= WS_P && WS_P + (size_t)M * INWP * 2 <= WS_QB, "ws map 2");
static_assert(WS_QB + (size_t)M * 512 * 2 <= WS_QI && WS_QI + (size_t)M * 512 * 2 <= WS_KB && WS_KB + (size_t)M * 128 * 2 <= WS_VT && WS_VT + (size_t)MP * 128 * 2 <= WS_KI && WS_KI + (size_t)M * 64 * 2 <= WS_WI && WS_WI + (size_t)M * 8 * 4 <= WS_BG && WS_BG + (size_t)M * 8 * 4 <= WS_CAT, "ws map 3");
static_assert(WS_CAT + (size_t)M * D * 2 <= WS_OG && WS_OG + (size_t)M * 512 * 4 <= WS_GSC && WS_GSC + (size_t)GDN_UNITS * GSC_UNIT <= WS_GL && WS_SCS + (size_t)MS * SCS_LD * 4 <= WS_END, "ws map 4");
constexpr int CW_TMO = 0, CW_CODE = 1, CW_BAR = 4096;
constexpr int RING_OFF = 0, RING_BYTES = 151552;
constexpr int LDSCTL_OFF = RING_BYTES, MISC_OFF = LDSCTL_OFF + 320;
constexpr int LDS_BYTES = 152576;
static_assert(MISC_OFF + 128 <= LDS_BYTES, "LDS map");

#define GAS __attribute__((address_space(1)))
#define LAS __attribute__((address_space(3)))
typedef unsigned short bf16;
typedef _Float16 f16;
typedef unsigned v4u __attribute__((ext_vector_type(4)));
typedef unsigned v2u __attribute__((ext_vector_type(2)));
typedef float f32x4 __attribute__((ext_vector_type(4)));
typedef float f32x2 __attribute__((ext_vector_type(2)));
typedef float f32x16 __attribute__((ext_vector_type(16)));
typedef short bf16x8 __attribute__((ext_vector_type(8)));
typedef short s16x4 __attribute__((ext_vector_type(4)));
typedef _Float16 f16x8 __attribute__((ext_vector_type(8)));
typedef GAS unsigned gu32;
#define RLX_AGENT __ATOMIC_RELAXED, __HIP_MEMORY_SCOPE_AGENT
#define LDS_WAIT() asm volatile("s_waitcnt lgkmcnt(0)" ::: "memory")
#define VM_WAIT() asm volatile("s_waitcnt vmcnt(0)" ::: "memory")
__device__ __forceinline__ unsigned f2bf(float f) { unsigned u = __builtin_bit_cast(unsigned, f); return (u + 0x7fffu + ((u >> 16) & 1u)) >> 16; }
__device__ __forceinline__ unsigned pk2(float lo, float hi) { return f2bf(lo) | (f2bf(hi) << 16); }
__device__ __forceinline__ float bf2f(unsigned short b) { return __builtin_bit_cast(float, (unsigned)b << 16); }
__device__ __forceinline__ float bflo(unsigned w) { return __builtin_bit_cast(float, w << 16); }
__device__ __forceinline__ float bfhi(unsigned w) { return __builtin_bit_cast(float, w & 0xffff0000u); }
__device__ __forceinline__ float wave_sum(float v) {
#pragma unroll
    for (int o = 1; o < 64; o <<= 1) v += __shfl_xor(v, o);
    return v;
}
__device__ __forceinline__ float wave_max(float v) {
#pragma unroll
    for (int o = 1; o < 64; o <<= 1) v = fmaxf(v, __shfl_xor(v, o));
    return v;
}
__device__ __forceinline__ int lane_fresh() { int l; asm volatile("v_mbcnt_lo_u32_b32 %0, -1, 0\n\tv_mbcnt_hi_u32_b32 %0, -1, %0" : "=v"(l)); return l; }
__device__ __forceinline__ int lane_dep(int dep) { int l; asm volatile("v_mbcnt_lo_u32_b32 %0, -1, 0\n\tv_mbcnt_hi_u32_b32 %0, -1, %0" : "=v"(l) : "s"(dep)); return l; }
template <int CTRL> __device__ __forceinline__ int dpp_mov(int v) { return __builtin_amdgcn_update_dpp(0, v, CTRL, 0xf, 0xf, true); }
#define WAVE_REDUCE_U32(v, OP) do { unsigned t_; \
    t_ = (unsigned)dpp_mov<0xB1>((int)(v)); (v) = OP((v), t_); t_ = (unsigned)dpp_mov<0x4E>((int)(v)); (v) = OP((v), t_); \
    t_ = (unsigned)dpp_mov<0x141>((int)(v)); (v) = OP((v), t_); t_ = (unsigned)dpp_mov<0x140>((int)(v)); (v) = OP((v), t_); \
    const unsigned a_ = (unsigned)__builtin_amdgcn_readlane((int)(v), 0), b_ = (unsigned)__builtin_amdgcn_readlane((int)(v), 16), c_ = (unsigned)__builtin_amdgcn_readlane((int)(v), 32), d_ = (unsigned)__builtin_amdgcn_readlane((int)(v), 48); \
    (v) = OP(OP(a_, b_), OP(c_, d_)); } while (0)
__device__ __forceinline__ unsigned umin_(unsigned a, unsigned b) { return a < b ? a : b; }
__device__ __forceinline__ unsigned umax_(unsigned a, unsigned b) { return a > b ? a : b; }
__device__ __forceinline__ unsigned wave_suffix_sum(unsigned v, int lane) {
    unsigned s = v;
    s += (unsigned)dpp_mov<0x101>((int)s); s += (unsigned)dpp_mov<0x102>((int)s); s += (unsigned)dpp_mov<0x104>((int)s); s += (unsigned)dpp_mov<0x108>((int)s);
    const unsigned t1 = (unsigned)__builtin_amdgcn_readlane((int)s, 16), t2 = (unsigned)__builtin_amdgcn_readlane((int)s, 32), t3 = (unsigned)__builtin_amdgcn_readlane((int)s, 48);
    const int row = lane >> 4;
    return s + (row == 0 ? t1 + t2 + t3 : row == 1 ? t2 + t3 : row == 2 ? t3 : 0u);
}
#define XB_TMO      128
#define XB_XCNT(j)  (256  + 64 * (j))
#define XB_XSUB(j)  (1280 + 64 * (j))
#define XB_XGEN(j)  (2304 + 64 * (j))
#define XB_TOP      3328
#define XB_TOPGEN   3392
#define XCD_BAR_WORDS 3456
#define XB_SPIN_CAP (1u << 18)

__device__ __forceinline__ unsigned xb_ld(unsigned* p)              { return __hip_atomic_load(p, __ATOMIC_RELAXED, __HIP_MEMORY_SCOPE_AGENT); }
__device__ __forceinline__ unsigned xb_add(unsigned* p, unsigned v) { return __hip_atomic_fetch_add(p, v, __ATOMIC_RELAXED, __HIP_MEMORY_SCOPE_AGENT); }
__device__ __forceinline__ unsigned xb_xcc_id() { return (unsigned)__builtin_amdgcn_s_getreg((3 << 11) | 20) & 0xFu; }
#define XB_SPIN(cond, bar) do { unsigned _sp = 0; while (cond) { __builtin_amdgcn_s_sleep(1); \
    if ((++_sp & 255u) == 0u) { if (xb_ld(&(bar)[XB_TMO])) break; if (_sp > XB_SPIN_CAP) { atomicAdd(&(bar)[XB_TMO], 1u); break; } } } } while (0)

struct XcdBarrier {
    int wave; unsigned* bar; unsigned x;
    volatile LAS unsigned* st;
};

__device__ __forceinline__ XcdBarrier xcd_barrier_post(unsigned* bar, volatile LAS unsigned* st, int wave) {
    XcdBarrier b; b.wave = wave; b.bar = bar; b.x = xb_xcc_id(); b.st = st;
    if (wave == 0 && lane_fresh() == 0) (void)xb_add(&bar[XB_XCNT(b.x)], 1u);
    return b;
}
__device__ __forceinline__ void xcd_barrier_complete(unsigned* bar, unsigned x, unsigned& nloc, unsigned& nx) {
    const unsigned G = gridDim.x * gridDim.y * gridDim.z;
    unsigned sum, cnt, mine, sp = 0u;
    for (;;) {
        sum = 0u; cnt = 0u; mine = 0u;
#pragma unroll
        for (unsigned j = 0; j < 16; ++j) { const unsigned c = xb_ld(&bar[XB_XCNT(j)]); sum += c; cnt += (c > 0u) ? 1u : 0u; mine = (j == x) ? c : mine; }
        if (sum == G) break;
        __builtin_amdgcn_s_sleep(1);
        if ((++sp & 255u) == 0u) { if (xb_ld(&bar[XB_TMO])) break; if (sp > XB_SPIN_CAP) { atomicAdd(&bar[XB_TMO], 1u); break; } }
    }
    nloc = mine > 0u ? mine : 1u; nx = cnt > 0u ? cnt : 1u;
}

__device__ __forceinline__ void xcd_barrier(const XcdBarrier& b) {
    asm volatile("s_waitcnt vmcnt(0)" ::: "memory");
    __syncthreads();
    if (b.wave == 0 && lane_fresh() == 0) {
        unsigned* bar = b.bar;
        __builtin_amdgcn_s_waitcnt(0);
        unsigned nloc = b.st[0], nx = b.st[1];
        if (nloc == 0u) { xcd_barrier_complete(bar, b.x, nloc, nx); b.st[0] = nloc; b.st[1] = nx; }
        const unsigned old = xb_add(&bar[XB_XSUB(b.x)], 1u);
        const unsigned gen = old / nloc;
        if (old + 1u == (gen + 1u) * nloc) {
            __builtin_amdgcn_fence(__ATOMIC_RELEASE, "agent");
            asm volatile("s_waitcnt vmcnt(0)" ::: "memory");
            const unsigned og = xb_add(&bar[XB_TOP], 1u);
            const unsigned tg = og / nx;
            if (og + 1u == (tg + 1u) * nx) xb_add(&bar[XB_TOPGEN], 1u);
            else XB_SPIN(xb_ld(&bar[XB_TOPGEN]) == tg, bar);
            __builtin_amdgcn_fence(__ATOMIC_ACQUIRE, "agent");
            xb_add(&bar[XB_XGEN(b.x)], 1u);
            asm volatile("s_waitcnt vmcnt(0)" ::: "memory");
        } else {
            XB_SPIN(xb_ld(&bar[XB_XGEN(b.x)]) == gen, bar);
            __builtin_amdgcn_fence(__ATOMIC_ACQUIRE, "agent");
            asm volatile("s_waitcnt vmcnt(0)" ::: "memory");
        }
    }
    __syncthreads();
}
struct Frame {
    LAS unsigned char* lds;
    volatile LAS unsigned* MISC;
    gu32* ctl;
    int wave, G, bx;
    float* out; unsigned char* ws;
};
struct Args { const float* in[26]; float* out; unsigned char* ws; int ph_lo, ph_hi; };
#define WSP(T, off) ((T*)(F.ws + (off)))

__device__ __forceinline__ void p0_transpose_item(const float* W, int K, int N, bf16* WT, int drow0, int k0, int n0, LAS float* scr, int lane) {
    const int nc = n0 + (lane & 31); const bool ok = nc < N;
#pragma unroll 8
    for (int i = 0; i < 32; ++i) { const int kk = 2 * i + (lane >> 5); scr[kk * 33 + (lane & 31)] = ok ? W[(size_t)(k0 + kk) * N + nc] : 0.f; }
    LDS_WAIT(); asm volatile("" ::: "memory");
    const int c = lane & 7;
#pragma unroll
    for (int j = 0; j < 4; ++j) { const int n = (lane >> 3) + 8 * j; const LAS float* s = scr + (8 * c) * 33 + n;
        v4u o; o.x = pk2(s[0 * 33], s[1 * 33]); o.y = pk2(s[2 * 33], s[3 * 33]); o.z = pk2(s[4 * 33], s[5 * 33]); o.w = pk2(s[6 * 33], s[7 * 33]);
        *(GAS v4u*)(WT + (size_t)(drow0 + n) * K + k0 + 8 * c) = o; }
    LDS_WAIT(); asm volatile("" ::: "memory");
}
__device__ __forceinline__ void p0_prologue(Frame& F, const Args& A) {
    LAS float* scr = (LAS float*)(F.lds + RING_OFF + F.wave * 16384);
    const int lane = lane_fresh();
    const int gw = F.bx * NWAVES + F.wave, NGW = F.G * NWAVES;
    constexpr int I_GU = (D / 64) * (FF / 32), I_D = (FF / 64) * (D / 32), I_IN = (D / 64) * (INWP / 32), I_O = (D / 64) * (D / 32);
    constexpr int NITEMS = 4 * I_GU + 2 * I_D + I_IN + I_O;
    for (int it = gw; it < NITEMS; it += NGW) {
        int r = it;
        if (r < 4 * I_GU) {
            const int which = r / I_GU; r -= which * I_GU; const int nblk = FF / 32, kb = r / nblk, nb = r % nblk, n0 = 32 * nb;
            const float* W = which == 0 ? A.in[8] : which == 1 ? A.in[9] : which == 2 ? A.in[21] : A.in[22];
            bf16* WT = WSP(bf16, (which < 2) ? WS_WGU1 : WS_WGU2);
            const int drow0 = 256 * (n0 >> 7) + (n0 & 127) + ((which & 1) ? 128 : 0);
            p0_transpose_item(W, D, FF, WT, drow0, 64 * kb, n0, scr, lane); continue; }
        r -= 4 * I_GU;
        if (r < 2 * I_D) { const int which = r / I_D; r -= which * I_D; const int nblk = D / 32, kb = r / nblk, nb = r % nblk;
            p0_transpose_item(which ? A.in[23] : A.in[10], FF, D, WSP(bf16, which ? WS_WD2 : WS_WD1), 32 * nb, 64 * kb, 32 * nb, scr, lane); continue; }
        r -= 2 * I_D;
        if (r < I_IN) { const int nblk = INWP / 32, kb = r / nblk, nb = r % nblk;
            p0_transpose_item(A.in[13], D, INW, WSP(bf16, WS_WIN), 32 * nb, 64 * kb, 32 * nb, scr, lane); continue; }
        r -= I_IN;
        { const int nblk = D / 32, kb = r / nblk, nb = r % nblk; p0_transpose_item(A.in[18], D, D, WSP(bf16, WS_WO), 32 * nb, 64 * kb, 32 * nb, scr, lane); }
    }
    bf16* XB = WSP(bf16, WS_XB);
    for (int m = gw; m < M; m += NGW) {
        const float* xr = (m < MP) ? A.in[0] + (size_t)m * D : A.in[1] + (size_t)(m - MP) * D;
        const GAS f32x4* x4 = (const GAS f32x4*)xr + lane; GAS unsigned long long* o8 = (GAS unsigned long long*)(XB + (size_t)m * D) + lane;
#pragma unroll
        for (int j = 0; j < 4; ++j) { const f32x4 v = x4[64 * j]; o8[64 * j] = (unsigned long long)pk2(v.x, v.y) | ((unsigned long long)pk2(v.z, v.w) << 32); }
    }
    float* rope = WSP(float, WS_ROPE);
    for (int i = gw * 64 + lane; i < (SEQ + DECT) * 8; i += NGW * 64) {
        const int pi = i >> 3, f = i & 7; const float pos = (float)(pi < SEQ ? pi : PAST + pi - SEQ);
        const float invf = powf(500000.0f, -(float)f / 8.0f); const float ang = pos * invf;
        rope[pi * 16 + f] = cosf(ang); rope[pi * 16 + 8 + f] = sinf(ang);
    }
}
__device__ __forceinline__ void ln_phase(Frame& F, const bf16* RB, const float* g, const float* b, float* dstf, bf16* dstb, const float* part, int nsplit, const float* resf, const bf16* resb, float pscale) {
    const int lane = lane_fresh();
    const int gw = F.bx * NWAVES + F.wave, NGW = F.G * NWAVES;
    f32x4 gv[4], bv[4];
#pragma unroll
    for (int j = 0; j < 2; ++j) { gv[2 * j] = *(const GAS f32x4*)(g + 512 * j + 8 * lane); gv[2 * j + 1] = *(const GAS f32x4*)(g + 512 * j + 8 * lane + 4); bv[2 * j] = *(const GAS f32x4*)(b + 512 * j + 8 * lane); bv[2 * j + 1] = *(const GAS f32x4*)(b + 512 * j + 8 * lane + 4); }
#define LN_UNPK(W, A0, A1) do { A0 = (f32x4){bflo(W.x), bfhi(W.x), bflo(W.y), bfhi(W.y)}; A1 = (f32x4){bflo(W.z), bfhi(W.z), bflo(W.w), bfhi(W.w)}; } while (0)
    for (int m = gw; m < M; m += NGW) {
        f32x4 v[4]; float s = 0.f;
        if (m >= MP) {
            const int ms = m - MP;
#pragma unroll
            for (int j = 0; j < 4; ++j) v[j] = (f32x4){0.f, 0.f, 0.f, 0.f};
#pragma unroll 1
            for (int k = 0; k < nsplit; ++k) { const float* pp = part + ((size_t)k * MS + ms) * D + 8 * lane;
#pragma unroll
                for (int j = 0; j < 2; ++j) { v[2 * j] = v[2 * j] + *(const GAS f32x4*)(pp + 512 * j); v[2 * j + 1] = v[2 * j + 1] + *(const GAS f32x4*)(pp + 512 * j + 4); } }
#pragma unroll
            for (int j = 0; j < 2; ++j) { f32x4 r0, r1;
                if (resf) { r0 = *(const GAS f32x4*)(resf + (size_t)ms * D + 512 * j + 8 * lane); r1 = *(const GAS f32x4*)(resf + (size_t)ms * D + 512 * j + 8 * lane + 4); }
                else { const v4u w = *(const GAS v4u*)(resb + (size_t)m * D + 512 * j + 8 * lane); LN_UNPK(w, r0, r1); }
                v[2 * j] = r0 * ALPHA + v[2 * j] * pscale; v[2 * j + 1] = r1 * ALPHA + v[2 * j + 1] * pscale; }
        } else {
#pragma unroll
            for (int j = 0; j < 2; ++j) { const v4u w = *(const GAS v4u*)(RB + (size_t)m * D + 512 * j + 8 * lane); LN_UNPK(w, v[2 * j], v[2 * j + 1]); }
        }
#pragma unroll
        for (int j = 0; j < 4; ++j) s += (v[j].x + v[j].y) + (v[j].z + v[j].w);
        const float mean = wave_sum(s) * (1.f / D); float s2 = 0.f;
#pragma unroll
        for (int j = 0; j < 4; ++j) { v[j] = v[j] - mean; s2 += (v[j].x * v[j].x + v[j].y * v[j].y) + (v[j].z * v[j].z + v[j].w * v[j].w); }
        const float rstd = 1.f / sqrtf(wave_sum(s2) * (1.f / D) + LN_EPS);
#pragma unroll
        for (int j = 0; j < 4; ++j) { v[j] = v[j] * rstd * gv[j] + bv[j]; }
        if (dstf) {
#pragma unroll
            for (int j = 0; j < 2; ++j) { *(GAS f32x4*)(dstf + (size_t)m * D + 512 * j + 8 * lane) = v[2 * j]; *(GAS f32x4*)(dstf + (size_t)m * D + 512 * j + 8 * lane + 4) = v[2 * j + 1]; } }
        if (dstb) {
#pragma unroll
            for (int j = 0; j < 2; ++j) { v4u w; w.x = pk2(v[2 * j].x, v[2 * j].y); w.y = pk2(v[2 * j].z, v[2 * j].w); w.z = pk2(v[2 * j + 1].x, v[2 * j + 1].y); w.w = pk2(v[2 * j + 1].z, v[2 * j + 1].w);
                *(GAS v4u*)(dstb + (size_t)m * D + 512 * j + 8 * lane) = w; } }
    }
#undef LN_UNPK
}
__device__ __forceinline__ void post_phase(Frame& F, const Args& A) {
    const int lane = lane_fresh();
    const int gw = F.bx * NWAVES + F.wave, NGW = F.G * NWAVES;
    const bf16* P = WSP(bf16, WS_P); const float* rope = WSP(float, WS_ROPE);
    bf16* Qb = WSP(bf16, WS_QB); f16* QIh = WSP(f16, WS_QI); bf16* Kb = WSP(bf16, WS_KB); f16* KIh = WSP(f16, WS_KI); float* WI = WSP(float, WS_WI); float* BG = WSP(float, WS_BG);
    const f32x4 alog = *(const GAS f32x4*)A.in[15], dtb4 = *(const GAS f32x4*)A.in[16];
    const float a_exp[4] = {expf(alog.x), expf(alog.y), expf(alog.z), expf(alog.w)}; const float dtb[4] = {dtb4.x, dtb4.y, dtb4.z, dtb4.w};
    const int j8 = lane & 7; const bool rot = j8 < 2; const float sgn = (j8 == 0) ? -1.f : 1.f;
    for (int m = gw; m < M; m += NGW) {
        const bool prm = m < MP; const int ms = m - MP; const int b = prm ? (m >> 11) : (ms >> 3), t = prm ? (m & 2047) : (ms & 7), pi = prm ? t : SEQ + t;
        const bf16* p = P + (size_t)m * INWP;
        const int c3 = lane < 32 ? C_K + 8 * lane : (lane < 41 ? C_KI + 8 * (lane - 32) : C_BG);
        const v4u rq = *(const GAS v4u*)(p + C_Q + 8 * lane), ri = *(const GAS v4u*)(p + C_QI + 8 * lane);
        v4u r3 = (v4u){0u, 0u, 0u, 0u}; if (lane < 42) r3 = *(const GAS v4u*)(p + c3);
        const f32x4 c0 = *(const GAS f32x4*)(rope + pi * 16), c1 = *(const GAS f32x4*)(rope + pi * 16 + 4), s0 = *(const GAS f32x4*)(rope + pi * 16 + 8), s1 = *(const GAS f32x4*)(rope + pi * 16 + 12);
        const float cs[8] = {c0.x, c0.y, c0.z, c0.w, c1.x, c1.y, c1.z, c1.w}; const float sn[8] = {s0.x, s0.y, s0.z, s0.w, s1.x, s1.y, s1.z, s1.w};
        float xq[8], xi[8], x3[8];
#pragma unroll
        for (int e = 0; e < 4; ++e) { xq[2 * e] = bflo(rq[e]); xq[2 * e + 1] = bfhi(rq[e]); xi[2 * e] = bflo(ri[e]); xi[2 * e + 1] = bfhi(ri[e]); x3[2 * e] = bflo(r3[e]); x3[2 * e + 1] = bfhi(r3[e]); }
        const bool rot3 = rot && (lane < 16 || (lane >= 32 && lane < 40));
#pragma unroll
        for (int e = 0; e < 8; ++e) { const float pq = __shfl_xor(xq[e], 1), pi_ = __shfl_xor(xi[e], 1), p3 = __shfl_xor(x3[e], 1);
            if (rot) { xq[e] = xq[e] * cs[e] + sgn * pq * sn[e]; xi[e] = xi[e] * cs[e] + sgn * pi_ * sn[e]; }
            if (rot3) x3[e] = x3[e] * cs[e] + sgn * p3 * sn[e]; }
        { v4u w; const float qs = 0.125f * 1.4426950408889634f;
#pragma unroll
          for (int e = 0; e < 4; ++e) w[e] = pk2(xq[2 * e] * qs, xq[2 * e + 1] * qs);
          *(GAS v4u*)(Qb + (size_t)m * 512 + 8 * lane) = w;
          f16x8 h;
#pragma unroll
          for (int e = 0; e < 8; ++e) h[e] = (f16)xi[e];
          *(GAS f16x8*)(QIh + (size_t)m * 512 + 8 * lane) = h; }
        if (lane < 32) {
            float* o = F.out + (lane < 16 ? (prm ? O_KP + (size_t)m * 128 : O_KS + (size_t)ms * 128) + 8 * lane : (prm ? O_VP + (size_t)m * 128 : O_VS + (size_t)ms * 128) + 8 * (lane - 16));
            *(GAS f32x4*)o = (f32x4){x3[0], x3[1], x3[2], x3[3]}; *(GAS f32x4*)(o + 4) = (f32x4){x3[4], x3[5], x3[6], x3[7]};
            if (lane < 16) { v4u w;
#pragma unroll
                for (int e = 0; e < 4; ++e) w[e] = pk2(x3[2 * e], x3[2 * e + 1]);
                *(GAS v4u*)(Kb + (size_t)m * 128 + 8 * lane) = w; }
        } else if (lane < 40) {
            float* o = F.out + (prm ? O_IP + (size_t)m * 64 : O_IS + (size_t)ms * 64) + 8 * (lane - 32);
            *(GAS f32x4*)o = (f32x4){x3[0], x3[1], x3[2], x3[3]}; *(GAS f32x4*)(o + 4) = (f32x4){x3[4], x3[5], x3[6], x3[7]};
            f16x8 h;
#pragma unroll
            for (int e = 0; e < 8; ++e) h[e] = (f16)x3[e];
            *(GAS f16x8*)(KIh + (size_t)m * 64 + 8 * (lane - 32)) = h;
        } else if (lane == 40) {
            const float ws = 0.35355339059327373f * 0.125f;
            *(GAS f32x4*)(WI + (size_t)m * 8) = (f32x4){x3[0] * ws, x3[1] * ws, x3[2] * ws, x3[3] * ws}; *(GAS f32x4*)(WI + (size_t)m * 8 + 4) = (f32x4){x3[4] * ws, x3[5] * ws, x3[6] * ws, x3[7] * ws};
        } else if (lane == 41) {
            float be[4], gg[4];
#pragma unroll
            for (int e = 0; e < 4; ++e) { be[e] = 1.f / (1.f + expf(-x3[e])); const float ag = x3[4 + e] + dtb[e]; gg[e] = -a_exp[e] * (ag > 20.f ? ag : log1pf(expf(ag))); }
            *(GAS f32x4*)(BG + (size_t)m * 8) = (f32x4){be[0], be[1], be[2], be[3]}; *(GAS f32x4*)(BG + (size_t)m * 8 + 4) = (f32x4){gg[0], gg[1], gg[2], gg[3]};
        }
        const int trow = prm ? t - (SEQ - 3) : t - (DECT - 3);
        if (trow >= 0) { float* co = F.out + (prm ? O_CP : O_CS) + ((size_t)b * 3 + trow) * CONVC;
#pragma unroll
            for (int k = 0; k < 3; ++k) { const v4u rc = *(const GAS v4u*)(p + C_QKV + 512 * k + 8 * lane);
                *(GAS f32x4*)(co + 512 * k + 8 * lane) = (f32x4){bflo(rc[0]), bfhi(rc[0]), bflo(rc[1]), bfhi(rc[1])}; *(GAS f32x4*)(co + 512 * k + 8 * lane + 4) = (f32x4){bflo(rc[2]), bfhi(rc[2]), bflo(rc[3]), bfhi(rc[3])}; } }
    }
    LAS bf16* tile = (LAS bf16*)(F.lds + RING_OFF + F.wave * 16384);
    bf16* VT = WSP(bf16, WS_VT);
    for (int it = gw; it < BATCH * 2 * (SEQ / 64); it += NGW) {
        const int tb = it % (SEQ / 64), g = (it / (SEQ / 64)) & 1, b = it / (2 * (SEQ / 64));
        for (int tt = 0; tt < 64; ++tt) tile[tt * 66 + lane] = P[(size_t)(b * SEQ + tb * 64 + tt) * INWP + C_V + g * 64 + lane];
        LDS_WAIT(); asm volatile("" ::: "memory");
        { const int kk = lane & 31, pos = ((kk >> 2) & 1) * 16 + ((kk >> 4) * 2 + ((kk >> 3) & 1)) * 4 + (kk & 3); bf16* vt = VT + (((size_t)(b * 2 + g) * (SEQ / 32) + 2 * tb + (lane >> 5)) * 64) * 32 + pos;
          for (int d = 0; d < 64; ++d) vt[d * 32] = tile[lane * 66 + d]; }
        LDS_WAIT(); asm volatile("" ::: "memory");
    }
}
#define MFMA32 __builtin_amdgcn_mfma_f32_32x32x16_bf16
__device__ __forceinline__ int crow(int r, int hh) { return (r & 3) + 8 * (r >> 2) + 4 * hh; }
__device__ __forceinline__ f32x16 zero16() { f32x16 z; for (int i = 0; i < 16; ++i) z[i] = 0.f; return z; }
constexpr int GT_LD = 272;
constexpr int GP_HALF = 72704;
constexpr int GP_Q = 0, GP_K = 17408, GP_V = 34816, GP_A = 52224, GP_G = 69632, GP_B = 69888, GP_EG = 70144;
__device__ __forceinline__ void gdn_prep_phase(Frame& F, const Args& A) {
    const int half = F.wave >> 2, hw = F.wave & 3;
    LAS unsigned char* L = F.lds + RING_OFF + half * GP_HALF;
    const bf16* P = WSP(bf16, WS_P); const float* BG = WSP(float, WS_BG); const float* cw = A.in[14];
    const float* sconv = A.in[6];
    const int nit = (GDN_UNITS + 2 * F.G - 1) / (2 * F.G);
    for (int it = 0; it < nit; ++it) {
        const int lane = lane_fresh();
        const int ht = (hw << 6) | lane;
        const int u = (it * F.G + F.bx) * 2 + half; const bool live = u < GDN_UNITS;
        const bool smp = u >= 2048; const int us = u - 2048;
        const int c = smp ? 0 : (u & 31), h = smp ? (us & 3) : ((u >> 5) & 3), b = smp ? (us >> 2) : (u >> 7);
        const size_t mrow0 = smp ? (size_t)MP + (size_t)b * DECT : (size_t)b * SEQ;
        const int nreal = smp ? DECT : 64;
        unsigned char* gs = F.ws + WS_GSC + (size_t)u * GSC_UNIT;
        if (live) {
            LAS float* wl = (LAS float*)(L + GP_A);
#pragma unroll
            for (int k = 0; k < 6; ++k) { const int idx = ht + 256 * k, p = idx >> 9, j = (idx >> 7) & 3, ch = idx & 127; wl[idx] = cw[j * CONVC + p * 512 + h * 128 + ch]; }
        }
        LDS_WAIT(); __syncthreads();
        if (live) {
            const LAS float* wl = (const LAS float*)(L + GP_A);
            const int ti = lane >> 2, qq = lane & 3, row = hw * 16 + ti, tt = c * 64 + row; const bool real = row < nreal;
#pragma unroll 1
            for (int p = 0; p < 3; ++p) {
                float y[32];
#pragma unroll
                for (int ch4 = 0; ch4 < 4; ++ch4) { const int col = p * 512 + h * 128 + 32 * qq + 8 * ch4;
                    float a[8];
#pragma unroll
                    for (int e = 0; e < 8; ++e) a[e] = 0.f;
#pragma unroll
                    for (int j = 0; j < 4; ++j) { const int rr = tt - 3 + j; float x[8];
                        if (rr >= 0 && (!smp || rr < nreal)) { const v4u xv = *(const GAS v4u*)(P + (mrow0 + rr) * INWP + C_QKV + col);
#pragma unroll
                            for (int e = 0; e < 4; ++e) { x[2 * e] = bflo(xv[e]); x[2 * e + 1] = bfhi(xv[e]); } }
                        else if (smp && rr < 0) { const f32x4 s0 = *(const GAS f32x4*)(sconv + ((size_t)b * 3 + (3 + rr)) * CONVC + col), s1 = *(const GAS f32x4*)(sconv + ((size_t)b * 3 + (3 + rr)) * CONVC + col + 4);
                            x[0] = s0.x; x[1] = s0.y; x[2] = s0.z; x[3] = s0.w; x[4] = s1.x; x[5] = s1.y; x[6] = s1.z; x[7] = s1.w; }
                        else {
#pragma unroll
                            for (int e = 0; e < 8; ++e) x[e] = 0.f; }
                        const f32x4 w0 = *(const LAS f32x4*)(wl + (p * 4 + j) * 128 + 32 * qq + 8 * ch4), w1 = *(const LAS f32x4*)(wl + (p * 4 + j) * 128 + 32 * qq + 8 * ch4 + 4);
                        a[0] += w0.x * x[0]; a[1] += w0.y * x[1]; a[2] += w0.z * x[2]; a[3] += w0.w * x[3]; a[4] += w1.x * x[4]; a[5] += w1.y * x[5]; a[6] += w1.z * x[6]; a[7] += w1.w * x[7]; }
#pragma unroll
                    for (int e = 0; e < 8; ++e) { y[8 * ch4 + e] = a[e] / (1.f + __expf(-a[e])); asm volatile("" : "+v"(y[8 * ch4 + e])); }
                    asm volatile("" ::: "memory"); __builtin_amdgcn_sched_barrier(0); }
                if (p < 2) { float ss = 0.f;
#pragma unroll
                    for (int e = 0; e < 32; ++e) ss += y[e] * y[e];
                    ss += __shfl_xor(ss, 1); ss += __shfl_xor(ss, 2);
                    const float rn = 1.f / sqrtf(ss + NORM_EPS);
#pragma unroll
                    for (int e = 0; e < 32; ++e) y[e] *= rn; }
#pragma unroll
                for (int k = 0; k < 4; ++k) { v4u w4;
#pragma unroll
                    for (int e = 0; e < 4; ++e) w4[e] = real ? pk2(y[8 * k + 2 * e], y[8 * k + 2 * e + 1]) : 0u;
                    *(LAS v4u*)(L + p * 17408 + row * GT_LD + 64 * qq + 16 * k) = w4; }
            }
            if (hw == 0) { const size_t m = mrow0 + c * 64 + lane; const bool rl = lane < nreal; float g = rl ? BG[m * 8 + 4 + h] : 0.f; const float be = rl ? BG[m * 8 + h] : 0.f;
#pragma unroll
                for (int o = 1; o < 64; o <<= 1) { const float t = __shfl_up(g, o); if (lane >= o) g += t; }
                ((LAS float*)(L + GP_G))[lane] = g; ((LAS float*)(L + GP_B))[lane] = be; }
        }
        LDS_WAIT(); __syncthreads();
        if (live) {
            const LAS float* Gs = (const LAS float*)(L + GP_G); const LAS float* Bs = (const LAS float*)(L + GP_B);
            bf16* QKg = (bf16*)(gs + 65536);
            const int r = lane & 31, hh = lane >> 5;
            if (hw < 3) {
                const int ti = hw > 0 ? 1 : 0, tj = hw > 1 ? 1 : 0;
                f32x16 akk = zero16(), aqk = zero16();
#pragma unroll
                for (int s = 0; s < 8; ++s) {
                    const bf16x8 bk = *(const LAS bf16x8*)(L + GP_K + (32 * tj + r) * GT_LD + (16 * s + 8 * hh) * 2);
                    const bf16x8 ak = *(const LAS bf16x8*)(L + GP_K + (32 * ti + r) * GT_LD + (16 * s + 8 * hh) * 2);
                    const bf16x8 aq = *(const LAS bf16x8*)(L + GP_Q + (32 * ti + r) * GT_LD + (16 * s + 8 * hh) * 2);
                    akk = MFMA32(ak, bk, akk, 0, 0, 0); aqk = MFMA32(aq, bk, aqk, 0, 0, 0);
                }
                const int j = 32 * tj + r; const float Gj = Gs[j];
#pragma unroll
                for (int q = 0; q < 16; ++q) { const int i = 32 * ti + crow(q, hh); const float dec = __expf(Gs[i] - Gj);
                    ((LAS float*)(L + GP_A))[i * 68 + j] = (i > j) ? Bs[i] * akk[q] * dec : 0.f;
                    QKg[(((i >> 5) * 4 + (j >> 4)) * 64 + ((j >> 3) & 1) * 32 + (i & 31)) * 8 + (j & 7)] = (bf16)f2bf((i >= j) ? aqk[q] * dec * 0.08838834764831845f : 0.f); }
            } else {
#pragma unroll
                for (int q = 0; q < 16; ++q) { const int i = crow(q, hh), j = 32 + r; QKg[(((i >> 5) * 4 + (j >> 4)) * 64 + ((j >> 3) & 1) * 32 + (i & 31)) * 8 + (j & 7)] = 0; }
            }
        }
        LDS_WAIT(); __syncthreads();
        if (live) {
            const LAS float* Gs = (const LAS float*)(L + GP_G); const LAS float* Bs = (const LAS float*)(L + GP_B); const LAS float* As = (const LAS float*)(L + GP_A);
            const bool isu = ht < 128; const int cc = ht & 127;
            const LAS unsigned char* src = L + (isu ? GP_V : GP_K) + cc * 2;
            float X[64];
#pragma unroll
            for (int i = 0; i < 64; ++i) X[i] = 0.f;
#pragma unroll
            for (int i = 0; i < 64; ++i) {
                float acc = bf2f(*(const LAS bf16*)(src + i * GT_LD)) * Bs[i] * (isu ? 1.f : __expf(Gs[i]));
                float a1_ = 0.f, a2_ = 0.f, a3_ = 0.f;
#pragma unroll
                for (int j4 = 0; j4 < (i + 3) / 4; ++j4) { const f32x4 a = *(const LAS f32x4*)(As + i * 68 + 4 * j4);
                    acc -= a.x * X[4 * j4]; a1_ -= a.y * X[4 * j4 + 1]; a2_ -= a.z * X[4 * j4 + 2]; a3_ -= a.w * X[4 * j4 + 3]; }
                acc = (acc + a1_) + (a2_ + a3_);
                X[i] = acc; asm volatile("" : "+v"(X[i]) :: "memory"); __builtin_amdgcn_sched_barrier(0);
            }
            if (isu) {
#pragma unroll
                for (int q = 0; q < 16; ++q) { const int rt_ = q >> 3, g_ = (q >> 1) & 3, hh_ = q & 1, i0 = 32 * rt_ + 8 * g_ + 4 * hh_;
                    v2u w2; w2.x = pk2(X[i0], X[i0 + 1]); w2.y = pk2(X[i0 + 2], X[i0 + 3]);
                    *(GAS v2u*)(gs + (size_t)((((cc >> 5) * 2 + rt_) * 4 + g_) * 64 + hh_ * 32 + (cc & 31)) * 8) = w2; }
            } else {
                bf16* wg = (bf16*)(gs + 16384) + (size_t)(((cc >> 4) * 64 + ((cc >> 3) & 1) * 32) * 8 + (cc & 7));
#pragma unroll
                for (int i = 0; i < 64; ++i) wg[(size_t)(((i >> 5) * 8) * 64 + (i & 31)) * 8] = (bf16)f2bf(X[i]); }
            { bf16* qt = (bf16*)(gs + 32768);
#pragma unroll
              for (int e = 0; e < 16; ++e) { const int idx = e * 256 + ht, i = idx >> 6, cp = idx & 63, dk = 2 * cp; const unsigned qv = *(const LAS unsigned*)(L + GP_Q + i * GT_LD + 4 * cp); const float sc = __expf(Gs[i]) * 0.08838834764831845f;
                  *(GAS unsigned*)(qt + (size_t)((((i >> 5) * 8 + (dk >> 4)) * 64 + ((dk >> 3) & 1) * 32 + (i & 31)) * 8 + (dk & 7))) = pk2(bflo(qv) * sc, bfhi(qv) * sc); } }
            if (!isu) { const float G63 = Gs[63];
#pragma unroll
                for (int q = 0; q < 8; ++q) { float kv[8];
#pragma unroll
                    for (int e = 0; e < 8; ++e) { const int i = 8 * q + e; kv[e] = bf2f(*(const LAS bf16*)(L + GP_K + i * GT_LD + cc * 2)) * __expf(G63 - Gs[i]); }
                    v4u w4; w4.x = pk2(kv[0], kv[1]); w4.y = pk2(kv[2], kv[3]); w4.z = pk2(kv[4], kv[5]); w4.w = pk2(kv[6], kv[7]);
                    *(GAS v4u*)(gs + 49152 + (size_t)((((cc >> 5) * 4 + (q >> 1)) * 64 + (q & 1) * 32 + (cc & 31)) * 16)) = w4; } }
            if (ht == 0) WSP(float, WS_GL)[u] = __expf(Gs[63]);
        }
        LDS_WAIT(); __syncthreads();
    }
}
constexpr int GS_SB = 0, GS_SB_LD = 272, GS_VN = 8704, GS_VN_LD = 144;
__device__ __forceinline__ void gdn_scan_phase(Frame& F, const Args& A) {
    const int wave = F.wave;
    LAS unsigned char* L = F.lds + RING_OFF;
    float* OG = WSP(float, WS_OG); const float* GL = WSP(float, WS_GL);
    for (int uu0 = F.bx; uu0 < (BATCH * GH * 4 + DECB * GH * 4) * (MK_X == 3 || MK_X == 4 ? 2 : 1); uu0 += F.G) {
        int uu = uu0; if (MK_X == 3 && uu0 >= BATCH * GH * 4 + DECB * GH * 4) { uu = uu0 - (BATCH * GH * 4 + DECB * GH * 4); if (uu >= BATCH * GH * 4) continue; }
        if (MK_X == 4 && uu0 >= BATCH * GH * 4 + DECB * GH * 4) { uu = uu0 - (BATCH * GH * 4 + DECB * GH * 4); if (uu < BATCH * GH * 4) continue; }
        const int lane = lane_fresh(); const int r = lane & 31, hh = lane >> 5;
        const bool smp = uu >= BATCH * GH * 4; const int u = smp ? uu - BATCH * GH * 4 : uu;
        const int sl = u & 3, h = (u >> 2) & 3, b = u >> 4, dv0 = sl * 32;
        const int role = wave < 2 ? 0 : (wave < 4 ? 1 : 2), rt = wave < 2 ? wave : (wave < 4 ? wave - 2 : wave - 4);
        const int nch = smp ? 1 : NCHUNK, un0 = smp ? 2048 + b * GH + h : (b * GH + h) * NCHUNK;
        const size_t mrow0 = smp ? (size_t)MP + (size_t)b * DECT : (size_t)b * SEQ;
        f32x16 Sacc = zero16();
        __syncthreads();
        if (!smp) { for (int i = wave * 64 + lane; i < (GS_VN + 32 * GS_VN_LD) / 4; i += NTHR) ((LAS unsigned*)L)[i] = 0u; }
        else if (role == 2) {
            const GAS float* sp = (const GAS float*)(A.in[5] + ((size_t)(b * GH + h) * GDK + 32 * rt) * GDV + dv0 + r);
#pragma unroll
            for (int q = 0; q < 16; ++q) Sacc[q] = sp[(size_t)crow(q, hh) * GDV];
#pragma unroll
            for (int g = 0; g < 4; ++g) { v2u w2; w2.x = pk2(Sacc[4 * g], Sacc[4 * g + 1]); w2.y = pk2(Sacc[4 * g + 2], Sacc[4 * g + 3]); *(LAS v2u*)(L + GS_SB + r * GS_SB_LD + (32 * rt + 8 * g + 4 * hh) * 2) = w2; }
        }
        LDS_WAIT(); __syncthreads();
        const size_t offA = (role == 1 ? 32768 : 16384) + (size_t)(((role == 2 ? 0 : rt) * 8) * 64 + lane) * 16;
        const size_t offB = (role == 2 ? 49152 : 65536) + (size_t)(((role == 0 ? 0 : rt) * 4) * 64 + lane) * 16;
        const size_t offU = (size_t)(((sl * 2 + (role == 0 ? rt : 0)) * 4) * 64 + lane) * 8;
#define GS_LOAD(FA, UV, FB, GLV, cc) do { const int un_ = un0 + (cc); const unsigned char* gs = F.ws + WS_GSC + (size_t)un_ * GSC_UNIT; \
            _Pragma("unroll") for (int s = 0; s < 8; ++s) FA[s] = *(const GAS bf16x8*)(gs + offA + (size_t)s * 1024); \
            _Pragma("unroll") for (int s = 0; s < 4; ++s) FB[s] = *(const GAS bf16x8*)(gs + offB + (size_t)s * 1024); \
            _Pragma("unroll") for (int g = 0; g < 4; ++g) UV[g] = *(const GAS s16x4*)(gs + offU + (size_t)g * 512); \
            GLV = GL[un_]; } while (0)
#define GS_STEP(FA, UV, FB, GLV, cc) do { asm volatile("; SCAN_STEP_BEGIN"); \
            f32x16 acc = zero16(); \
            if (role < 2) { \
                _Pragma("unroll") for (int s = 0; s < 8; ++s) { const bf16x8 sb = *(const LAS bf16x8*)(L + GS_SB + r * GS_SB_LD + (16 * s + 8 * hh) * 2); acc = MFMA32(FA[s], sb, acc, 0, 0, 0); } } \
            if (role == 0) { \
                _Pragma("unroll") for (int g = 0; g < 4; ++g) { const float v0 = bf2f((unsigned short)UV[g][0]) - acc[4 * g], v1 = bf2f((unsigned short)UV[g][1]) - acc[4 * g + 1], v2 = bf2f((unsigned short)UV[g][2]) - acc[4 * g + 2], v3 = bf2f((unsigned short)UV[g][3]) - acc[4 * g + 3]; \
                    v2u w2; w2.x = pk2(v0, v1); w2.y = pk2(v2, v3); *(LAS v2u*)(L + GS_VN + r * GS_VN_LD + (32 * rt + 8 * g + 4 * hh) * 2) = w2; } } \
            LDS_WAIT(); __builtin_amdgcn_s_barrier(); asm volatile("" ::: "memory"); \
            if (role == 1) { \
                _Pragma("unroll") for (int s = 0; s < 4; ++s) { const bf16x8 vn = *(const LAS bf16x8*)(L + GS_VN + r * GS_VN_LD + (16 * s + 8 * hh) * 2); acc = MFMA32(FB[s], vn, acc, 0, 0, 0); } \
                float* op = OG + (mrow0 + (cc) * 64 + 32 * rt) * 512 + h * 128 + dv0 + r; \
                const int nreal = smp ? DECT : 64; \
                _Pragma("unroll") for (int q = 0; q < 16; ++q) if (32 * rt + crow(q, hh) < nreal) op[(size_t)crow(q, hh) * 512] = acc[q]; \
            } else if (role == 2) { \
                _Pragma("unroll") for (int q = 0; q < 16; ++q) Sacc[q] *= GLV; \
                _Pragma("unroll") for (int s = 0; s < 4; ++s) { const bf16x8 vn = *(const LAS bf16x8*)(L + GS_VN + r * GS_VN_LD + (16 * s + 8 * hh) * 2); Sacc = MFMA32(FB[s], vn, Sacc, 0, 0, 0); } \
                _Pragma("unroll") for (int g = 0; g < 4; ++g) { v2u w2; w2.x = pk2(Sacc[4 * g], Sacc[4 * g + 1]); w2.y = pk2(Sacc[4 * g + 2], Sacc[4 * g + 3]); *(LAS v2u*)(L + GS_SB + r * GS_SB_LD + (32 * rt + 8 * g + 4 * hh) * 2) = w2; } } \
            LDS_WAIT(); __builtin_amdgcn_s_barrier(); asm volatile("" ::: "memory"); } while (0)
        bf16x8 fa0[8], fa1[8], fb0[4], fb1[4]; s16x4 uv0[4], uv1[4]; float gl0 = 1.f, gl1 = 1.f;
        GS_LOAD(fa0, uv0, fb0, gl0, 0);
#pragma unroll 1
        for (int c = 0; c < nch; c += 2) {
            { const int cn = (c + 1 < nch) ? c + 1 : nch - 1; GS_LOAD(fa1, uv1, fb1, gl1, cn); }
            GS_STEP(fa0, uv0, fb0, gl0, c);
            if (c + 1 < nch) {
                { const int cn = (c + 2 < nch) ? c + 2 : nch - 1; GS_LOAD(fa0, uv0, fb0, gl0, cn); }
                GS_STEP(fa1, uv1, fb1, gl1, c + 1);
            }
        }
#undef GS_LOAD
#undef GS_STEP
        if (role == 2) { float* so = F.out + (smp ? O_GS : O_GP) + ((size_t)(b * GH + h) * GDK + 32 * rt) * GDV + dv0 + r;
#pragma unroll
            for (int q = 0; q < 16; ++q) so[(size_t)crow(q, hh) * GDV] = Sacc[q]; }
    }
}
__device__ __forceinline__ void gdn_out_phase(Frame& F, const Args& A) {
    const int lane = lane_fresh(); const bf16* P = WSP(bf16, WS_P); const float* OG = WSP(float, WS_OG); bf16* CAT = WSP(bf16, WS_CAT);
    const f32x2 nw = *(const GAS f32x2*)(A.in[17] + 2 * lane);
    for (int it = F.bx * NWAVES + F.wave; it < M * GH; it += F.G * NWAVES) {
        const int m = it >> 2, h = it & 3;
        const f32x2 o = *(const GAS f32x2*)(OG + (size_t)m * 512 + h * 128 + 2 * lane);
        const float rs = 1.f / sqrtf(wave_sum(o.x * o.x + o.y * o.y) * (1.f / 128.f) + NORM_EPS);
        const unsigned zz = *(const GAS unsigned*)(P + (size_t)m * INWP + C_Z + h * 128 + 2 * lane); const float z0 = bflo(zz), z1 = bfhi(zz);
        *(GAS unsigned*)(CAT + (size_t)m * D + 512 + h * 128 + 2 * lane) = pk2(o.x * rs * nw.x * (z0 / (1.f + __expf(-z0))), o.y * rs * nw.y * (z1 / (1.f + __expf(-z1))));
    }
}
#define MFMA32H __builtin_amdgcn_mfma_f32_32x32x16_f16
__device__ __forceinline__ unsigned f2key(float x) { unsigned b = __builtin_bit_cast(unsigned, x); if ((b << 1) == 0u) b = 0u; return (b & 0x80000000u) ? ~b : (b | 0x80000000u); }
__device__ __forceinline__ float key2f(unsigned k) { const unsigned b = (k & 0x80000000u) ? (k & 0x7fffffffu) : ~k; return __builtin_bit_cast(float, b); }
template <class Get>
__device__ __forceinline__ void wave_topk_threshold(const Get& get, int n, int lane, LAS unsigned* hist, unsigned& thr_key, int& tie_cut) {
    const int niter = (n + 63) >> 6;
    unsigned kmin = 0xffffffffu, kmax = 0u;
#pragma unroll 4
    for (int it = 0; it < niter; ++it) { const int idx = 64 * it + lane; if (idx < n) { const unsigned uk = f2key(get(idx)); kmin = uk < kmin ? uk : kmin; kmax = uk > kmax ? uk : kmax; } }
#pragma unroll
    for (int o = 1; o < 64; o <<= 1) { const unsigned a = (unsigned)__shfl_xor((int)kmin, o), b = (unsigned)__shfl_xor((int)kmax, o); kmin = a < kmin ? a : kmin; kmax = b > kmax ? b : kmax; }
    thr_key = kmax; tie_cut = KSEL - 1;
    if (kmax == kmin) return;
    unsigned base = kmin; int bits = 32 - __builtin_clz(kmax - kmin), kk = KSEL; unsigned cnt = (unsigned)n;
#pragma unroll 1
    while (bits > 0 && cnt > 64u) {
        const int shift = bits > 8 ? bits - 8 : 0;
        *(LAS v4u*)(hist + 4 * lane) = (v4u){0u, 0u, 0u, 0u};
        LDS_WAIT(); asm volatile("" ::: "memory");
#pragma unroll 4
        for (int it = 0; it < niter; ++it) { const int idx = 64 * it + lane;
            if (idx < n) { const unsigned uk = f2key(get(idx)); const unsigned rel = uk - base; if (uk >= base && (bits >= 32 || (rel >> bits) == 0u)) __hip_atomic_fetch_add(hist + (rel >> shift), 1u, __ATOMIC_RELAXED, __HIP_MEMORY_SCOPE_WORKGROUP); } }
        LDS_WAIT(); asm volatile("" ::: "memory");
        const v4u h4 = *(const LAS v4u*)(hist + 4 * lane);
        const unsigned tot = h4.x + h4.y + h4.z + h4.w; unsigned incl = tot;
#pragma unroll
        for (int o = 1; o < 64; o <<= 1) { const unsigned t = __shfl_down(incl, o); if (lane + o < 64) incl += t; }
        const unsigned excl = incl - tot, c3 = excl + h4.w, c2 = c3 + h4.z, c1 = c2 + h4.y, c0 = c1 + h4.x; const unsigned k_ = (unsigned)kk;
        int dj = -1; unsigned above = 0u, cn = 0u;
        if (excl < k_ && k_ <= c3) { dj = 3; above = excl; cn = h4.w; } else if (c3 < k_ && k_ <= c2) { dj = 2; above = c3; cn = h4.z; } else if (c2 < k_ && k_ <= c1) { dj = 1; above = c2; cn = h4.y; } else if (c1 < k_ && k_ <= c0) { dj = 0; above = c1; cn = h4.x; }
        const unsigned long long bm = __ballot(dj >= 0); const int src = bm ? __builtin_ctzll(bm) : 0;
        const unsigned digit = (unsigned)__shfl(4 * lane + dj, src); above = (unsigned)__shfl((int)above, src); cn = (unsigned)__shfl((int)cn, src);
        base += digit << shift; kk -= (int)above; cnt = cn; bits = shift;
    }
    if (bits == 0) {
        thr_key = base; tie_cut = 0x7fffffff;
        if ((int)cnt > kk) { int run = 0;
#pragma unroll 1
            for (int it = 0; it < niter; ++it) { const int idx = 64 * it + lane; const bool eq = idx < n && f2key(get(idx)) == base;
                unsigned long long bm = __ballot(eq); const int c = __builtin_popcountll(bm);
                if (run + c >= kk) { int skip = kk - run - 1; while (skip-- > 0) bm &= bm - 1; tie_cut = 64 * it + __builtin_ctzll(bm); break; }
                run += c; } }
        return;
    }
    { int run = 0;
#pragma unroll 4
      for (int it = 0; it < niter; ++it) { const int idx = 64 * it + lane; bool in = false; unsigned uk = 0u;
          if (idx < n) { uk = f2key(get(idx)); in = uk >= base && ((uk - base) >> bits) == 0u; }
          const unsigned long long bm = __ballot(in);
          if (in) { const int pos = run + __builtin_popcountll(bm & ((1ull << lane) - 1ull)); hist[pos] = uk; hist[64 + pos] = (unsigned)idx; }
          run += __builtin_popcountll(bm); } }
    LDS_WAIT(); asm volatile("" ::: "memory");
    const bool have = lane < (int)cnt; const unsigned my = have ? hist[lane] : 0u; const int myi = have ? (int)hist[64 + lane] : 0x7fffffff;
    int rank = 0; bool later_tie = false;
#pragma unroll 1
    for (int j = 0; j < (int)cnt; ++j) { const unsigned kj = hist[j]; const int ij = (int)hist[64 + j]; rank += (kj > my || (kj == my && ij < myi)) ? 1 : 0; later_tie = later_tie || (kj == my && ij > myi); }
    const unsigned long long hit = __ballot(have && rank == kk - 1); const int src = hit ? __builtin_ctzll(hit) : 0;
    thr_key = (unsigned)__shfl((int)my, src); const int cut = __shfl(myi, src); const int lt = __shfl(later_tie ? 1 : 0, src);
    tie_cut = lt ? cut : 0x7fffffff;
}
template <int NIT>
__device__ __forceinline__ void wave_topk_reg(const LAS float* row, int n, int lane, LAS unsigned* hist, unsigned& thr_key, int& tie_cut) {
    unsigned key[NIT]; unsigned kmin = 0xffffffffu, kmax = 0u;
#pragma unroll
    for (int i = 0; i < NIT; ++i) { const float x = row[64 * i + lane]; const unsigned uk = f2key(x); const bool ok = 64 * i + lane < n; key[i] = ok ? uk : 0u;
        kmin = (ok && uk < kmin) ? uk : kmin; kmax = (ok && uk > kmax) ? uk : kmax; }
    WAVE_REDUCE_U32(kmin, umin_); WAVE_REDUCE_U32(kmax, umax_);
    thr_key = kmax; tie_cut = KSEL - 1;
    if (kmax == kmin) return;
    unsigned base = kmin, kcap = kmax; int kk = KSEL; unsigned cnt = (unsigned)n;
#define TK_SCAN(DIGIT, ABOVE, CN) do { \
        const v4u h4 = *(const LAS v4u*)(hist + 4 * lane); \
        const unsigned tot = h4.x + h4.y + h4.z + h4.w; const unsigned incl = wave_suffix_sum(tot, lane); \
        const unsigned excl = incl - tot, c3 = excl + h4.w, c2 = c3 + h4.z, c1 = c2 + h4.y, c0 = c1 + h4.x; const unsigned k_ = (unsigned)kk; \
        int dj = -1; unsigned ab_ = 0u, cn_ = 0u; \
        if (excl < k_ && k_ <= c3) { dj = 3; ab_ = excl; cn_ = h4.w; } else if (c3 < k_ && k_ <= c2) { dj = 2; ab_ = c3; cn_ = h4.z; } else if (c2 < k_ && k_ <= c1) { dj = 1; ab_ = c2; cn_ = h4.y; } else if (c1 < k_ && k_ <= c0) { dj = 0; ab_ = c1; cn_ = h4.x; } \
        const unsigned long long bm_ = __ballot(dj >= 0); const int src_ = bm_ ? __builtin_ctzll(bm_) : 0; \
        DIGIT = (unsigned)__builtin_amdgcn_readlane(4 * lane + dj, src_); ABOVE = (unsigned)__builtin_amdgcn_readlane((int)ab_, src_); CN = (unsigned)__builtin_amdgcn_readlane((int)cn_, src_); } while (0)
    { const float xmin = key2f(kmin), range = key2f(kmax) - xmin;
      if (range > 1e-30f && range < 1e30f) {
          const float scale = 255.99f / range;
          *(LAS v4u*)(hist + 4 * lane) = (v4u){0u, 0u, 0u, 0u};
          LDS_WAIT(); asm volatile("" ::: "memory");
#pragma unroll
          for (int i = 0; i < NIT; ++i) { int d = (int)((key2f(key[i]) - xmin) * scale); d = d > 255 ? 255 : d; if (key[i] != 0u) __hip_atomic_fetch_add(hist + d, 1u, __ATOMIC_RELAXED, __HIP_MEMORY_SCOPE_WORKGROUP); }
          LDS_WAIT(); asm volatile("" ::: "memory");
          unsigned digit, above, cn; TK_SCAN(digit, above, cn);
          kk -= (int)above; cnt = cn;
          unsigned k2min = 0xffffffffu, k2max = 0u;
#pragma unroll
          for (int i = 0; i < NIT; ++i) { int d = (int)((key2f(key[i]) - xmin) * scale); d = d > 255 ? 255 : d; const bool in = key[i] != 0u && d == (int)digit; k2min = (in && key[i] < k2min) ? key[i] : k2min; k2max = (in && key[i] > k2max) ? key[i] : k2max; }
          WAVE_REDUCE_U32(k2min, umin_); WAVE_REDUCE_U32(k2max, umax_);
          base = k2min; kcap = k2max;
      } }
    int bits = (kcap == base) ? 0 : 32 - __builtin_clz(kcap - base);
#pragma unroll 1
    while (bits > 0 && cnt > 64u) {
        const int shift = bits > 8 ? bits - 8 : 0; const unsigned lim = bits >= 32 ? 0xffffffffu : ((1u << bits) - 1u);
        *(LAS v4u*)(hist + 4 * lane) = (v4u){0u, 0u, 0u, 0u};
        LDS_WAIT(); asm volatile("" ::: "memory");
#pragma unroll
        for (int i = 0; i < NIT; ++i) { const unsigned rel = key[i] - base; if (key[i] >= base && key[i] <= kcap && rel <= lim) __hip_atomic_fetch_add(hist + (rel >> shift), 1u, __ATOMIC_RELAXED, __HIP_MEMORY_SCOPE_WORKGROUP); }
        LDS_WAIT(); asm volatile("" ::: "memory");
        unsigned digit, above, cn; TK_SCAN(digit, above, cn);
        base += digit << shift; kk -= (int)above; cnt = cn; bits = shift;
    }
#undef TK_SCAN
    if (bits == 0) {
        thr_key = base; tie_cut = 0x7fffffff;
        if ((int)cnt > kk) { int run = 0; bool done = false;
#pragma unroll
            for (int i = 0; i < NIT; ++i) { unsigned long long bm = __ballot(key[i] == base); const int c = __builtin_popcountll(bm);
                if (!done && run + c >= kk) { int skip = kk - run - 1; while (skip-- > 0) bm &= bm - 1; tie_cut = 64 * i + __builtin_ctzll(bm); done = true; }
                run += c; } }
        return;
    }
    const unsigned lim = bits >= 32 ? 0xffffffffu : ((1u << bits) - 1u);
    { int run = 0;
#pragma unroll
      for (int i = 0; i < NIT; ++i) { const unsigned rel = key[i] - base; const bool in = key[i] >= base && key[i] <= kcap && rel <= lim;
          const unsigned long long bm = __ballot(in);
          if (in) { const int pos = run + __builtin_popcountll(bm & ((1ull << lane) - 1ull)); hist[pos] = key[i]; hist[64 + pos] = (unsigned)(64 * i + lane); }
          run += __builtin_popcountll(bm); } }
    LDS_WAIT(); asm volatile("" ::: "memory");
    const bool have = lane < (int)cnt; const unsigned my = have ? hist[lane] : 0u; const int myi = have ? (int)hist[64 + lane] : 0x7fffffff;
    int rank = 0; bool later_tie = false;
#pragma unroll 1
    for (int j = 0; j < (int)cnt; ++j) { const unsigned kj = (unsigned)__builtin_amdgcn_readlane((int)my, j); const int ij = __builtin_amdgcn_readlane(myi, j);
        rank += (kj > my || (kj == my && ij < myi)) ? 1 : 0; later_tie = later_tie || (kj == my && ij > myi); }
    const unsigned long long hit = __ballot(have && rank == kk - 1); const int src = hit ? __builtin_ctzll(hit) : 0;
    thr_key = (unsigned)__builtin_amdgcn_readlane((int)my, src); const int cut = __builtin_amdgcn_readlane(myi, src); const int lt = __builtin_amdgcn_readlane(later_tie ? 1 : 0, src);
    tie_cut = lt ? cut : 0x7fffffff;
}
__device__ __forceinline__ int idx_row_q(int i) { return 2 * ((i >> 2) & 1) + (i >> 4); }
__device__ __forceinline__ int idx_row_h(int i) { return 4 * ((i >> 3) & 1) + (i & 3); }

constexpr int SC_LD = 2052;
constexpr int DP_SC = 0, DP_WI = 131328, DP_THR = 131840, DP_TIE = 131904, DP_HIST = 132096, DP_END = 140288;
static_assert(DP_END <= RING_BYTES, "DSA prompt LDS");
constexpr float QK_SCALE = 0.125f * 1.4426950408889634f;
__device__ __forceinline__ void dsa_prompt_unit(Frame& F, int b, int qt) {
    const int wave = F.wave; const int lane = lane_dep(qt); const int c = lane & 31, hh = lane >> 5;
    LAS unsigned char* L = F.lds + RING_OFF;
    LAS float* SC = (LAS float*)(L + DP_SC); LAS float* WIs = (LAS float*)(L + DP_WI); LAS float* THR = (LAS float*)(L + DP_THR); LAS int* TIE = (LAS int*)(L + DP_TIE);
    const f16* QIh = WSP(f16, WS_QI); const f16* KIh = WSP(f16, WS_KI); const float* WI = WSP(float, WS_WI);
    const bf16* Qb = WSP(bf16, WS_QB); const bf16* Kb = WSP(bf16, WS_KB); const bf16* VT = WSP(bf16, WS_VT); bf16* CAT = WSP(bf16, WS_CAT);
    const int q0 = 16 * qt; const size_t mb = (size_t)b * SEQ; const int Lk = q0 + 16, nkt = (Lk + 31) >> 5;
#pragma unroll 1
    for (int rep_a = 0; rep_a < (MK_X == 1 ? 2 : 1); ++rep_a) {
    if (wave == 0 && lane < 32) *(LAS f32x4*)(WIs + 4 * lane) = *(const GAS f32x4*)(WI + (mb + q0) * 8 + 4 * lane);
    {
        f16x8 aq[4][4];
#pragma unroll
        for (int rt4 = 0; rt4 < 4; ++rt4)
#pragma unroll
            for (int s = 0; s < 4; ++s) aq[rt4][s] = *(const GAS f16x8*)(QIh + (mb + q0 + 4 * rt4 + idx_row_q(c)) * 512 + idx_row_h(c) * 64 + 16 * s + 8 * hh);
        LDS_WAIT(); __syncthreads();
#define DA_LOAD(BK, kt_) do { _Pragma("unroll") for (int s = 0; s < 4; ++s) BK[s] = *(const GAS f16x8*)(KIh + (mb + 32 * (kt_) + c) * 64 + 16 * s + 8 * hh); } while (0)
#define DA_STEP(BK, kt_) do { const int key = 32 * (kt_) + c; \
            _Pragma("unroll") for (int rt4 = 0; rt4 < 4; ++rt4) { \
                f32x16 acc = zero16(); \
                _Pragma("unroll") for (int s = 0; s < 4; ++s) acc = MFMA32H(aq[rt4][s], BK[s], acc, 0, 0, 0); \
                const int ql0 = 4 * rt4 + 2 * hh; \
                const f32x4 w0 = *(const LAS f32x4*)(WIs + ql0 * 8), w1 = *(const LAS f32x4*)(WIs + ql0 * 8 + 4), w2 = *(const LAS f32x4*)(WIs + ql0 * 8 + 8), w3 = *(const LAS f32x4*)(WIs + ql0 * 8 + 12); \
                float s0 = w0.x * fmaxf(acc[0], 0.f) + w0.y * fmaxf(acc[1], 0.f) + w0.z * fmaxf(acc[2], 0.f) + w0.w * fmaxf(acc[3], 0.f) + w1.x * fmaxf(acc[4], 0.f) + w1.y * fmaxf(acc[5], 0.f) + w1.z * fmaxf(acc[6], 0.f) + w1.w * fmaxf(acc[7], 0.f); \
                float s1 = w2.x * fmaxf(acc[8], 0.f) + w2.y * fmaxf(acc[9], 0.f) + w2.z * fmaxf(acc[10], 0.f) + w2.w * fmaxf(acc[11], 0.f) + w3.x * fmaxf(acc[12], 0.f) + w3.y * fmaxf(acc[13], 0.f) + w3.z * fmaxf(acc[14], 0.f) + w3.w * fmaxf(acc[15], 0.f); \
                SC[ql0 * SC_LD + key] = (key <= q0 + ql0) ? s0 : -INFINITY; SC[(ql0 + 1) * SC_LD + key] = (key <= q0 + ql0 + 1) ? s1 : -INFINITY; } } while (0)
        { f16x8 bkA[4], bkB[4];
          if (wave < nkt) DA_LOAD(bkA, wave);
#pragma unroll 1
          for (int kt = wave; kt < nkt; kt += 2 * NWAVES) {
              if (kt + NWAVES < nkt) DA_LOAD(bkB, kt + NWAVES);
              DA_STEP(bkA, kt);
              if (kt + NWAVES < nkt) {
                  if (kt + 2 * NWAVES < nkt) DA_LOAD(bkA, kt + 2 * NWAVES);
                  DA_STEP(bkB, kt + NWAVES);
              }
          } }
#undef DA_LOAD
#undef DA_STEP
    }
    LDS_WAIT(); __syncthreads();
    }
#pragma unroll 1
    for (int rep_b = 0; rep_b < (MK_X == 2 ? 2 : 1); ++rep_b)
#pragma unroll 1
    for (int e = 0; e < 2; ++e) { const int ql = 2 * wave + e, n = q0 + ql + 1; unsigned tk = 0u; int tc = 0x7fffffff; float thr = -3.0e38f;
        if (n > KSEL) { const LAS float* row = SC + ql * SC_LD; LAS unsigned* hist = (LAS unsigned*)(L + DP_HIST) + wave * 256;
            if (n <= 1024) wave_topk_reg<16>(row, n, lane, hist, tk, tc); else wave_topk_reg<32>(row, n, lane, hist, tk, tc);
            thr = key2f(tk); }
        if (lane == 0) { THR[ql] = thr; TIE[ql] = tc; } }
    LDS_WAIT(); __syncthreads();
    const int rt = wave & 3, kh = wave >> 2, g = rt >> 1, ql = 8 * (rt & 1) + (c >> 2), head = 4 * g + (c & 3), qpos = q0 + ql;
    bf16x8 bq[4];
#pragma unroll
    for (int s = 0; s < 4; ++s) bq[s] = *(const GAS bf16x8*)(Qb + (mb + qpos) * 512 + head * 64 + 16 * s + 8 * hh);
    const float thr = THR[ql]; const int tie = TIE[ql];
    float m_run = -INFINITY, l_run = 0.f; f32x16 O0 = zero16(), O1 = zero16();
    const bf16* vtb = VT + (((size_t)(b * 2 + g) * (SEQ / 32)) * 64 + c) * 32 + 16 * hh;
#define DP_LOAD(AK, V8, kt_) do { \
        _Pragma("unroll") for (int s = 0; s < 4; ++s) AK[s] = *(const GAS bf16x8*)(Kb + (mb + 32 * (kt_) + c) * 128 + g * 64 + 16 * s + 8 * hh); \
        _Pragma("unroll") for (int dt = 0; dt < 2; ++dt) _Pragma("unroll") for (int s2 = 0; s2 < 2; ++s2) \
            V8[dt][s2] = *(const GAS bf16x8*)(vtb + ((size_t)(kt_) * 64 + 32 * dt) * 32 + 8 * s2); } while (0)
#define DP_STEP(AK, V8, kt_) do { \
        f32x16 acc = zero16(); \
        _Pragma("unroll") for (int s = 0; s < 4; ++s) acc = MFMA32(AK[s], bq[s], acc, 0, 0, 0); \
        float p[16]; float mx = -INFINITY; \
        if (notie) { \
            _Pragma("unroll") for (int g4 = 0; g4 < 4; ++g4) { const f32x4 scv = *(const LAS f32x4*)(SC + ql * SC_LD + 32 * (kt_) + 8 * g4 + 4 * hh); \
                _Pragma("unroll") for (int e = 0; e < 4; ++e) { const float s = (scv[e] >= thr) ? acc[4 * g4 + e] : -INFINITY; p[4 * g4 + e] = s; mx = fmaxf(mx, s); } } \
        } else { \
            _Pragma("unroll") for (int g4 = 0; g4 < 4; ++g4) { const f32x4 scv = *(const LAS f32x4*)(SC + ql * SC_LD + 32 * (kt_) + 8 * g4 + 4 * hh); \
                _Pragma("unroll") for (int e = 0; e < 4; ++e) { const int key = 32 * (kt_) + 8 * g4 + 4 * hh + e; const float sv = scv[e]; \
                    const bool sel = sv > thr || (sv == thr && key <= tie); \
                    const float s = sel ? acc[4 * g4 + e] : -INFINITY; p[4 * g4 + e] = s; mx = fmaxf(mx, s); } } } \
        mx = fmaxf(mx, __shfl_xor(mx, 32)); \
        const float m_new = fmaxf(m_run, mx), m_safe = (m_new == -INFINITY) ? 0.f : m_new; \
        float ps = 0.f; \
        _Pragma("unroll") for (int r = 0; r < 16; ++r) { p[r] = __builtin_amdgcn_exp2f(p[r] - m_safe); ps += p[r]; } \
        if (__any(m_new != m_run)) { const float alpha = __builtin_amdgcn_exp2f(m_run - m_safe); l_run *= alpha; \
            _Pragma("unroll") for (int r = 0; r < 16; ++r) { O0[r] *= alpha; O1[r] *= alpha; } } \
        l_run += ps; m_run = m_new; \
        _Pragma("unroll") for (int s2 = 0; s2 < 2; ++s2) { \
            v4u pw; pw.x = pg8::cvt_pk_bf16(p[8 * s2], p[8 * s2 + 1]); pw.y = pg8::cvt_pk_bf16(p[8 * s2 + 2], p[8 * s2 + 3]); pw.z = pg8::cvt_pk_bf16(p[8 * s2 + 4], p[8 * s2 + 5]); pw.w = pg8::cvt_pk_bf16(p[8 * s2 + 6], p[8 * s2 + 7]); \
            const bf16x8 pb = __builtin_bit_cast(bf16x8, pw); \
            O0 = MFMA32(V8[0][s2], pb, O0, 0, 0, 0); O1 = MFMA32(V8[1][s2], pb, O1, 0, 0, 0); } } while (0)
    { bf16x8 akA[4], akB[4], akC[4]; bf16x8 v8A[2][2], v8B[2][2], v8C[2][2];
      const bool notie = __all(tie == 0x7fffffff);
      if (kh < nkt) DP_LOAD(akA, v8A, kh);
      if (kh + 2 < nkt) DP_LOAD(akB, v8B, kh + 2);
#pragma unroll 1
      for (int kt = kh; kt < nkt; kt += 6) {
          if (kt + 4 < nkt) DP_LOAD(akC, v8C, kt + 4);
          DP_STEP(akA, v8A, kt);
          if (kt + 2 < nkt) {
              if (kt + 6 < nkt) DP_LOAD(akA, v8A, kt + 6);
              DP_STEP(akB, v8B, kt + 2);
              if (kt + 4 < nkt) {
                  if (kt + 8 < nkt) DP_LOAD(akB, v8B, kt + 8);
                  DP_STEP(akC, v8C, kt + 4);
              }
          }
      } }
#undef DP_LOAD
#undef DP_STEP
    l_run += __shfl_xor(l_run, 32);
    __syncthreads();
    LAS float* CB = (LAS float*)(L + DP_SC) + rt * (34 * 64);
    if (kh == 1) { CB[lane] = m_run; CB[64 + lane] = l_run;
#pragma unroll
        for (int r = 0; r < 16; ++r) { CB[(2 + r) * 64 + lane] = O0[r]; CB[(18 + r) * 64 + lane] = O1[r]; } }
    LDS_WAIT(); __syncthreads();
    if (kh == 0) {
        const float m1 = CB[lane], l1 = CB[64 + lane]; const float m = fmaxf(m_run, m1), ms = (m == -INFINITY) ? 0.f : m;
        const float a0 = __builtin_amdgcn_exp2f(m_run - ms), a1 = __builtin_amdgcn_exp2f(m1 - ms); const float inv = 1.f / (l_run * a0 + l1 * a1);
        bf16* op = CAT + (mb + qpos) * D + head * 64 + 4 * hh;
#pragma unroll
        for (int g4 = 0; g4 < 4; ++g4) { float o[8];
#pragma unroll
            for (int e = 0; e < 4; ++e) { o[e] = (O0[4 * g4 + e] * a0 + CB[(2 + 4 * g4 + e) * 64 + lane] * a1) * inv; o[4 + e] = (O1[4 * g4 + e] * a0 + CB[(18 + 4 * g4 + e) * 64 + lane] * a1) * inv; }
            v2u w0; w0.x = pk2(o[0], o[1]); w0.y = pk2(o[2], o[3]); *(GAS v2u*)(op + 8 * g4) = w0;
            v2u w1; w1.x = pk2(o[4], o[5]); w1.y = pk2(o[6], o[7]); *(GAS v2u*)(op + 32 + 8 * g4) = w1; }
    }
    LDS_WAIT(); __syncthreads();
}
__device__ __forceinline__ void dsa_prompt_phase(Frame& F) {
    for (int w0 = F.bx; w0 < 256; w0 += F.G) { const int w = ((w0 & 7) << 5) | (w0 >> 3);
        const int b = w >> 4, sub = w & 15;
#pragma unroll 1
        for (int j = 0; j < 8; ++j) { const int qt = 32 * (j >> 1) + ((j & 1) ? 31 - sub : sub); dsa_prompt_unit(F, b, qt); } }
}
__device__ __forceinline__ void dsa_sample_scores_phase(Frame& F, const Args& A) {
    const int wave = F.wave;
    const f16* QIh = WSP(f16, WS_QI); const f16* KIh = WSP(f16, WS_KI); const float* WI = WSP(float, WS_WI); float* SCS = WSP(float, WS_SCS);
    const float* ckidx = A.in[4]; const int* ptab = (const int*)A.in[7];
    const int kt4 = wave & 3, rt2 = wave >> 2;
    { const int lane = lane_fresh(); const int c = lane & 31, hh = lane >> 5; const int NU = DECB * NPAGES;
      LAS unsigned char* L = F.lds + RING_OFF + wave * 4608;
      f32x4 xa[8], xb[8];
#define D1_GLOAD(X, u_) do { const int kk_ = ((u_) - u0 < per) ? (u_) - u0 : per - 1; const int phys = phl[kk_]; const GAS f32x4* src = (const GAS f32x4*)(ckidx + ((size_t)phys * PAGE + 32 * kt4) * 64); \
        _Pragma("unroll") for (int i = 0; i < 8; ++i) X[i] = src[lane + 64 * i]; } while (0)
#define D1_STEP(X, u_) do { \
        _Pragma("unroll") for (int i = 0; i < 8; ++i) { const int idx = lane + 64 * i, key = idx >> 4, d4 = idx & 15; \
            typedef _Float16 f16x4_ __attribute__((ext_vector_type(4))); f16x4_ h; h[0] = (f16)X[i].x; h[1] = (f16)X[i].y; h[2] = (f16)X[i].z; h[3] = (f16)X[i].w; \
            *(LAS f16x4_*)(L + key * 144 + d4 * 8) = h; } \
        LDS_WAIT(); asm volatile("" ::: "memory"); \
        const int bs = (u_) >> 6, j = (u_) & 63; const size_t ms = (size_t)MP + (size_t)bs * DECT; \
        f16x8 bk[4]; \
        _Pragma("unroll") for (int s = 0; s < 4; ++s) bk[s] = *(const LAS f16x8*)(L + c * 144 + (16 * s + 8 * hh) * 2); \
        LDS_WAIT(); asm volatile("" ::: "memory"); \
        const int ql0 = 4 * rt2 + 2 * hh; \
        if (bs != bs_cur) { bs_cur = bs; \
            _Pragma("unroll") for (int s = 0; s < 4; ++s) aq[s] = *(const GAS f16x8*)(QIh + (ms + 4 * rt2 + idx_row_q(c)) * 512 + idx_row_h(c) * 64 + 16 * s + 8 * hh); \
            const GAS f32x4* wp = (const GAS f32x4*)(WI + (ms + ql0) * 8); w0 = wp[0]; w1 = wp[1]; w2 = wp[2]; w3 = wp[3]; } \
        f32x16 acc = zero16(); \
        _Pragma("unroll") for (int s = 0; s < 4; ++s) acc = MFMA32H(aq[s], bk[s], acc, 0, 0, 0); \
        const float s0 = w0.x * fmaxf(acc[0], 0.f) + w0.y * fmaxf(acc[1], 0.f) + w0.z * fmaxf(acc[2], 0.f) + w0.w * fmaxf(acc[3], 0.f) + w1.x * fmaxf(acc[4], 0.f) + w1.y * fmaxf(acc[5], 0.f) + w1.z * fmaxf(acc[6], 0.f) + w1.w * fmaxf(acc[7], 0.f); \
        const float s1 = w2.x * fmaxf(acc[8], 0.f) + w2.y * fmaxf(acc[9], 0.f) + w2.z * fmaxf(acc[10], 0.f) + w2.w * fmaxf(acc[11], 0.f) + w3.x * fmaxf(acc[12], 0.f) + w3.y * fmaxf(acc[13], 0.f) + w3.z * fmaxf(acc[14], 0.f) + w3.w * fmaxf(acc[15], 0.f); \
        const int key = PAGE * j + 32 * kt4 + c; \
        SCS[((size_t)bs * DECT + ql0) * SCS_LD + key] = s0; SCS[((size_t)bs * DECT + ql0 + 1) * SCS_LD + key] = s1; } while (0)
      const int per = (NU + F.G - 1) / F.G, u0 = F.bx * per, u1 = (u0 + per < NU) ? u0 + per : NU;
      LAS int* phl = (LAS int*)(F.lds + RING_OFF + 8 * 4608);
      for (int k = wave * 64 + lane; k < per; k += NTHR) { const int uu = (u0 + k < NU) ? u0 + k : NU - 1; phl[k] = ptab[(uu >> 6) * NPAGES + (uu & 63)]; }
      LDS_WAIT(); __syncthreads();
      int bs_cur = -1; f16x8 aq[4]; f32x4 w0, w1, w2, w3; f32x4 xc[8], xd[8];
      D1_GLOAD(xa, u0); D1_GLOAD(xb, u0 + 1); D1_GLOAD(xc, u0 + 2); D1_GLOAD(xd, u0 + 3);
#pragma unroll 1
      for (int u = u0; u < u1; u += 4) {
          D1_STEP(xa, u); D1_GLOAD(xa, u + 4);
          if (u + 1 < u1) { D1_STEP(xb, u + 1); D1_GLOAD(xb, u + 5); }
          if (u + 2 < u1) { D1_STEP(xc, u + 2); D1_GLOAD(xc, u + 6); }
          if (u + 3 < u1) { D1_STEP(xd, u + 3); D1_GLOAD(xd, u + 7); }
      }
#undef D1_GLOAD
#undef D1_STEP
    }
    __syncthreads();
#pragma unroll 1
    for (int bs = F.bx * NWAVES + wave; bs < DECB; bs += F.G * NWAVES) {
        const int lane = lane_dep(bs); const int t = lane >> 3, t2 = lane & 7; const size_t ms = (size_t)MP + (size_t)bs * DECT;
        float sc = 0.f;
#pragma unroll 1
        for (int h = 0; h < 8; ++h) { float d = 0.f;
#pragma unroll 8
            for (int e = 0; e < 64; ++e) d += (float)QIh[(ms + t) * 512 + h * 64 + e] * (float)KIh[(ms + t2) * 64 + e];
            sc += WI[(ms + t) * 8 + h] * fmaxf(d, 0.f); }
        SCS[((size_t)bs * DECT + t) * SCS_LD + PAST + t2] = (t2 <= t) ? sc : -INFINITY;
    }
}
constexpr int DS_ROW = 0, DS_HIST = 32832, DS_LIST = 33856, DS_RID = 34880, DS_WAVE = 35904;
static_assert(4 * DS_WAVE <= RING_BYTES, "DSA sample LDS");
__device__ __forceinline__ void dsa_sample_attend_phase(Frame& F, const Args& A) {
    const int wave = F.wave;
    if (wave >= 4) return;
    LAS unsigned char* L = F.lds + RING_OFF + wave * DS_WAVE;
    LAS float* rowl = (LAS float*)(L + DS_ROW); LAS unsigned* hist = (LAS unsigned*)(L + DS_HIST); LAS int* list = (LAS int*)(L + DS_LIST); LAS int* rowid = (LAS int*)(L + DS_RID);
    LAS float* qv = rowl; LAS float* sc = rowl + 512;
    const float* SCS = WSP(float, WS_SCS); const bf16* Qb = WSP(bf16, WS_QB); bf16* CAT = WSP(bf16, WS_CAT);
    const float* ck = A.in[2]; const float* cv = A.in[3]; const int* ptab = (const int*)A.in[7];
#pragma unroll 1
    for (int qi = wave * F.G + F.bx; qi < MS; qi += 4 * F.G) {
        const int lane = lane_dep(qi);
        const int bs = qi >> 3, t = qi & 7, n = PAST + t + 1; const size_t m = (size_t)MP + qi;
        { const GAS f32x4* src = (const GAS f32x4*)(SCS + (size_t)qi * SCS_LD);
#pragma unroll 1
          for (int k0 = 0; k0 < 33; k0 += 11) { f32x4 tmp[11];
#pragma unroll
              for (int k = 0; k < 11; ++k) { const int i4 = lane + 64 * (k0 + k); tmp[k] = (i4 < SCS_LD / 4) ? src[i4] : (f32x4){0.f, 0.f, 0.f, 0.f}; }
#pragma unroll
              for (int k = 0; k < 11; ++k) { const int i4 = lane + 64 * (k0 + k); if (i4 < SCS_LD / 4) *(LAS f32x4*)(rowl + 4 * i4) = tmp[k]; } } }
        LDS_WAIT(); asm volatile("" ::: "memory");
        unsigned tk; int tc; auto get = [&](int i) { return rowl[i]; };
        wave_topk_threshold(get, n, lane, hist, tk, tc);
        int cnt = 0;
#pragma unroll 1
        for (int it = 0; it < (n + 63) / 64; ++it) { const int idx = 64 * it + lane; bool sel = false;
            if (idx < n) { const unsigned uk = f2key(rowl[idx]); sel = uk > tk || (uk == tk && idx <= tc); }
            const unsigned long long bm = __ballot(sel); const int pos = cnt + __builtin_popcountll(bm & ((1ull << lane) - 1ull));
            if (sel && pos < KSEL) list[pos] = idx;
            cnt += __builtin_popcountll(bm); }
        LDS_WAIT(); asm volatile("" ::: "memory");
#pragma unroll
        for (int e = 0; e < 4; ++e) { const unsigned qq = *(const GAS unsigned*)(Qb + m * 512 + 128 * e + 2 * lane); qv[128 * e + 2 * lane] = bflo(qq); qv[128 * e + 2 * lane + 1] = bfhi(qq); }
        LDS_WAIT(); asm volatile("" ::: "memory");
        float mxh[8];
#pragma unroll
        for (int h = 0; h < 8; ++h) mxh[h] = -INFINITY;
#pragma unroll 1
        for (int p = 0; p < 4; ++p) { const int jj = 64 * p + lane; const int idx = list[jj];
            const float* kp; int rid;
            if (idx < PAST) { rid = ptab[bs * NPAGES + (idx >> 7)] * PAGE + (idx & 127); kp = ck + (size_t)rid * 128; }
            else { rid = -(idx - PAST) - 1; kp = F.out + O_KS + ((size_t)bs * DECT + (idx - PAST)) * 128; }
            rowid[jj] = rid;
            f32x4 kr[32];
#pragma unroll
            for (int e = 0; e < 32; ++e) kr[e] = *(const GAS f32x4*)(kp + 4 * e);
            float s[8];
#pragma unroll
            for (int h = 0; h < 8; ++h) s[h] = 0.f;
#pragma unroll
            for (int g = 0; g < 2; ++g)
#pragma unroll
                for (int d4 = 0; d4 < 16; ++d4) { const f32x4 kv = kr[16 * g + d4];
#pragma unroll
                    for (int hl = 0; hl < 4; ++hl) { const f32x4 q4 = *(const LAS f32x4*)(qv + (4 * g + hl) * 64 + 4 * d4); s[4 * g + hl] += kv.x * q4.x + kv.y * q4.y + kv.z * q4.z + kv.w * q4.w; } }
#pragma unroll
            for (int h = 0; h < 8; ++h) { const float v = s[h];   sc[h * 256 + jj] = v; mxh[h] = fmaxf(mxh[h], v); } }
        LDS_WAIT(); asm volatile("" ::: "memory");
        float invl[8];
#pragma unroll
        for (int h = 0; h < 8; ++h) { const float mm = wave_max(mxh[h]); float ps = 0.f;
#pragma unroll
            for (int p = 0; p < 4; ++p) { const float e = __builtin_amdgcn_exp2f(sc[h * 256 + 64 * p + lane] - mm); sc[h * 256 + 64 * p + lane] = e; ps += e; }
            invl[h] = 1.f / wave_sum(ps); }
        LDS_WAIT(); asm volatile("" ::: "memory");
        const int g = lane >> 5, dp = lane & 31; float o[4][2];
#pragma unroll
        for (int hl = 0; hl < 4; ++hl) { o[hl][0] = 0.f; o[hl][1] = 0.f; }
#pragma unroll 1
        for (int j0 = 0; j0 < KSEL; j0 += 16) { f32x2 vv[16];
#pragma unroll
            for (int e = 0; e < 16; ++e) { const int rid = __builtin_amdgcn_readfirstlane(rowid[j0 + e]);
                const float* vp = (rid >= 0) ? cv + (size_t)rid * 128 : F.out + O_VS + ((size_t)bs * DECT + (-rid - 1)) * 128;
                vv[e] = *(const GAS f32x2*)(vp + 64 * g + 2 * dp); }
#pragma unroll
            for (int e = 0; e < 16; ++e)
#pragma unroll
                for (int hl = 0; hl < 4; ++hl) { const float pp = sc[(4 * g + hl) * 256 + j0 + e]; o[hl][0] += pp * vv[e].x; o[hl][1] += pp * vv[e].y; } }
#pragma unroll
        for (int hl = 0; hl < 4; ++hl) { const float il = (g == 0) ? invl[hl] : invl[4 + hl];
            *(GAS unsigned*)(CAT + m * D + (4 * g + hl) * 64 + 2 * dp) = pk2(o[hl][0] * il, o[hl][1] * il); }
        LDS_WAIT(); asm volatile("" ::: "memory");
    }
}
#if MK_DIAG
constexpr int CW_DG = 2048;
__device__ __forceinline__ void dg_add(Frame& F, int k, float num, float den) {
    LAS float* red = (LAS float*)(F.lds + RING_OFF + 140000);
    __syncthreads(); if ((int)threadIdx.x < 2) red[(int)threadIdx.x] = 0.f; __syncthreads();
    atomicAdd((float*)&red[0], num); atomicAdd((float*)&red[1], den); __syncthreads();
    if ((int)threadIdx.x == 0) { atomicAdd((float*)(F.ctl + CW_DG + 2 * k), red[0]); atomicAdd((float*)(F.ctl + CW_DG + 2 * k + 1), red[1]); }
    __syncthreads();
}
__device__ __forceinline__ int dg_row(int i) { const int rows[8] = {0, 777, 2047, 2048, 20000, 32767, 32768, 33791}; int r = 0;
#pragma unroll
    for (int j = 0; j < 8; ++j) r = (i == j) ? rows[j] : r; return r; }
__device__ __forceinline__ void chk_ffn(Frame& F, const float* x0, const float* x1, int split, const float* Wg, const float* Wu, const float* Wd, const float* lg, const float* lb, const float* Xout, int ch) {
    if (F.bx >= 8) return;
    const int row = dg_row(F.bx), tid = (int)threadIdx.x;
    LAS float* xs = (LAS float*)(F.lds + RING_OFF); LAS float* hs = xs + 1024; LAS float* rs = hs + 2816;
    const float* xr = row < split ? x0 + (size_t)row * D : x1 + (size_t)(row - split) * D;
    for (int c = tid; c < D; c += NTHR) xs[c] = xr[c];
    __syncthreads();
    for (int j = tid; j < FF; j += NTHR) { float g = 0.f, u = 0.f; for (int k = 0; k < D; ++k) { g += xs[k] * Wg[(size_t)k * FF + j]; u += xs[k] * Wu[(size_t)k * FF + j]; } hs[j] = g / (1.f + expf(-g)) * u; }
    __syncthreads();
    for (int c = tid; c < D; c += NTHR) { float y = 0.f; for (int j = 0; j < FF; ++j) y += hs[j] * Wd[(size_t)j * D + c]; rs[c] = ALPHA * xs[c] + 0.5f * y; }
    __syncthreads();
    float mean = 0.f; for (int c = 0; c < D; ++c) mean += rs[c]; mean *= (1.f / D);
    float var = 0.f; for (int c = 0; c < D; ++c) { const float d = rs[c] - mean; var += d * d; } var *= (1.f / D);
    const float rstd = 1.f / sqrtf(var + LN_EPS);
    float num = 0.f, den = 0.f;
    for (int c = tid; c < D; c += NTHR) { const float ref = (rs[c] - mean) * rstd * lg[c] + lb[c]; const float d = Xout[(size_t)row * D + c] - ref; num += d * d; den += ref * ref; }
    dg_add(F, ch, num, den);
}
__device__ __forceinline__ void chk_proj(Frame& F, const float* X1, const float* Win, const bf16* P, int ch) {
    if (F.bx >= 8) return;
    const int row = dg_row(F.bx), tid = (int)threadIdx.x;
    LAS float* xs = (LAS float*)(F.lds + RING_OFF);
    for (int c = tid; c < D; c += NTHR) xs[c] = X1[(size_t)row * D + c];
    __syncthreads();
    float num = 0.f, den = 0.f;
    for (int c = tid; c < INW; c += NTHR) { float p = 0.f; for (int k = 0; k < D; ++k) p += xs[k] * Win[(size_t)k * INW + c]; const float d = bf2f(P[(size_t)row * INWP + c]) - p; num += d * d; den += p * p; }
    dg_add(F, ch, num, den);
}

__device__ __forceinline__ void chk_gdn(Frame& F, const Args& A, bool sample, int b, int h, int ch_o, int ch_s) {
    const int tid = (int)threadIdx.x;
    LAS float* S = (LAS float*)(F.lds + RING_OFF); LAS float* y = S + 16384; LAS float* qn = y + 384; LAS float* kn = qn + 128; LAS float* rv = kn + 128;
    const bf16* P = WSP(bf16, WS_P); const float* BG = WSP(float, WS_BG); const float* OG = WSP(float, WS_OG); const float* cw = A.in[14];
    const int T = sample ? DECT : SEQ; const size_t m0 = sample ? (size_t)MP + b * DECT : (size_t)b * SEQ;
    const float* st_in = A.in[5] + (size_t)(b * GH + h) * GDK * GDV; const float* st_out = F.out + (sample ? O_GS : O_GP) + (size_t)(b * GH + h) * GDK * GDV;
    for (int e = tid; e < 16384; e += NTHR) S[e] = sample ? st_in[e] : 0.f;
    float no = 0.f, dn = 0.f;
    __syncthreads();
    for (int t = 0; t < T; ++t) {
        const size_t m = m0 + t;
        if (tid < 384) { const int col = (tid < 128) ? h * 128 + tid : (tid < 256) ? 512 + h * 128 + (tid - 128) : 1024 + h * 128 + (tid - 256); float a = 0.f;
            for (int j = 0; j < 4; ++j) { const int rr = t + j; float x;
                if (rr < 3) x = sample ? A.in[6][((size_t)b * 3 + rr) * CONVC + col] : 0.f; else x = bf2f(P[(m0 + rr - 3) * INWP + C_QKV + col]);
                a += cw[j * CONVC + col] * x; }
            y[tid] = a / (1.f + expf(-a)); }
        __syncthreads();
        float sq = 0.f, sk = 0.f; for (int i = 0; i < 128; ++i) { sq += y[i] * y[i]; sk += y[128 + i] * y[128 + i]; }
        const float rq = 1.f / sqrtf(sq + NORM_EPS), rk = 1.f / sqrtf(sk + NORM_EPS);
        if (tid < 128) { qn[tid] = y[tid] * rq; kn[tid] = y[128 + tid] * rk; }
        __syncthreads();
        const float be = BG[m * 8 + h], a = expf(BG[m * 8 + 4 + h]);
        if (tid < 128) { float part = 0.f; for (int dk = 0; dk < 128; ++dk) part += a * S[dk * 128 + tid] * kn[dk]; rv[tid] = (y[256 + tid] - part) * be; }
        __syncthreads();
        for (int e = tid; e < 16384; e += NTHR) S[e] = a * S[e] + kn[e >> 7] * rv[e & 127];
        __syncthreads();
        if (tid < 128) { float o = 0.f; for (int dk = 0; dk < 128; ++dk) o += S[dk * 128 + tid] * qn[dk]; o *= 0.08838834764831845f;
            const float d = OG[m * 512 + h * 128 + tid] - o; no += d * d; dn += o * o; }
        __syncthreads();
    }
    float ns = 0.f, ds = 0.f;
    for (int e = tid; e < 16384; e += NTHR) { const float d = st_out[e] - S[e]; ns += d * d; ds += S[e] * S[e]; }
    dg_add(F, ch_o, no, dn); dg_add(F, ch_s, ns, ds);
}

__device__ __forceinline__ void chk_dsa(Frame& F, const Args& A, bool sample, int b, int t, int ch) {
    const int tid = (int)threadIdx.x;
    LAS float* sc = (LAS float*)(F.lds + RING_OFF); LAS unsigned char* sel = (LAS unsigned char*)(sc + 8208); LAS float* qs = (LAS float*)(sel + 8208);
    const f16* QIh = WSP(f16, WS_QI); const f16* KIh = WSP(f16, WS_KI); const float* WI = WSP(float, WS_WI); const bf16* Qb = WSP(bf16, WS_QB); const bf16* Kb = WSP(bf16, WS_KB); const bf16* P = WSP(bf16, WS_P); const bf16* CAT = WSP(bf16, WS_CAT);
    const int* ptab = (const int*)A.in[7];
    const size_t m = sample ? (size_t)MP + b * DECT + t : (size_t)b * SEQ + t; const int n = sample ? PAST + t + 1 : t + 1;
    for (int l = tid; l < n; l += NTHR) { float s = 0.f;
        for (int h = 0; h < 8; ++h) { float d = 0.f;
            for (int e = 0; e < 64; ++e) { float kv;
                if (sample) { if (l < PAST) kv = (float)(f16)A.in[4][((size_t)ptab[b * NPAGES + (l >> 7)] * PAGE + (l & 127)) * 64 + e]; else kv = (float)KIh[((size_t)MP + b * DECT + (l - PAST)) * 64 + e]; }
                else kv = (float)KIh[((size_t)b * SEQ + l) * 64 + e];
                d += (float)QIh[m * 512 + h * 64 + e] * kv; }
            s += WI[m * 8 + h] * fmaxf(d, 0.f); }
        if (s == 0.f) s = 0.f;
        sc[l] = s; }
    for (int e = tid; e < 512; e += NTHR) qs[e] = bf2f(Qb[m * 512 + e]);
    __syncthreads();
    for (int l = tid; l < n; l += NTHR) { const float x = sc[l]; int rank = 0; for (int l2 = 0; l2 < n; ++l2) { const float y = sc[l2]; rank += (y > x || (y == x && l2 < l)) ? 1 : 0; } sel[l] = rank < KSEL ? 1 : 0; }
    __syncthreads();
    const int h = tid >> 6, d = tid & 63, g = h >> 2; float mx = -INFINITY;
    for (int pass = 0; pass < 2; ++pass) { float lsum = 0.f, o = 0.f;
        for (int l = 0; l < n; ++l) { if (!sel[l]) continue; float dot = 0.f; float vv;
            if (sample) { const float* kp; const float* vp;
                if (l < PAST) { const size_t rid = (size_t)ptab[b * NPAGES + (l >> 7)] * PAGE + (l & 127); kp = A.in[2] + rid * 128; vp = A.in[3] + rid * 128; }
                else { kp = F.out + O_KS + ((size_t)b * DECT + (l - PAST)) * 128; vp = F.out + O_VS + ((size_t)b * DECT + (l - PAST)) * 128; }
                for (int e = 0; e < 64; ++e) dot += qs[h * 64 + e] * kp[g * 64 + e]; vv = vp[g * 64 + d];
            } else { const size_t mk = (size_t)b * SEQ + l; for (int e = 0; e < 64; ++e) dot += qs[h * 64 + e] * bf2f(Kb[mk * 128 + g * 64 + e]); vv = bf2f(P[mk * INWP + C_V + g * 64 + d]); }
            dot *= 0.6931471805599453f;
            if (pass == 0) mx = fmaxf(mx, dot); else { const float p = expf(dot - mx); lsum += p; o += p * vv; } }
        if (pass == 1) { const float ref = o / lsum; const float dd = bf2f(CAT[m * D + h * 64 + d]) - ref; dg_add(F, ch, dd * dd, ref * ref); } }
}
__device__ __forceinline__ void dg_report(Frame& F) {
    if (F.bx != 0 || (int)threadIdx.x >= 12) return;
    const size_t offs[12] = {O_YP, O_YS, O_KP, O_VP, O_IP, O_GP, O_CP, O_KS, O_VS, O_IS, O_GS, O_CS};
    size_t off = 0;
#pragma unroll
    for (int j = 0; j < 12; ++j) off = ((int)threadIdx.x == j) ? offs[j] : off;
    const float num = __hip_atomic_load((float*)(F.ctl + CW_DG + 2 * (int)threadIdx.x), RLX_AGENT), den = __hip_atomic_load((float*)(F.ctl + CW_DG + 2 * (int)threadIdx.x + 1), RLX_AGENT);
    int n = 99;
    if (den > 0.f) { const float e = sqrtf(num / den); const float L = -log10f(fmaxf(e, 1e-9f)); n = 1 + (int)(10.f * fmaxf(L, 0.f) + 0.5f); n = n > 98 ? 98 : n; if (!(e == e)) n = 1; }
    for (int i = 0; i < n; ++i) ((unsigned*)F.out)[off + i] = 0xAAAAAAAAu;
}
#endif

#if MK_DIAG == 2
constexpr int CW_TS = 3072;
__device__ __forceinline__ void ts_stamp(Frame& F, int k) { if (F.bx == 0 && F.wave == 0 && lane_fresh() == 0) { const unsigned long long t = __builtin_amdgcn_s_memrealtime(); F.ctl[CW_TS + 2 * k] = (unsigned)t; F.ctl[CW_TS + 2 * k + 1] = (unsigned)(t >> 32); } }
__device__ __forceinline__ void ts_report(Frame& F) {
    if (F.bx != 0 || F.wave != 0) return; const int lane = lane_fresh(); if (lane >= 12) return;
    const size_t offs[12] = {O_YP, O_YS, O_KP, O_VP, O_IP, O_GP, O_CP, O_KS, O_VS, O_IS, O_GS, O_CS};
    const int lo[12] = TS_LO; const int hi[12] = TS_HI;
    size_t off = 0; int a = 0, b = 0;
#pragma unroll
    for (int j = 0; j < 12; ++j) { off = (lane == j) ? offs[j] : off; a = (lane == j) ? lo[j] : a; b = (lane == j) ? hi[j] : b; }
    const unsigned long long t0 = (unsigned long long)F.ctl[CW_TS + 2 * a] | ((unsigned long long)F.ctl[CW_TS + 2 * a + 1] << 32), t1 = (unsigned long long)F.ctl[CW_TS + 2 * b] | ((unsigned long long)F.ctl[CW_TS + 2 * b + 1] << 32);
    int n = (int)((t1 - t0) / 100ull); n = n < 1 ? 1 : (n > 60000 ? 60000 : n);
    for (int i = 0; i < n; ++i) ((unsigned*)F.out)[off + i] = 0xAAAAAAAAu;
}
#endif
#ifndef MK_ONE_LAUNCH
#define MK_ONE_LAUNCH 0
#endif
constexpr int NPH = 14 + (MK_DIAG == 1 ? 2 : MK_DIAG == 2 ? 1 : 0);
__global__ void __launch_bounds__(NTHR, 2) mk_fwd(Args args) {
    extern __shared__ __attribute__((aligned(16))) unsigned char lds[];
    Frame F;
    F.lds = (LAS unsigned char*)lds; F.MISC = (volatile LAS unsigned*)(F.lds + MISC_OFF);
    F.wave = __builtin_amdgcn_readfirstlane(threadIdx.x >> 6); F.G = gridDim.x; F.bx = blockIdx.x;
    F.out = args.out; F.ws = args.ws; F.ctl = (gu32*)(args.ws + WS_CTL);
    for (int u = F.wave * 64 + lane_fresh(); u < (LDS_BYTES - LDSCTL_OFF) / 4; u += NTHR) ((LAS unsigned*)(F.lds + LDSCTL_OFF))[u] = 0u;
    __syncthreads();
    XcdBarrier bar; bar.wave = F.wave; bar.bar = (unsigned*)(F.ctl + CW_BAR); bar.x = 0; bar.st = nullptr;
    if (MK_ONE_LAUNCH) bar = xcd_barrier_post((unsigned*)(F.ctl + CW_BAR), F.MISC + 8, F.wave);
    const int lo = args.ph_lo, hi = args.ph_hi;
#define IN(k) (lo <= (k) && (k) < hi)
#define PHASE(k, ...) do { if (IN(k)) { __VA_ARGS__ } if (MK_DUP == (k)) { xcd_barrier(bar); __VA_ARGS__ } SEAM(k); } while (0)
#if MK_DIAG == 2
#define SEAM(k) do { if (IN(k) && IN((k) + 1)) xcd_barrier(bar); ts_stamp(F, (k) + 1); } while (0)
#else
#define SEAM(k) do { if (IN(k) && IN((k) + 1)) xcd_barrier(bar); } while (0)
#endif
    const float* xp = args.in[0]; const float* xs = args.in[1];
    bf16* XB = WSP(bf16, WS_XB); float* X1 = WSP(float, WS_X1); float* X2 = WSP(float, WS_X2); float* R = WSP(float, WS_R); bf16* RB = WSP(bf16, WS_R); bf16* H = WSP(bf16, WS_H); bf16* P = WSP(bf16, WS_P); bf16* CAT = WSP(bf16, WS_CAT);

#if MK_DIAG == 2
    ts_stamp(F, 0);
#endif
    PHASE(0,  p0_prologue(F, args); );
    PHASE(1,
        pg8::Gemm g{XB, WSP(bf16, WS_WGU1), M, NGU, D}; pg8::StaticOrder S; S.init(M, NGU, F.G, F.bx);
        pg8::EpiSwiGLU E{H, FF};
        pg8::gemm_phase<pg8::EpiSwiGLU, pg8::StaticOrder, true, true>(F.lds + RING_OFF, g, S, E, F.wave);
    );
    PHASE(2,
        pg8::Gemm g{H, WSP(bf16, WS_WD1), MP, D, FF}; pg8::StaticOrder S; S.init(MP, D, F.G, F.bx);
        pg8::EpiResBf16<true> E{xp, RB, D, ALPHA, 0.5f};
        pg8::gemm_phase<pg8::EpiResBf16<true>, pg8::StaticOrder, true, true>(F.lds + RING_OFF, g, S, E, F.wave);
        pg8::Gemm gs{H + (size_t)MP * FF, WSP(bf16, WS_WD1), MS, D, FF, 256}; pg8::SplitOrder SS; SS.init(MS, D, FF / 256, F.G, F.bx);
        pg8::EpiPartialF32 ES{WSP(float, WS_PART), D, (size_t)MS * D};
        pg8::gemm_phase<pg8::EpiPartialF32, pg8::SplitOrder, true, true>(F.lds + RING_OFF, gs, SS, ES, F.wave);
    );
    PHASE(3,  ln_phase(F, RB, args.in[11], args.in[12], nullptr, XB, WSP(float, WS_PART), FF / 256, xs, nullptr, 0.5f); );
    PHASE(4,
        pg8::Gemm g{XB, WSP(bf16, WS_WIN), M, INWP, D}; pg8::StaticOrder S; S.init(M, INWP, F.G, F.bx);
        pg8::EpiPlainBf16 E{P, INWP};
        pg8::gemm_phase<pg8::EpiPlainBf16, pg8::StaticOrder, true, true>(F.lds + RING_OFF, g, S, E, F.wave);
    );
    PHASE(5,  post_phase(F, args); );
    PHASE(6,  gdn_prep_phase(F, args); if (MK_DUP == 60) gdn_prep_phase(F, args); dsa_sample_scores_phase(F, args); if (MK_DUP == 61) dsa_sample_scores_phase(F, args); );
    PHASE(7,  gdn_scan_phase(F, args); if (MK_DUP == 70) gdn_scan_phase(F, args); dsa_sample_attend_phase(F, args); if (MK_DUP == 71) dsa_sample_attend_phase(F, args); dsa_prompt_phase(F); if (MK_DUP == 72) dsa_prompt_phase(F); );
    PHASE(8,  gdn_out_phase(F, args); );
#if MK_DIAG != 1
    PHASE(9,
        pg8::Gemm g{CAT, WSP(bf16, WS_WO), MP, D, D}; pg8::StaticOrder S; S.init(MP, D, F.G, F.bx);
        pg8::EpiResBf16<false> E{XB, RB, D, ALPHA, 1.0f};
        pg8::gemm_phase<pg8::EpiResBf16<false>, pg8::StaticOrder, true, true>(F.lds + RING_OFF, g, S, E, F.wave);
        pg8::Gemm gs{CAT + (size_t)MP * D, WSP(bf16, WS_WO), MS, D, D, 256}; pg8::SplitOrder SS; SS.init(MS, D, D / 256, F.G, F.bx);
        pg8::EpiPartialF32 ES{WSP(float, WS_PART), D, (size_t)MS * D};
        pg8::gemm_phase<pg8::EpiPartialF32, pg8::SplitOrder, true, true>(F.lds + RING_OFF, gs, SS, ES, F.wave);
    );
    PHASE(10,  ln_phase(F, RB, args.in[19], args.in[20], nullptr, XB, WSP(float, WS_PART), D / 256, nullptr, XB, 1.0f); );
    PHASE(11,
        pg8::Gemm g{XB, WSP(bf16, WS_WGU2), M, NGU, D}; pg8::StaticOrder S; S.init(M, NGU, F.G, F.bx);
        pg8::EpiSwiGLU E{H, FF};
        pg8::gemm_phase<pg8::EpiSwiGLU, pg8::StaticOrder, true, true>(F.lds + RING_OFF, g, S, E, F.wave);
    );
    PHASE(12,
        pg8::Gemm g{H, WSP(bf16, WS_WD2), MP, D, FF}; pg8::StaticOrder S; S.init(MP, D, F.G, F.bx);
        pg8::EpiResBf16<false> E{XB, RB, D, ALPHA, 0.5f};
        pg8::gemm_phase<pg8::EpiResBf16<false>, pg8::StaticOrder, true, true>(F.lds + RING_OFF, g, S, E, F.wave);
        pg8::Gemm gs{H + (size_t)MP * FF, WSP(bf16, WS_WD2), MS, D, FF, 256}; pg8::SplitOrder SS; SS.init(MS, D, FF / 256, F.G, F.bx);
        pg8::EpiPartialF32 ES{WSP(float, WS_PART), D, (size_t)MS * D};
        pg8::gemm_phase<pg8::EpiPartialF32, pg8::SplitOrder, true, true>(F.lds + RING_OFF, gs, SS, ES, F.wave);
    );
    PHASE(13,  ln_phase(F, RB, args.in[24], args.in[25], F.out + O_YP, nullptr, WSP(float, WS_PART), FF / 256, nullptr, XB, 0.5f); );
#endif
#if MK_DIAG == 1
    if (IN(14)) {
#if MK_DIAG_ALL
        chk_ffn(F, xp, xs, MP, args.in[8], args.in[9], args.in[10], args.in[11], args.in[12], X1, 0);
        chk_proj(F, X1, args.in[13], P, 1);
#endif
        if (F.bx >= 8 && F.bx < 12) { const int i = F.bx - 8; chk_gdn(F, args, false, 5 * i, i, 2, 3); }
        if (F.bx >= 16 && F.bx < 24) { const int i = F.bx - 16; chk_dsa(F, args, false, (3 * i + 1) & 15, i == 0 ? 5 : i == 1 ? 255 : i == 2 ? 256 : i == 3 ? 300 : i == 4 ? 777 : i == 5 ? 1500 : i == 6 ? 2046 : 2047, 6); }
        if (F.bx >= 24 && F.bx < 28) { const int i = F.bx - 24; chk_dsa(F, args, true, i == 0 ? 0 : i == 1 ? 50 : i == 2 ? 99 : 127, i == 0 ? 0 : i == 1 ? 3 : i == 2 ? 6 : 7, 7); }
        if (F.bx >= 12 && F.bx < 16) { const int i = F.bx - 12; chk_gdn(F, args, true, i == 0 ? 0 : i == 1 ? 37 : i == 2 ? 100 : 127, i, 4, 5); }
    }
#endif
#if MK_DIAG == 1
    if (IN(15)) dg_report(F);
#endif
#if MK_DIAG == 2
    if (IN(14)) ts_report(F);
#endif
#undef IN
#undef SEAM
}

extern "C" void kernel_launch(void* const* d_in, const int* in_sizes, int n_in, void* d_out, int out_size, void* d_ws, size_t ws_size, hipStream_t stream) {
    static int grid = 0;
    if (grid == 0) {
        if (n_in != 26 || out_size != (int)O_END || ws_size < WS_END) { fprintf(stderr, "kernel_launch: unexpected shapes (n_in %d out %d ws %zu)\n", n_in, out_size, ws_size); grid = -1; return; }
        int dev = 0, cus = 0, per_cu = 0;
        if (hipGetDevice(&dev) != hipSuccess || hipDeviceGetAttribute(&cus, hipDeviceAttributeMultiprocessorCount, dev) != hipSuccess) { grid = -1; return; }
        if (hipFuncSetAttribute((const void*)mk_fwd, hipFuncAttributeMaxDynamicSharedMemorySize, LDS_BYTES) != hipSuccess) { fprintf(stderr, "kernel_launch: hipFuncSetAttribute failed\n"); grid = -1; return; }
        if (hipOccupancyMaxActiveBlocksPerMultiprocessor(&per_cu, (const void*)mk_fwd, NTHR, LDS_BYTES) != hipSuccess || per_cu < 1) fprintf(stderr, "kernel_launch: occupancy query reports %d\n", per_cu);
        (void)hipGetLastError();
        grid = cus;
    }
    if (grid < 0) return;
    if (hipMemsetAsync((char*)d_ws + WS_CTL, 0, CTL_ZERO_BYTES, stream) != hipSuccess) return;
    Args a{};
    for (int i = 0; i < 26; ++i) a.in[i] = (const float*)d_in[i];
    a.out = (float*)d_out; a.ws = (unsigned char*)d_ws;
#if MK_ONE_LAUNCH
    a.ph_lo = 0; a.ph_hi = NPH;
    hipLaunchKernelGGL(mk_fwd, dim3(grid), dim3(NTHR), LDS_BYTES, stream, a);
#else
    for (int k = 0; k < NPH; ++k) { if (MK_DIAG == 1 && k >= 9 && k <= 13) continue; a.ph_lo = k; a.ph_hi = k + 1; hipLaunchKernelGGL(mk_fwd, dim3(grid), dim3(NTHR), LDS_BYTES, stream, a); }
#endif
}
```

```cpp
#define MK_DIAG 0
#define MK_DIAG_ALL 0
#define TS_LO {0,1,2,3,4,5,6,7,8,9,10,11}
#define TS_HI {1,2,3,4,5,6,7,8,9,10,11,14}
#define MK_ONE_LAUNCH 1
#define MK_DUP -1
#define MK_X 0
#include <hip/hip_runtime.h>
#include <cstdio>
#include <cstdint>
namespace pg8 {
#define PG8_LAS __attribute__((address_space(3)))
typedef unsigned short bf16_t;
typedef short bf16x8 __attribute__((ext_vector_type(8)));
typedef float f32x4 __attribute__((ext_vector_type(4)));
typedef unsigned u32x4 __attribute__((ext_vector_type(4)));
constexpr int BM = 256, BK = 64, HALF = 128, HTB = HALF * BK * 2  , STAGE_BYTES = 8 * HTB, NXCD = 8, WGM = 8;

__host__ __device__ __forceinline__ int lds_byte(int r, int c) { const int st = (r >> 4) * 2 + (c >> 5), rr = r & 15, cc = c & 31, ob = rr * 64 + cc * 2; return st * 1024 + (ob ^ (((ob >> 9) & 1) << 5)); }
__host__ __device__ __forceinline__ void stage_rc(int b, int& R, int& C) { const int st = b / 1024, sb = b % 1024, swz = sb ^ (((sb >> 9) & 1) << 5); R = (st >> 1) * 16 + swz / 64; C = (st & 1) * 32 + (swz % 64) / 2; }
__host__ __device__ __forceinline__ int perm32(int rho) { const int n = rho >> 4, i = rho & 15; return 8 * (i >> 2) + 4 * n + (i & 3); }

struct Unit { int pm, pn, kc; };
struct Gemm { const bf16_t* A; const bf16_t* Bt; int M, N, K; int klen = 0; };

struct StaticOrder {
    int nM, nN, nwg, G, c;
    __host__ __device__ void init(int M, int N, int G_, int c_) { nM = M / BM; nN = N / BM; nwg = nM * nN; G = G_; c = c_; }
    __host__ __device__ bool next(int i, Unit& u) const {
        const long L = (long)i * G + c; if (L >= nwg) return false;
        int wgid = (int)L; { const int q = nwg / NXCD, r = nwg % NXCD, xcd = wgid % NXCD, off = wgid / NXCD; wgid = (xcd < r ? xcd * (q + 1) : r * (q + 1) + (xcd - r) * q) + off; }
        const int nig = WGM * nN, gid = wgid / nig, fm = gid * WGM, gsz = (nM - fm) < WGM ? (nM - fm) : WGM;
        u.pm = fm + ((wgid % nig) % gsz); u.pn = (wgid % nig) / gsz; u.kc = 0; return true;
    }
    __device__ __forceinline__ void a_ready(const Unit&) const {}
    __device__ __forceinline__ void done(const Unit&) const {}
};

__device__ __forceinline__ unsigned cvt_pk_bf16(float lo, float hi) { unsigned r; asm volatile("v_cvt_pk_bf16_f32 %0, %1, %2" : "=v"(r) : "v"(lo), "v"(hi)); return r; }
typedef float f32x2 __attribute__((ext_vector_type(2)));
__device__ __forceinline__ float silu_f(float x) { return x * __builtin_amdgcn_rcpf(1.0f + __builtin_amdgcn_exp2f(-1.4426950408889634f * x)); }
struct EpiSwiGLU {
    static constexpr bool PERM = true, AFTER_DRAIN = false;
    bf16_t* O; int ldc;
    __device__ __forceinline__ void operator()(const f32x4 (&acc)[2][2][4][2], const Unit& u, int wr, int wc, int fr, int fq) const {
        const int row0 = u.pm * BM + wr * 64 + fr, col0 = u.pn * HALF + wc * 32 + 8 * fq;
#pragma unroll
        for (int ai = 0; ai < 2; ++ai)
#pragma unroll
            for (int m = 0; m < 4; ++m) { bf16_t* p = O + (size_t)(row0 + ai * HALF + m * 16) * ldc + col0;
                const f32x4 g0 = acc[ai][0][m][0], g1 = acc[ai][0][m][1], u0 = acc[ai][1][m][0], u1 = acc[ai][1][m][1];
                u32x4 w; w.x = cvt_pk_bf16(silu_f(g0[0]) * u0[0], silu_f(g0[1]) * u0[1]); w.y = cvt_pk_bf16(silu_f(g0[2]) * u0[2], silu_f(g0[3]) * u0[3]);
                w.z = cvt_pk_bf16(silu_f(g1[0]) * u1[0], silu_f(g1[1]) * u1[1]); w.w = cvt_pk_bf16(silu_f(g1[2]) * u1[2], silu_f(g1[3]) * u1[3]);
                *(u32x4*)p = w; }
    }
};
struct EpiResF32 {
    static constexpr bool PERM = false, AFTER_DRAIN = false;
    const float* res0; const float* res1; int split; float* out; int ldc; float alpha, s;
    __device__ __forceinline__ void operator()(const f32x4 (&acc)[2][2][4][2], const Unit& u, int wr, int wc, int fr, int fq) const {
        const int col0 = u.pn * BM + wc * 32 + 4 * fq;
#pragma unroll
        for (int ai = 0; ai < 2; ++ai)
#pragma unroll
            for (int m = 0; m < 4; ++m) { const int r = u.pm * BM + ai * HALF + wr * 64 + m * 16 + fr;
                const float* rp = (r < split) ? res0 + (size_t)r * ldc : res1 + (size_t)(r - split) * ldc; float* op = out + (size_t)r * ldc;
#pragma unroll
                for (int bj = 0; bj < 2; ++bj)
#pragma unroll
                    for (int n = 0; n < 2; ++n) { const int c = col0 + bj * HALF + n * 16; const f32x4 x = *(const f32x4*)(rp + c); *(f32x4*)(op + c) = x * alpha + acc[ai][bj][m][n] * s; }
                if (m & 1) asm volatile("" ::: "memory"); }
    }
};
struct EpiPlainBf16 {
    static constexpr bool PERM = true, AFTER_DRAIN = false;
    bf16_t* O; int ldc;
    __device__ __forceinline__ void operator()(const f32x4 (&acc)[2][2][4][2], const Unit& u, int wr, int wc, int fr, int fq) const {
        const int row0 = u.pm * BM + wr * 64 + fr, col0 = u.pn * BM + wc * 32 + 8 * fq;
#pragma unroll
        for (int ai = 0; ai < 2; ++ai)
#pragma unroll
            for (int m = 0; m < 4; ++m) { bf16_t* rowp = O + (size_t)(row0 + ai * HALF + m * 16) * ldc + col0;
#pragma unroll
                for (int bj = 0; bj < 2; ++bj) { const f32x4 v0 = acc[ai][bj][m][0], v1 = acc[ai][bj][m][1];
                    u32x4 w; w.x = cvt_pk_bf16(v0[0], v0[1]); w.y = cvt_pk_bf16(v0[2], v0[3]); w.z = cvt_pk_bf16(v1[0], v1[1]); w.w = cvt_pk_bf16(v1[2], v1[3]);
                    *(u32x4*)(rowp + bj * HALF) = w; } }
    }
};
struct SplitOrder {
    int nM, nN, ns, nwg, G, c;
    __host__ __device__ void init(int M, int N, int ns_, int G_, int c_) { nM = M / BM; nN = N / BM; ns = ns_; nwg = nM * nN * ns; G = G_; c = c_; }
    __host__ __device__ bool next(int i, Unit& u) const { const long L = (long)i * G + c; if (L >= nwg) return false; const int l = (int)L; u.kc = l % ns; u.pn = (l / ns) % nN; u.pm = l / (ns * nN); return true; }
    __device__ __forceinline__ void a_ready(const Unit&) const {}
    __device__ __forceinline__ void done(const Unit&) const {}
};
struct EpiPartialF32 {
    static constexpr bool PERM = false, AFTER_DRAIN = false;
    float* part; int ldc; size_t slice;
    __device__ __forceinline__ void operator()(const f32x4 (&acc)[2][2][4][2], const Unit& u, int wr, int wc, int fr, int fq) const {
        const int col0 = u.pn * BM + wc * 32 + 4 * fq; float* base = part + (size_t)u.kc * slice;
#pragma unroll
        for (int ai = 0; ai < 2; ++ai)
#pragma unroll
            for (int m = 0; m < 4; ++m) { const int r = u.pm * BM + ai * HALF + wr * 64 + m * 16 + fr; float* op = base + (size_t)r * ldc;
#pragma unroll
                for (int bj = 0; bj < 2; ++bj)
#pragma unroll
                    for (int n = 0; n < 2; ++n) *(f32x4*)(op + col0 + bj * HALF + n * 16) = acc[ai][bj][m][n]; }
    }
};
template <bool RESF32> struct EpiResBf16 {
    static constexpr bool PERM = true, AFTER_DRAIN = false;
    const void* res; bf16_t* out; int ldc; float alpha, s;
    __device__ __forceinline__ void operator()(const f32x4 (&acc)[2][2][4][2], const Unit& u, int wr, int wc, int fr, int fq) const {
        const int row0 = u.pm * BM + wr * 64 + fr, col0 = u.pn * BM + wc * 32 + 8 * fq;
#pragma unroll
        for (int ai = 0; ai < 2; ++ai)
#pragma unroll
            for (int m = 0; m < 4; ++m) { const size_t ro = (size_t)(row0 + ai * HALF + m * 16) * ldc + col0;
#pragma unroll
                for (int bj = 0; bj < 2; ++bj) { f32x4 r0, r1;
                    if (RESF32) { const float* rp = (const float*)res + ro + bj * HALF; r0 = *(const f32x4*)rp; r1 = *(const f32x4*)(rp + 4); }
                    else { const u32x4 rw = *(const u32x4*)((const bf16_t*)res + ro + bj * HALF);
                        r0 = (f32x4){__builtin_bit_cast(float, rw.x << 16), __builtin_bit_cast(float, rw.x & 0xffff0000u), __builtin_bit_cast(float, rw.y << 16), __builtin_bit_cast(float, rw.y & 0xffff0000u)};
                        r1 = (f32x4){__builtin_bit_cast(float, rw.z << 16), __builtin_bit_cast(float, rw.z & 0xffff0000u), __builtin_bit_cast(float, rw.w << 16), __builtin_bit_cast(float, rw.w & 0xffff0000u)}; }
                    const f32x4 v0 = r0 * alpha + acc[ai][bj][m][0] * s, v1 = r1 * alpha + acc[ai][bj][m][1] * s;
                    u32x4 w; w.x = cvt_pk_bf16(v0[0], v0[1]); w.y = cvt_pk_bf16(v0[2], v0[3]); w.z = cvt_pk_bf16(v1[0], v1[1]); w.w = cvt_pk_bf16(v1[2], v1[3]);
                    *(u32x4*)(out + ro + bj * HALF) = w; }
                if (m & 1) asm volatile("" ::: "memory"); }
    }
};
template <class Epi, class Sched, bool ALIGN_EPI = false, bool SP2 = false>
__device__ __forceinline__ void gemm_phase(PG8_LAS unsigned char* lds, const Gemm g, const Sched& S, const Epi& E, const int wid) {
    int lane_; asm volatile("v_mbcnt_lo_u32_b32 %0, -1, 0\n\tv_mbcnt_hi_u32_b32 %0, -1, %0" : "=v"(lane_));
    const int lane = lane_, tid = wid * 64 + lane, wr = wid >> 2, wc = wid & 3, fr = lane & 15, fq = lane >> 4;
    const int K = g.K, nt = (g.klen ? g.klen : K) / BK;
    const size_t kcstep = (size_t)g.klen * 2;
    unsigned voffA[2], voffB[2];
#pragma unroll
    for (int i = 0; i < 2; ++i) { int R, C; stage_rc(tid * 16 + i * 8192, R, C); const int Rb = Epi::PERM ? ((R & ~31) + perm32(R & 31)) : R;
        voffA[i] = (unsigned)(R * K + C) * 2u; voffB[i] = (unsigned)(Rb * K + C) * 2u; }
    const size_t kstep = (size_t)(BK * 2);
    const size_t hstep = (size_t)HALF * K * 2;
    const size_t tstep = 2 * hstep;
    const unsigned ldsw = (unsigned)wid * 1024u;
    const int aoff = lds_byte(wr * 64 + fr, fq * 8), boff = lds_byte(wc * 32 + fr, fq * 8);
#define PG8_SA(b, h) (((b) * 2 + (h)) * HTB)
#define PG8_SB(b, h) ((4 + (b) * 2 + (h)) * HTB)
#define PG8_STAGE(bufoff, gbase, voff) do { _Pragma("unroll") for (int _i = 0; _i < 2; ++_i) \
        __builtin_amdgcn_global_load_lds((const unsigned*)((const char*)(gbase) + (voff)[_i]), (PG8_LAS unsigned*)(lds + (bufoff) + ldsw + _i * 8192), 16, 0, 0); } while (0)
#define PG8_LDA(dst, b, h) do { _Pragma("unroll") for (int m = 0; m < 4; ++m) _Pragma("unroll") for (int k = 0; k < 2; ++k) dst[m][k] = *(const PG8_LAS bf16x8*)(lds + PG8_SA(b, h) + aoff + m * 2048 + k * 1024); } while (0)
#define PG8_LDB(dst, b, h) do { _Pragma("unroll") for (int n = 0; n < 2; ++n) _Pragma("unroll") for (int k = 0; k < 2; ++k) dst[n][k] = *(const PG8_LAS bf16x8*)(lds + PG8_SB(b, h) + boff + n * 2048 + k * 1024); } while (0)
#define PG8_MMA(ai, bj, At, Bt) do { __builtin_amdgcn_s_setprio(1); _Pragma("unroll") for (int m = 0; m < 4; ++m) _Pragma("unroll") for (int n = 0; n < 2; ++n) _Pragma("unroll") for (int k = 0; k < 2; ++k) \
        acc[ai][bj][m][n] = __builtin_amdgcn_mfma_f32_16x16x32_bf16(Bt[n][k], At[m][k], acc[ai][bj][m][n], 0, 0, 0); __builtin_amdgcn_s_setprio(0); } while (0)
#define PG8_WAIT_V(n) asm volatile("s_waitcnt vmcnt(" #n ")" ::: "memory")
#define PG8_WAIT_L(n) asm volatile("s_waitcnt lgkmcnt(" #n ")" ::: "memory")
#define PG8_BAR __builtin_amdgcn_s_barrier()
#define PG8_SCHED __builtin_amdgcn_sched_barrier(0)
    Unit cur, nxt; int ui = 0;
    if (!S.next(0, cur)) return;
    f32x4 acc[2][2][4][2];
#pragma unroll
    for (int a = 0; a < 2; ++a)
#pragma unroll
        for (int b = 0; b < 2; ++b)
#pragma unroll
            for (int m = 0; m < 4; ++m)
#pragma unroll
                for (int n = 0; n < 2; ++n) acc[a][b][m][n] = (f32x4){0.f, 0.f, 0.f, 0.f};
    bf16x8 At[4][2], B0[2][2], B1[2][2];
    const char* cA = (const char*)g.A + (size_t)cur.pm * tstep + (size_t)cur.kc * kcstep; const char* cB = (const char*)g.Bt + (size_t)cur.pn * tstep + (size_t)cur.kc * kcstep;
    S.a_ready(cur);
    if constexpr (SP2) {
        PG8_STAGE(PG8_SB(0, 0), cB, voffB); PG8_STAGE(PG8_SB(0, 1), cB + hstep, voffB); PG8_STAGE(PG8_SA(0, 0), cA, voffA); PG8_STAGE(PG8_SA(0, 1), cA + hstep, voffA);
        if (wr == 1) PG8_BAR;
        PG8_WAIT_V(2); PG8_BAR;
        PG8_STAGE(PG8_SB(1, 0), cB + kstep, voffB); PG8_STAGE(PG8_SA(1, 0), cA + kstep, voffA); PG8_STAGE(PG8_SB(1, 1), cB + hstep + kstep, voffB);
        PG8_WAIT_V(6); PG8_BAR;
    } else {
        PG8_STAGE(PG8_SB(0, 0), cB, voffB); PG8_STAGE(PG8_SA(0, 0), cA, voffA); PG8_STAGE(PG8_SB(0, 1), cB + hstep, voffB); PG8_STAGE(PG8_SA(0, 1), cA + hstep, voffA);
        if (wr == 1) PG8_BAR;
        PG8_WAIT_V(4); PG8_BAR;
        PG8_STAGE(PG8_SB(1, 0), cB + kstep, voffB); PG8_STAGE(PG8_SA(1, 0), cA + kstep, voffA); PG8_STAGE(PG8_SB(1, 1), cB + hstep + kstep, voffB);
        PG8_WAIT_V(6); PG8_BAR;
    }
    for (;;) {
        const bool has_next = S.next(ui + 1, nxt);
        const char* nA = has_next ? (const char*)g.A + (size_t)nxt.pm * tstep + (size_t)nxt.kc * kcstep : cA; const char* nB = has_next ? (const char*)g.Bt + (size_t)nxt.pn * tstep + (size_t)nxt.kc * kcstep : cB;
        for (int t = 0; t < nt; t += 2) {
            const bool last = (t == nt - 2);
            const char* a1 = cA + (size_t)(t + 1) * kstep;
            const char* a2 = last ? nA : cA + (size_t)(t + 2) * kstep; const char* b2 = last ? nB : cB + (size_t)(t + 2) * kstep;
            const char* a3 = a2 + kstep; const char* b3 = b2 + kstep;
            if (last && has_next) S.a_ready(nxt);
            if constexpr (SP2) {
            PG8_LDB(B0, 0, 0); PG8_LDB(B1, 0, 1); PG8_SCHED; PG8_LDA(At, 0, 0); PG8_STAGE(PG8_SA(1, 1), a1 + hstep, voffA);
            PG8_WAIT_V(8); PG8_WAIT_L(0); PG8_BAR; PG8_MMA(0, 0, At, B0); PG8_MMA(0, 1, At, B1); PG8_BAR; PG8_SCHED;
            PG8_LDA(At, 0, 1); PG8_STAGE(PG8_SB(0, 0), b2, voffB); PG8_STAGE(PG8_SB(0, 1), b2 + hstep, voffB); PG8_STAGE(PG8_SA(0, 0), a2, voffA);
            PG8_WAIT_V(8); PG8_WAIT_L(0); PG8_BAR; PG8_MMA(1, 0, At, B0); PG8_MMA(1, 1, At, B1); PG8_BAR; PG8_SCHED;
            PG8_LDB(B0, 1, 0); PG8_LDB(B1, 1, 1); PG8_SCHED; PG8_LDA(At, 1, 0); PG8_STAGE(PG8_SA(0, 1), a2 + hstep, voffA);
            PG8_WAIT_V(8); PG8_WAIT_L(0); PG8_BAR; PG8_MMA(0, 0, At, B0); PG8_MMA(0, 1, At, B1); PG8_BAR; PG8_SCHED;
            PG8_LDA(At, 1, 1); PG8_STAGE(PG8_SB(1, 0), b3, voffB); PG8_STAGE(PG8_SB(1, 1), b3 + hstep, voffB); PG8_STAGE(PG8_SA(1, 0), a3, voffA);
            PG8_WAIT_V(8); PG8_WAIT_L(0); PG8_BAR; PG8_MMA(1, 0, At, B0); PG8_MMA(1, 1, At, B1); PG8_BAR; PG8_SCHED;
            } else {
            PG8_LDB(B0, 0, 0); PG8_SCHED; PG8_LDA(At, 0, 0); PG8_STAGE(PG8_SA(1, 1), a1 + hstep, voffA);
            PG8_WAIT_L(8); PG8_BAR; PG8_WAIT_L(0); PG8_MMA(0, 0, At, B0); PG8_BAR; PG8_SCHED;
            PG8_LDB(B1, 0, 1); PG8_STAGE(PG8_SB(0, 0), b2, voffB);
            PG8_BAR; PG8_WAIT_L(0); PG8_MMA(0, 1, At, B1); PG8_BAR;
            PG8_LDA(At, 0, 1); PG8_STAGE(PG8_SA(0, 0), a2, voffA);
            PG8_BAR; PG8_WAIT_L(0); PG8_MMA(1, 0, At, B0); PG8_BAR; PG8_SCHED;
            PG8_STAGE(PG8_SB(0, 1), b2 + hstep, voffB);
            PG8_WAIT_V(6); PG8_BAR; PG8_MMA(1, 1, At, B1); PG8_BAR;
            PG8_LDB(B0, 1, 0); PG8_SCHED; PG8_LDA(At, 1, 0); PG8_STAGE(PG8_SA(0, 1), a2 + hstep, voffA);
            PG8_WAIT_L(8); PG8_BAR; PG8_WAIT_L(0); PG8_MMA(0, 0, At, B0); PG8_BAR; PG8_SCHED;
            PG8_LDB(B1, 1, 1); PG8_STAGE(PG8_SB(1, 0), b3, voffB);
            PG8_BAR; PG8_WAIT_L(0); PG8_MMA(0, 1, At, B1); PG8_BAR;
            PG8_LDA(At, 1, 1); PG8_STAGE(PG8_SA(1, 0), a3, voffA);
            PG8_BAR; PG8_WAIT_L(0); PG8_MMA(1, 0, At, B0); PG8_BAR; PG8_SCHED;
            PG8_STAGE(PG8_SB(1, 1), b3 + hstep, voffB);
            PG8_WAIT_V(6); PG8_BAR; PG8_MMA(1, 1, At, B1); PG8_BAR;
            }
        }
        if constexpr (ALIGN_EPI) { if (wr == 0) PG8_BAR; }
        if constexpr (!Epi::AFTER_DRAIN) { E(acc, cur, wr, wc, fr, fq); S.done(cur); }
        if (!has_next) break;
#pragma unroll
        for (int a = 0; a < 2; ++a)
#pragma unroll
            for (int b = 0; b < 2; ++b)
#pragma unroll
                for (int m = 0; m < 4; ++m)
#pragma unroll
                    for (int n = 0; n < 2; ++n) acc[a][b][m][n] = (f32x4){0.f, 0.f, 0.f, 0.f};
        cur = nxt; cA = nA; cB = nB; ++ui;
        if constexpr (ALIGN_EPI) { if (wr == 1) PG8_BAR; }
    }
    PG8_WAIT_V(0);
    if constexpr (!ALIGN_EPI) { if (wr == 0) PG8_BAR; }
    PG8_BAR;
    if constexpr (Epi::AFTER_DRAIN) { E.fused(acc, cur, wr, wc, fr, fq, lds, wid, lane); S.done(cur); }
#undef PG8_SA
#undef PG8_SB
#undef PG8_STAGE
#undef PG8_LDA
#undef PG8_LDB
#undef PG8_MMA
#undef PG8_WAIT_V
#undef PG8_WAIT_L
#undef PG8_BAR
#undef PG8_SCHED
}
}
constexpr int NWAVES = 8, NTHR = 512;
constexpr int D = 1024, BATCH = 16, SEQ = 2048, DECB = 128, DECT = 8, PAST = 8192, PAGE = 128, NPAGES = 64;
constexpr int MP = BATCH * SEQ, MS = DECB * DECT, M = MP + MS;
constexpr int FF = 2816, NGU = 2 * FF, INW = 3408, INWP = 3584;
constexpr int C_Q = 0, C_K = 512, C_V = 640, C_QI = 768, C_KI = 1280, C_WI = 1344, C_QKV = 1352, C_Z = 2888, C_BG = 3400, C_AG = 3404;
constexpr int GH = 4, GDK = 128, GDV = 128, CONVC = 1536, NCHUNK = SEQ / 64, GDN_UNITS = 2048 + DECB * GH;
constexpr int KSEL = 256, LS = PAST + DECT, SCS_LD = 8208;
constexpr float LN_EPS = 1e-5f, NORM_EPS = 1e-6f, ALPHA = 1.189207115002721f;
constexpr size_t O_YP = 0, O_YS = 33554432, O_KP = 34603008, O_VP = 38797312, O_IP = 42991616, O_GP = 45088768, O_CP = 46137344, O_KS = 46211072, O_VS = 46342144, O_IS = 46473216, O_GS = 46538752, O_CS = 54927360, O_END = 55517184;
constexpr size_t MiB = 1u << 20;
constexpr size_t WS_CTL = 0, CTL_ZERO_BYTES = 1 * MiB, WS_ROPE = 1 * MiB;
constexpr size_t WS_WGU1 = 2 * MiB, WS_WD1 = 13 * MiB, WS_WIN = 19 * MiB, WS_WO = 26 * MiB, WS_WGU2 = 28 * MiB, WS_WD2 = 39 * MiB;
constexpr size_t WS_XB = 48 * MiB, WS_X1 = 116 * MiB, WS_X2 = 248 * MiB, WS_R = 380 * MiB, WS_H = 512 * MiB, WS_P = 696 * MiB;
constexpr size_t WS_QB = 928 * MiB, WS_QI = 961 * MiB, WS_KB = 994 * MiB, WS_VT = 1003 * MiB, WS_KI = 1011 * MiB, WS_WI = 1016 * MiB, WS_BG = 1018 * MiB;
constexpr size_t WS_CAT = 1020 * MiB, WS_OG = 1086 * MiB, WS_GSC = 1152 * MiB, WS_GL = 1334 * MiB, WS_SCS = 1336 * MiB, WS_PART = 1370 * MiB, WS_END = 1418 * MiB;
constexpr size_t GSC_UNIT = 73728;
static_assert(WS_WGU1 + (size_t)NGU * D * 2 <= WS_WD1 && WS_WD1 + (size_t)D * FF * 2 <= WS_WIN && WS_WIN + (size_t)INWP * D * 2 <= WS_WO && WS_WO + (size_t)D * D * 2 <= WS_WGU2, "ws map 1");
static_assert(WS_XB + (size_t)M * D * 2 <= WS_X1 && WS_X1 + (size_t)M * D * 4 <= WS_X2 && WS_X2 + (size_t)M * D * 4 <= WS_R && WS_R + (size_t)M * D * 4 <= WS_H && WS_H + (size_t)M * FF * 2 <= WS_P && WS_P + (size_t)M * INWP * 2 <= WS_QB, "ws map 2");
static_assert(WS_QB + (size_t)M * 512 * 2 <= WS_QI && WS_QI + (size_t)M * 512 * 2 <= WS_KB && WS_KB + (size_t)M * 128 * 2 <= WS_VT && WS_VT + (size_t)MP * 128 * 2 <= WS_KI && WS_KI + (size_t)M * 64 * 2 <= WS_WI && WS_WI + (size_t)M * 8 * 4 <= WS_BG && WS_BG + (size_t)M * 8 * 4 <= WS_CAT, "ws map 3");
static_assert(WS_CAT + (size_t)M * D * 2 <= WS_OG && WS_OG + (size_t)M * 512 * 4 <= WS_GSC && WS_GSC + (size_t)GDN_UNITS * GSC_UNIT <= WS_GL && WS_SCS + (size_t)MS * SCS_LD * 4 <= WS_END, "ws map 4");
constexpr int CW_TMO = 0, CW_CODE = 1, CW_BAR = 4096;
constexpr int RING_OFF = 0, RING_BYTES = 151552;
constexpr int LDSCTL_OFF = RING_BYTES, MISC_OFF = LDSCTL_OFF + 320;
constexpr int LDS_BYTES = 152576;
static_assert(MISC_OFF + 128 <= LDS_BYTES, "LDS map");

#define GAS __attribute__((address_space(1)))
#define LAS __attribute__((address_space(3)))
typedef unsigned short bf16;
typedef _Float16 f16;
typedef unsigned v4u __attribute__((ext_vector_type(4)));
typedef unsigned v2u __attribute__((ext_vector_type(2)));
typedef float f32x4 __attribute__((ext_vector_type(4)));
typedef float f32x2 __attribute__((ext_vector_type(2)));
typedef float f32x16 __attribute__((ext_vector_type(16)));
typedef short bf16x8 __attribute__((ext_vector_type(8)));
typedef short s16x4 __attribute__((ext_vector_type(4)));
typedef _Float16 f16x8 __attribute__((ext_vector_type(8)));
typedef GAS unsigned gu32;
#define RLX_AGENT __ATOMIC_RELAXED, __HIP_MEMORY_SCOPE_AGENT
#define LDS_WAIT() asm volatile("s_waitcnt lgkmcnt(0)" ::: "memory")
#define VM_WAIT() asm volatile("s_waitcnt vmcnt(0)" ::: "memory")
__device__ __forceinline__ unsigned f2bf(float f) { unsigned u = __builtin_bit_cast(unsigned, f); return (u + 0x7fffu + ((u >> 16) & 1u)) >> 16; }
__device__ __forceinline__ unsigned pk2(float lo, float hi) { return f2bf(lo) | (f2bf(hi) << 16); }
__device__ __forceinline__ float bf2f(unsigned short b) { return __builtin_bit_cast(float, (unsigned)b << 16); }
__device__ __forceinline__ float bflo(unsigned w) { return __builtin_bit_cast(float, w << 16); }
__device__ __forceinline__ float bfhi(unsigned w) { return __builtin_bit_cast(float, w & 0xffff0000u); }
__device__ __forceinline__ float wave_sum(float v) {
#pragma unroll
    for (int o = 1; o < 64; o <<= 1) v += __shfl_xor(v, o);
    return v;
}
__device__ __forceinline__ float wave_max(float v) {
#pragma unroll
    for (int o = 1; o < 64; o <<= 1) v = fmaxf(v, __shfl_xor(v, o));
    return v;
}
__device__ __forceinline__ int lane_fresh() { int l; asm volatile("v_mbcnt_lo_u32_b32 %0, -1, 0\n\tv_mbcnt_hi_u32_b32 %0, -1, %0" : "=v"(l)); return l; }
__device__ __forceinline__ int lane_dep(int dep) { int l; asm volatile("v_mbcnt_lo_u32_b32 %0, -1, 0\n\tv_mbcnt_hi_u32_b32 %0, -1, %0" : "=v"(l) : "s"(dep)); return l; }
template <int CTRL> __device__ __forceinline__ int dpp_mov(int v) { return __builtin_amdgcn_update_dpp(0, v, CTRL, 0xf, 0xf, true); }
#define WAVE_REDUCE_U32(v, OP) do { unsigned t_; \
    t_ = (unsigned)dpp_mov<0xB1>((int)(v)); (v) = OP((v), t_); t_ = (unsigned)dpp_mov<0x4E>((int)(v)); (v) = OP((v), t_); \
    t_ = (unsigned)dpp_mov<0x141>((int)(v)); (v) = OP((v), t_); t_ = (unsigned)dpp_mov<0x140>((int)(v)); (v) = OP((v), t_); \
    const unsigned a_ = (unsigned)__builtin_amdgcn_readlane((int)(v), 0), b_ = (unsigned)__builtin_amdgcn_readlane((int)(v), 16), c_ = (unsigned)__builtin_amdgcn_readlane((int)(v), 32), d_ = (unsigned)__builtin_amdgcn_readlane((int)(v), 48); \
    (v) = OP(OP(a_, b_), OP(c_, d_)); } while (0)
__device__ __forceinline__ unsigned umin_(unsigned a, unsigned b) { return a < b ? a : b; }
__device__ __forceinline__ unsigned umax_(unsigned a, unsigned b) { return a > b ? a : b; }
__device__ __forceinline__ unsigned wave_suffix_sum(unsigned v, int lane) {
    unsigned s = v;
    s += (unsigned)dpp_mov<0x101>((int)s); s += (unsigned)dpp_mov<0x102>((int)s); s += (unsigned)dpp_mov<0x104>((int)s); s += (unsigned)dpp_mov<0x108>((int)s);
    const unsigned t1 = (unsigned)__builtin_amdgcn_readlane((int)s, 16), t2 = (unsigned)__builtin_amdgcn_readlane((int)s, 32), t3 = (unsigned)__builtin_amdgcn_readlane((int)s, 48);
    const int row = lane >> 4;
    return s + (row == 0 ? t1 + t2 + t3 : row == 1 ? t2 + t3 : row == 2 ? t3 : 0u);
}
__device__ __forceinline__ float dpp_movf(float v, const int which) { const int i = __builtin_bit_cast(int, v); int r;
    switch (which) { case 0: r = dpp_mov<0xB1>(i); break; case 1: r = dpp_mov<0x4E>(i); break; case 2: r = dpp_mov<0x141>(i); break; default: r = dpp_mov<0x140>(i); break; }
    return __builtin_bit_cast(float, r); }
__device__ __forceinline__ float wave_sum_fast(float v) {
    v += dpp_movf(v, 0); v += dpp_movf(v, 1); v += dpp_movf(v, 2); v += dpp_movf(v, 3);
    const int i = __builtin_bit_cast(int, v);
    const float a = __builtin_bit_cast(float, __builtin_amdgcn_readlane(i, 0)), b = __builtin_bit_cast(float, __builtin_amdgcn_readlane(i, 16)), c = __builtin_bit_cast(float, __builtin_amdgcn_readlane(i, 32)), d = __builtin_bit_cast(float, __builtin_amdgcn_readlane(i, 48));
    return (a + b) + (c + d);
}
#define XB_TMO      128
#define XB_XCNT(j)  (256  + 64 * (j))
#define XB_XSUB(j)  (1280 + 64 * (j))
#define XB_XGEN(j)  (2304 + 64 * (j))
#define XB_TOP      3328
#define XB_TOPGEN   3392
#define XCD_BAR_WORDS 3456
#define XB_SPIN_CAP (1u << 18)

__device__ __forceinline__ unsigned xb_ld(unsigned* p)              { return __hip_atomic_load(p, __ATOMIC_RELAXED, __HIP_MEMORY_SCOPE_AGENT); }
__device__ __forceinline__ unsigned xb_add(unsigned* p, unsigned v) { return __hip_atomic_fetch_add(p, v, __ATOMIC_RELAXED, __HIP_MEMORY_SCOPE_AGENT); }
__device__ __forceinline__ unsigned xb_xcc_id() { return (unsigned)__builtin_amdgcn_s_getreg((3 << 11) | 20) & 0xFu; }
#define XB_SPIN(cond, bar) do { unsigned _sp = 0; while (cond) { __builtin_amdgcn_s_sleep(1); \
    if ((++_sp & 255u) == 0u) { if (xb_ld(&(bar)[XB_TMO])) break; if (_sp > XB_SPIN_CAP) { atomicAdd(&(bar)[XB_TMO], 1u); break; } } } } while (0)

struct XcdBarrier {
    int wave; unsigned* bar; unsigned x;
    volatile LAS unsigned* st;
};

__device__ __forceinline__ XcdBarrier xcd_barrier_post(unsigned* bar, volatile LAS unsigned* st, int wave) {
    XcdBarrier b; b.wave = wave; b.bar = bar; b.x = xb_xcc_id(); b.st = st;
    if (wave == 0 && lane_fresh() == 0) (void)xb_add(&bar[XB_XCNT(b.x)], 1u);
    return b;
}
__device__ __forceinline__ void xcd_barrier_complete(unsigned* bar, unsigned x, unsigned& nloc, unsigned& nx) {
    const unsigned G = gridDim.x * gridDim.y * gridDim.z;
    unsigned sum, cnt, mine, sp = 0u;
    for (;;) {
        sum = 0u; cnt = 0u; mine = 0u;
#pragma unroll
        for (unsigned j = 0; j < 16; ++j) { const unsigned c = xb_ld(&bar[XB_XCNT(j)]); sum += c; cnt += (c > 0u) ? 1u : 0u; mine = (j == x) ? c : mine; }
        if (sum == G) break;
        __builtin_amdgcn_s_sleep(1);
        if ((++sp & 255u) == 0u) { if (xb_ld(&bar[XB_TMO])) break; if (sp > XB_SPIN_CAP) { atomicAdd(&bar[XB_TMO], 1u); break; } }
    }
    nloc = mine > 0u ? mine : 1u; nx = cnt > 0u ? cnt : 1u;
}

__device__ __forceinline__ void xcd_barrier(const XcdBarrier& b) {
    asm volatile("s_waitcnt vmcnt(0)" ::: "memory");
    __syncthreads();
    if (b.wave == 0 && lane_fresh() == 0) {
        unsigned* bar = b.bar;
        __builtin_amdgcn_s_waitcnt(0);
        unsigned nloc = b.st[0], nx = b.st[1];
        if (nloc == 0u) { xcd_barrier_complete(bar, b.x, nloc, nx); b.st[0] = nloc; b.st[1] = nx; }
        const unsigned old = xb_add(&bar[XB_XSUB(b.x)], 1u);
        const unsigned gen = old / nloc;
        if (old + 1u == (gen + 1u) * nloc) {
            __builtin_amdgcn_fence(__ATOMIC_RELEASE, "agent");
            asm volatile("s_waitcnt vmcnt(0)" ::: "memory");
            const unsigned og = xb_add(&bar[XB_TOP], 1u);
            const unsigned tg = og / nx;
            if (og + 1u == (tg + 1u) * nx) xb_add(&bar[XB_TOPGEN], 1u);
            else XB_SPIN(xb_ld(&bar[XB_TOPGEN]) == tg, bar);
            __builtin_amdgcn_fence(__ATOMIC_ACQUIRE, "agent");
            xb_add(&bar[XB_XGEN(b.x)], 1u);
            asm volatile("s_waitcnt vmcnt(0)" ::: "memory");
        } else {
            XB_SPIN(xb_ld(&bar[XB_XGEN(b.x)]) == gen, bar);
            __builtin_amdgcn_fence(__ATOMIC_ACQUIRE, "agent");
            asm volatile("s_waitcnt vmcnt(0)" ::: "memory");
        }
    }
    __syncthreads();
}
struct Frame {
    LAS unsigned char* lds;
    volatile LAS unsigned* MISC;
    gu32* ctl;
    int wave, G, bx;
    float* out; unsigned char* ws;
};
struct Args { const float* in[26]; float* out; unsigned char* ws; int ph_lo, ph_hi; };
#define WSP(T, off) ((T*)(F.ws + (off)))

__device__ __forceinline__ void p0_transpose_item(const float* W, int K, int N, bf16* WT, int drow0, int k0, int n0, LAS float* scr, int lane) {
    const int n4 = (lane & 7) * 4; const bool ok = n0 + n4 < N;
    f32x4 t[8];
#pragma unroll
    for (int i = 0; i < 8; ++i) t[i] = ok ? *(const GAS f32x4*)(W + (size_t)(k0 + 8 * i + (lane >> 3)) * N + n0 + n4) : (f32x4){0.f, 0.f, 0.f, 0.f};
#pragma unroll
    for (int i = 0; i < 8; ++i) { LAS float* d = scr + (8 * i + (lane >> 3)) * 33 + n4; d[0] = t[i].x; d[1] = t[i].y; d[2] = t[i].z; d[3] = t[i].w; }
    LDS_WAIT(); asm volatile("" ::: "memory");
    const int c = lane & 7;
#pragma unroll
    for (int j = 0; j < 4; ++j) { const int n = (lane >> 3) + 8 * j; const LAS float* s = scr + (8 * c) * 33 + n;
        v4u o; o.x = pk2(s[0 * 33], s[1 * 33]); o.y = pk2(s[2 * 33], s[3 * 33]); o.z = pk2(s[4 * 33], s[5 * 33]); o.w = pk2(s[6 * 33], s[7 * 33]);
        *(GAS v4u*)(WT + (size_t)(drow0 + n) * K + k0 + 8 * c) = o; }
    LDS_WAIT(); asm volatile("" ::: "memory");
}
__device__ __forceinline__ void p0_convert_items(Frame& F, const Args& A, int first, int last, int wi, int nw) {
    const int lane = lane_fresh();
    LAS float* scr = (LAS float*)(F.lds + RING_OFF + F.wave * 16384);
    constexpr int I_GU = (D / 64) * (FF / 32), I_D = (FF / 64) * (D / 32), I_IN = (D / 64) * (INWP / 32);
    for (int it = first + wi * NWAVES + F.wave; it < last; it += nw * NWAVES) {
        int r = it;
        if (r < 4 * I_GU) {
            const int which = r / I_GU; r -= which * I_GU; const int nblk = FF / 32, kb = r / nblk, nb = r % nblk, n0 = 32 * nb;
            const float* W = which == 0 ? A.in[8] : which == 1 ? A.in[9] : which == 2 ? A.in[21] : A.in[22];
            bf16* WT = WSP(bf16, (which < 2) ? WS_WGU1 : WS_WGU2);
            const int drow0 = 256 * (n0 >> 7) + (n0 & 127) + ((which & 1) ? 128 : 0);
            p0_transpose_item(W, D, FF, WT, drow0, 64 * kb, n0, scr, lane); continue; }
        r -= 4 * I_GU;
        if (r < 2 * I_D) { const int which = r / I_D; r -= which * I_D; const int nblk = D / 32, kb = r / nblk, nb = r % nblk;
            p0_transpose_item(which ? A.in[23] : A.in[10], FF, D, WSP(bf16, which ? WS_WD2 : WS_WD1), 32 * nb, 64 * kb, 32 * nb, scr, lane); continue; }
        r -= 2 * I_D;
        if (r < I_IN) { const int nblk = INWP / 32, kb = r / nblk, nb = r % nblk;
            p0_transpose_item(A.in[13], D, INW, WSP(bf16, WS_WIN), 32 * nb, 64 * kb, 32 * nb, scr, lane); continue; }
        r -= I_IN;
        { const int nblk = D / 32, kb = r / nblk, nb = r % nblk; p0_transpose_item(A.in[18], D, D, WSP(bf16, WS_WO), 32 * nb, 64 * kb, 32 * nb, scr, lane); }
    }
}
constexpr int P0_I_GU = (D / 64) * (FF / 32), P0_NITEMS = 4 * P0_I_GU + 2 * (FF / 64) * (D / 32) + (D / 64) * (INWP / 32) + (D / 64) * (D / 32);
__device__ __forceinline__ void p0_prologue(Frame& F, const Args& A) {
    const int lane = lane_fresh();
    const int gw = F.bx * NWAVES + F.wave, NGW = F.G * NWAVES;
    p0_convert_items(F, A, 0, P0_NITEMS, F.bx, F.G);
    bf16* XB = WSP(bf16, WS_XB);
    for (int m0 = gw; m0 < M; m0 += 4 * NGW) {
        f32x4 v[4][4];
#pragma unroll
        for (int k = 0; k < 4; ++k) { const int m = m0 + k * NGW, mm = m < M ? m : m0;
            const float* xr = (mm < MP) ? A.in[0] + (size_t)mm * D : A.in[1] + (size_t)(mm - MP) * D; const GAS f32x4* x4 = (const GAS f32x4*)xr + lane;
#pragma unroll
            for (int j = 0; j < 4; ++j) v[k][j] = x4[64 * j]; }
#pragma unroll
        for (int k = 0; k < 4; ++k) { const int m = m0 + k * NGW;
            if (m < M) { GAS unsigned long long* o8 = (GAS unsigned long long*)(XB + (size_t)m * D) + lane;
#pragma unroll
                for (int j = 0; j < 4; ++j) o8[64 * j] = (unsigned long long)pk2(v[k][j].x, v[k][j].y) | ((unsigned long long)pk2(v[k][j].z, v[k][j].w) << 32); } }
    }
    float* rope = WSP(float, WS_ROPE);
    for (int i = gw * 64 + lane; i < (SEQ + DECT) * 8; i += NGW * 64) {
        const int pi = i >> 3, f = i & 7; const float pos = (float)(pi < SEQ ? pi : PAST + pi - SEQ);
        const float invf = powf(500000.0f, -(float)f / 8.0f); const float ang = pos * invf;
        rope[pi * 16 + f] = cosf(ang); rope[pi * 16 + 8 + f] = sinf(ang);
    }
}
__device__ __forceinline__ void ln_phase(Frame& F, const bf16* RB, const float* g, const float* b, float* dstf, bf16* dstb, const float* part, int nsplit, const float* resf, const bf16* resb, float pscale) {
    const int lane = lane_fresh();
    const int gw = F.bx * NWAVES + F.wave, NGW = F.G * NWAVES;
    f32x4 gv[4], bv[4];
#pragma unroll
    for (int j = 0; j < 2; ++j) { gv[2 * j] = *(const GAS f32x4*)(g + 512 * j + 8 * lane); gv[2 * j + 1] = *(const GAS f32x4*)(g + 512 * j + 8 * lane + 4); bv[2 * j] = *(const GAS f32x4*)(b + 512 * j + 8 * lane); bv[2 * j + 1] = *(const GAS f32x4*)(b + 512 * j + 8 * lane + 4); }
#define LN_UNPK(W, A0, A1) do { A0 = (f32x4){bflo(W.x), bfhi(W.x), bflo(W.y), bfhi(W.y)}; A1 = (f32x4){bflo(W.z), bfhi(W.z), bflo(W.w), bfhi(W.w)}; } while (0)
#define LN_FINISH(v, m) do { float s = 0.f; \
        _Pragma("unroll") for (int j = 0; j < 4; ++j) s += (v[j].x + v[j].y) + (v[j].z + v[j].w); \
        const float mean = wave_sum_fast(s) * (1.f / D); float s2 = 0.f; \
        _Pragma("unroll") for (int j = 0; j < 4; ++j) { v[j] = v[j] - mean; s2 += (v[j].x * v[j].x + v[j].y * v[j].y) + (v[j].z * v[j].z + v[j].w * v[j].w); } \
        const float rstd = 1.f / sqrtf(wave_sum_fast(s2) * (1.f / D) + LN_EPS); \
        _Pragma("unroll") for (int j = 0; j < 4; ++j) { v[j] = v[j] * rstd * gv[j] + bv[j]; } \
        if (dstf) { _Pragma("unroll") for (int j = 0; j < 2; ++j) { *(GAS f32x4*)(dstf + (size_t)(m) * D + 512 * j + 8 * lane) = v[2 * j]; *(GAS f32x4*)(dstf + (size_t)(m) * D + 512 * j + 8 * lane + 4) = v[2 * j + 1]; } } \
        if (dstb) { _Pragma("unroll") for (int j = 0; j < 2; ++j) { v4u w; w.x = pk2(v[2 * j].x, v[2 * j].y); w.y = pk2(v[2 * j].z, v[2 * j].w); w.z = pk2(v[2 * j + 1].x, v[2 * j + 1].y); w.w = pk2(v[2 * j + 1].z, v[2 * j + 1].w); \
                *(GAS v4u*)(dstb + (size_t)(m) * D + 512 * j + 8 * lane) = w; } } } while (0)
    for (int m0 = gw; m0 < MP; m0 += 4 * NGW) {
        v4u raw[4][2];
#pragma unroll
        for (int k = 0; k < 4; ++k) { const int m = m0 + k * NGW; const int mm = m < MP ? m : m0;
#pragma unroll
            for (int j = 0; j < 2; ++j) raw[k][j] = *(const GAS v4u*)(RB + (size_t)mm * D + 512 * j + 8 * lane); }
#pragma unroll
        for (int k = 0; k < 4; ++k) { const int m = m0 + k * NGW;
            if (m < MP) { f32x4 v[4];
#pragma unroll
                for (int j = 0; j < 2; ++j) LN_UNPK(raw[k][j], v[2 * j], v[2 * j + 1]);
                LN_FINISH(v, m); } }
    }
    for (int m = MP + gw; m < M; m += NGW) {
        f32x4 v[4];
        {
            const int ms = m - MP;
#pragma unroll
            for (int j = 0; j < 4; ++j) v[j] = (f32x4){0.f, 0.f, 0.f, 0.f};
#pragma unroll 1
            for (int k = 0; k < nsplit; ++k) { const float* pp = part + ((size_t)k * MS + ms) * D + 8 * lane;
#pragma unroll
                for (int j = 0; j < 2; ++j) { v[2 * j] = v[2 * j] + *(const GAS f32x4*)(pp + 512 * j); v[2 * j + 1] = v[2 * j + 1] + *(const GAS f32x4*)(pp + 512 * j + 4); } }
#pragma unroll
            for (int j = 0; j < 2; ++j) { f32x4 r0, r1;
                if (resf) { r0 = *(const GAS f32x4*)(resf + (size_t)ms * D + 512 * j + 8 * lane); r1 = *(const GAS f32x4*)(resf + (size_t)ms * D + 512 * j + 8 * lane + 4); }
                else { const v4u w = *(const GAS v4u*)(resb + (size_t)m * D + 512 * j + 8 * lane); LN_UNPK(w, r0, r1); }
                v[2 * j] = r0 * ALPHA + v[2 * j] * pscale; v[2 * j + 1] = r1 * ALPHA + v[2 * j + 1] * pscale; }
        }
        LN_FINISH(v, m);
    }
#undef LN_FINISH
#undef LN_UNPK
}
__device__ __forceinline__ void post_phase(Frame& F, const Args& A) {
    const int lane = lane_fresh();
    const int gw = F.bx * NWAVES + F.wave, NGW = F.G * NWAVES;
    const bf16* P = WSP(bf16, WS_P); const float* rope = WSP(float, WS_ROPE);
    bf16* Qb = WSP(bf16, WS_QB); f16* QIh = WSP(f16, WS_QI); bf16* Kb = WSP(bf16, WS_KB); f16* KIh = WSP(f16, WS_KI); float* WI = WSP(float, WS_WI); float* BG = WSP(float, WS_BG);
    const f32x4 alog = *(const GAS f32x4*)A.in[15], dtb4 = *(const GAS f32x4*)A.in[16];
    const float a_exp[4] = {expf(alog.x), expf(alog.y), expf(alog.z), expf(alog.w)}; const float dtb[4] = {dtb4.x, dtb4.y, dtb4.z, dtb4.w};
    const int j8 = lane & 7; const bool rot = j8 < 2; const float sgn = (j8 == 0) ? -1.f : 1.f;
    for (int m = gw; m < M; m += NGW) {
        const bool prm = m < MP; const int ms = m - MP; const int b = prm ? (m >> 11) : (ms >> 3), t = prm ? (m & 2047) : (ms & 7), pi = prm ? t : SEQ + t;
        const bf16* p = P + (size_t)m * INWP;
        const int c3 = lane < 32 ? C_K + 8 * lane : (lane < 41 ? C_KI + 8 * (lane - 32) : C_BG);
        const v4u rq = *(const GAS v4u*)(p + C_Q + 8 * lane), ri = *(const GAS v4u*)(p + C_QI + 8 * lane);
        v4u r3 = (v4u){0u, 0u, 0u, 0u}; if (lane < 42) r3 = *(const GAS v4u*)(p + c3);
        const f32x4 c0 = *(const GAS f32x4*)(rope + pi * 16), c1 = *(const GAS f32x4*)(rope + pi * 16 + 4), s0 = *(const GAS f32x4*)(rope + pi * 16 + 8), s1 = *(const GAS f32x4*)(rope + pi * 16 + 12);
        const float cs[8] = {c0.x, c0.y, c0.z, c0.w, c1.x, c1.y, c1.z, c1.w}; const float sn[8] = {s0.x, s0.y, s0.z, s0.w, s1.x, s1.y, s1.z, s1.w};
        float xq[8], xi[8], x3[8];
#pragma unroll
        for (int e = 0; e < 4; ++e) { xq[2 * e] = bflo(rq[e]); xq[2 * e + 1] = bfhi(rq[e]); xi[2 * e] = bflo(ri[e]); xi[2 * e + 1] = bfhi(ri[e]); x3[2 * e] = bflo(r3[e]); x3[2 * e + 1] = bfhi(r3[e]); }
        const bool rot3 = rot && (lane < 16 || (lane >= 32 && lane < 40));
#pragma unroll
        for (int e = 0; e < 8; ++e) { const float pq = __shfl_xor(xq[e], 1), pi_ = __shfl_xor(xi[e], 1), p3 = __shfl_xor(x3[e], 1);
            if (rot) { xq[e] = xq[e] * cs[e] + sgn * pq * sn[e]; xi[e] = xi[e] * cs[e] + sgn * pi_ * sn[e]; }
            if (rot3) x3[e] = x3[e] * cs[e] + sgn * p3 * sn[e]; }
        { v4u w; const float qs = 0.125f * 1.4426950408889634f;
#pragma unroll
          for (int e = 0; e < 4; ++e) w[e] = pk2(xq[2 * e] * qs, xq[2 * e + 1] * qs);
          *(GAS v4u*)(Qb + (size_t)m * 512 + 8 * lane) = w;
          f16x8 h;
#pragma unroll
          for (int e = 0; e < 8; ++e) h[e] = (f16)xi[e];
          *(GAS f16x8*)(QIh + (size_t)m * 512 + 8 * lane) = h; }
        if (lane < 32) {
            float* o = F.out + (lane < 16 ? (prm ? O_KP + (size_t)m * 128 : O_KS + (size_t)ms * 128) + 8 * lane : (prm ? O_VP + (size_t)m * 128 : O_VS + (size_t)ms * 128) + 8 * (lane - 16));
            *(GAS f32x4*)o = (f32x4){x3[0], x3[1], x3[2], x3[3]}; *(GAS f32x4*)(o + 4) = (f32x4){x3[4], x3[5], x3[6], x3[7]};
            if (lane < 16) { v4u w;
#pragma unroll
                for (int e = 0; e < 4; ++e) w[e] = pk2(x3[2 * e], x3[2 * e + 1]);
                *(GAS v4u*)(Kb + (size_t)m * 128 + 8 * lane) = w; }
        } else if (lane < 40) {
            float* o = F.out + (prm ? O_IP + (size_t)m * 64 : O_IS + (size_t)ms * 64) + 8 * (lane - 32);
            *(GAS f32x4*)o = (f32x4){x3[0], x3[1], x3[2], x3[3]}; *(GAS f32x4*)(o + 4) = (f32x4){x3[4], x3[5], x3[6], x3[7]};
            f16x8 h;
#pragma unroll
            for (int e = 0; e < 8; ++e) h[e] = (f16)x3[e];
            *(GAS f16x8*)(KIh + (size_t)m * 64 + 8 * (lane - 32)) = h;
        } else if (lane == 40) {
            const float ws = 0.35355339059327373f * 0.125f;
            *(GAS f32x4*)(WI + (size_t)m * 8) = (f32x4){x3[0] * ws, x3[1] * ws, x3[2] * ws, x3[3] * ws}; *(GAS f32x4*)(WI + (size_t)m * 8 + 4) = (f32x4){x3[4] * ws, x3[5] * ws, x3[6] * ws, x3[7] * ws};
        } else if (lane == 41) {
            float be[4], gg[4];
#pragma unroll
            for (int e = 0; e < 4; ++e) { be[e] = 1.f / (1.f + expf(-x3[e])); const float ag = x3[4 + e] + dtb[e]; gg[e] = -a_exp[e] * (ag > 20.f ? ag : log1pf(expf(ag))); }
            *(GAS f32x4*)(BG + (size_t)m * 8) = (f32x4){be[0], be[1], be[2], be[3]}; *(GAS f32x4*)(BG + (size_t)m * 8 + 4) = (f32x4){gg[0], gg[1], gg[2], gg[3]};
        }
        const int trow = prm ? t - (SEQ - 3) : t - (DECT - 3);
        if (trow >= 0) { float* co = F.out + (prm ? O_CP : O_CS) + ((size_t)b * 3 + trow) * CONVC;
#pragma unroll
            for (int k = 0; k < 3; ++k) { const v4u rc = *(const GAS v4u*)(p + C_QKV + 512 * k + 8 * lane);
                *(GAS f32x4*)(co + 512 * k + 8 * lane) = (f32x4){bflo(rc[0]), bfhi(rc[0]), bflo(rc[1]), bfhi(rc[1])}; *(GAS f32x4*)(co + 512 * k + 8 * lane + 4) = (f32x4){bflo(rc[2]), bfhi(rc[2]), bflo(rc[3]), bfhi(rc[3])}; } }
    }
    LAS bf16* tile = (LAS bf16*)(F.lds + RING_OFF + F.wave * 16384);
    bf16* VT = WSP(bf16, WS_VT);
    for (int it = gw; it < BATCH * 2 * (SEQ / 64); it += NGW) {
        const int tb = it % (SEQ / 64), g = (it / (SEQ / 64)) & 1, b = it / (2 * (SEQ / 64));
        for (int tt = 0; tt < 64; ++tt) tile[tt * 66 + lane] = P[(size_t)(b * SEQ + tb * 64 + tt) * INWP + C_V + g * 64 + lane];
        LDS_WAIT(); asm volatile("" ::: "memory");
        { const int kk = lane & 31, pos = ((kk >> 2) & 1) * 16 + ((kk >> 4) * 2 + ((kk >> 3) & 1)) * 4 + (kk & 3); bf16* vt = VT + (((size_t)(b * 2 + g) * (SEQ / 32) + 2 * tb + (lane >> 5)) * 64) * 32 + pos;
          for (int d = 0; d < 64; ++d) vt[d * 32] = tile[lane * 66 + d]; }
        LDS_WAIT(); asm volatile("" ::: "memory");
    }
}
#define MFMA32 __builtin_amdgcn_mfma_f32_32x32x16_bf16
__device__ __forceinline__ int crow(int r, int hh) { return (r & 3) + 8 * (r >> 2) + 4 * hh; }
__device__ __forceinline__ f32x16 zero16() { f32x16 z; for (int i = 0; i < 16; ++i) z[i] = 0.f; return z; }
constexpr int GT_LD = 272;
constexpr int GP_HALF = 72704;
constexpr int GP_Q = 0, GP_K = 17408, GP_V = 34816, GP_A = 52224, GP_G = 69632, GP_B = 69888, GP_EG = 70144;
__device__ __forceinline__ void gdn_prep_phase(Frame& F, const Args& A) {
    const int half = F.wave >> 2, hw = F.wave & 3;
    LAS unsigned char* L = F.lds + RING_OFF + half * GP_HALF;
    const bf16* P = WSP(bf16, WS_P); const float* BG = WSP(float, WS_BG); const float* cw = A.in[14];
    const float* sconv = A.in[6];
    const int nit = (GDN_UNITS + 2 * F.G - 1) / (2 * F.G);
    for (int it = 0; it < nit; ++it) {
        const int lane = lane_fresh();
        const int ht = (hw << 6) | lane;
        const int u = (it * F.G + F.bx) * 2 + half; const bool live = u < GDN_UNITS;
        const bool smp = u >= 2048; const int us = u - 2048;
        const int c = smp ? 0 : (u & 31), h = smp ? (us & 3) : ((u >> 5) & 3), b = smp ? (us >> 2) : (u >> 7);
        const size_t mrow0 = smp ? (size_t)MP + (size_t)b * DECT : (size_t)b * SEQ;
        const int nreal = smp ? DECT : 64;
        unsigned char* gs = F.ws + WS_GSC + (size_t)u * GSC_UNIT;
        if (live) {
            LAS float* wl = (LAS float*)(L + GP_A);
#pragma unroll
            for (int k = 0; k < 6; ++k) { const int idx = ht + 256 * k, p = idx >> 9, j = (idx >> 7) & 3, ch = idx & 127; wl[idx] = cw[j * CONVC + p * 512 + h * 128 + ch]; }
        }
        LDS_WAIT(); __syncthreads();
        if (live) {
            const LAS float* wl = (const LAS float*)(L + GP_A);
            const int ti = lane >> 2, qq = lane & 3, row = hw * 16 + ti, tt = c * 64 + row; const bool real = row < nreal;
#pragma unroll 1
            for (int p = 0; p < 3; ++p) {
                float y[32];
#pragma unroll
                for (int ch4 = 0; ch4 < 4; ++ch4) { const int col = p * 512 + h * 128 + 32 * qq + 8 * ch4;
                    float a[8];
#pragma unroll
                    for (int e = 0; e < 8; ++e) a[e] = 0.f;
#pragma unroll
                    for (int j = 0; j < 4; ++j) { const int rr = tt - 3 + j; float x[8];
                        if (rr >= 0 && (!smp || rr < nreal)) { const v4u xv = *(const GAS v4u*)(P + (mrow0 + rr) * INWP + C_QKV + col);
#pragma unroll
                            for (int e = 0; e < 4; ++e) { x[2 * e] = bflo(xv[e]); x[2 * e + 1] = bfhi(xv[e]); } }
                        else if (smp && rr < 0) { const f32x4 s0 = *(const GAS f32x4*)(sconv + ((size_t)b * 3 + (3 + rr)) * CONVC + col), s1 = *(const GAS f32x4*)(sconv + ((size_t)b * 3 + (3 + rr)) * CONVC + col + 4);
                            x[0] = s0.x; x[1] = s0.y; x[2] = s0.z; x[3] = s0.w; x[4] = s1.x; x[5] = s1.y; x[6] = s1.z; x[7] = s1.w; }
                        else {
#pragma unroll
                            for (int e = 0; e < 8; ++e) x[e] = 0.f; }
                        const f32x4 w0 = *(const LAS f32x4*)(wl + (p * 4 + j) * 128 + 32 * qq + 8 * ch4), w1 = *(const LAS f32x4*)(wl + (p * 4 + j) * 128 + 32 * qq + 8 * ch4 + 4);
                        a[0] += w0.x * x[0]; a[1] += w0.y * x[1]; a[2] += w0.z * x[2]; a[3] += w0.w * x[3]; a[4] += w1.x * x[4]; a[5] += w1.y * x[5]; a[6] += w1.z * x[6]; a[7] += w1.w * x[7]; }
#pragma unroll
                    for (int e = 0; e < 8; ++e) { y[8 * ch4 + e] = a[e] / (1.f + __expf(-a[e])); asm volatile("" : "+v"(y[8 * ch4 + e])); }
                    asm volatile("" ::: "memory"); __builtin_amdgcn_sched_barrier(0); }
                if (p < 2) { float ss = 0.f;
#pragma unroll
                    for (int e = 0; e < 32; ++e) ss += y[e] * y[e];
                    ss += __shfl_xor(ss, 1); ss += __shfl_xor(ss, 2);
                    const float rn = 1.f / sqrtf(ss + NORM_EPS);
#pragma unroll
                    for (int e = 0; e < 32; ++e) y[e] *= rn; }
#pragma unroll
                for (int k = 0; k < 4; ++k) { v4u w4;
#pragma unroll
                    for (int e = 0; e < 4; ++e) w4[e] = real ? pk2(y[8 * k + 2 * e], y[8 * k + 2 * e + 1]) : 0u;
                    *(LAS v4u*)(L + p * 17408 + row * GT_LD + 64 * qq + 16 * k) = w4; }
            }
            if (hw == 0) { const size_t m = mrow0 + c * 64 + lane; const bool rl = lane < nreal; float g = rl ? BG[m * 8 + 4 + h] : 0.f; const float be = rl ? BG[m * 8 + h] : 0.f;
#pragma unroll
                for (int o = 1; o < 64; o <<= 1) { const float t = __shfl_up(g, o); if (lane >= o) g += t; }
                ((LAS float*)(L + GP_G))[lane] = g; ((LAS float*)(L + GP_B))[lane] = be;
                const float g63 = __shfl(g, 63); ((LAS float*)(L + GP_EG))[lane] = __expf(g); ((LAS float*)(L + GP_EG))[64 + lane] = __expf(g63 - g); }
        }
        LDS_WAIT(); __syncthreads();
        if (live) {
            const LAS float* Gs = (const LAS float*)(L + GP_G); const LAS float* Bs = (const LAS float*)(L + GP_B);
            bf16* QKg = (bf16*)(gs + 65536);
            const int r = lane & 31, hh = lane >> 5;
            if (hw < 3) {
                const int ti = hw > 0 ? 1 : 0, tj = hw > 1 ? 1 : 0;
                f32x16 akk = zero16(), aqk = zero16();
#pragma unroll
                for (int s = 0; s < 8; ++s) {
                    const bf16x8 bk = *(const LAS bf16x8*)(L + GP_K + (32 * tj + r) * GT_LD + (16 * s + 8 * hh) * 2);
                    const bf16x8 ak = *(const LAS bf16x8*)(L + GP_K + (32 * ti + r) * GT_LD + (16 * s + 8 * hh) * 2);
                    const bf16x8 aq = *(const LAS bf16x8*)(L + GP_Q + (32 * ti + r) * GT_LD + (16 * s + 8 * hh) * 2);
                    akk = MFMA32(ak, bk, akk, 0, 0, 0); aqk = MFMA32(aq, bk, aqk, 0, 0, 0);
                }
                const int j = 32 * tj + r; const float Gj = Gs[j];
#pragma unroll
                for (int q = 0; q < 16; ++q) { const int i = 32 * ti + crow(q, hh); const float dec = __expf(Gs[i] - Gj);
                    ((LAS float*)(L + GP_A))[i * 68 + j] = (i > j) ? Bs[i] * akk[q] * dec : 0.f;
                    QKg[(((i >> 5) * 4 + (j >> 4)) * 64 + ((j >> 3) & 1) * 32 + (i & 31)) * 8 + (j & 7)] = (bf16)f2bf((i >= j) ? aqk[q] * dec * 0.08838834764831845f : 0.f); }
            } else {
#pragma unroll
                for (int q = 0; q < 16; ++q) { const int i = crow(q, hh), j = 32 + r; QKg[(((i >> 5) * 4 + (j >> 4)) * 64 + ((j >> 3) & 1) * 32 + (i & 31)) * 8 + (j & 7)] = 0; }
            }
        }
        LDS_WAIT(); __syncthreads();
        if (live) {
            const LAS float* Gs = (const LAS float*)(L + GP_G); const LAS float* Bs = (const LAS float*)(L + GP_B); const LAS float* As = (const LAS float*)(L + GP_A);
            const bool isu = ht < 128; const int cc = ht & 127; const LAS float* EGs = (const LAS float*)(L + GP_EG);
            const LAS unsigned char* src = L + (isu ? GP_V : GP_K) + cc * 2;
            float X[64];
#pragma unroll 1
            for (int rep_s4 = 0; rep_s4 < (MK_X == 5 ? 2 : 1); ++rep_s4) {
#pragma unroll
            for (int i = 0; i < 64; ++i) X[i] = 0.f;
#pragma unroll
            for (int i = 0; i < 64; ++i) {
                float acc = bf2f(*(const LAS bf16*)(src + i * GT_LD)) * Bs[i] * (isu ? 1.f : EGs[i]);
                float a1_ = 0.f, a2_ = 0.f, a3_ = 0.f;
#pragma unroll
                for (int j4 = 0; j4 < (i + 3) / 4; ++j4) { const f32x4 a = *(const LAS f32x4*)(As + i * 68 + 4 * j4);
                    acc -= a.x * X[4 * j4]; a1_ -= a.y * X[4 * j4 + 1]; a2_ -= a.z * X[4 * j4 + 2]; a3_ -= a.w * X[4 * j4 + 3]; }
                acc = (acc + a1_) + (a2_ + a3_);
                X[i] = acc; asm volatile("" : "+v"(X[i]) :: "memory"); __builtin_amdgcn_sched_barrier(0);
            }
            }
            if (isu) {
#pragma unroll
                for (int q = 0; q < 16; ++q) { const int rt_ = q >> 3, g_ = (q >> 1) & 3, hh_ = q & 1, i0 = 32 * rt_ + 8 * g_ + 4 * hh_;
                    v2u w2; w2.x = pk2(X[i0], X[i0 + 1]); w2.y = pk2(X[i0 + 2], X[i0 + 3]);
                    *(GAS v2u*)(gs + (size_t)((((cc >> 5) * 2 + rt_) * 4 + g_) * 64 + hh_ * 32 + (cc & 31)) * 8) = w2; }
            } else {
                bf16* wg = (bf16*)(gs + 16384) + (size_t)(((cc >> 4) * 64 + ((cc >> 3) & 1) * 32) * 8 + (cc & 7));
#pragma unroll
                for (int i = 0; i < 64; ++i) wg[(size_t)(((i >> 5) * 8) * 64 + (i & 31)) * 8] = (bf16)f2bf(X[i]); }
            { bf16* qt = (bf16*)(gs + 32768);
#pragma unroll
              for (int e = 0; e < 16; ++e) { const int idx = e * 256 + ht, i = idx >> 6, cp = idx & 63, dk = 2 * cp; const unsigned qv = *(const LAS unsigned*)(L + GP_Q + i * GT_LD + 4 * cp); const float sc = EGs[i] * 0.08838834764831845f;
                  *(GAS unsigned*)(qt + (size_t)((((i >> 5) * 8 + (dk >> 4)) * 64 + ((dk >> 3) & 1) * 32 + (i & 31)) * 8 + (dk & 7))) = pk2(bflo(qv) * sc, bfhi(qv) * sc); } }
            if (!isu) {
#pragma unroll
                for (int q = 0; q < 8; ++q) { float kv[8];
#pragma unroll
                    for (int e = 0; e < 8; ++e) { const int i = 8 * q + e; kv[e] = bf2f(*(const LAS bf16*)(L + GP_K + i * GT_LD + cc * 2)) * EGs[64 + i]; }
                    v4u w4; w4.x = pk2(kv[0], kv[1]); w4.y = pk2(kv[2], kv[3]); w4.z = pk2(kv[4], kv[5]); w4.w = pk2(kv[6], kv[7]);
                    *(GAS v4u*)(gs + 49152 + (size_t)((((cc >> 5) * 4 + (q >> 1)) * 64 + (q & 1) * 32 + (cc & 31)) * 16)) = w4; } }
            if (ht == 0) WSP(float, WS_GL)[u] = EGs[63];
        }
        LDS_WAIT(); __syncthreads();
    }
}
constexpr int GS_SB = 0, GS_SB_LD = 272, GS_VN = 8704, GS_VN_LD = 144;
__device__ __forceinline__ void gdn_scan_phase(Frame& F, const Args& A) {
    const int wave = F.wave;
    LAS unsigned char* L = F.lds + RING_OFF;
    float* OG = WSP(float, WS_OG); const float* GL = WSP(float, WS_GL);
    for (int uu0 = F.bx; uu0 < (BATCH * GH * 4 + DECB * GH * 4) * (MK_X == 3 || MK_X == 4 ? 2 : 1); uu0 += F.G) {
        int uu = uu0; if (MK_X == 3 && uu0 >= BATCH * GH * 4 + DECB * GH * 4) { uu = uu0 - (BATCH * GH * 4 + DECB * GH * 4); if (uu >= BATCH * GH * 4) continue; }
        if (MK_X == 4 && uu0 >= BATCH * GH * 4 + DECB * GH * 4) { uu = uu0 - (BATCH * GH * 4 + DECB * GH * 4); if (uu < BATCH * GH * 4) continue; }
        const int lane = lane_fresh(); const int r = lane & 31, hh = lane >> 5;
        const bool smp = uu >= BATCH * GH * 4; const int u0_ = smp ? uu - BATCH * GH * 4 : uu;
        const int nseq_ = smp ? DECB * GH : BATCH * GH;
        const int x_ = u0_ & 7, i_ = u0_ >> 3, sl = i_ & 3, seq_ = x_ * (nseq_ >> 3) + (i_ >> 2);
        const int h = seq_ & 3, b = seq_ >> 2, dv0 = sl * 32;
        const int role = wave < 2 ? 0 : (wave < 4 ? 1 : 2), rt = wave < 2 ? wave : (wave < 4 ? wave - 2 : wave - 4);
        const int nch = smp ? 1 : NCHUNK, un0 = smp ? 2048 + b * GH + h : (b * GH + h) * NCHUNK;
        const size_t mrow0 = smp ? (size_t)MP + (size_t)b * DECT : (size_t)b * SEQ;
        f32x16 Sacc = zero16();
        __syncthreads();
        if (!smp) { for (int i = wave * 64 + lane; i < (GS_VN + 32 * GS_VN_LD) / 4; i += NTHR) ((LAS unsigned*)L)[i] = 0u; }
        else if (role == 2) {
            const GAS float* sp = (const GAS float*)(A.in[5] + ((size_t)(b * GH + h) * GDK + 32 * rt) * GDV + dv0 + r);
#pragma unroll
            for (int q = 0; q < 16; ++q) Sacc[q] = sp[(size_t)crow(q, hh) * GDV];
#pragma unroll
            for (int g = 0; g < 4; ++g) { v2u w2; w2.x = pk2(Sacc[4 * g], Sacc[4 * g + 1]); w2.y = pk2(Sacc[4 * g + 2], Sacc[4 * g + 3]); *(LAS v2u*)(L + GS_SB + r * GS_SB_LD + (32 * rt + 8 * g + 4 * hh) * 2) = w2; }
        }
        LDS_WAIT(); __syncthreads();
        const size_t offA = (role == 2) ? (size_t)lane * 16 : (role == 1 ? 32768 : 16384) + (size_t)((rt * 8) * 64 + lane) * 16;
        const size_t strA = (role == 2) ? 0 : 1024;
        const size_t offB = (role == 0) ? (size_t)lane * 16 : (role == 2 ? 49152 : 65536) + (size_t)((rt * 4) * 64 + lane) * 16;
        const size_t strB = (role == 0) ? 0 : 1024;
        const size_t offU = (role == 0) ? (size_t)(((sl * 2 + rt) * 4) * 64 + lane) * 8 : (size_t)lane * 8;
        const size_t strU = (role == 0) ? 512 : 0;
#define GS_LOAD(FA, UV, FB, GLV, cc) do { const int un_ = un0 + (cc); const unsigned char* gs = F.ws + WS_GSC + (size_t)un_ * GSC_UNIT; \
            _Pragma("unroll") for (int s = 0; s < 8; ++s) FA[s] = *(const GAS bf16x8*)(gs + offA + (size_t)s * strA); \
            _Pragma("unroll") for (int s = 0; s < 4; ++s) FB[s] = *(const GAS bf16x8*)(gs + offB + (size_t)s * strB); \
            _Pragma("unroll") for (int g = 0; g < 4; ++g) UV[g] = *(const GAS s16x4*)(gs + offU + (size_t)g * strU); \
            GLV = GL[un_]; } while (0)
#define GS_STEP(FA, UV, FB, GLV, cc) do { asm volatile("; SCAN_STEP_BEGIN"); \
            f32x16 acc = zero16(); \
            if (role < 2) { \
                _Pragma("unroll") for (int s = 0; s < 8; ++s) { const bf16x8 sb = *(const LAS bf16x8*)(L + GS_SB + r * GS_SB_LD + (16 * s + 8 * hh) * 2); acc = MFMA32(FA[s], sb, acc, 0, 0, 0); } } \
            if (role == 0) { \
                _Pragma("unroll") for (int g = 0; g < 4; ++g) { const float v0 = bf2f((unsigned short)UV[g][0]) - acc[4 * g], v1 = bf2f((unsigned short)UV[g][1]) - acc[4 * g + 1], v2 = bf2f((unsigned short)UV[g][2]) - acc[4 * g + 2], v3 = bf2f((unsigned short)UV[g][3]) - acc[4 * g + 3]; \
                    v2u w2; w2.x = pk2(v0, v1); w2.y = pk2(v2, v3); *(LAS v2u*)(L + GS_VN + r * GS_VN_LD + (32 * rt + 8 * g + 4 * hh) * 2) = w2; } } \
            LDS_WAIT(); __builtin_amdgcn_s_barrier(); asm volatile("" ::: "memory"); \
            if (role == 1) { \
                _Pragma("unroll") for (int s = 0; s < 4; ++s) { const bf16x8 vn = *(const LAS bf16x8*)(L + GS_VN + r * GS_VN_LD + (16 * s + 8 * hh) * 2); acc = MFMA32(FB[s], vn, acc, 0, 0, 0); } \
                float* op = OG + (mrow0 + (cc) * 64 + 32 * rt) * 512 + h * 128 + dv0 + r; \
                const int nreal = smp ? DECT : 64; \
                _Pragma("unroll") for (int q = 0; q < 16; ++q) if (32 * rt + crow(q, hh) < nreal) op[(size_t)crow(q, hh) * 512] = acc[q]; \
            } else if (role == 2) { \
                _Pragma("unroll") for (int q = 0; q < 16; ++q) Sacc[q] *= GLV; \
                _Pragma("unroll") for (int s = 0; s < 4; ++s) { const bf16x8 vn = *(const LAS bf16x8*)(L + GS_VN + r * GS_VN_LD + (16 * s + 8 * hh) * 2); Sacc = MFMA32(FB[s], vn, Sacc, 0, 0, 0); } \
                _Pragma("unroll") for (int g = 0; g < 4; ++g) { v2u w2; w2.x = pk2(Sacc[4 * g], Sacc[4 * g + 1]); w2.y = pk2(Sacc[4 * g + 2], Sacc[4 * g + 3]); *(LAS v2u*)(L + GS_SB + r * GS_SB_LD + (32 * rt + 8 * g + 4 * hh) * 2) = w2; } } \
            LDS_WAIT(); __builtin_amdgcn_s_barrier(); asm volatile("" ::: "memory"); } while (0)
        bf16x8 fa0[8], fa1[8], fb0[4], fb1[4]; s16x4 uv0[4], uv1[4]; float gl0 = 1.f, gl1 = 1.f;
        GS_LOAD(fa0, uv0, fb0, gl0, 0);
#pragma unroll 1
        for (int c = 0; c < nch; c += 2) {
            { const int cn = (c + 1 < nch) ? c + 1 : nch - 1; GS_LOAD(fa1, uv1, fb1, gl1, cn); }
            GS_STEP(fa0, uv0, fb0, gl0, c);
            if (c + 1 < nch) {
                { const int cn = (c + 2 < nch) ? c + 2 : nch - 1; GS_LOAD(fa0, uv0, fb0, gl0, cn); }
                GS_STEP(fa1, uv1, fb1, gl1, c + 1);
            }
        }
#undef GS_LOAD
#undef GS_STEP
        if (role == 2) { float* so = F.out + (smp ? O_GS : O_GP) + ((size_t)(b * GH + h) * GDK + 32 * rt) * GDV + dv0 + r;
#pragma unroll
            for (int q = 0; q < 16; ++q) so[(size_t)crow(q, hh) * GDV] = Sacc[q]; }
    }
}
__device__ __forceinline__ void gdn_out_phase(Frame& F, const Args& A) {
    const int lane = lane_fresh(); const bf16* P = WSP(bf16, WS_P); const float* OG = WSP(float, WS_OG); bf16* CAT = WSP(bf16, WS_CAT);
    const int gw = F.bx * NWAVES + F.wave, NGW = F.G * NWAVES;
    const f32x4 nw0 = *(const GAS f32x4*)(A.in[17] + 8 * (lane & 15)), nw1 = *(const GAS f32x4*)(A.in[17] + 8 * (lane & 15) + 4);
    for (int m0 = gw; m0 < M; m0 += 4 * NGW) {
        f32x4 o0[4], o1[4]; v4u zz[4];
#pragma unroll
        for (int k = 0; k < 4; ++k) { const int m = m0 + k * NGW; const int mm = m < M ? m : m0;
            o0[k] = *(const GAS f32x4*)(OG + (size_t)mm * 512 + 8 * lane); o1[k] = *(const GAS f32x4*)(OG + (size_t)mm * 512 + 8 * lane + 4); zz[k] = *(const GAS v4u*)(P + (size_t)mm * INWP + C_Z + 8 * lane); }
#pragma unroll
        for (int k = 0; k < 4; ++k) { const int m = m0 + k * NGW;
            if (m < M) {
                float ss = (o0[k].x * o0[k].x + o0[k].y * o0[k].y) + (o0[k].z * o0[k].z + o0[k].w * o0[k].w) + (o1[k].x * o1[k].x + o1[k].y * o1[k].y) + (o1[k].z * o1[k].z + o1[k].w * o1[k].w);
                ss += dpp_movf(ss, 0); ss += dpp_movf(ss, 1); ss += dpp_movf(ss, 2); ss += dpp_movf(ss, 3);
                const float rs = 1.f / sqrtf(ss * (1.f / 128.f) + NORM_EPS);
                float z[8] = {bflo(zz[k].x), bfhi(zz[k].x), bflo(zz[k].y), bfhi(zz[k].y), bflo(zz[k].z), bfhi(zz[k].z), bflo(zz[k].w), bfhi(zz[k].w)};
                const float ov[8] = {o0[k].x, o0[k].y, o0[k].z, o0[k].w, o1[k].x, o1[k].y, o1[k].z, o1[k].w}; const float nwv[8] = {nw0.x, nw0.y, nw0.z, nw0.w, nw1.x, nw1.y, nw1.z, nw1.w};
                float r[8];
#pragma unroll
                for (int e = 0; e < 8; ++e) r[e] = ov[e] * rs * nwv[e] * (z[e] / (1.f + __expf(-z[e])));
                v4u w; w.x = pk2(r[0], r[1]); w.y = pk2(r[2], r[3]); w.z = pk2(r[4], r[5]); w.w = pk2(r[6], r[7]);
                *(GAS v4u*)(CAT + (size_t)m * D + 512 + 8 * lane) = w; } }
    }
}
#define MFMA32H __builtin_amdgcn_mfma_f32_32x32x16_f16
__device__ __forceinline__ unsigned f2key(float x) { unsigned b = __builtin_bit_cast(unsigned, x); if ((b << 1) == 0u) b = 0u; return (b & 0x80000000u) ? ~b : (b | 0x80000000u); }
__device__ __forceinline__ float key2f(unsigned k) { const unsigned b = (k & 0x80000000u) ? (k & 0x7fffffffu) : ~k; return __builtin_bit_cast(float, b); }
template <class Get>
__device__ __forceinline__ void wave_topk_threshold(const Get& get, int n, int lane, LAS unsigned* hist, unsigned& thr_key, int& tie_cut) {
    const int niter = (n + 63) >> 6;
    unsigned kmin = 0xffffffffu, kmax = 0u;
#pragma unroll 4
    for (int it = 0; it < niter; ++it) { const int idx = 64 * it + lane; if (idx < n) { const unsigned uk = f2key(get(idx)); kmin = uk < kmin ? uk : kmin; kmax = uk > kmax ? uk : kmax; } }
#pragma unroll
    for (int o = 1; o < 64; o <<= 1) { const unsigned a = (unsigned)__shfl_xor((int)kmin, o), b = (unsigned)__shfl_xor((int)kmax, o); kmin = a < kmin ? a : kmin; kmax = b > kmax ? b : kmax; }
    thr_key = kmax; tie_cut = KSEL - 1;
    if (kmax == kmin) return;
    unsigned base = kmin; int bits = 32 - __builtin_clz(kmax - kmin), kk = KSEL; unsigned cnt = (unsigned)n;
#pragma unroll 1
    while (bits > 0 && cnt > 64u) {
        const int shift = bits > 8 ? bits - 8 : 0;
        *(LAS v4u*)(hist + 4 * lane) = (v4u){0u, 0u, 0u, 0u};
        LDS_WAIT(); asm volatile("" ::: "memory");
#pragma unroll 4
        for (int it = 0; it < niter; ++it) { const int idx = 64 * it + lane;
            if (idx < n) { const unsigned uk = f2key(get(idx)); const unsigned rel = uk - base; if (uk >= base && (bits >= 32 || (rel >> bits) == 0u)) __hip_atomic_fetch_add(hist + (rel >> shift), 1u, __ATOMIC_RELAXED, __HIP_MEMORY_SCOPE_WORKGROUP); } }
        LDS_WAIT(); asm volatile("" ::: "memory");
        const v4u h4 = *(const LAS v4u*)(hist + 4 * lane);
        const unsigned tot = h4.x + h4.y + h4.z + h4.w; unsigned incl = tot;
#pragma unroll
        for (int o = 1; o < 64; o <<= 1) { const unsigned t = __shfl_down(incl, o); if (lane + o < 64) incl += t; }
        const unsigned excl = incl - tot, c3 = excl + h4.w, c2 = c3 + h4.z, c1 = c2 + h4.y, c0 = c1 + h4.x; const unsigned k_ = (unsigned)kk;
        int dj = -1; unsigned above = 0u, cn = 0u;
        if (excl < k_ && k_ <= c3) { dj = 3; above = excl; cn = h4.w; } else if (c3 < k_ && k_ <= c2) { dj = 2; above = c3; cn = h4.z; } else if (c2 < k_ && k_ <= c1) { dj = 1; above = c2; cn = h4.y; } else if (c1 < k_ && k_ <= c0) { dj = 0; above = c1; cn = h4.x; }
        const unsigned long long bm = __ballot(dj >= 0); const int src = bm ? __builtin_ctzll(bm) : 0;
        const unsigned digit = (unsigned)__shfl(4 * lane + dj, src); above = (unsigned)__shfl((int)above, src); cn = (unsigned)__shfl((int)cn, src);
        base += digit << shift; kk -= (int)above; cnt = cn; bits = shift;
    }
    if (bits == 0) {
        thr_key = base; tie_cut = 0x7fffffff;
        if ((int)cnt > kk) { int run = 0;
#pragma unroll 1
            for (int it = 0; it < niter; ++it) { const int idx = 64 * it + lane; const bool eq = idx < n && f2key(get(idx)) == base;
                unsigned long long bm = __ballot(eq); const int c = __builtin_popcountll(bm);
                if (run + c >= kk) { int skip = kk - run - 1; while (skip-- > 0) bm &= bm - 1; tie_cut = 64 * it + __builtin_ctzll(bm); break; }
                run += c; } }
        return;
    }
    { int run = 0;
#pragma unroll 4
      for (int it = 0; it < niter; ++it) { const int idx = 64 * it + lane; bool in = false; unsigned uk = 0u;
          if (idx < n) { uk = f2key(get(idx)); in = uk >= base && ((uk - base) >> bits) == 0u; }
          const unsigned long long bm = __ballot(in);
          if (in) { const int pos = run + __builtin_popcountll(bm & ((1ull << lane) - 1ull)); hist[pos] = uk; hist[64 + pos] = (unsigned)idx; }
          run += __builtin_popcountll(bm); } }
    LDS_WAIT(); asm volatile("" ::: "memory");
    const bool have = lane < (int)cnt; const unsigned my = have ? hist[lane] : 0u; const int myi = have ? (int)hist[64 + lane] : 0x7fffffff;
    int rank = 0; bool later_tie = false;
#pragma unroll 1
    for (int j = 0; j < (int)cnt; ++j) { const unsigned kj = hist[j]; const int ij = (int)hist[64 + j]; rank += (kj > my || (kj == my && ij < myi)) ? 1 : 0; later_tie = later_tie || (kj == my && ij > myi); }
    const unsigned long long hit = __ballot(have && rank == kk - 1); const int src = hit ? __builtin_ctzll(hit) : 0;
    thr_key = (unsigned)__shfl((int)my, src); const int cut = __shfl(myi, src); const int lt = __shfl(later_tie ? 1 : 0, src);
    tie_cut = lt ? cut : 0x7fffffff;
}
template <int NIT>
__device__ __forceinline__ void wave_topk_reg(const LAS float* row, int n, int lane, LAS unsigned* hist, unsigned& thr_key, int& tie_cut) {
    unsigned key[NIT]; unsigned kmin = 0xffffffffu, kmax = 0u;
#pragma unroll
    for (int i = 0; i < NIT; ++i) { const float x = row[64 * i + lane]; const unsigned uk = f2key(x); const bool ok = 64 * i + lane < n; key[i] = ok ? uk : 0u;
        kmin = (ok && uk < kmin) ? uk : kmin; kmax = (ok && uk > kmax) ? uk : kmax; }
    WAVE_REDUCE_U32(kmin, umin_); WAVE_REDUCE_U32(kmax, umax_);
    thr_key = kmax; tie_cut = KSEL - 1;
    if (kmax == kmin) return;
    unsigned base = kmin, kcap = kmax; int kk = KSEL; unsigned cnt = (unsigned)n;
#define TK_SCAN(DIGIT, ABOVE, CN) do { \
        const v4u h4 = *(const LAS v4u*)(hist + 4 * lane); \
        const unsigned tot = h4.x + h4.y + h4.z + h4.w; const unsigned incl = wave_suffix_sum(tot, lane); \
        const unsigned excl = incl - tot, c3 = excl + h4.w, c2 = c3 + h4.z, c1 = c2 + h4.y, c0 = c1 + h4.x; const unsigned k_ = (unsigned)kk; \
        int dj = -1; unsigned ab_ = 0u, cn_ = 0u; \
        if (excl < k_ && k_ <= c3) { dj = 3; ab_ = excl; cn_ = h4.w; } else if (c3 < k_ && k_ <= c2) { dj = 2; ab_ = c3; cn_ = h4.z; } else if (c2 < k_ && k_ <= c1) { dj = 1; ab_ = c2; cn_ = h4.y; } else if (c1 < k_ && k_ <= c0) { dj = 0; ab_ = c1; cn_ = h4.x; } \
        const unsigned long long bm_ = __ballot(dj >= 0); const int src_ = bm_ ? __builtin_ctzll(bm_) : 0; \
        DIGIT = (unsigned)__builtin_amdgcn_readlane(4 * lane + dj, src_); ABOVE = (unsigned)__builtin_amdgcn_readlane((int)ab_, src_); CN = (unsigned)__builtin_amdgcn_readlane((int)cn_, src_); } while (0)
    bool uselin = false; float lxmin = 0.f, lscale = 0.f; int ldig = 0;
    { const float xmin = key2f(kmin), range = key2f(kmax) - xmin;
      if (range > 1e-30f && range < 1e30f) {
          const float scale = 255.99f / range;
          *(LAS v4u*)(hist + 4 * lane) = (v4u){0u, 0u, 0u, 0u};
          LDS_WAIT(); asm volatile("" ::: "memory");
#pragma unroll
          for (int i = 0; i < NIT; ++i) { int d = (int)((key2f(key[i]) - xmin) * scale); d = d > 255 ? 255 : d; if (key[i] != 0u) __hip_atomic_fetch_add(hist + d, 1u, __ATOMIC_RELAXED, __HIP_MEMORY_SCOPE_WORKGROUP); }
          LDS_WAIT(); asm volatile("" ::: "memory");
          unsigned digit, above, cn; TK_SCAN(digit, above, cn);
          kk -= (int)above; cnt = cn; uselin = true; lxmin = xmin; lscale = scale; ldig = (int)digit;
          if (cnt > 64u) {
              uselin = false;
              unsigned k2min = 0xffffffffu, k2max = 0u;
#pragma unroll
              for (int i = 0; i < NIT; ++i) { int d = (int)((key2f(key[i]) - xmin) * scale); d = d > 255 ? 255 : d; const bool in = key[i] != 0u && d == (int)digit; k2min = (in && key[i] < k2min) ? key[i] : k2min; k2max = (in && key[i] > k2max) ? key[i] : k2max; }
              WAVE_REDUCE_U32(k2min, umin_); WAVE_REDUCE_U32(k2max, umax_);
              base = k2min; kcap = k2max; }
      } }
    int bits = (kcap == base) ? 0 : 32 - __builtin_clz(kcap - base);
#pragma unroll 1
    while (bits > 0 && cnt > 64u) {
        const int shift = bits > 8 ? bits - 8 : 0; const unsigned lim = bits >= 32 ? 0xffffffffu : ((1u << bits) - 1u);
        *(LAS v4u*)(hist + 4 * lane) = (v4u){0u, 0u, 0u, 0u};
        LDS_WAIT(); asm volatile("" ::: "memory");
#pragma unroll
        for (int i = 0; i < NIT; ++i) { const unsigned rel = key[i] - base; if (key[i] >= base && key[i] <= kcap && rel <= lim) __hip_atomic_fetch_add(hist + (rel >> shift), 1u, __ATOMIC_RELAXED, __HIP_MEMORY_SCOPE_WORKGROUP); }
        LDS_WAIT(); asm volatile("" ::: "memory");
        unsigned digit, above, cn; TK_SCAN(digit, above, cn);
        base += digit << shift; kk -= (int)above; cnt = cn; bits = shift;
    }
#undef TK_SCAN
    if (bits == 0) {
        thr_key = base; tie_cut = 0x7fffffff;
        if ((int)cnt > kk) { int run = 0; bool done = false;
#pragma unroll
            for (int i = 0; i < NIT; ++i) { unsigned long long bm = __ballot(key[i] == base); const int c = __builtin_popcountll(bm);
                if (!done && run + c >= kk) { int skip = kk - run - 1; while (skip-- > 0) bm &= bm - 1; tie_cut = 64 * i + __builtin_ctzll(bm); done = true; }
                run += c; } }
        return;
    }
    const unsigned lim = bits >= 32 ? 0xffffffffu : ((1u << bits) - 1u);
    { int run = 0;
#pragma unroll
      for (int i = 0; i < NIT; ++i) { const unsigned rel = key[i] - base; bool in;
          if (uselin) { int d = (int)((key2f(key[i]) - lxmin) * lscale); d = d > 255 ? 255 : d; in = key[i] != 0u && d == ldig; } else in = key[i] >= base && key[i] <= kcap && rel <= lim;
          const unsigned long long bm = __ballot(in);
          if (in) { const int pos = run + __builtin_popcountll(bm & ((1ull << lane) - 1ull)); hist[pos] = key[i]; hist[64 + pos] = (unsigned)(64 * i + lane); }
          run += __builtin_popcountll(bm); } }
    LDS_WAIT(); asm volatile("" ::: "memory");
    const bool have = lane < (int)cnt; const unsigned my = have ? hist[lane] : 0u; const int myi = have ? (int)hist[64 + lane] : 0x7fffffff;
    int rank = 0; bool later_tie = false;
#pragma unroll 1
    for (int j = 0; j < (int)cnt; ++j) { const unsigned kj = (unsigned)__builtin_amdgcn_readlane((int)my, j); const int ij = __builtin_amdgcn_readlane(myi, j);
        rank += (kj > my || (kj == my && ij < myi)) ? 1 : 0; later_tie = later_tie || (kj == my && ij > myi); }
    const unsigned long long hit = __ballot(have && rank == kk - 1); const int src = hit ? __builtin_ctzll(hit) : 0;
    thr_key = (unsigned)__builtin_amdgcn_readlane((int)my, src); const int cut = __builtin_amdgcn_readlane(myi, src); const int lt = __builtin_amdgcn_readlane(later_tie ? 1 : 0, src);
    tie_cut = lt ? cut : 0x7fffffff;
}
__device__ __forceinline__ int idx_row_q(int i) { return 2 * ((i >> 2) & 1) + (i >> 4); }
__device__ __forceinline__ int idx_row_h(int i) { return 4 * ((i >> 3) & 1) + (i & 3); }

constexpr int SC_LD = 2052;
constexpr int DP_SC = 0, DP_WI = 131328, DP_THR = 131840, DP_TIE = 131904, DP_HIST = 132096, DP_END = 140288;
static_assert(DP_END <= RING_BYTES, "DSA prompt LDS");
constexpr float QK_SCALE = 0.125f * 1.4426950408889634f;
__device__ __forceinline__ void dsa_prompt_unit(Frame& F, int b, int qt) {
    const int wave = F.wave; const int lane = lane_dep(qt); const int c = lane & 31, hh = lane >> 5;
    LAS unsigned char* L = F.lds + RING_OFF;
    LAS float* SC = (LAS float*)(L + DP_SC); LAS float* WIs = (LAS float*)(L + DP_WI); LAS float* THR = (LAS float*)(L + DP_THR); LAS int* TIE = (LAS int*)(L + DP_TIE);
    const f16* QIh = WSP(f16, WS_QI); const f16* KIh = WSP(f16, WS_KI); const float* WI = WSP(float, WS_WI);
    const bf16* Qb = WSP(bf16, WS_QB); const bf16* Kb = WSP(bf16, WS_KB); const bf16* VT = WSP(bf16, WS_VT); bf16* CAT = WSP(bf16, WS_CAT);
    const int q0 = 16 * qt; const size_t mb = (size_t)b * SEQ; const int Lk = q0 + 16, nkt = (Lk + 31) >> 5;
#pragma unroll 1
    for (int rep_a = 0; rep_a < (MK_X == 1 ? 2 : 1); ++rep_a) {
    if (wave == 0 && lane < 32) *(LAS f32x4*)(WIs + 4 * lane) = *(const GAS f32x4*)(WI + (mb + q0) * 8 + 4 * lane);
    {
        f16x8 aq[4][4];
#pragma unroll
        for (int rt4 = 0; rt4 < 4; ++rt4)
#pragma unroll
            for (int s = 0; s < 4; ++s) aq[rt4][s] = *(const GAS f16x8*)(QIh + (mb + q0 + 4 * rt4 + idx_row_q(c)) * 512 + idx_row_h(c) * 64 + 16 * s + 8 * hh);
        LDS_WAIT(); __syncthreads();
#define DA_LOAD(BK, kt_) do { _Pragma("unroll") for (int s = 0; s < 4; ++s) BK[s] = *(const GAS f16x8*)(KIh + (mb + 32 * (kt_) + c) * 64 + 16 * s + 8 * hh); } while (0)
#define DA_STEP(BK, kt_) do { const int key = 32 * (kt_) + c; \
            _Pragma("unroll") for (int rt4 = 0; rt4 < 4; ++rt4) { \
                f32x16 acc = zero16(); \
                _Pragma("unroll") for (int s = 0; s < 4; ++s) acc = MFMA32H(aq[rt4][s], BK[s], acc, 0, 0, 0); \
                const int ql0 = 4 * rt4 + 2 * hh; \
                const f32x4 w0 = *(const LAS f32x4*)(WIs + ql0 * 8), w1 = *(const LAS f32x4*)(WIs + ql0 * 8 + 4), w2 = *(const LAS f32x4*)(WIs + ql0 * 8 + 8), w3 = *(const LAS f32x4*)(WIs + ql0 * 8 + 12); \
                float s0 = w0.x * fmaxf(acc[0], 0.f) + w0.y * fmaxf(acc[1], 0.f) + w0.z * fmaxf(acc[2], 0.f) + w0.w * fmaxf(acc[3], 0.f) + w1.x * fmaxf(acc[4], 0.f) + w1.y * fmaxf(acc[5], 0.f) + w1.z * fmaxf(acc[6], 0.f) + w1.w * fmaxf(acc[7], 0.f); \
                float s1 = w2.x * fmaxf(acc[8], 0.f) + w2.y * fmaxf(acc[9], 0.f) + w2.z * fmaxf(acc[10], 0.f) + w2.w * fmaxf(acc[11], 0.f) + w3.x * fmaxf(acc[12], 0.f) + w3.y * fmaxf(acc[13], 0.f) + w3.z * fmaxf(acc[14], 0.f) + w3.w * fmaxf(acc[15], 0.f); \
                SC[ql0 * SC_LD + key] = (key <= q0 + ql0) ? s0 : -INFINITY; SC[(ql0 + 1) * SC_LD + key] = (key <= q0 + ql0 + 1) ? s1 : -INFINITY; } } while (0)
        { f16x8 bkA[4], bkB[4];
          if (wave < nkt) DA_LOAD(bkA, wave);
#pragma unroll 1
          for (int kt = wave; kt < nkt; kt += 2 * NWAVES) {
              if (kt + NWAVES < nkt) DA_LOAD(bkB, kt + NWAVES);
              DA_STEP(bkA, kt);
              if (kt + NWAVES < nkt) {
                  if (kt + 2 * NWAVES < nkt) DA_LOAD(bkA, kt + 2 * NWAVES);
                  DA_STEP(bkB, kt + NWAVES);
              }
          } }
#undef DA_LOAD
#undef DA_STEP
    }
    LDS_WAIT(); __syncthreads();
    }
#pragma unroll 1
    for (int rep_b = 0; rep_b < (MK_X == 2 ? 2 : 1); ++rep_b)
#pragma unroll 1
    for (int e = 0; e < 2; ++e) { const int ql = 2 * wave + e, n = q0 + ql + 1; unsigned tk = 0u; int tc = 0x7fffffff; float thr = -3.0e38f;
        if (n > KSEL) { const LAS float* row = SC + ql * SC_LD; LAS unsigned* hist = (LAS unsigned*)(L + DP_HIST) + wave * 256;
            if (MK_X != 6 && n <= 1024) wave_topk_reg<16>(row, n, lane, hist, tk, tc); else wave_topk_reg<32>(row, n, lane, hist, tk, tc);
            thr = key2f(tk); }
        if (lane == 0) { THR[ql] = thr; TIE[ql] = tc; } }
    LDS_WAIT(); __syncthreads();
    const int rt = wave & 3, kh = wave >> 2, g = rt >> 1, ql = 8 * (rt & 1) + (c >> 2), head = 4 * g + (c & 3), qpos = q0 + ql;
    bf16x8 bq[4];
#pragma unroll
    for (int s = 0; s < 4; ++s) bq[s] = *(const GAS bf16x8*)(Qb + (mb + qpos) * 512 + head * 64 + 16 * s + 8 * hh);
    const float thr = THR[ql]; const int tie = TIE[ql];
    float m_run = -INFINITY, l_run = 0.f; f32x16 O0 = zero16(), O1 = zero16();
    const bf16* vtb = VT + (((size_t)(b * 2 + g) * (SEQ / 32)) * 64 + c) * 32 + 16 * hh;
#define DP_LOAD(AK, V8, kt_) do { \
        _Pragma("unroll") for (int s = 0; s < 4; ++s) AK[s] = *(const GAS bf16x8*)(Kb + (mb + 32 * (kt_) + c) * 128 + g * 64 + 16 * s + 8 * hh); \
        _Pragma("unroll") for (int dt = 0; dt < 2; ++dt) _Pragma("unroll") for (int s2 = 0; s2 < 2; ++s2) \
            V8[dt][s2] = *(const GAS bf16x8*)(vtb + ((size_t)(kt_) * 64 + 32 * dt) * 32 + 8 * s2); } while (0)
#define DP_STEP(AK, V8, kt_) do { \
        f32x16 acc = zero16(); \
        _Pragma("unroll") for (int s = 0; s < 4; ++s) acc = MFMA32(AK[s], bq[s], acc, 0, 0, 0); \
        float p[16]; float mx = -INFINITY; \
        if (notie) { \
            _Pragma("unroll") for (int g4 = 0; g4 < 4; ++g4) { const f32x4 scv = *(const LAS f32x4*)(SC + ql * SC_LD + 32 * (kt_) + 8 * g4 + 4 * hh); \
                _Pragma("unroll") for (int e = 0; e < 4; ++e) { const float s = (scv[e] >= thr) ? acc[4 * g4 + e] : -INFINITY; p[4 * g4 + e] = s; mx = fmaxf(mx, s); } } \
        } else { \
            _Pragma("unroll") for (int g4 = 0; g4 < 4; ++g4) { const f32x4 scv = *(const LAS f32x4*)(SC + ql * SC_LD + 32 * (kt_) + 8 * g4 + 4 * hh); \
                _Pragma("unroll") for (int e = 0; e < 4; ++e) { const int key = 32 * (kt_) + 8 * g4 + 4 * hh + e; const float sv = scv[e]; \
                    const bool sel = sv > thr || (sv == thr && key <= tie); \
                    const float s = sel ? acc[4 * g4 + e] : -INFINITY; p[4 * g4 + e] = s; mx = fmaxf(mx, s); } } } \
        mx = fmaxf(mx, __shfl_xor(mx, 32)); \
        const float m_new = fmaxf(m_run, mx), m_safe = (m_new == -INFINITY) ? 0.f : m_new; \
        float ps = 0.f; \
        _Pragma("unroll") for (int r = 0; r < 16; ++r) { p[r] = __builtin_amdgcn_exp2f(p[r] - m_safe); ps += p[r]; } \
        if (__any(m_new != m_run)) { const float alpha = __builtin_amdgcn_exp2f(m_run - m_safe); l_run *= alpha; \
            _Pragma("unroll") for (int r = 0; r < 16; ++r) { O0[r] *= alpha; O1[r] *= alpha; } } \
        l_run += ps; m_run = m_new; \
        _Pragma("unroll") for (int s2 = 0; s2 < 2; ++s2) { \
            v4u pw; pw.x = pg8::cvt_pk_bf16(p[8 * s2], p[8 * s2 + 1]); pw.y = pg8::cvt_pk_bf16(p[8 * s2 + 2], p[8 * s2 + 3]); pw.z = pg8::cvt_pk_bf16(p[8 * s2 + 4], p[8 * s2 + 5]); pw.w = pg8::cvt_pk_bf16(p[8 * s2 + 6], p[8 * s2 + 7]); \
            const bf16x8 pb = __builtin_bit_cast(bf16x8, pw); \
            O0 = MFMA32(V8[0][s2], pb, O0, 0, 0, 0); O1 = MFMA32(V8[1][s2], pb, O1, 0, 0, 0); } } while (0)
    { bf16x8 akA[4], akB[4], akC[4]; bf16x8 v8A[2][2], v8B[2][2], v8C[2][2];
      const bool notie = __all(tie == 0x7fffffff);
      if (kh < nkt) DP_LOAD(akA, v8A, kh);
      if (kh + 2 < nkt) DP_LOAD(akB, v8B, kh + 2);
#pragma unroll 1
      for (int kt = kh; kt < nkt; kt += 6) {
          if (kt + 4 < nkt) DP_LOAD(akC, v8C, kt + 4);
          DP_STEP(akA, v8A, kt);
          if (kt + 2 < nkt) {
              if (kt + 6 < nkt) DP_LOAD(akA, v8A, kt + 6);
              DP_STEP(akB, v8B, kt + 2);
              if (kt + 4 < nkt) {
                  if (kt + 8 < nkt) DP_LOAD(akB, v8B, kt + 8);
                  DP_STEP(akC, v8C, kt + 4);
              }
          }
      } }
#undef DP_LOAD
#undef DP_STEP
    l_run += __shfl_xor(l_run, 32);
    __syncthreads();
    LAS float* CB = (LAS float*)(L + DP_SC) + rt * (34 * 64);
    if (kh == 1) { CB[lane] = m_run; CB[64 + lane] = l_run;
#pragma unroll
        for (int r = 0; r < 16; ++r) { CB[(2 + r) * 64 + lane] = O0[r]; CB[(18 + r) * 64 + lane] = O1[r]; } }
    LDS_WAIT(); __syncthreads();
    if (kh == 0) {
        const float m1 = CB[lane], l1 = CB[64 + lane]; const float m = fmaxf(m_run, m1), ms = (m == -INFINITY) ? 0.f : m;
        const float a0 = __builtin_amdgcn_exp2f(m_run - ms), a1 = __builtin_amdgcn_exp2f(m1 - ms); const float inv = 1.f / (l_run * a0 + l1 * a1);
        bf16* op = CAT + (mb + qpos) * D + head * 64 + 4 * hh;
#pragma unroll
        for (int g4 = 0; g4 < 4; ++g4) { float o[8];
#pragma unroll
            for (int e = 0; e < 4; ++e) { o[e] = (O0[4 * g4 + e] * a0 + CB[(2 + 4 * g4 + e) * 64 + lane] * a1) * inv; o[4 + e] = (O1[4 * g4 + e] * a0 + CB[(18 + 4 * g4 + e) * 64 + lane] * a1) * inv; }
            v2u w0; w0.x = pk2(o[0], o[1]); w0.y = pk2(o[2], o[3]); *(GAS v2u*)(op + 8 * g4) = w0;
            v2u w1; w1.x = pk2(o[4], o[5]); w1.y = pk2(o[6], o[7]); *(GAS v2u*)(op + 32 + 8 * g4) = w1; }
    }
    LDS_WAIT(); __syncthreads();
}
__device__ __forceinline__ void dsa_prompt_phase(Frame& F) {
    for (int w0 = F.bx; w0 < 256; w0 += F.G) { const int w = ((w0 & 7) << 5) | (w0 >> 3);
        const int b = w >> 4, sub = w & 15;
#pragma unroll 1
        for (int j = 0; j < 8; ++j) { const int qt = 32 * (j >> 1) + ((j & 1) ? 31 - sub : sub); dsa_prompt_unit(F, b, qt); } }
}
__device__ __forceinline__ void dsa_sample_scores_phase(Frame& F, const Args& A) {
    const int wave = F.wave;
    const f16* QIh = WSP(f16, WS_QI); const f16* KIh = WSP(f16, WS_KI); const float* WI = WSP(float, WS_WI); float* SCS = WSP(float, WS_SCS);
    const float* ckidx = A.in[4]; const int* ptab = (const int*)A.in[7];
    const int kt4 = wave & 3, rt2 = wave >> 2;
    { const int lane = lane_fresh(); const int c = lane & 31, hh = lane >> 5; const int NU = DECB * NPAGES;
      LAS unsigned char* L = F.lds + RING_OFF + wave * 4608;
      f32x4 xa[8], xb[8];
#define D1_GLOAD(X, u_) do { const int kk_ = ((u_) - u0 < per) ? (u_) - u0 : per - 1; const int phys = phl[kk_]; const GAS f32x4* src = (const GAS f32x4*)(ckidx + ((size_t)phys * PAGE + 32 * kt4) * 64); \
        _Pragma("unroll") for (int i = 0; i < 8; ++i) X[i] = src[lane + 64 * i]; } while (0)
#define D1_STEP(X, u_) do { \
        _Pragma("unroll") for (int i = 0; i < 8; ++i) { const int idx = lane + 64 * i, key = idx >> 4, d4 = idx & 15; \
            typedef _Float16 f16x4_ __attribute__((ext_vector_type(4))); f16x4_ h; h[0] = (f16)X[i].x; h[1] = (f16)X[i].y; h[2] = (f16)X[i].z; h[3] = (f16)X[i].w; \
            *(LAS f16x4_*)(L + key * 144 + d4 * 8) = h; } \
        LDS_WAIT(); asm volatile("" ::: "memory"); \
        const int bs = (u_) >> 6, j = (u_) & 63; const size_t ms = (size_t)MP + (size_t)bs * DECT; \
        f16x8 bk[4]; \
        _Pragma("unroll") for (int s = 0; s < 4; ++s) bk[s] = *(const LAS f16x8*)(L + c * 144 + (16 * s + 8 * hh) * 2); \
        LDS_WAIT(); asm volatile("" ::: "memory"); \
        const int ql0 = 4 * rt2 + 2 * hh; \
        if (bs != bs_cur) { bs_cur = bs; \
            _Pragma("unroll") for (int s = 0; s < 4; ++s) aq[s] = *(const GAS f16x8*)(QIh + (ms + 4 * rt2 + idx_row_q(c)) * 512 + idx_row_h(c) * 64 + 16 * s + 8 * hh); \
            const GAS f32x4* wp = (const GAS f32x4*)(WI + (ms + ql0) * 8); w0 = wp[0]; w1 = wp[1]; w2 = wp[2]; w3 = wp[3]; } \
        f32x16 acc = zero16(); \
        _Pragma("unroll") for (int s = 0; s < 4; ++s) acc = MFMA32H(aq[s], bk[s], acc, 0, 0, 0); \
        const float s0 = w0.x * fmaxf(acc[0], 0.f) + w0.y * fmaxf(acc[1], 0.f) + w0.z * fmaxf(acc[2], 0.f) + w0.w * fmaxf(acc[3], 0.f) + w1.x * fmaxf(acc[4], 0.f) + w1.y * fmaxf(acc[5], 0.f) + w1.z * fmaxf(acc[6], 0.f) + w1.w * fmaxf(acc[7], 0.f); \
        const float s1 = w2.x * fmaxf(acc[8], 0.f) + w2.y * fmaxf(acc[9], 0.f) + w2.z * fmaxf(acc[10], 0.f) + w2.w * fmaxf(acc[11], 0.f) + w3.x * fmaxf(acc[12], 0.f) + w3.y * fmaxf(acc[13], 0.f) + w3.z * fmaxf(acc[14], 0.f) + w3.w * fmaxf(acc[15], 0.f); \
        const int key = PAGE * j + 32 * kt4 + c; \
        SCS[((size_t)bs * DECT + ql0) * SCS_LD + key] = s0; SCS[((size_t)bs * DECT + ql0 + 1) * SCS_LD + key] = s1; } while (0)
      const int per = (NU + F.G - 1) / F.G, u0 = F.bx * per, u1 = (u0 + per < NU) ? u0 + per : NU;
      LAS int* phl = (LAS int*)(F.lds + RING_OFF + 8 * 4608);
      for (int k = wave * 64 + lane; k < per; k += NTHR) { const int uu = (u0 + k < NU) ? u0 + k : NU - 1; phl[k] = ptab[(uu >> 6) * NPAGES + (uu & 63)]; }
      LDS_WAIT(); __syncthreads();
      int bs_cur = -1; f16x8 aq[4]; f32x4 w0, w1, w2, w3; f32x4 xc[8], xd[8];
      D1_GLOAD(xa, u0); D1_GLOAD(xb, u0 + 1); D1_GLOAD(xc, u0 + 2); D1_GLOAD(xd, u0 + 3);
#pragma unroll 1
      for (int u = u0; u < u1; u += 4) {
          D1_STEP(xa, u); D1_GLOAD(xa, u + 4);
          if (u + 1 < u1) { D1_STEP(xb, u + 1); D1_GLOAD(xb, u + 5); }
          if (u + 2 < u1) { D1_STEP(xc, u + 2); D1_GLOAD(xc, u + 6); }
          if (u + 3 < u1) { D1_STEP(xd, u + 3); D1_GLOAD(xd, u + 7); }
      }
#undef D1_GLOAD
#undef D1_STEP
    }
    __syncthreads();
#pragma unroll 1
    for (int bs = F.bx * NWAVES + wave; bs < DECB; bs += F.G * NWAVES) {
        const int lane = lane_dep(bs); const int t = lane >> 3, t2 = lane & 7; const size_t ms = (size_t)MP + (size_t)bs * DECT;
        float sc = 0.f;
#pragma unroll 1
        for (int h = 0; h < 8; ++h) { float d = 0.f;
#pragma unroll 8
            for (int e = 0; e < 64; ++e) d += (float)QIh[(ms + t) * 512 + h * 64 + e] * (float)KIh[(ms + t2) * 64 + e];
            sc += WI[(ms + t) * 8 + h] * fmaxf(d, 0.f); }
        SCS[((size_t)bs * DECT + t) * SCS_LD + PAST + t2] = (t2 <= t) ? sc : -INFINITY;
    }
}
constexpr int DS_ROW = 0, DS_HIST = 32832, DS_LIST = 33856, DS_RID = 34880, DS_WAVE = 35904;
static_assert(4 * DS_WAVE <= RING_BYTES, "DSA sample LDS");
__device__ __forceinline__ void dsa_sample_attend_phase(Frame& F, const Args& A) {
    const int wave = F.wave;
    if (wave >= 4) return;
    LAS unsigned char* L = F.lds + RING_OFF + wave * DS_WAVE;
    LAS float* rowl = (LAS float*)(L + DS_ROW); LAS unsigned* hist = (LAS unsigned*)(L + DS_HIST); LAS int* list = (LAS int*)(L + DS_LIST); LAS int* rowid = (LAS int*)(L + DS_RID);
    LAS float* qv = rowl; LAS float* sc = rowl + 512;
    const float* SCS = WSP(float, WS_SCS); const bf16* Qb = WSP(bf16, WS_QB); bf16* CAT = WSP(bf16, WS_CAT);
    const float* ck = A.in[2]; const float* cv = A.in[3]; const int* ptab = (const int*)A.in[7];
#pragma unroll 1
    for (int qi = wave * F.G + F.bx; qi < MS; qi += 4 * F.G) {
        const int lane = lane_dep(qi);
        const int bs = qi >> 3, t = qi & 7, n = PAST + t + 1; const size_t m = (size_t)MP + qi;
        { const GAS f32x4* src = (const GAS f32x4*)(SCS + (size_t)qi * SCS_LD);
#pragma unroll 1
          for (int k0 = 0; k0 < 33; k0 += 11) { f32x4 tmp[11];
#pragma unroll
              for (int k = 0; k < 11; ++k) { const int i4 = lane + 64 * (k0 + k); tmp[k] = (i4 < SCS_LD / 4) ? src[i4] : (f32x4){0.f, 0.f, 0.f, 0.f}; }
#pragma unroll
              for (int k = 0; k < 11; ++k) { const int i4 = lane + 64 * (k0 + k); if (i4 < SCS_LD / 4) *(LAS f32x4*)(rowl + 4 * i4) = tmp[k]; } } }
        LDS_WAIT(); asm volatile("" ::: "memory");
        unsigned tk; int tc;
        wave_topk_reg<(LS + 63) / 64>(rowl, n, lane, hist, tk, tc);
        int cnt = 0;
#pragma unroll 1
        for (int it = 0; it < (n + 63) / 64; ++it) { const int idx = 64 * it + lane; bool sel = false;
            if (idx < n) { const unsigned uk = f2key(rowl[idx]); sel = uk > tk || (uk == tk && idx <= tc); }
            const unsigned long long bm = __ballot(sel); const int pos = cnt + __builtin_popcountll(bm & ((1ull << lane) - 1ull));
            if (sel && pos < KSEL) list[pos] = idx;
            cnt += __builtin_popcountll(bm); }
        LDS_WAIT(); asm volatile("" ::: "memory");
#pragma unroll
        for (int e = 0; e < 4; ++e) { const unsigned qq = *(const GAS unsigned*)(Qb + m * 512 + 128 * e + 2 * lane); qv[128 * e + 2 * lane] = bflo(qq); qv[128 * e + 2 * lane + 1] = bfhi(qq); }
        LDS_WAIT(); asm volatile("" ::: "memory");
        float mxh[8];
#pragma unroll
        for (int h = 0; h < 8; ++h) mxh[h] = -INFINITY;
#pragma unroll 1
        for (int p = 0; p < 4; ++p) { const int jj = 64 * p + lane; const int idx = list[jj];
            const float* kp; int rid;
            if (idx < PAST) { rid = ptab[bs * NPAGES + (idx >> 7)] * PAGE + (idx & 127); kp = ck + (size_t)rid * 128; }
            else { rid = -(idx - PAST) - 1; kp = F.out + O_KS + ((size_t)bs * DECT + (idx - PAST)) * 128; }
            rowid[jj] = rid;
            f32x4 kr[32];
#pragma unroll
            for (int e = 0; e < 32; ++e) kr[e] = *(const GAS f32x4*)(kp + 4 * e);
            float s[8];
#pragma unroll
            for (int h = 0; h < 8; ++h) s[h] = 0.f;
#pragma unroll
            for (int g = 0; g < 2; ++g)
#pragma unroll
                for (int d4 = 0; d4 < 16; ++d4) { const f32x4 kv = kr[16 * g + d4];
#pragma unroll
                    for (int hl = 0; hl < 4; ++hl) { const f32x4 q4 = *(const LAS f32x4*)(qv + (4 * g + hl) * 64 + 4 * d4); s[4 * g + hl] += kv.x * q4.x + kv.y * q4.y + kv.z * q4.z + kv.w * q4.w; } }
#pragma unroll
            for (int h = 0; h < 8; ++h) { const float v = s[h];   sc[h * 256 + jj] = v; mxh[h] = fmaxf(mxh[h], v); } }
        LDS_WAIT(); asm volatile("" ::: "memory");
        float invl[8];
#pragma unroll
        for (int h = 0; h < 8; ++h) { const float mm = wave_max(mxh[h]); float ps = 0.f;
#pragma unroll
            for (int p = 0; p < 4; ++p) { const float e = __builtin_amdgcn_exp2f(sc[h * 256 + 64 * p + lane] - mm); sc[h * 256 + 64 * p + lane] = e; ps += e; }
            invl[h] = 1.f / wave_sum(ps); }
        LDS_WAIT(); asm volatile("" ::: "memory");
        const int g = lane >> 5, dp = lane & 31; float o[4][2];
#pragma unroll
        for (int hl = 0; hl < 4; ++hl) { o[hl][0] = 0.f; o[hl][1] = 0.f; }
#pragma unroll 1
        for (int j0 = 0; j0 < KSEL; j0 += 32) { f32x2 vv[32];
#pragma unroll
            for (int e = 0; e < 32; ++e) { const int rid = __builtin_amdgcn_readfirstlane(rowid[j0 + e]);
                const float* vp = (rid >= 0) ? cv + (size_t)rid * 128 : F.out + O_VS + ((size_t)bs * DECT + (-rid - 1)) * 128;
                vv[e] = *(const GAS f32x2*)(vp + 64 * g + 2 * dp); }
#pragma unroll
            for (int e = 0; e < 32; ++e)
#pragma unroll
                for (int hl = 0; hl < 4; ++hl) { const float pp = sc[(4 * g + hl) * 256 + j0 + e]; o[hl][0] += pp * vv[e].x; o[hl][1] += pp * vv[e].y; } }
#pragma unroll
        for (int hl = 0; hl < 4; ++hl) { const float il = (g == 0) ? invl[hl] : invl[4 + hl];
            *(GAS unsigned*)(CAT + m * D + (4 * g + hl) * 64 + 2 * dp) = pk2(o[hl][0] * il, o[hl][1] * il); }
        LDS_WAIT(); asm volatile("" ::: "memory");
    }
}
#if MK_DIAG
constexpr int CW_DG = 2048;
__device__ __forceinline__ void dg_add(Frame& F, int k, float num, float den) {
    LAS float* red = (LAS float*)(F.lds + RING_OFF + 140000);
    __syncthreads(); if ((int)threadIdx.x < 2) red[(int)threadIdx.x] = 0.f; __syncthreads();
    atomicAdd((float*)&red[0], num); atomicAdd((float*)&red[1], den); __syncthreads();
    if ((int)threadIdx.x == 0) { atomicAdd((float*)(F.ctl + CW_DG + 2 * k), red[0]); atomicAdd((float*)(F.ctl + CW_DG + 2 * k + 1), red[1]); }
    __syncthreads();
}
__device__ __forceinline__ int dg_row(int i) { const int rows[8] = {0, 777, 2047, 2048, 20000, 32767, 32768, 33791}; int r = 0;
#pragma unroll
    for (int j = 0; j < 8; ++j) r = (i == j) ? rows[j] : r; return r; }
__device__ __forceinline__ void chk_ffn(Frame& F, const float* x0, const float* x1, int split, const float* Wg, const float* Wu, const float* Wd, const float* lg, const float* lb, const float* Xout, int ch) {
    if (F.bx >= 8) return;
    const int row = dg_row(F.bx), tid = (int)threadIdx.x;
    LAS float* xs = (LAS float*)(F.lds + RING_OFF); LAS float* hs = xs + 1024; LAS float* rs = hs + 2816;
    const float* xr = row < split ? x0 + (size_t)row * D : x1 + (size_t)(row - split) * D;
    for (int c = tid; c < D; c += NTHR) xs[c] = xr[c];
    __syncthreads();
    for (int j = tid; j < FF; j += NTHR) { float g = 0.f, u = 0.f; for (int k = 0; k < D; ++k) { g += xs[k] * Wg[(size_t)k * FF + j]; u += xs[k] * Wu[(size_t)k * FF + j]; } hs[j] = g / (1.f + expf(-g)) * u; }
    __syncthreads();
    for (int c = tid; c < D; c += NTHR) { float y = 0.f; for (int j = 0; j < FF; ++j) y += hs[j] * Wd[(size_t)j * D + c]; rs[c] = ALPHA * xs[c] + 0.5f * y; }
    __syncthreads();
    float mean = 0.f; for (int c = 0; c < D; ++c) mean += rs[c]; mean *= (1.f / D);
    float var = 0.f; for (int c = 0; c < D; ++c) { const float d = rs[c] - mean; var += d * d; } var *= (1.f / D);
    const float rstd = 1.f / sqrtf(var + LN_EPS);
    float num = 0.f, den = 0.f;
    for (int c = tid; c < D; c += NTHR) { const float ref = (rs[c] - mean) * rstd * lg[c] + lb[c]; const float d = Xout[(size_t)row * D + c] - ref; num += d * d; den += ref * ref; }
    dg_add(F, ch, num, den);
}
__device__ __forceinline__ void chk_proj(Frame& F, const float* X1, const float* Win, const bf16* P, int ch) {
    if (F.bx >= 8) return;
    const int row = dg_row(F.bx), tid = (int)threadIdx.x;
    LAS float* xs = (LAS float*)(F.lds + RING_OFF);
    for (int c = tid; c < D; c += NTHR) xs[c] = X1[(size_t)row * D + c];
    __syncthreads();
    float num = 0.f, den = 0.f;
    for (int c = tid; c < INW; c += NTHR) { float p = 0.f; for (int k = 0; k < D; ++k) p += xs[k] * Win[(size_t)k * INW + c]; const float d = bf2f(P[(size_t)row * INWP + c]) - p; num += d * d; den += p * p; }
    dg_add(F, ch, num, den);
}

__device__ __forceinline__ void chk_gdn(Frame& F, const Args& A, bool sample, int b, int h, int ch_o, int ch_s) {
    const int tid = (int)threadIdx.x;
    LAS float* S = (LAS float*)(F.lds + RING_OFF); LAS float* y = S + 16384; LAS float* qn = y + 384; LAS float* kn = qn + 128; LAS float* rv = kn + 128;
    const bf16* P = WSP(bf16, WS_P); const float* BG = WSP(float, WS_BG); const float* OG = WSP(float, WS_OG); const float* cw = A.in[14];
    const int T = sample ? DECT : SEQ; const size_t m0 = sample ? (size_t)MP + b * DECT : (size_t)b * SEQ;
    const float* st_in = A.in[5] + (size_t)(b * GH + h) * GDK * GDV; const float* st_out = F.out + (sample ? O_GS : O_GP) + (size_t)(b * GH + h) * GDK * GDV;
    for (int e = tid; e < 16384; e += NTHR) S[e] = sample ? st_in[e] : 0.f;
    float no = 0.f, dn = 0.f;
    __syncthreads();
    for (int t = 0; t < T; ++t) {
        const size_t m = m0 + t;
        if (tid < 384) { const int col = (tid < 128) ? h * 128 + tid : (tid < 256) ? 512 + h * 128 + (tid - 128) : 1024 + h * 128 + (tid - 256); float a = 0.f;
            for (int j = 0; j < 4; ++j) { const int rr = t + j; float x;
                if (rr < 3) x = sample ? A.in[6][((size_t)b * 3 + rr) * CONVC + col] : 0.f; else x = bf2f(P[(m0 + rr - 3) * INWP + C_QKV + col]);
                a += cw[j * CONVC + col] * x; }
            y[tid] = a / (1.f + expf(-a)); }
        __syncthreads();
        float sq = 0.f, sk = 0.f; for (int i = 0; i < 128; ++i) { sq += y[i] * y[i]; sk += y[128 + i] * y[128 + i]; }
        const float rq = 1.f / sqrtf(sq + NORM_EPS), rk = 1.f / sqrtf(sk + NORM_EPS);
        if (tid < 128) { qn[tid] = y[tid] * rq; kn[tid] = y[128 + tid] * rk; }
        __syncthreads();
        const float be = BG[m * 8 + h], a = expf(BG[m * 8 + 4 + h]);
        if (tid < 128) { float part = 0.f; for (int dk = 0; dk < 128; ++dk) part += a * S[dk * 128 + tid] * kn[dk]; rv[tid] = (y[256 + tid] - part) * be; }
        __syncthreads();
        for (int e = tid; e < 16384; e += NTHR) S[e] = a * S[e] + kn[e >> 7] * rv[e & 127];
        __syncthreads();
        if (tid < 128) { float o = 0.f; for (int dk = 0; dk < 128; ++dk) o += S[dk * 128 + tid] * qn[dk]; o *= 0.08838834764831845f;
            const float d = OG[m * 512 + h * 128 + tid] - o; no += d * d; dn += o * o; }
        __syncthreads();
    }
    float ns = 0.f, ds = 0.f;
    for (int e = tid; e < 16384; e += NTHR) { const float d = st_out[e] - S[e]; ns += d * d; ds += S[e] * S[e]; }
    dg_add(F, ch_o, no, dn); dg_add(F, ch_s, ns, ds);
}

__device__ __forceinline__ void chk_dsa(Frame& F, const Args& A, bool sample, int b, int t, int ch) {
    const int tid = (int)threadIdx.x;
    LAS float* sc = (LAS float*)(F.lds + RING_OFF); LAS unsigned char* sel = (LAS unsigned char*)(sc + 8208); LAS float* qs = (LAS float*)(sel + 8208);
    const f16* QIh = WSP(f16, WS_QI); const f16* KIh = WSP(f16, WS_KI); const float* WI = WSP(float, WS_WI); const bf16* Qb = WSP(bf16, WS_QB); const bf16* Kb = WSP(bf16, WS_KB); const bf16* P = WSP(bf16, WS_P); const bf16* CAT = WSP(bf16, WS_CAT);
    const int* ptab = (const int*)A.in[7];
    const size_t m = sample ? (size_t)MP + b * DECT + t : (size_t)b * SEQ + t; const int n = sample ? PAST + t + 1 : t + 1;
    for (int l = tid; l < n; l += NTHR) { float s = 0.f;
        for (int h = 0; h < 8; ++h) { float d = 0.f;
            for (int e = 0; e < 64; ++e) { float kv;
                if (sample) { if (l < PAST) kv = (float)(f16)A.in[4][((size_t)ptab[b * NPAGES + (l >> 7)] * PAGE + (l & 127)) * 64 + e]; else kv = (float)KIh[((size_t)MP + b * DECT + (l - PAST)) * 64 + e]; }
                else kv = (float)KIh[((size_t)b * SEQ + l) * 64 + e];
                d += (float)QIh[m * 512 + h * 64 + e] * kv; }
            s += WI[m * 8 + h] * fmaxf(d, 0.f); }
        if (s == 0.f) s = 0.f;
        sc[l] = s; }
    for (int e = tid; e < 512; e += NTHR) qs[e] = bf2f(Qb[m * 512 + e]);
    __syncthreads();
    for (int l = tid; l < n; l += NTHR) { const float x = sc[l]; int rank = 0; for (int l2 = 0; l2 < n; ++l2) { const float y = sc[l2]; rank += (y > x || (y == x && l2 < l)) ? 1 : 0; } sel[l] = rank < KSEL ? 1 : 0; }
    __syncthreads();
    const int h = tid >> 6, d = tid & 63, g = h >> 2; float mx = -INFINITY;
    for (int pass = 0; pass < 2; ++pass) { float lsum = 0.f, o = 0.f;
        for (int l = 0; l < n; ++l) { if (!sel[l]) continue; float dot = 0.f; float vv;
            if (sample) { const float* kp; const float* vp;
                if (l < PAST) { const size_t rid = (size_t)ptab[b * NPAGES + (l >> 7)] * PAGE + (l & 127); kp = A.in[2] + rid * 128; vp = A.in[3] + rid * 128; }
                else { kp = F.out + O_KS + ((size_t)b * DECT + (l - PAST)) * 128; vp = F.out + O_VS + ((size_t)b * DECT + (l - PAST)) * 128; }
                for (int e = 0; e < 64; ++e) dot += qs[h * 64 + e] * kp[g * 64 + e]; vv = vp[g * 64 + d];
            } else { const size_t mk = (size_t)b * SEQ + l; for (int e = 0; e < 64; ++e) dot += qs[h * 64 + e] * bf2f(Kb[mk * 128 + g * 64 + e]); vv = bf2f(P[mk * INWP + C_V + g * 64 + d]); }
            dot *= 0.6931471805599453f;
            if (pass == 0) mx = fmaxf(mx, dot); else { const float p = expf(dot - mx); lsum += p; o += p * vv; } }
        if (pass == 1) { const float ref = o / lsum; const float dd = bf2f(CAT[m * D + h * 64 + d]) - ref; dg_add(F, ch, dd * dd, ref * ref); } }
}
__device__ __forceinline__ void dg_report(Frame& F) {
    if (F.bx != 0 || (int)threadIdx.x >= 12) return;
    const size_t offs[12] = {O_YP, O_YS, O_KP, O_VP, O_IP, O_GP, O_CP, O_KS, O_VS, O_IS, O_GS, O_CS};
    size_t off = 0;
#pragma unroll
    for (int j = 0; j < 12; ++j) off = ((int)threadIdx.x == j) ? offs[j] : off;
    const float num = __hip_atomic_load((float*)(F.ctl + CW_DG + 2 * (int)threadIdx.x), RLX_AGENT), den = __hip_atomic_load((float*)(F.ctl + CW_DG + 2 * (int)threadIdx.x + 1), RLX_AGENT);
    int n = 99;
    if (den > 0.f) { const float e = sqrtf(num / den); const float L = -log10f(fmaxf(e, 1e-9f)); n = 1 + (int)(10.f * fmaxf(L, 0.f) + 0.5f); n = n > 98 ? 98 : n; if (!(e == e)) n = 1; }
    for (int i = 0; i < n; ++i) ((unsigned*)F.out)[off + i] = 0xAAAAAAAAu;
}
#endif

#if MK_DIAG == 2
constexpr int CW_TS = 3072;
__device__ __forceinline__ void ts_stamp(Frame& F, int k) { if (F.bx == 0 && F.wave == 0 && lane_fresh() == 0) { const unsigned long long t = __builtin_amdgcn_s_memrealtime(); F.ctl[CW_TS + 2 * k] = (unsigned)t; F.ctl[CW_TS + 2 * k + 1] = (unsigned)(t >> 32); } }
__device__ __forceinline__ void ts_report(Frame& F) {
    if (F.bx != 0 || F.wave != 0) return; const int lane = lane_fresh(); if (lane >= 12) return;
    const size_t offs[12] = {O_YP, O_YS, O_KP, O_VP, O_IP, O_GP, O_CP, O_KS, O_VS, O_IS, O_GS, O_CS};
    const int lo[12] = TS_LO; const int hi[12] = TS_HI;
    size_t off = 0; int a = 0, b = 0;
#pragma unroll
    for (int j = 0; j < 12; ++j) { off = (lane == j) ? offs[j] : off; a = (lane == j) ? lo[j] : a; b = (lane == j) ? hi[j] : b; }
    const unsigned long long t0 = (unsigned long long)F.ctl[CW_TS + 2 * a] | ((unsigned long long)F.ctl[CW_TS + 2 * a + 1] << 32), t1 = (unsigned long long)F.ctl[CW_TS + 2 * b] | ((unsigned long long)F.ctl[CW_TS + 2 * b + 1] << 32);
    int n = (int)((t1 - t0) / 100ull); n = n < 1 ? 1 : (n > 60000 ? 60000 : n);
    for (int i = 0; i < n; ++i) ((unsigned*)F.out)[off + i] = 0xAAAAAAAAu;
}
#endif
#ifndef MK_ONE_LAUNCH
#define MK_ONE_LAUNCH 0
#endif
constexpr int NPH = 14 + (MK_DIAG == 1 ? 2 : MK_DIAG == 2 ? 1 : 0);
__global__ void __launch_bounds__(NTHR, 2) mk_fwd(Args args) {
    extern __shared__ __attribute__((aligned(16))) unsigned char lds[];
    Frame F;
    F.lds = (LAS unsigned char*)lds; F.MISC = (volatile LAS unsigned*)(F.lds + MISC_OFF);
    F.wave = __builtin_amdgcn_readfirstlane(threadIdx.x >> 6); F.G = gridDim.x; F.bx = blockIdx.x;
    F.out = args.out; F.ws = args.ws; F.ctl = (gu32*)(args.ws + WS_CTL);
    for (int u = F.wave * 64 + lane_fresh(); u < (LDS_BYTES - LDSCTL_OFF) / 4; u += NTHR) ((LAS unsigned*)(F.lds + LDSCTL_OFF))[u] = 0u;
    __syncthreads();
    XcdBarrier bar; bar.wave = F.wave; bar.bar = (unsigned*)(F.ctl + CW_BAR); bar.x = 0; bar.st = nullptr;
    if (MK_ONE_LAUNCH) bar = xcd_barrier_post((unsigned*)(F.ctl + CW_BAR), F.MISC + 8, F.wave);
    const int lo = args.ph_lo, hi = args.ph_hi;
#define IN(k) (lo <= (k) && (k) < hi)
#define PHASE(k, ...) do { if (IN(k)) { __VA_ARGS__ } if (MK_DUP == (k)) { xcd_barrier(bar); __VA_ARGS__ } SEAM(k); } while (0)
#if MK_DIAG == 2
#define SEAM(k) do { if (IN(k) && IN((k) + 1)) xcd_barrier(bar); ts_stamp(F, (k) + 1); } while (0)
#else
#define SEAM(k) do { if (IN(k) && IN((k) + 1)) xcd_barrier(bar); } while (0)
#endif
    const float* xp = args.in[0]; const float* xs = args.in[1];
    bf16* XB = WSP(bf16, WS_XB); float* X1 = WSP(float, WS_X1); float* X2 = WSP(float, WS_X2); float* R = WSP(float, WS_R); bf16* RB = WSP(bf16, WS_R); bf16* H = WSP(bf16, WS_H); bf16* P = WSP(bf16, WS_P); bf16* CAT = WSP(bf16, WS_CAT);

#if MK_DIAG == 2
    ts_stamp(F, 0);
#endif
    PHASE(0,  p0_prologue(F, args); );
    PHASE(1,
        pg8::Gemm g{XB, WSP(bf16, WS_WGU1), M, NGU, D}; pg8::StaticOrder S; S.init(M, NGU, F.G, F.bx);
        pg8::EpiSwiGLU E{H, FF};
        pg8::gemm_phase<pg8::EpiSwiGLU, pg8::StaticOrder, true, true>(F.lds + RING_OFF, g, S, E, F.wave);
    );
    PHASE(2,
        pg8::Gemm g{H, WSP(bf16, WS_WD1), MP, D, FF}; pg8::StaticOrder S; S.init(MP, D, F.G, F.bx);
        pg8::EpiResBf16<true> E{xp, RB, D, ALPHA, 0.5f};
        pg8::gemm_phase<pg8::EpiResBf16<true>, pg8::StaticOrder, true, true>(F.lds + RING_OFF, g, S, E, F.wave);
        pg8::Gemm gs{H + (size_t)MP * FF, WSP(bf16, WS_WD1), MS, D, FF, 256}; pg8::SplitOrder SS; SS.init(MS, D, FF / 256, F.G, F.bx);
        pg8::EpiPartialF32 ES{WSP(float, WS_PART), D, (size_t)MS * D};
        pg8::gemm_phase<pg8::EpiPartialF32, pg8::SplitOrder, true, true>(F.lds + RING_OFF, gs, SS, ES, F.wave);
    );
    PHASE(3,  ln_phase(F, RB, args.in[11], args.in[12], nullptr, XB, WSP(float, WS_PART), FF / 256, xs, nullptr, 0.5f); );
    PHASE(4,
        pg8::Gemm g{XB, WSP(bf16, WS_WIN), M, INWP, D}; pg8::StaticOrder S; S.init(M, INWP, F.G, F.bx);
        pg8::EpiPlainBf16 E{P, INWP};
        pg8::gemm_phase<pg8::EpiPlainBf16, pg8::StaticOrder, true, true>(F.lds + RING_OFF, g, S, E, F.wave);
    );
    PHASE(5,  post_phase(F, args); );
    PHASE(6,  gdn_prep_phase(F, args); if (MK_DUP == 60) gdn_prep_phase(F, args); dsa_sample_scores_phase(F, args); if (MK_DUP == 61) dsa_sample_scores_phase(F, args); );
    PHASE(7,  gdn_scan_phase(F, args); if (MK_DUP == 70) gdn_scan_phase(F, args); dsa_sample_attend_phase(F, args); if (MK_DUP == 71) dsa_sample_attend_phase(F, args); dsa_prompt_phase(F); if (MK_DUP == 72) dsa_prompt_phase(F); );
    PHASE(8,  gdn_out_phase(F, args); );
#if MK_DIAG != 1
    PHASE(9,
        pg8::Gemm g{CAT, WSP(bf16, WS_WO), MP, D, D}; pg8::StaticOrder S; S.init(MP, D, F.G, F.bx);
        pg8::EpiResBf16<false> E{XB, RB, D, ALPHA, 1.0f};
        pg8::gemm_phase<pg8::EpiResBf16<false>, pg8::StaticOrder, true, true>(F.lds + RING_OFF, g, S, E, F.wave);
        pg8::Gemm gs{CAT + (size_t)MP * D, WSP(bf16, WS_WO), MS, D, D, 256}; pg8::SplitOrder SS; SS.init(MS, D, D / 256, F.G, F.bx);
        pg8::EpiPartialF32 ES{WSP(float, WS_PART), D, (size_t)MS * D};
        pg8::gemm_phase<pg8::EpiPartialF32, pg8::SplitOrder, true, true>(F.lds + RING_OFF, gs, SS, ES, F.wave);
    );
    PHASE(10,  ln_phase(F, RB, args.in[19], args.in[20], nullptr, XB, WSP(float, WS_PART), D / 256, nullptr, XB, 1.0f); );
    PHASE(11,
        pg8::Gemm g{XB, WSP(bf16, WS_WGU2), M, NGU, D}; pg8::StaticOrder S; S.init(M, NGU, F.G, F.bx);
        pg8::EpiSwiGLU E{H, FF};
        pg8::gemm_phase<pg8::EpiSwiGLU, pg8::StaticOrder, true, true>(F.lds + RING_OFF, g, S, E, F.wave);
    );
    PHASE(12,
        pg8::Gemm g{H, WSP(bf16, WS_WD2), MP, D, FF}; pg8::StaticOrder S; S.init(MP, D, F.G, F.bx);
        pg8::EpiResBf16<false> E{XB, RB, D, ALPHA, 0.5f};
        pg8::gemm_phase<pg8::EpiResBf16<false>, pg8::StaticOrder, true, true>(F.lds + RING_OFF, g, S, E, F.wave);
        pg8::Gemm gs{H + (size_t)MP * FF, WSP(bf16, WS_WD2), MS, D, FF, 256}; pg8::SplitOrder SS; SS.init(MS, D, FF / 256, F.G, F.bx);
        pg8::EpiPartialF32 ES{WSP(float, WS_PART), D, (size_t)MS * D};
        pg8::gemm_phase<pg8::EpiPartialF32, pg8::SplitOrder, true, true>(F.lds + RING_OFF, gs, SS, ES, F.wave);
    );
    PHASE(13,  ln_phase(F, RB, args.in[24], args.in[25], F.out + O_YP, nullptr, WSP(float, WS_PART), FF / 256, nullptr, XB, 0.5f); );
#endif
#if MK_DIAG == 1
    if (IN(14)) {
#if MK_DIAG_ALL
        chk_ffn(F, xp, xs, MP, args.in[8], args.in[9], args.in[10], args.in[11], args.in[12], X1, 0);
        chk_proj(F, X1, args.in[13], P, 1);
#endif
        if (F.bx >= 8 && F.bx < 12) { const int i = F.bx - 8; chk_gdn(F, args, false, 5 * i, i, 2, 3); }
        if (F.bx >= 16 && F.bx < 24) { const int i = F.bx - 16; chk_dsa(F, args, false, (3 * i + 1) & 15, i == 0 ? 5 : i == 1 ? 255 : i == 2 ? 256 : i == 3 ? 300 : i == 4 ? 777 : i == 5 ? 1500 : i == 6 ? 2046 : 2047, 6); }
        if (F.bx >= 24 && F.bx < 28) { const int i = F.bx - 24; chk_dsa(F, args, true, i == 0 ? 0 : i == 1 ? 50 : i == 2 ? 99 : 127, i == 0 ? 0 : i == 1 ? 3 : i == 2 ? 6 : 7, 7); }
        if (F.bx >= 12 && F.bx < 16) { const int i = F.bx - 12; chk_gdn(F, args, true, i == 0 ? 0 : i == 1 ? 37 : i == 2 ? 100 : 127, i, 4, 5); }
    }
#endif
#if MK_DIAG == 1
    if (IN(15)) dg_report(F);
#endif
#if MK_DIAG == 2
    if (IN(14)) ts_report(F);
#endif
#undef IN
#undef SEAM
}

extern "C" void kernel_launch(void* const* d_in, const int* in_sizes, int n_in, void* d_out, int out_size, void* d_ws, size_t ws_size, hipStream_t stream) {
    static int grid = 0;
    if (grid == 0) {
        if (n_in != 26 || out_size != (int)O_END || ws_size < WS_END) { fprintf(stderr, "kernel_launch: unexpected shapes (n_in %d out %d ws %zu)\n", n_in, out_size, ws_size); grid = -1; return; }
        int dev = 0, cus = 0, per_cu = 0;
        if (hipGetDevice(&dev) != hipSuccess || hipDeviceGetAttribute(&cus, hipDeviceAttributeMultiprocessorCount, dev) != hipSuccess) { grid = -1; return; }
        if (hipFuncSetAttribute((const void*)mk_fwd, hipFuncAttributeMaxDynamicSharedMemorySize, LDS_BYTES) != hipSuccess) { fprintf(stderr, "kernel_launch: hipFuncSetAttribute failed\n"); grid = -1; return; }
        if (hipOccupancyMaxActiveBlocksPerMultiprocessor(&per_cu, (const void*)mk_fwd, NTHR, LDS_BYTES) != hipSuccess || per_cu < 1) fprintf(stderr, "kernel_launch: occupancy query reports %d\n", per_cu);
        (void)hipGetLastError();
        grid = cus;
    }
    if (grid < 0) return;
    if (hipMemsetAsync((char*)d_ws + WS_CTL, 0, CTL_ZERO_BYTES, stream) != hipSuccess) return;
    Args a{};
    for (int i = 0; i < 26; ++i) a.in[i] = (const float*)d_in[i];
    a.out = (float*)d_out; a.ws = (unsigned char*)d_ws;
#if MK_ONE_LAUNCH
    a.ph_lo = 0; a.ph_hi = NPH;
    hipLaunchKernelGGL(mk_fwd, dim3(grid), dim3(NTHR), LDS_BYTES, stream, a);
#else
    for (int k = 0; k < NPH; ++k) { if (MK_DIAG == 1 && k >= 9 && k <= 13) continue; a.ph_lo = k; a.ph_hi = k + 1; hipLaunchKernelGGL(mk_fwd, dim3(grid), dim3(NTHR), LDS_BYTES, stream, a); }
#endif
}
```

```cpp
#define MK_DIAG 0
#define MK_DIAG_ALL 0
#define TS_LO {0,1,2,3,4,5,6,7,8,9,10,11}
#define TS_HI {1,2,3,4,5,6,7,8,9,10,11,14}
#define MK_ONE_LAUNCH 1
#define MK_DUP -1
#define MK_X 0
#define MK_Y 0
#include <hip/hip_runtime.h>
#include <cstdio>
#include <cstdint>
namespace pg8 {
#define PG8_LAS __attribute__((address_space(3)))
typedef unsigned short bf16_t;
typedef short bf16x8 __attribute__((ext_vector_type(8)));
typedef float f32x4 __attribute__((ext_vector_type(4)));
typedef unsigned u32x4 __attribute__((ext_vector_type(4)));
constexpr int BM = 256, BK = 64, HALF = 128, HTB = HALF * BK * 2  , STAGE_BYTES = 8 * HTB, NXCD = 8, WGM = 8;

__host__ __device__ __forceinline__ int lds_byte(int r, int c) { const int st = (r >> 4) * 2 + (c >> 5), rr = r & 15, cc = c & 31, ob = rr * 64 + cc * 2; return st * 1024 + (ob ^ (((ob >> 9) & 1) << 5)); }
__host__ __device__ __forceinline__ void stage_rc(int b, int& R, int& C) { const int st = b / 1024, sb = b % 1024, swz = sb ^ (((sb >> 9) & 1) << 5); R = (st >> 1) * 16 + swz / 64; C = (st & 1) * 32 + (swz % 64) / 2; }
__host__ __device__ __forceinline__ int perm32(int rho) { const int n = rho >> 4, i = rho & 15; return 8 * (i >> 2) + 4 * n + (i & 3); }

struct Unit { int pm, pn, kc; };
struct Gemm { const bf16_t* A; const bf16_t* Bt; int M, N, K; int klen = 0; };

struct StaticOrder {
    int nM, nN, nwg, G, c;
    __host__ __device__ void init(int M, int N, int G_, int c_) { nM = M / BM; nN = N / BM; nwg = nM * nN; G = G_; c = c_; }
    __host__ __device__ bool next(int i, Unit& u) const {
        const long L = (long)i * G + c; if (L >= nwg) return false;
        int wgid = (int)L; { const int q = nwg / NXCD, r = nwg % NXCD, xcd = wgid % NXCD, off = wgid / NXCD; wgid = (xcd < r ? xcd * (q + 1) : r * (q + 1) + (xcd - r) * q) + off; }
        const int nig = WGM * nN, gid = wgid / nig, fm = gid * WGM, gsz = (nM - fm) < WGM ? (nM - fm) : WGM;
        u.pm = fm + ((wgid % nig) % gsz); u.pn = (wgid % nig) / gsz; u.kc = 0; return true;
    }
    __device__ __forceinline__ void a_ready(const Unit&) const {}
    __device__ __forceinline__ void done(const Unit&) const {}
};

__device__ __forceinline__ unsigned cvt_pk_bf16(float lo, float hi) { unsigned r; asm volatile("v_cvt_pk_bf16_f32 %0, %1, %2" : "=v"(r) : "v"(lo), "v"(hi)); return r; }
typedef float f32x2 __attribute__((ext_vector_type(2)));
__device__ __forceinline__ float silu_f(float x) { return x * __builtin_amdgcn_rcpf(1.0f + __builtin_amdgcn_exp2f(-1.4426950408889634f * x)); }
struct EpiSwiGLU {
    static constexpr bool PERM = true, AFTER_DRAIN = false;
    bf16_t* O; int ldc;
    __device__ __forceinline__ void operator()(const f32x4 (&acc)[2][2][4][2], const Unit& u, int wr, int wc, int fr, int fq) const {
        const int row0 = u.pm * BM + wr * 64 + fr, col0 = u.pn * HALF + wc * 32 + 8 * fq;
#pragma unroll
        for (int ai = 0; ai < 2; ++ai)
#pragma unroll
            for (int m = 0; m < 4; ++m) { bf16_t* p = O + (size_t)(row0 + ai * HALF + m * 16) * ldc + col0;
                const f32x4 g0 = acc[ai][0][m][0], g1 = acc[ai][0][m][1], u0 = acc[ai][1][m][0], u1 = acc[ai][1][m][1];
                u32x4 w; w.x = cvt_pk_bf16(silu_f(g0[0]) * u0[0], silu_f(g0[1]) * u0[1]); w.y = cvt_pk_bf16(silu_f(g0[2]) * u0[2], silu_f(g0[3]) * u0[3]);
                w.z = cvt_pk_bf16(silu_f(g1[0]) * u1[0], silu_f(g1[1]) * u1[1]); w.w = cvt_pk_bf16(silu_f(g1[2]) * u1[2], silu_f(g1[3]) * u1[3]);
                *(u32x4*)p = w; }
    }
};
struct EpiResF32 {
    static constexpr bool PERM = false, AFTER_DRAIN = false;
    const float* res0; const float* res1; int split; float* out; int ldc; float alpha, s;
    __device__ __forceinline__ void operator()(const f32x4 (&acc)[2][2][4][2], const Unit& u, int wr, int wc, int fr, int fq) const {
        const int col0 = u.pn * BM + wc * 32 + 4 * fq;
#pragma unroll
        for (int ai = 0; ai < 2; ++ai)
#pragma unroll
            for (int m = 0; m < 4; ++m) { const int r = u.pm * BM + ai * HALF + wr * 64 + m * 16 + fr;
                const float* rp = (r < split) ? res0 + (size_t)r * ldc : res1 + (size_t)(r - split) * ldc; float* op = out + (size_t)r * ldc;
#pragma unroll
                for (int bj = 0; bj < 2; ++bj)
#pragma unroll
                    for (int n = 0; n < 2; ++n) { const int c = col0 + bj * HALF + n * 16; const f32x4 x = *(const f32x4*)(rp + c); *(f32x4*)(op + c) = x * alpha + acc[ai][bj][m][n] * s; }
                if (m & 1) asm volatile("" ::: "memory"); }
    }
};
struct EpiPlainBf16 {
    static constexpr bool PERM = true, AFTER_DRAIN = false;
    bf16_t* O; int ldc;
    __device__ __forceinline__ void operator()(const f32x4 (&acc)[2][2][4][2], const Unit& u, int wr, int wc, int fr, int fq) const {
        const int row0 = u.pm * BM + wr * 64 + fr, col0 = u.pn * BM + wc * 32 + 8 * fq;
#pragma unroll
        for (int ai = 0; ai < 2; ++ai)
#pragma unroll
            for (int m = 0; m < 4; ++m) { bf16_t* rowp = O + (size_t)(row0 + ai * HALF + m * 16) * ldc + col0;
#pragma unroll
                for (int bj = 0; bj < 2; ++bj) { const f32x4 v0 = acc[ai][bj][m][0], v1 = acc[ai][bj][m][1];
                    u32x4 w; w.x = cvt_pk_bf16(v0[0], v0[1]); w.y = cvt_pk_bf16(v0[2], v0[3]); w.z = cvt_pk_bf16(v1[0], v1[1]); w.w = cvt_pk_bf16(v1[2], v1[3]);
                    *(u32x4*)(rowp + bj * HALF) = w; } }
    }
};
struct SplitOrder {
    int nM, nN, ns, nwg, G, c;
    __host__ __device__ void init(int M, int N, int ns_, int G_, int c_) { nM = M / BM; nN = N / BM; ns = ns_; nwg = nM * nN * ns; G = G_; c = c_; }
    __host__ __device__ bool next(int i, Unit& u) const { const long L = (long)i * G + c; if (L >= nwg) return false; const int l = (int)L; u.kc = l % ns; u.pn = (l / ns) % nN; u.pm = l / (ns * nN); return true; }
    __device__ __forceinline__ void a_ready(const Unit&) const {}
    __device__ __forceinline__ void done(const Unit&) const {}
};
struct EpiPartialF32 {
    static constexpr bool PERM = false, AFTER_DRAIN = false;
    float* part; int ldc; size_t slice;
    __device__ __forceinline__ void operator()(const f32x4 (&acc)[2][2][4][2], const Unit& u, int wr, int wc, int fr, int fq) const {
        const int col0 = u.pn * BM + wc * 32 + 4 * fq; float* base = part + (size_t)u.kc * slice;
#pragma unroll
        for (int ai = 0; ai < 2; ++ai)
#pragma unroll
            for (int m = 0; m < 4; ++m) { const int r = u.pm * BM + ai * HALF + wr * 64 + m * 16 + fr; float* op = base + (size_t)r * ldc;
#pragma unroll
                for (int bj = 0; bj < 2; ++bj)
#pragma unroll
                    for (int n = 0; n < 2; ++n) *(f32x4*)(op + col0 + bj * HALF + n * 16) = acc[ai][bj][m][n]; }
    }
};
template <bool RESF32> struct EpiResBf16 {
    static constexpr bool PERM = true, AFTER_DRAIN = false;
    const void* res; bf16_t* out; int ldc; float alpha, s;
    __device__ __forceinline__ void operator()(const f32x4 (&acc)[2][2][4][2], const Unit& u, int wr, int wc, int fr, int fq) const {
        const int row0 = u.pm * BM + wr * 64 + fr, col0 = u.pn * BM + wc * 32 + 8 * fq;
#pragma unroll
        for (int ai = 0; ai < 2; ++ai)
#pragma unroll
            for (int m = 0; m < 4; ++m) { const size_t ro = (size_t)(row0 + ai * HALF + m * 16) * ldc + col0;
#pragma unroll
                for (int bj = 0; bj < 2; ++bj) { f32x4 r0, r1;
                    if (RESF32) { const float* rp = (const float*)res + ro + bj * HALF; r0 = *(const f32x4*)rp; r1 = *(const f32x4*)(rp + 4); }
                    else { const u32x4 rw = *(const u32x4*)((const bf16_t*)res + ro + bj * HALF);
                        r0 = (f32x4){__builtin_bit_cast(float, rw.x << 16), __builtin_bit_cast(float, rw.x & 0xffff0000u), __builtin_bit_cast(float, rw.y << 16), __builtin_bit_cast(float, rw.y & 0xffff0000u)};
                        r1 = (f32x4){__builtin_bit_cast(float, rw.z << 16), __builtin_bit_cast(float, rw.z & 0xffff0000u), __builtin_bit_cast(float, rw.w << 16), __builtin_bit_cast(float, rw.w & 0xffff0000u)}; }
                    const f32x4 v0 = r0 * alpha + acc[ai][bj][m][0] * s, v1 = r1 * alpha + acc[ai][bj][m][1] * s;
                    u32x4 w; w.x = cvt_pk_bf16(v0[0], v0[1]); w.y = cvt_pk_bf16(v0[2], v0[3]); w.z = cvt_pk_bf16(v1[0], v1[1]); w.w = cvt_pk_bf16(v1[2], v1[3]);
                    *(u32x4*)(out + ro + bj * HALF) = w; }
                if (m & 1) asm volatile("" ::: "memory"); }
    }
};
template <class Epi, class Sched, bool ALIGN_EPI = false, bool SP2 = false>
__device__ __forceinline__ void gemm_phase(PG8_LAS unsigned char* lds, const Gemm g, const Sched& S, const Epi& E, const int wid) {
    int lane_; asm volatile("v_mbcnt_lo_u32_b32 %0, -1, 0\n\tv_mbcnt_hi_u32_b32 %0, -1, %0" : "=v"(lane_));
    const int lane = lane_, tid = wid * 64 + lane, wr = wid >> 2, wc = wid & 3, fr = lane & 15, fq = lane >> 4;
    const int K = g.K, nt = (g.klen ? g.klen : K) / BK;
    const size_t kcstep = (size_t)g.klen * 2;
    unsigned voffA[2], voffB[2];
#pragma unroll
    for (int i = 0; i < 2; ++i) { int R, C; stage_rc(tid * 16 + i * 8192, R, C); const int Rb = Epi::PERM ? ((R & ~31) + perm32(R & 31)) : R;
        voffA[i] = (unsigned)(R * K + C) * 2u; voffB[i] = (unsigned)(Rb * K + C) * 2u; }
    const size_t kstep = (size_t)(BK * 2);
    const size_t hstep = (size_t)HALF * K * 2;
    const size_t tstep = 2 * hstep;
    const unsigned ldsw = (unsigned)wid * 1024u;
    const int aoff = lds_byte(wr * 64 + fr, fq * 8), boff = lds_byte(wc * 32 + fr, fq * 8);
#define PG8_SA(b, h) (((b) * 2 + (h)) * HTB)
#define PG8_SB(b, h) ((4 + (b) * 2 + (h)) * HTB)
#define PG8_STAGE(bufoff, gbase, voff) do { _Pragma("unroll") for (int _i = 0; _i < 2; ++_i) \
        __builtin_amdgcn_global_load_lds((const unsigned*)((const char*)(gbase) + (voff)[_i]), (PG8_LAS unsigned*)(lds + (bufoff) + ldsw + _i * 8192), 16, 0, 0); } while (0)
#define PG8_LDA(dst, b, h) do { _Pragma("unroll") for (int m = 0; m < 4; ++m) _Pragma("unroll") for (int k = 0; k < 2; ++k) dst[m][k] = *(const PG8_LAS bf16x8*)(lds + PG8_SA(b, h) + aoff + m * 2048 + k * 1024); } while (0)
#define PG8_LDB(dst, b, h) do { _Pragma("unroll") for (int n = 0; n < 2; ++n) _Pragma("unroll") for (int k = 0; k < 2; ++k) dst[n][k] = *(const PG8_LAS bf16x8*)(lds + PG8_SB(b, h) + boff + n * 2048 + k * 1024); } while (0)
#define PG8_MMA(ai, bj, At, Bt) do { __builtin_amdgcn_s_setprio(1); _Pragma("unroll") for (int m = 0; m < 4; ++m) _Pragma("unroll") for (int n = 0; n < 2; ++n) _Pragma("unroll") for (int k = 0; k < 2; ++k) \
        acc[ai][bj][m][n] = __builtin_amdgcn_mfma_f32_16x16x32_bf16(Bt[n][k], At[m][k], acc[ai][bj][m][n], 0, 0, 0); __builtin_amdgcn_s_setprio(0); } while (0)
#define PG8_WAIT_V(n) asm volatile("s_waitcnt vmcnt(" #n ")" ::: "memory")
#define PG8_WAIT_L(n) asm volatile("s_waitcnt lgkmcnt(" #n ")" ::: "memory")
#define PG8_BAR __builtin_amdgcn_s_barrier()
#define PG8_SCHED __builtin_amdgcn_sched_barrier(0)
    Unit cur, nxt; int ui = 0;
    if (!S.next(0, cur)) return;
    f32x4 acc[2][2][4][2];
#pragma unroll
    for (int a = 0; a < 2; ++a)
#pragma unroll
        for (int b = 0; b < 2; ++b)
#pragma unroll
            for (int m = 0; m < 4; ++m)
#pragma unroll
                for (int n = 0; n < 2; ++n) acc[a][b][m][n] = (f32x4){0.f, 0.f, 0.f, 0.f};
    bf16x8 At[4][2], B0[2][2], B1[2][2];
    const char* cA = (const char*)g.A + (size_t)cur.pm * tstep + (size_t)cur.kc * kcstep; const char* cB = (const char*)g.Bt + (size_t)cur.pn * tstep + (size_t)cur.kc * kcstep;
    S.a_ready(cur);
    if constexpr (SP2) {
        PG8_STAGE(PG8_SB(0, 0), cB, voffB); PG8_STAGE(PG8_SB(0, 1), cB + hstep, voffB); PG8_STAGE(PG8_SA(0, 0), cA, voffA); PG8_STAGE(PG8_SA(0, 1), cA + hstep, voffA);
        if (wr == 1) PG8_BAR;
        PG8_WAIT_V(2); PG8_BAR;
        PG8_STAGE(PG8_SB(1, 0), cB + kstep, voffB); PG8_STAGE(PG8_SA(1, 0), cA + kstep, voffA); PG8_STAGE(PG8_SB(1, 1), cB + hstep + kstep, voffB);
        PG8_WAIT_V(6); PG8_BAR;
    } else {
        PG8_STAGE(PG8_SB(0, 0), cB, voffB); PG8_STAGE(PG8_SA(0, 0), cA, voffA); PG8_STAGE(PG8_SB(0, 1), cB + hstep, voffB); PG8_STAGE(PG8_SA(0, 1), cA + hstep, voffA);
        if (wr == 1) PG8_BAR;
        PG8_WAIT_V(4); PG8_BAR;
        PG8_STAGE(PG8_SB(1, 0), cB + kstep, voffB); PG8_STAGE(PG8_SA(1, 0), cA + kstep, voffA); PG8_STAGE(PG8_SB(1, 1), cB + hstep + kstep, voffB);
        PG8_WAIT_V(6); PG8_BAR;
    }
    for (;;) {
        const bool has_next = S.next(ui + 1, nxt);
        const char* nA = has_next ? (const char*)g.A + (size_t)nxt.pm * tstep + (size_t)nxt.kc * kcstep : cA; const char* nB = has_next ? (const char*)g.Bt + (size_t)nxt.pn * tstep + (size_t)nxt.kc * kcstep : cB;
        for (int t = 0; t < nt; t += 2) {
            const bool last = (t == nt - 2);
            const char* a1 = cA + (size_t)(t + 1) * kstep;
            const char* a2 = last ? nA : cA + (size_t)(t + 2) * kstep; const char* b2 = last ? nB : cB + (size_t)(t + 2) * kstep;
            const char* a3 = a2 + kstep; const char* b3 = b2 + kstep;
            if (last && has_next) S.a_ready(nxt);
            if constexpr (SP2) {
            PG8_LDB(B0, 0, 0); PG8_LDB(B1, 0, 1); PG8_SCHED; PG8_LDA(At, 0, 0); PG8_STAGE(PG8_SA(1, 1), a1 + hstep, voffA);
            PG8_WAIT_V(8); PG8_WAIT_L(0); PG8_BAR; PG8_MMA(0, 0, At, B0); PG8_MMA(0, 1, At, B1); PG8_BAR; PG8_SCHED;
            PG8_LDA(At, 0, 1); PG8_STAGE(PG8_SB(0, 0), b2, voffB); PG8_STAGE(PG8_SB(0, 1), b2 + hstep, voffB); PG8_STAGE(PG8_SA(0, 0), a2, voffA);
            PG8_WAIT_V(8); PG8_WAIT_L(0); PG8_BAR; PG8_MMA(1, 0, At, B0); PG8_MMA(1, 1, At, B1); PG8_BAR; PG8_SCHED;
            PG8_LDB(B0, 1, 0); PG8_LDB(B1, 1, 1); PG8_SCHED; PG8_LDA(At, 1, 0); PG8_STAGE(PG8_SA(0, 1), a2 + hstep, voffA);
            PG8_WAIT_V(8); PG8_WAIT_L(0); PG8_BAR; PG8_MMA(0, 0, At, B0); PG8_MMA(0, 1, At, B1); PG8_BAR; PG8_SCHED;
            PG8_LDA(At, 1, 1); PG8_STAGE(PG8_SB(1, 0), b3, voffB); PG8_STAGE(PG8_SB(1, 1), b3 + hstep, voffB); PG8_STAGE(PG8_SA(1, 0), a3, voffA);
            PG8_WAIT_V(8); PG8_WAIT_L(0); PG8_BAR; PG8_MMA(1, 0, At, B0); PG8_MMA(1, 1, At, B1); PG8_BAR; PG8_SCHED;
            } else {
            PG8_LDB(B0, 0, 0); PG8_SCHED; PG8_LDA(At, 0, 0); PG8_STAGE(PG8_SA(1, 1), a1 + hstep, voffA);
            PG8_WAIT_L(8); PG8_BAR; PG8_WAIT_L(0); PG8_MMA(0, 0, At, B0); PG8_BAR; PG8_SCHED;
            PG8_LDB(B1, 0, 1); PG8_STAGE(PG8_SB(0, 0), b2, voffB);
            PG8_BAR; PG8_WAIT_L(0); PG8_MMA(0, 1, At, B1); PG8_BAR;
            PG8_LDA(At, 0, 1); PG8_STAGE(PG8_SA(0, 0), a2, voffA);
            PG8_BAR; PG8_WAIT_L(0); PG8_MMA(1, 0, At, B0); PG8_BAR; PG8_SCHED;
            PG8_STAGE(PG8_SB(0, 1), b2 + hstep, voffB);
            PG8_WAIT_V(6); PG8_BAR; PG8_MMA(1, 1, At, B1); PG8_BAR;
            PG8_LDB(B0, 1, 0); PG8_SCHED; PG8_LDA(At, 1, 0); PG8_STAGE(PG8_SA(0, 1), a2 + hstep, voffA);
            PG8_WAIT_L(8); PG8_BAR; PG8_WAIT_L(0); PG8_MMA(0, 0, At, B0); PG8_BAR; PG8_SCHED;
            PG8_LDB(B1, 1, 1); PG8_STAGE(PG8_SB(1, 0), b3, voffB);
            PG8_BAR; PG8_WAIT_L(0); PG8_MMA(0, 1, At, B1); PG8_BAR;
            PG8_LDA(At, 1, 1); PG8_STAGE(PG8_SA(1, 0), a3, voffA);
            PG8_BAR; PG8_WAIT_L(0); PG8_MMA(1, 0, At, B0); PG8_BAR; PG8_SCHED;
            PG8_STAGE(PG8_SB(1, 1), b3 + hstep, voffB);
            PG8_WAIT_V(6); PG8_BAR; PG8_MMA(1, 1, At, B1); PG8_BAR;
            }
        }
        if constexpr (ALIGN_EPI) { if (wr == 0) PG8_BAR; }
        if constexpr (!Epi::AFTER_DRAIN) { E(acc, cur, wr, wc, fr, fq); S.done(cur); }
        if (!has_next) break;
#pragma unroll
        for (int a = 0; a < 2; ++a)
#pragma unroll
            for (int b = 0; b < 2; ++b)
#pragma unroll
                for (int m = 0; m < 4; ++m)
#pragma unroll
                    for (int n = 0; n < 2; ++n) acc[a][b][m][n] = (f32x4){0.f, 0.f, 0.f, 0.f};
        cur = nxt; cA = nA; cB = nB; ++ui;
        if constexpr (ALIGN_EPI) { if (wr == 1) PG8_BAR; }
    }
    PG8_WAIT_V(0);
    if constexpr (!ALIGN_EPI) { if (wr == 0) PG8_BAR; }
    PG8_BAR;
    if constexpr (Epi::AFTER_DRAIN) { E.fused(acc, cur, wr, wc, fr, fq, lds, wid, lane); S.done(cur); }
#undef PG8_SA
#undef PG8_SB
#undef PG8_STAGE
#undef PG8_LDA
#undef PG8_LDB
#undef PG8_MMA
#undef PG8_WAIT_V
#undef PG8_WAIT_L
#undef PG8_BAR
#undef PG8_SCHED
}
}
constexpr int NWAVES = 8, NTHR = 512;
constexpr int D = 1024, BATCH = 16, SEQ = 2048, DECB = 128, DECT = 8, PAST = 8192, PAGE = 128, NPAGES = 64;
constexpr int MP = BATCH * SEQ, MS = DECB * DECT, M = MP + MS;
constexpr int FF = 2816, NGU = 2 * FF, INW = 3408, INWP = 3584;
constexpr int C_Q = 0, C_K = 512, C_V = 640, C_QI = 768, C_KI = 1280, C_WI = 1344, C_QKV = 1352, C_Z = 2888, C_BG = 3400, C_AG = 3404;
constexpr int GH = 4, GDK = 128, GDV = 128, CONVC = 1536, NCHUNK = SEQ / 64, GDN_UNITS = 2048 + DECB * GH;
constexpr int KSEL = 256, LS = PAST + DECT, SCS_LD = 8208;
constexpr float LN_EPS = 1e-5f, NORM_EPS = 1e-6f, ALPHA = 1.189207115002721f;
constexpr size_t O_YP = 0, O_YS = 33554432, O_KP = 34603008, O_VP = 38797312, O_IP = 42991616, O_GP = 45088768, O_CP = 46137344, O_KS = 46211072, O_VS = 46342144, O_IS = 46473216, O_GS = 46538752, O_CS = 54927360, O_END = 55517184;
constexpr size_t MiB = 1u << 20;
constexpr size_t WS_CTL = 0, CTL_ZERO_BYTES = 1 * MiB, WS_ROPE = 1 * MiB;
constexpr size_t WS_WGU1 = 2 * MiB, WS_WD1 = 13 * MiB, WS_WIN = 19 * MiB, WS_WO = 26 * MiB, WS_WGU2 = 28 * MiB, WS_WD2 = 39 * MiB;
constexpr size_t WS_XB = 48 * MiB, WS_X1 = 116 * MiB, WS_X2 = 248 * MiB, WS_R = 380 * MiB, WS_H = 512 * MiB, WS_P = 696 * MiB;
constexpr size_t WS_QB = 928 * MiB, WS_QI = 961 * MiB, WS_KB = 994 * MiB, WS_VT = 1003 * MiB, WS_KI = 1011 * MiB, WS_WI = 1016 * MiB, WS_BG = 1018 * MiB;
constexpr size_t WS_CAT = 1020 * MiB, WS_OG = 1086 * MiB, WS_GSC = 1152 * MiB, WS_GL = 1334 * MiB, WS_SCS = 1336 * MiB, WS_PART = 1370 * MiB, WS_END = 1418 * MiB;
constexpr size_t GSC_UNIT = 73728;
static_assert(WS_WGU1 + (size_t)NGU * D * 2 <= WS_WD1 && WS_WD1 + (size_t)D * FF * 2 <= WS_WIN && WS_WIN + (size_t)INWP * D * 2 <= WS_WO && WS_WO + (size_t)D * D * 2 <= WS_WGU2, "ws map 1");
static_assert(WS_XB + (size_t)M * D * 2 <= WS_X1 && WS_X1 + (size_t)M * D * 4 <= WS_X2 && WS_X2 + (size_t)M * D * 4 <= WS_R && WS_R + (size_t)M * D * 4 <= WS_H && WS_H + (size_t)M * FF * 2 <= WS_P && WS_P + (size_t)M * INWP * 2 <= WS_QB, "ws map 2");
static_assert(WS_QB + (size_t)M * 512 * 2 <= WS_QI && WS_QI + (size_t)M * 512 * 2 <= WS_KB && WS_KB + (size_t)M * 128 * 2 <= WS_VT && WS_VT + (size_t)MP * 128 * 2 <= WS_KI && WS_KI + (size_t)M * 64 * 2 <= WS_WI && WS_WI + (size_t)M * 8 * 4 <= WS_BG && WS_BG + (size_t)M * 8 * 4 <= WS_CAT, "ws map 3");
static_assert(WS_CAT + (size_t)M * D * 2 <= WS_OG && WS_OG + (size_t)M * 512 * 4 <= WS_GSC && WS_GSC + (size_t)GDN_UNITS * GSC_UNIT <= WS_GL && WS_SCS + (size_t)MS * SCS_LD * 4 <= WS_END, "ws map 4");
constexpr int CW_TMO = 0, CW_CODE = 1, CW_BAR = 4096;
constexpr int RING_OFF = 0, RING_BYTES = 151552;
constexpr int LDSCTL_OFF = RING_BYTES, MISC_OFF = LDSCTL_OFF + 320;
constexpr int LDS_BYTES = 152576;
static_assert(MISC_OFF + 128 <= LDS_BYTES, "LDS map");

#define GAS __attribute__((address_space(1)))
#define LAS __attribute__((address_space(3)))
typedef unsigned short bf16;
typedef _Float16 f16;
typedef unsigned v4u __attribute__((ext_vector_type(4)));
typedef unsigned v2u __attribute__((ext_vector_type(2)));
typedef float f32x4 __attribute__((ext_vector_type(4)));
typedef float f32x2 __attribute__((ext_vector_type(2)));
typedef float f32x16 __attribute__((ext_vector_type(16)));
typedef short bf16x8 __attribute__((ext_vector_type(8)));
typedef short s16x4 __attribute__((ext_vector_type(4)));
typedef _Float16 f16x8 __attribute__((ext_vector_type(8)));
typedef GAS unsigned gu32;
#define RLX_AGENT __ATOMIC_RELAXED, __HIP_MEMORY_SCOPE_AGENT
#define LDS_WAIT() asm volatile("s_waitcnt lgkmcnt(0)" ::: "memory")
#define VM_WAIT() asm volatile("s_waitcnt vmcnt(0)" ::: "memory")
__device__ __forceinline__ unsigned f2bf(float f) { unsigned u = __builtin_bit_cast(unsigned, f); return (u + 0x7fffu + ((u >> 16) & 1u)) >> 16; }
__device__ __forceinline__ unsigned pk2(float lo, float hi) { return f2bf(lo) | (f2bf(hi) << 16); }
__device__ __forceinline__ float bf2f(unsigned short b) { return __builtin_bit_cast(float, (unsigned)b << 16); }
__device__ __forceinline__ float bflo(unsigned w) { return __builtin_bit_cast(float, w << 16); }
__device__ __forceinline__ float bfhi(unsigned w) { return __builtin_bit_cast(float, w & 0xffff0000u); }
__device__ __forceinline__ float wave_sum(float v) {
#pragma unroll
    for (int o = 1; o < 64; o <<= 1) v += __shfl_xor(v, o);
    return v;
}
__device__ __forceinline__ float wave_max(float v) {
#pragma unroll
    for (int o = 1; o < 64; o <<= 1) v = fmaxf(v, __shfl_xor(v, o));
    return v;
}
__device__ __forceinline__ int lane_fresh() { int l; asm volatile("v_mbcnt_lo_u32_b32 %0, -1, 0\n\tv_mbcnt_hi_u32_b32 %0, -1, %0" : "=v"(l)); return l; }
__device__ __forceinline__ int lane_dep(int dep) { int l; asm volatile("v_mbcnt_lo_u32_b32 %0, -1, 0\n\tv_mbcnt_hi_u32_b32 %0, -1, %0" : "=v"(l) : "s"(dep)); return l; }
template <int CTRL> __device__ __forceinline__ int dpp_mov(int v) { return __builtin_amdgcn_update_dpp(0, v, CTRL, 0xf, 0xf, true); }
#define WAVE_REDUCE_U32(v, OP) do { unsigned t_; \
    t_ = (unsigned)dpp_mov<0xB1>((int)(v)); (v) = OP((v), t_); t_ = (unsigned)dpp_mov<0x4E>((int)(v)); (v) = OP((v), t_); \
    t_ = (unsigned)dpp_mov<0x141>((int)(v)); (v) = OP((v), t_); t_ = (unsigned)dpp_mov<0x140>((int)(v)); (v) = OP((v), t_); \
    const unsigned a_ = (unsigned)__builtin_amdgcn_readlane((int)(v), 0), b_ = (unsigned)__builtin_amdgcn_readlane((int)(v), 16), c_ = (unsigned)__builtin_amdgcn_readlane((int)(v), 32), d_ = (unsigned)__builtin_amdgcn_readlane((int)(v), 48); \
    (v) = OP(OP(a_, b_), OP(c_, d_)); } while (0)
__device__ __forceinline__ unsigned umin_(unsigned a, unsigned b) { return a < b ? a : b; }
__device__ __forceinline__ unsigned umax_(unsigned a, unsigned b) { return a > b ? a : b; }
__device__ __forceinline__ unsigned wave_suffix_sum(unsigned v, int lane) {
    unsigned s = v;
    s += (unsigned)dpp_mov<0x101>((int)s); s += (unsigned)dpp_mov<0x102>((int)s); s += (unsigned)dpp_mov<0x104>((int)s); s += (unsigned)dpp_mov<0x108>((int)s);
    const unsigned t1 = (unsigned)__builtin_amdgcn_readlane((int)s, 16), t2 = (unsigned)__builtin_amdgcn_readlane((int)s, 32), t3 = (unsigned)__builtin_amdgcn_readlane((int)s, 48);
    const int row = lane >> 4;
    return s + (row == 0 ? t1 + t2 + t3 : row == 1 ? t2 + t3 : row == 2 ? t3 : 0u);
}
__device__ __forceinline__ float dpp_movf(float v, const int which) { const int i = __builtin_bit_cast(int, v); int r;
    switch (which) { case 0: r = dpp_mov<0xB1>(i); break; case 1: r = dpp_mov<0x4E>(i); break; case 2: r = dpp_mov<0x141>(i); break; default: r = dpp_mov<0x140>(i); break; }
    return __builtin_bit_cast(float, r); }
__device__ __forceinline__ float wave_sum_fast(float v) {
    v += dpp_movf(v, 0); v += dpp_movf(v, 1); v += dpp_movf(v, 2); v += dpp_movf(v, 3);
    const int i = __builtin_bit_cast(int, v);
    const float a = __builtin_bit_cast(float, __builtin_amdgcn_readlane(i, 0)), b = __builtin_bit_cast(float, __builtin_amdgcn_readlane(i, 16)), c = __builtin_bit_cast(float, __builtin_amdgcn_readlane(i, 32)), d = __builtin_bit_cast(float, __builtin_amdgcn_readlane(i, 48));
    return (a + b) + (c + d);
}
#define XB_TMO      128
#define XB_XCNT(j)  (256  + 64 * (j))
#define XB_XSUB(j)  (1280 + 64 * (j))
#define XB_XGEN(j)  (2304 + 64 * (j))
#define XB_TOP      3328
#define XB_TOPGEN   3392
#define XCD_BAR_WORDS 3456
#define XB_SPIN_CAP (1u << 18)

__device__ __forceinline__ unsigned xb_ld(unsigned* p)              { return __hip_atomic_load(p, __ATOMIC_RELAXED, __HIP_MEMORY_SCOPE_AGENT); }
__device__ __forceinline__ unsigned xb_add(unsigned* p, unsigned v) { return __hip_atomic_fetch_add(p, v, __ATOMIC_RELAXED, __HIP_MEMORY_SCOPE_AGENT); }
__device__ __forceinline__ unsigned xb_xcc_id() { return (unsigned)__builtin_amdgcn_s_getreg((3 << 11) | 20) & 0xFu; }
#define XB_SPIN(cond, bar) do { unsigned _sp = 0; while (cond) { __builtin_amdgcn_s_sleep(1); \
    if ((++_sp & 255u) == 0u) { if (xb_ld(&(bar)[XB_TMO])) break; if (_sp > XB_SPIN_CAP) { atomicAdd(&(bar)[XB_TMO], 1u); break; } } } } while (0)

struct XcdBarrier {
    int wave; unsigned* bar; unsigned x;
    volatile LAS unsigned* st;
};

__device__ __forceinline__ XcdBarrier xcd_barrier_post(unsigned* bar, volatile LAS unsigned* st, int wave) {
    XcdBarrier b; b.wave = wave; b.bar = bar; b.x = xb_xcc_id(); b.st = st;
    if (wave == 0 && lane_fresh() == 0) (void)xb_add(&bar[XB_XCNT(b.x)], 1u);
    return b;
}
__device__ __forceinline__ void xcd_barrier_complete(unsigned* bar, unsigned x, unsigned& nloc, unsigned& nx) {
    const unsigned G = gridDim.x * gridDim.y * gridDim.z;
    unsigned sum, cnt, mine, sp = 0u;
    for (;;) {
        sum = 0u; cnt = 0u; mine = 0u;
#pragma unroll
        for (unsigned j = 0; j < 16; ++j) { const unsigned c = xb_ld(&bar[XB_XCNT(j)]); sum += c; cnt += (c > 0u) ? 1u : 0u; mine = (j == x) ? c : mine; }
        if (sum == G) break;
        __builtin_amdgcn_s_sleep(1);
        if ((++sp & 255u) == 0u) { if (xb_ld(&bar[XB_TMO])) break; if (sp > XB_SPIN_CAP) { atomicAdd(&bar[XB_TMO], 1u); break; } }
    }
    nloc = mine > 0u ? mine : 1u; nx = cnt > 0u ? cnt : 1u;
}

__device__ __forceinline__ void xcd_barrier(const XcdBarrier& b) {
    asm volatile("s_waitcnt vmcnt(0)" ::: "memory");
    __syncthreads();
    if (b.wave == 0 && lane_fresh() == 0) {
        unsigned* bar = b.bar;
        __builtin_amdgcn_s_waitcnt(0);
        unsigned nloc = b.st[0], nx = b.st[1];
        if (nloc == 0u) { xcd_barrier_complete(bar, b.x, nloc, nx); b.st[0] = nloc; b.st[1] = nx; }
        const unsigned old = xb_add(&bar[XB_XSUB(b.x)], 1u);
        const unsigned gen = old / nloc;
        if (old + 1u == (gen + 1u) * nloc) {
            __builtin_amdgcn_fence(__ATOMIC_RELEASE, "agent");
            asm volatile("s_waitcnt vmcnt(0)" ::: "memory");
            const unsigned og = xb_add(&bar[XB_TOP], 1u);
            const unsigned tg = og / nx;
            if (og + 1u == (tg + 1u) * nx) xb_add(&bar[XB_TOPGEN], 1u);
            else XB_SPIN(xb_ld(&bar[XB_TOPGEN]) == tg, bar);
            __builtin_amdgcn_fence(__ATOMIC_ACQUIRE, "agent");
            xb_add(&bar[XB_XGEN(b.x)], 1u);
            asm volatile("s_waitcnt vmcnt(0)" ::: "memory");
        } else {
            XB_SPIN(xb_ld(&bar[XB_XGEN(b.x)]) == gen, bar);
            __builtin_amdgcn_fence(__ATOMIC_ACQUIRE, "agent");
            asm volatile("s_waitcnt vmcnt(0)" ::: "memory");
        }
    }
    __syncthreads();
}
struct Frame {
    LAS unsigned char* lds;
    volatile LAS unsigned* MISC;
    gu32* ctl;
    int wave, G, bx;
    float* out; unsigned char* ws;
};
struct Args { const float* in[26]; float* out; unsigned char* ws; int ph_lo, ph_hi; };
#define WSP(T, off) ((T*)(F.ws + (off)))

__device__ __forceinline__ void p0_transpose_item(const float* W, int K, int N, bf16* WT, int drow0, int k0, int n0, LAS float* scr, int lane) {
    const int n4 = (lane & 7) * 4; const bool ok = n0 + n4 < N;
    f32x4 t[8];
#pragma unroll
    for (int i = 0; i < 8; ++i) t[i] = ok ? *(const GAS f32x4*)(W + (size_t)(k0 + 8 * i + (lane >> 3)) * N + n0 + n4) : (f32x4){0.f, 0.f, 0.f, 0.f};
#pragma unroll
    for (int i = 0; i < 8; ++i) { LAS float* d = scr + (8 * i + (lane >> 3)) * 33 + n4; d[0] = t[i].x; d[1] = t[i].y; d[2] = t[i].z; d[3] = t[i].w; }
    LDS_WAIT(); asm volatile("" ::: "memory");
    const int c = lane & 7;
#pragma unroll
    for (int j = 0; j < 4; ++j) { const int n = (lane >> 3) + 8 * j; const LAS float* s = scr + (8 * c) * 33 + n;
        v4u o; o.x = pk2(s[0 * 33], s[1 * 33]); o.y = pk2(s[2 * 33], s[3 * 33]); o.z = pk2(s[4 * 33], s[5 * 33]); o.w = pk2(s[6 * 33], s[7 * 33]);
        *(GAS v4u*)(WT + (size_t)(drow0 + n) * K + k0 + 8 * c) = o; }
    LDS_WAIT(); asm volatile("" ::: "memory");
}
__device__ __forceinline__ void p0_convert_items(Frame& F, const Args& A, int first, int last, int wi, int nw) {
    const int lane = lane_fresh();
    LAS float* scr = (LAS float*)(F.lds + RING_OFF + F.wave * 16384);
    constexpr int I_GU = (D / 64) * (FF / 32), I_D = (FF / 64) * (D / 32), I_IN = (D / 64) * (INWP / 32);
    for (int it = first + wi * NWAVES + F.wave; it < last; it += nw * NWAVES) {
        int r = it;
        if (r < 4 * I_GU) {
            const int which = r / I_GU; r -= which * I_GU; const int nblk = FF / 32, kb = r / nblk, nb = r % nblk, n0 = 32 * nb;
            const float* W = which == 0 ? A.in[8] : which == 1 ? A.in[9] : which == 2 ? A.in[21] : A.in[22];
            bf16* WT = WSP(bf16, (which < 2) ? WS_WGU1 : WS_WGU2);
            const int drow0 = 256 * (n0 >> 7) + (n0 & 127) + ((which & 1) ? 128 : 0);
            p0_transpose_item(W, D, FF, WT, drow0, 64 * kb, n0, scr, lane); continue; }
        r -= 4 * I_GU;
        if (r < 2 * I_D) { const int which = r / I_D; r -= which * I_D; const int nblk = D / 32, kb = r / nblk, nb = r % nblk;
            p0_transpose_item(which ? A.in[23] : A.in[10], FF, D, WSP(bf16, which ? WS_WD2 : WS_WD1), 32 * nb, 64 * kb, 32 * nb, scr, lane); continue; }
        r -= 2 * I_D;
        if (r < I_IN) { const int nblk = INWP / 32, kb = r / nblk, nb = r % nblk;
            p0_transpose_item(A.in[13], D, INW, WSP(bf16, WS_WIN), 32 * nb, 64 * kb, 32 * nb, scr, lane); continue; }
        r -= I_IN;
        { const int nblk = D / 32, kb = r / nblk, nb = r % nblk; p0_transpose_item(A.in[18], D, D, WSP(bf16, WS_WO), 32 * nb, 64 * kb, 32 * nb, scr, lane); }
    }
}
constexpr int P0_I_GU = (D / 64) * (FF / 32), P0_NITEMS = 4 * P0_I_GU + 2 * (FF / 64) * (D / 32) + (D / 64) * (INWP / 32) + (D / 64) * (D / 32);
__device__ __forceinline__ void p0_prologue(Frame& F, const Args& A) {
    const int lane = lane_fresh();
    const int gw = F.bx * NWAVES + F.wave, NGW = F.G * NWAVES;
    p0_convert_items(F, A, 0, 2 * P0_I_GU, F.bx, F.G);
    bf16* XB = WSP(bf16, WS_XB);
    for (int m0 = gw; m0 < M; m0 += 4 * NGW) {
        f32x4 v[4][4];
#pragma unroll
        for (int k = 0; k < 4; ++k) { const int m = m0 + k * NGW, mm = m < M ? m : m0;
            const float* xr = (mm < MP) ? A.in[0] + (size_t)mm * D : A.in[1] + (size_t)(mm - MP) * D; const GAS f32x4* x4 = (const GAS f32x4*)xr + lane;
#pragma unroll
            for (int j = 0; j < 4; ++j) v[k][j] = x4[64 * j]; }
#pragma unroll
        for (int k = 0; k < 4; ++k) { const int m = m0 + k * NGW;
            if (m < M) { GAS unsigned long long* o8 = (GAS unsigned long long*)(XB + (size_t)m * D) + lane;
#pragma unroll
                for (int j = 0; j < 4; ++j) o8[64 * j] = (unsigned long long)pk2(v[k][j].x, v[k][j].y) | ((unsigned long long)pk2(v[k][j].z, v[k][j].w) << 32); } }
    }
    float* rope = WSP(float, WS_ROPE);
    for (int i = gw * 64 + lane; i < (SEQ + DECT) * 8; i += NGW * 64) {
        const int pi = i >> 3, f = i & 7; const float pos = (float)(pi < SEQ ? pi : PAST + pi - SEQ);
        const float invf = powf(500000.0f, -(float)f / 8.0f); const float ang = pos * invf;
        rope[pi * 16 + f] = cosf(ang); rope[pi * 16 + 8 + f] = sinf(ang);
    }
}
__device__ __forceinline__ void ln_phase(Frame& F, const bf16* RB, const float* g, const float* b, float* dstf, bf16* dstb, const float* part, int nsplit, const float* resf, const bf16* resb, float pscale) {
    const int lane = lane_fresh();
    const int gw = F.bx * NWAVES + F.wave, NGW = F.G * NWAVES;
    f32x4 gv[4], bv[4];
#pragma unroll
    for (int j = 0; j < 2; ++j) { gv[2 * j] = *(const GAS f32x4*)(g + 512 * j + 8 * lane); gv[2 * j + 1] = *(const GAS f32x4*)(g + 512 * j + 8 * lane + 4); bv[2 * j] = *(const GAS f32x4*)(b + 512 * j + 8 * lane); bv[2 * j + 1] = *(const GAS f32x4*)(b + 512 * j + 8 * lane + 4); }
#define LN_UNPK(W, A0, A1) do { A0 = (f32x4){bflo(W.x), bfhi(W.x), bflo(W.y), bfhi(W.y)}; A1 = (f32x4){bflo(W.z), bfhi(W.z), bflo(W.w), bfhi(W.w)}; } while (0)
#define LN_FINISH(v, m) do { float s = 0.f; \
        _Pragma("unroll") for (int j = 0; j < 4; ++j) s += (v[j].x + v[j].y) + (v[j].z + v[j].w); \
        const float mean = wave_sum_fast(s) * (1.f / D); float s2 = 0.f; \
        _Pragma("unroll") for (int j = 0; j < 4; ++j) { v[j] = v[j] - mean; s2 += (v[j].x * v[j].x + v[j].y * v[j].y) + (v[j].z * v[j].z + v[j].w * v[j].w); } \
        const float rstd = 1.f / sqrtf(wave_sum_fast(s2) * (1.f / D) + LN_EPS); \
        _Pragma("unroll") for (int j = 0; j < 4; ++j) { v[j] = v[j] * rstd * gv[j] + bv[j]; } \
        if (dstf) { _Pragma("unroll") for (int j = 0; j < 2; ++j) { *(GAS f32x4*)(dstf + (size_t)(m) * D + 512 * j + 8 * lane) = v[2 * j]; *(GAS f32x4*)(dstf + (size_t)(m) * D + 512 * j + 8 * lane + 4) = v[2 * j + 1]; } } \
        if (dstb) { _Pragma("unroll") for (int j = 0; j < 2; ++j) { v4u w; w.x = pk2(v[2 * j].x, v[2 * j].y); w.y = pk2(v[2 * j].z, v[2 * j].w); w.z = pk2(v[2 * j + 1].x, v[2 * j + 1].y); w.w = pk2(v[2 * j + 1].z, v[2 * j + 1].w); \
                *(GAS v4u*)(dstb + (size_t)(m) * D + 512 * j + 8 * lane) = w; } } } while (0)
    for (int m0 = gw; m0 < MP; m0 += 4 * NGW) {
        v4u raw[4][2];
#pragma unroll
        for (int k = 0; k < 4; ++k) { const int m = m0 + k * NGW; const int mm = m < MP ? m : m0;
#pragma unroll
            for (int j = 0; j < 2; ++j) raw[k][j] = *(const GAS v4u*)(RB + (size_t)mm * D + 512 * j + 8 * lane); }
#pragma unroll
        for (int k = 0; k < 4; ++k) { const int m = m0 + k * NGW;
            if (m < MP) { f32x4 v[4];
#pragma unroll
                for (int j = 0; j < 2; ++j) LN_UNPK(raw[k][j], v[2 * j], v[2 * j + 1]);
                LN_FINISH(v, m); } }
    }
    for (int m = MP + gw; m < M; m += NGW) {
        f32x4 v[4];
        {
            const int ms = m - MP;
#pragma unroll
            for (int j = 0; j < 4; ++j) v[j] = (f32x4){0.f, 0.f, 0.f, 0.f};
#pragma unroll 1
            for (int k = 0; k < nsplit; ++k) { const float* pp = part + ((size_t)k * MS + ms) * D + 8 * lane;
#pragma unroll
                for (int j = 0; j < 2; ++j) { v[2 * j] = v[2 * j] + *(const GAS f32x4*)(pp + 512 * j); v[2 * j + 1] = v[2 * j + 1] + *(const GAS f32x4*)(pp + 512 * j + 4); } }
#pragma unroll
            for (int j = 0; j < 2; ++j) { f32x4 r0, r1;
                if (resf) { r0 = *(const GAS f32x4*)(resf + (size_t)ms * D + 512 * j + 8 * lane); r1 = *(const GAS f32x4*)(resf + (size_t)ms * D + 512 * j + 8 * lane + 4); }
                else { const v4u w = *(const GAS v4u*)(resb + (size_t)m * D + 512 * j + 8 * lane); LN_UNPK(w, r0, r1); }
                v[2 * j] = r0 * ALPHA + v[2 * j] * pscale; v[2 * j + 1] = r1 * ALPHA + v[2 * j + 1] * pscale; }
        }
        LN_FINISH(v, m);
    }
#undef LN_FINISH
#undef LN_UNPK
}
__device__ __forceinline__ void post_phase(Frame& F, const Args& A) {
    const int lane = lane_fresh();
    const int gw = F.bx * NWAVES + F.wave, NGW = F.G * NWAVES;
    const bf16* P = WSP(bf16, WS_P); const float* rope = WSP(float, WS_ROPE);
    bf16* Qb = WSP(bf16, WS_QB); f16* QIh = WSP(f16, WS_QI); bf16* Kb = WSP(bf16, WS_KB); f16* KIh = WSP(f16, WS_KI); float* WI = WSP(float, WS_WI); float* BG = WSP(float, WS_BG);
    const f32x4 alog = *(const GAS f32x4*)A.in[15], dtb4 = *(const GAS f32x4*)A.in[16];
    const float a_exp[4] = {expf(alog.x), expf(alog.y), expf(alog.z), expf(alog.w)}; const float dtb[4] = {dtb4.x, dtb4.y, dtb4.z, dtb4.w};
    const int j8 = lane & 7; const bool rot = j8 < 2; const float sgn = (j8 == 0) ? -1.f : 1.f;
    for (int m = gw; m < M; m += NGW) {
        const bool prm = m < MP; const int ms = m - MP; const int b = prm ? (m >> 11) : (ms >> 3), t = prm ? (m & 2047) : (ms & 7), pi = prm ? t : SEQ + t;
        const bf16* p = P + (size_t)m * INWP;
        const int c3 = lane < 32 ? C_K + 8 * lane : (lane < 41 ? C_KI + 8 * (lane - 32) : C_BG);
        const v4u rq = *(const GAS v4u*)(p + C_Q + 8 * lane), ri = *(const GAS v4u*)(p + C_QI + 8 * lane);
        v4u r3 = (v4u){0u, 0u, 0u, 0u}; if (lane < 42) r3 = *(const GAS v4u*)(p + c3);
        const f32x4 c0 = *(const GAS f32x4*)(rope + pi * 16), c1 = *(const GAS f32x4*)(rope + pi * 16 + 4), s0 = *(const GAS f32x4*)(rope + pi * 16 + 8), s1 = *(const GAS f32x4*)(rope + pi * 16 + 12);
        const float cs[8] = {c0.x, c0.y, c0.z, c0.w, c1.x, c1.y, c1.z, c1.w}; const float sn[8] = {s0.x, s0.y, s0.z, s0.w, s1.x, s1.y, s1.z, s1.w};
        float xq[8], xi[8], x3[8];
#pragma unroll
        for (int e = 0; e < 4; ++e) { xq[2 * e] = bflo(rq[e]); xq[2 * e + 1] = bfhi(rq[e]); xi[2 * e] = bflo(ri[e]); xi[2 * e + 1] = bfhi(ri[e]); x3[2 * e] = bflo(r3[e]); x3[2 * e + 1] = bfhi(r3[e]); }
        const bool rot3 = rot && (lane < 16 || (lane >= 32 && lane < 40));
#pragma unroll
        for (int e = 0; e < 8; ++e) { const float pq = __shfl_xor(xq[e], 1), pi_ = __shfl_xor(xi[e], 1), p3 = __shfl_xor(x3[e], 1);
            if (rot) { xq[e] = xq[e] * cs[e] + sgn * pq * sn[e]; xi[e] = xi[e] * cs[e] + sgn * pi_ * sn[e]; }
            if (rot3) x3[e] = x3[e] * cs[e] + sgn * p3 * sn[e]; }
        { v4u w; const float qs = 0.125f * 1.4426950408889634f;
#pragma unroll
          for (int e = 0; e < 4; ++e) w[e] = pk2(xq[2 * e] * qs, xq[2 * e + 1] * qs);
          *(GAS v4u*)(Qb + (size_t)m * 512 + 8 * lane) = w;
          f16x8 h;
#pragma unroll
          for (int e = 0; e < 8; ++e) h[e] = (f16)xi[e];
          *(GAS f16x8*)(QIh + (size_t)m * 512 + 8 * lane) = h; }
        if (lane < 32) {
            float* o = F.out + (lane < 16 ? (prm ? O_KP + (size_t)m * 128 : O_KS + (size_t)ms * 128) + 8 * lane : (prm ? O_VP + (size_t)m * 128 : O_VS + (size_t)ms * 128) + 8 * (lane - 16));
            *(GAS f32x4*)o = (f32x4){x3[0], x3[1], x3[2], x3[3]}; *(GAS f32x4*)(o + 4) = (f32x4){x3[4], x3[5], x3[6], x3[7]};
            if (lane < 16) { v4u w;
#pragma unroll
                for (int e = 0; e < 4; ++e) w[e] = pk2(x3[2 * e], x3[2 * e + 1]);
                *(GAS v4u*)(Kb + (size_t)m * 128 + 8 * lane) = w; }
        } else if (lane < 40) {
            float* o = F.out + (prm ? O_IP + (size_t)m * 64 : O_IS + (size_t)ms * 64) + 8 * (lane - 32);
            *(GAS f32x4*)o = (f32x4){x3[0], x3[1], x3[2], x3[3]}; *(GAS f32x4*)(o + 4) = (f32x4){x3[4], x3[5], x3[6], x3[7]};
            f16x8 h;
#pragma unroll
            for (int e = 0; e < 8; ++e) h[e] = (f16)x3[e];
            *(GAS f16x8*)(KIh + (size_t)m * 64 + 8 * (lane - 32)) = h;
        } else if (lane == 40) {
            const float ws = 0.35355339059327373f * 0.125f;
            *(GAS f32x4*)(WI + (size_t)m * 8) = (f32x4){x3[0] * ws, x3[1] * ws, x3[2] * ws, x3[3] * ws}; *(GAS f32x4*)(WI + (size_t)m * 8 + 4) = (f32x4){x3[4] * ws, x3[5] * ws, x3[6] * ws, x3[7] * ws};
        } else if (lane == 41) {
            float be[4], gg[4];
#pragma unroll
            for (int e = 0; e < 4; ++e) { be[e] = 1.f / (1.f + expf(-x3[e])); const float ag = x3[4 + e] + dtb[e]; gg[e] = -a_exp[e] * (ag > 20.f ? ag : log1pf(expf(ag))); }
            *(GAS f32x4*)(BG + (size_t)m * 8) = (f32x4){be[0], be[1], be[2], be[3]}; *(GAS f32x4*)(BG + (size_t)m * 8 + 4) = (f32x4){gg[0], gg[1], gg[2], gg[3]};
        }
        const int trow = prm ? t - (SEQ - 3) : t - (DECT - 3);
        if (trow >= 0) { float* co = F.out + (prm ? O_CP : O_CS) + ((size_t)b * 3 + trow) * CONVC;
#pragma unroll
            for (int k = 0; k < 3; ++k) { const v4u rc = *(const GAS v4u*)(p + C_QKV + 512 * k + 8 * lane);
                *(GAS f32x4*)(co + 512 * k + 8 * lane) = (f32x4){bflo(rc[0]), bfhi(rc[0]), bflo(rc[1]), bfhi(rc[1])}; *(GAS f32x4*)(co + 512 * k + 8 * lane + 4) = (f32x4){bflo(rc[2]), bfhi(rc[2]), bflo(rc[3]), bfhi(rc[3])}; } }
    }
    LAS bf16* tile = (LAS bf16*)(F.lds + RING_OFF + F.wave * 16384);
    bf16* VT = WSP(bf16, WS_VT);
    for (int it = gw; it < BATCH * 2 * (SEQ / 64); it += NGW) {
        const int tb = it % (SEQ / 64), g = (it / (SEQ / 64)) & 1, b = it / (2 * (SEQ / 64));
        for (int tt = 0; tt < 64; ++tt) tile[tt * 66 + lane] = P[(size_t)(b * SEQ + tb * 64 + tt) * INWP + C_V + g * 64 + lane];
        LDS_WAIT(); asm volatile("" ::: "memory");
        { const int kk = lane & 31, pos = ((kk >> 2) & 1) * 16 + ((kk >> 4) * 2 + ((kk >> 3) & 1)) * 4 + (kk & 3); bf16* vt = VT + (((size_t)(b * 2 + g) * (SEQ / 32) + 2 * tb + (lane >> 5)) * 64) * 32 + pos;
          for (int d = 0; d < 64; ++d) vt[d * 32] = tile[lane * 66 + d]; }
        LDS_WAIT(); asm volatile("" ::: "memory");
    }
}
#define MFMA32 __builtin_amdgcn_mfma_f32_32x32x16_bf16
__device__ __forceinline__ int crow(int r, int hh) { return (r & 3) + 8 * (r >> 2) + 4 * hh; }
__device__ __forceinline__ f32x16 zero16() { f32x16 z; for (int i = 0; i < 16; ++i) z[i] = 0.f; return z; }
constexpr int GT_LD = 272;
constexpr int GP_HALF = 72704;
constexpr int GP_Q = 0, GP_K = 17408, GP_V = 34816, GP_A = 52224, GP_G = 69632, GP_B = 69888, GP_EG = 70144;
__device__ __forceinline__ void gdn_prep_phase(Frame& F, const Args& A, const int abl = 0) {
    const int half = F.wave >> 2, hw = F.wave & 3;
    LAS unsigned char* L = F.lds + RING_OFF + half * GP_HALF;
    const bf16* P = WSP(bf16, WS_P); const float* BG = WSP(float, WS_BG); const float* cw = A.in[14];
    const float* sconv = A.in[6];
    const int nit = (GDN_UNITS + 2 * F.G - 1) / (2 * F.G);
    for (int it = 0; it < nit; ++it) {
        const int lane = lane_fresh();
        const int ht = (hw << 6) | lane;
        const int u = (it * F.G + F.bx) * 2 + half; const bool live = u < GDN_UNITS;
        const bool smp = u >= 2048; const int us = u - 2048;
        const int c = smp ? 0 : (u & 31), h = smp ? (us & 3) : ((u >> 5) & 3), b = smp ? (us >> 2) : (u >> 7);
        const size_t mrow0 = smp ? (size_t)MP + (size_t)b * DECT : (size_t)b * SEQ;
        const int nreal = smp ? DECT : 64;
        unsigned char* gs = F.ws + WS_GSC + (size_t)u * GSC_UNIT;
        if (live) {
            LAS float* wl = (LAS float*)(L + GP_A);
#pragma unroll
            for (int k = 0; k < 6; ++k) { const int idx = ht + 256 * k, p = idx >> 9, j = (idx >> 7) & 3, ch = idx & 127; wl[idx] = cw[j * CONVC + p * 512 + h * 128 + ch]; }
        }
        LDS_WAIT(); __syncthreads();
        if (live) {
            const LAS float* wl = (const LAS float*)(L + GP_A);
            const int ti = lane >> 2, qq = lane & 3, row = hw * 16 + ti, tt = c * 64 + row; const bool real = row < nreal;
#pragma unroll 1
            for (int p = 0; p < ((abl & 1) ? 0 : 3); ++p) {
                float y[32];
                v4u xv[4][4]; f32x4 sv[4][2]; bool isrow[4], iscv[4];
#pragma unroll
                for (int j = 0; j < 4; ++j) { const int rr = tt - 3 + j; isrow[j] = rr >= 0 && (!smp || rr < nreal); iscv[j] = smp && rr < 0; }
#pragma unroll
                for (int ch4 = 0; ch4 < 4; ++ch4) { const int col = p * 512 + h * 128 + 32 * qq + 8 * ch4;
#pragma unroll
                    for (int j = 0; j < 4; ++j) { const int rr = tt - 3 + j; xv[ch4][j] = isrow[j] ? *(const GAS v4u*)(P + (mrow0 + rr) * INWP + C_QKV + col) : (v4u){0u, 0u, 0u, 0u}; } }
#pragma unroll
                for (int ch4 = 0; ch4 < 4; ++ch4) { const int col = p * 512 + h * 128 + 32 * qq + 8 * ch4;
                    float a[8];
#pragma unroll
                    for (int e = 0; e < 8; ++e) a[e] = 0.f;
#pragma unroll
                    for (int j = 0; j < 4; ++j) { const int rr = tt - 3 + j; float x[8];
#pragma unroll
                        for (int e = 0; e < 4; ++e) { x[2 * e] = bflo(xv[ch4][j][e]); x[2 * e + 1] = bfhi(xv[ch4][j][e]); }
                        if (iscv[j]) { const f32x4 s0 = *(const GAS f32x4*)(sconv + ((size_t)b * 3 + (3 + rr)) * CONVC + col), s1 = *(const GAS f32x4*)(sconv + ((size_t)b * 3 + (3 + rr)) * CONVC + col + 4);
                            x[0] = s0.x; x[1] = s0.y; x[2] = s0.z; x[3] = s0.w; x[4] = s1.x; x[5] = s1.y; x[6] = s1.z; x[7] = s1.w; }
                        const f32x4 w0 = *(const LAS f32x4*)(wl + (p * 4 + j) * 128 + 32 * qq + 8 * ch4), w1 = *(const LAS f32x4*)(wl + (p * 4 + j) * 128 + 32 * qq + 8 * ch4 + 4);
                        a[0] += w0.x * x[0]; a[1] += w0.y * x[1]; a[2] += w0.z * x[2]; a[3] += w0.w * x[3]; a[4] += w1.x * x[4]; a[5] += w1.y * x[5]; a[6] += w1.z * x[6]; a[7] += w1.w * x[7]; }
#pragma unroll
                    for (int e = 0; e < 8; ++e) { y[8 * ch4 + e] = a[e] / (1.f + __expf(-a[e])); asm volatile("" : "+v"(y[8 * ch4 + e])); }
                    asm volatile("" ::: "memory"); __builtin_amdgcn_sched_barrier(0); }
                if (p < 2) { float ss = 0.f;
#pragma unroll
                    for (int e = 0; e < 32; ++e) ss += y[e] * y[e];
                    ss += __shfl_xor(ss, 1); ss += __shfl_xor(ss, 2);
                    const float rn = 1.f / sqrtf(ss + NORM_EPS);
#pragma unroll
                    for (int e = 0; e < 32; ++e) y[e] *= rn; }
#pragma unroll
                for (int k = 0; k < 4; ++k) { v4u w4;
#pragma unroll
                    for (int e = 0; e < 4; ++e) w4[e] = real ? pk2(y[8 * k + 2 * e], y[8 * k + 2 * e + 1]) : 0u;
                    *(LAS v4u*)(L + p * 17408 + row * GT_LD + 64 * qq + 16 * k) = w4; }
            }
            if (hw == 0) { const size_t m = mrow0 + c * 64 + lane; const bool rl = lane < nreal; float g = rl ? BG[m * 8 + 4 + h] : 0.f; const float be = rl ? BG[m * 8 + h] : 0.f;
#pragma unroll
                for (int o = 1; o < 64; o <<= 1) { const float t = __shfl_up(g, o); if (lane >= o) g += t; }
                ((LAS float*)(L + GP_G))[lane] = g; ((LAS float*)(L + GP_B))[lane] = be;
                const float g63 = __shfl(g, 63); ((LAS float*)(L + GP_EG))[lane] = __expf(g); ((LAS float*)(L + GP_EG))[64 + lane] = __expf(g63 - g); }
        }
        LDS_WAIT(); __syncthreads();
        if (live && !(abl & 2)) {
            const LAS float* Gs = (const LAS float*)(L + GP_G); const LAS float* Bs = (const LAS float*)(L + GP_B);
            bf16* QKg = (bf16*)(gs + 65536);
            const int r = lane & 31, hh = lane >> 5;
            if (hw < 3) {
                const int ti = hw > 0 ? 1 : 0, tj = hw > 1 ? 1 : 0;
                f32x16 akk = zero16(), aqk = zero16();
#pragma unroll
                for (int s = 0; s < 8; ++s) {
                    const bf16x8 bk = *(const LAS bf16x8*)(L + GP_K + (32 * tj + r) * GT_LD + (16 * s + 8 * hh) * 2);
                    const bf16x8 ak = *(const LAS bf16x8*)(L + GP_K + (32 * ti + r) * GT_LD + (16 * s + 8 * hh) * 2);
                    const bf16x8 aq = *(const LAS bf16x8*)(L + GP_Q + (32 * ti + r) * GT_LD + (16 * s + 8 * hh) * 2);
                    akk = MFMA32(ak, bk, akk, 0, 0, 0); aqk = MFMA32(aq, bk, aqk, 0, 0, 0);
                }
                const int j = 32 * tj + r; const float Gj = Gs[j];
#pragma unroll
                for (int q = 0; q < 16; ++q) { const int i = 32 * ti + crow(q, hh); const float dec = __expf(Gs[i] - Gj);
                    ((LAS float*)(L + GP_A))[i * 68 + j] = (i > j) ? Bs[i] * akk[q] * dec : 0.f;
                    QKg[(((i >> 5) * 4 + (j >> 4)) * 64 + ((j >> 3) & 1) * 32 + (i & 31)) * 8 + (j & 7)] = (bf16)f2bf((i >= j) ? aqk[q] * dec * 0.08838834764831845f : 0.f); }
            } else {
#pragma unroll
                for (int q = 0; q < 16; ++q) { const int i = crow(q, hh), j = 32 + r; QKg[(((i >> 5) * 4 + (j >> 4)) * 64 + ((j >> 3) & 1) * 32 + (i & 31)) * 8 + (j & 7)] = 0; }
            }
        }
        LDS_WAIT(); __syncthreads();
        if (live) {
            const LAS float* Gs = (const LAS float*)(L + GP_G); const LAS float* Bs = (const LAS float*)(L + GP_B); const LAS float* As = (const LAS float*)(L + GP_A);
            const bool isu = ht < 128; const int cc = ht & 127; const LAS float* EGs = (const LAS float*)(L + GP_EG);
            const LAS unsigned char* src = L + (isu ? GP_V : GP_K) + cc * 2;
            float X[64];
#pragma unroll 1
            for (int rep_s4 = 0; rep_s4 < ((abl & 4) ? 0 : (MK_X == 5 ? 2 : 1)); ++rep_s4) {
#pragma unroll
            for (int i = 0; i < 64; ++i) X[i] = 0.f;
#pragma unroll
            for (int i = 0; i < 64; ++i) {
                float acc = bf2f(*(const LAS bf16*)(src + i * GT_LD)) * Bs[i] * (isu ? 1.f : EGs[i]);
                float a1_ = 0.f, a2_ = 0.f, a3_ = 0.f;
#pragma unroll
                for (int j4 = 0; j4 < (i + 3) / 4; ++j4) { const f32x4 a = *(const LAS f32x4*)(As + i * 68 + 4 * j4);
                    acc -= a.x * X[4 * j4]; a1_ -= a.y * X[4 * j4 + 1]; a2_ -= a.z * X[4 * j4 + 2]; a3_ -= a.w * X[4 * j4 + 3]; }
                acc = (acc + a1_) + (a2_ + a3_);
                X[i] = acc; asm volatile("" : "+v"(X[i]) :: "memory"); __builtin_amdgcn_sched_barrier(0);
            }
            }
            if (!(abl & 8) && isu) {
#pragma unroll
                for (int q = 0; q < 16; ++q) { const int rt_ = q >> 3, g_ = (q >> 1) & 3, hh_ = q & 1, i0 = 32 * rt_ + 8 * g_ + 4 * hh_;
                    v2u w2; w2.x = pk2(X[i0], X[i0 + 1]); w2.y = pk2(X[i0 + 2], X[i0 + 3]);
                    *(GAS v2u*)(gs + (size_t)((((cc >> 5) * 2 + rt_) * 4 + g_) * 64 + hh_ * 32 + (cc & 31)) * 8) = w2; }
            }
            LDS_WAIT(); __builtin_amdgcn_s_barrier(); asm volatile("" ::: "memory");
            if (!isu) {
#pragma unroll
                for (int i = 0; i < 64; ++i) *(LAS bf16*)(L + GP_V + i * GT_LD + cc * 2) = (bf16)f2bf(X[i]); }
            if (!(abl & 8)) {
#pragma unroll
            for (int k = 0; k < 4; ++k) { const int q_ = ht + 256 * k, ln_ = q_ & 63, s_ = (q_ >> 6) & 7, rt_ = q_ >> 9, i = 32 * rt_ + (ln_ & 31);
                const v4u qv = *(const LAS v4u*)(L + GP_Q + i * GT_LD + (16 * s_ + 8 * (ln_ >> 5)) * 2); const float sc = EGs[i] * 0.08838834764831845f;
                v4u w4; w4.x = pk2(bflo(qv.x) * sc, bfhi(qv.x) * sc); w4.y = pk2(bflo(qv.y) * sc, bfhi(qv.y) * sc); w4.z = pk2(bflo(qv.z) * sc, bfhi(qv.z) * sc); w4.w = pk2(bflo(qv.w) * sc, bfhi(qv.w) * sc);
                *(GAS v4u*)(gs + 32768 + (size_t)q_ * 16) = w4; }
            if (!isu) {
#pragma unroll
                for (int q = 0; q < 8; ++q) { float kv[8];
#pragma unroll
                    for (int e = 0; e < 8; ++e) { const int i = 8 * q + e; kv[e] = bf2f(*(const LAS bf16*)(L + GP_K + i * GT_LD + cc * 2)) * EGs[64 + i]; }
                    v4u w4; w4.x = pk2(kv[0], kv[1]); w4.y = pk2(kv[2], kv[3]); w4.z = pk2(kv[4], kv[5]); w4.w = pk2(kv[6], kv[7]);
                    *(GAS v4u*)(gs + 49152 + (size_t)((((cc >> 5) * 4 + (q >> 1)) * 64 + (q & 1) * 32 + (cc & 31)) * 16)) = w4; } }
            if (ht == 0) WSP(float, WS_GL)[u] = EGs[63];
            }
            LDS_WAIT(); __builtin_amdgcn_s_barrier(); asm volatile("" ::: "memory");
            if (!(abl & 8)) {
#pragma unroll
            for (int k = 0; k < 4; ++k) { const int q_ = ht + 256 * k, ln_ = q_ & 63, s_ = (q_ >> 6) & 7, rt_ = q_ >> 9, i = 32 * rt_ + (ln_ & 31);
                *(GAS v4u*)(gs + 16384 + (size_t)q_ * 16) = *(const LAS v4u*)(L + GP_V + i * GT_LD + (16 * s_ + 8 * (ln_ >> 5)) * 2); }
            }
        } else { __builtin_amdgcn_s_barrier(); __builtin_amdgcn_s_barrier(); }
        LDS_WAIT(); __syncthreads();
    }
}
constexpr int GS_SB = 0, GS_SB_LD = 272, GS_VN = 8704, GS_VN_LD = 144, GS_OB = 13312;
__device__ __forceinline__ void gdn_scan_phase(Frame& F, const Args& A) {
    const int wave = F.wave;
    LAS unsigned char* L = F.lds + RING_OFF;
    float* OG = WSP(float, WS_OG); const float* GL = WSP(float, WS_GL);
    for (int uu0 = F.bx; uu0 < (BATCH * GH * 4 + DECB * GH * 4) * (MK_X == 3 || MK_X == 4 ? 2 : 1); uu0 += F.G) {
        const bool dup_ = uu0 >= BATCH * GH * 4 + DECB * GH * 4;
        int uu = uu0; if (MK_X == 3 && uu0 >= BATCH * GH * 4 + DECB * GH * 4) { uu = uu0 - (BATCH * GH * 4 + DECB * GH * 4); if (uu >= BATCH * GH * 4) continue; }
        if (MK_X == 4 && uu0 >= BATCH * GH * 4 + DECB * GH * 4) { uu = uu0 - (BATCH * GH * 4 + DECB * GH * 4); if (uu < BATCH * GH * 4) continue; }
        const int lane = lane_fresh(); const int r = lane & 31, hh = lane >> 5;
        const bool smp = uu >= BATCH * GH * 4; const int u0_ = smp ? uu - BATCH * GH * 4 : uu;
        const int nseq_ = smp ? DECB * GH : BATCH * GH;
        const int x_ = u0_ & 7, i_ = u0_ >> 3, sl = i_ & 3, seq_ = x_ * (nseq_ >> 3) + (i_ >> 2);
        const int h = seq_ & 3, b = seq_ >> 2, dv0 = sl * 32;
        const int role = wave < 2 ? 0 : (wave < 4 ? 1 : 2), rt = wave < 2 ? wave : (wave < 4 ? wave - 2 : wave - 4);
        const int nch = smp ? 1 : NCHUNK, un0 = smp ? 2048 + b * GH + h : (b * GH + h) * NCHUNK;
        const size_t mrow0 = smp ? (size_t)MP + (size_t)b * DECT : (size_t)b * SEQ;
        f32x16 Sacc = zero16();
        __syncthreads();
        if (!smp) { for (int i = wave * 64 + lane; i < (GS_VN + 32 * GS_VN_LD) / 4; i += NTHR) ((LAS unsigned*)L)[i] = 0u; }
        else if (role == 2) {
            const GAS float* sp = (const GAS float*)(A.in[5] + ((size_t)(b * GH + h) * GDK + 32 * rt) * GDV + dv0 + r);
#pragma unroll
            for (int q = 0; q < 16; ++q) Sacc[q] = sp[(size_t)crow(q, hh) * GDV];
#pragma unroll
            for (int g = 0; g < 4; ++g) { v2u w2; w2.x = pk2(Sacc[4 * g], Sacc[4 * g + 1]); w2.y = pk2(Sacc[4 * g + 2], Sacc[4 * g + 3]); *(LAS v2u*)(L + GS_SB + r * GS_SB_LD + (32 * rt + 8 * g + 4 * hh) * 2) = w2; }
        }
        LDS_WAIT(); __syncthreads();
        const size_t offA = (role == 2) ? (size_t)lane * 16 : (role == 1 ? 32768 : 16384) + (size_t)((rt * 8) * 64 + lane) * 16;
        const size_t strA = (role == 2) ? 0 : 1024;
        const size_t offB = (role == 0) ? (size_t)lane * 16 : (role == 2 ? 49152 : 65536) + (size_t)((rt * 4) * 64 + lane) * 16;
        const size_t strB = (role == 0) ? 0 : 1024;
        const size_t offU = (role == 0) ? (size_t)(((sl * 2 + rt) * 4) * 64 + lane) * 8 : (size_t)lane * 8;
        const size_t strU = (role == 0) ? 512 : 0;
#define GS_LOAD(FA, UV, FB, GLV, cc) do { const int un_ = un0 + (cc); const unsigned char* gs = F.ws + WS_GSC + (size_t)un_ * GSC_UNIT; \
            _Pragma("unroll") for (int s = 0; s < 8; ++s) FA[s] = *(const GAS bf16x8*)(gs + offA + (size_t)s * strA); \
            _Pragma("unroll") for (int s = 0; s < 4; ++s) FB[s] = *(const GAS bf16x8*)(gs + offB + (size_t)s * strB); \
            _Pragma("unroll") for (int g = 0; g < 4; ++g) UV[g] = *(const GAS s16x4*)(gs + offU + (size_t)g * strU); \
            GLV = GL[un_]; } while (0)
#define GS_STEP(FA, UV, FB, GLV, cc) do { asm volatile("; SCAN_STEP_BEGIN"); \
            f32x16 acc = zero16(); \
            if (role < 2) { \
                _Pragma("unroll") for (int s = 0; s < 8; ++s) { const bf16x8 sb = *(const LAS bf16x8*)(L + GS_SB + r * GS_SB_LD + (16 * s + 8 * hh) * 2); acc = MFMA32(FA[s], sb, acc, 0, 0, 0); } } \
            if (role == 0) { \
                _Pragma("unroll") for (int g = 0; g < 4; ++g) { const float v0 = bf2f((unsigned short)UV[g][0]) - acc[4 * g], v1 = bf2f((unsigned short)UV[g][1]) - acc[4 * g + 1], v2 = bf2f((unsigned short)UV[g][2]) - acc[4 * g + 2], v3 = bf2f((unsigned short)UV[g][3]) - acc[4 * g + 3]; \
                    v2u w2; w2.x = pk2(v0, v1); w2.y = pk2(v2, v3); *(LAS v2u*)(L + GS_VN + r * GS_VN_LD + (32 * rt + 8 * g + 4 * hh) * 2) = w2; } } \
            LDS_WAIT(); if (!(dup_ && (MK_Y & 2))) __builtin_amdgcn_s_barrier(); asm volatile("" ::: "memory"); \
            if (role == 1) { \
                _Pragma("unroll") for (int s = 0; s < 4; ++s) { const bf16x8 vn = *(const LAS bf16x8*)(L + GS_VN + r * GS_VN_LD + (16 * s + 8 * hh) * 2); acc = MFMA32(FB[s], vn, acc, 0, 0, 0); } \
                float* op = OG + (mrow0 + (cc) * 64 + 32 * rt) * 512 + h * 128 + dv0 + r; \
                const int nreal = smp ? DECT : 64; \
                if (!(dup_ && (MK_Y & 1))) { _Pragma("unroll") for (int q = 0; q < 16; ++q) if (32 * rt + crow(q, hh) < nreal) op[(size_t)crow(q, hh) * 512] = acc[q]; } \
            } else if (role == 2) { \
                _Pragma("unroll") for (int q = 0; q < 16; ++q) Sacc[q] *= GLV; \
                _Pragma("unroll") for (int s = 0; s < 4; ++s) { const bf16x8 vn = *(const LAS bf16x8*)(L + GS_VN + r * GS_VN_LD + (16 * s + 8 * hh) * 2); Sacc = MFMA32(FB[s], vn, Sacc, 0, 0, 0); } \
                _Pragma("unroll") for (int g = 0; g < 4; ++g) { v2u w2; w2.x = pk2(Sacc[4 * g], Sacc[4 * g + 1]); w2.y = pk2(Sacc[4 * g + 2], Sacc[4 * g + 3]); *(LAS v2u*)(L + GS_SB + r * GS_SB_LD + (32 * rt + 8 * g + 4 * hh) * 2) = w2; } } \
            LDS_WAIT(); if (!(dup_ && (MK_Y & 2))) __builtin_amdgcn_s_barrier(); asm volatile("" ::: "memory"); } while (0)
        bf16x8 fa0[8], fa1[8], fb0[4], fb1[4]; s16x4 uv0[4], uv1[4]; float gl0 = 1.f, gl1 = 1.f;
        GS_LOAD(fa0, uv0, fb0, gl0, 0);
#pragma unroll 1
        for (int c = 0; c < nch; c += 2) {
            { const int cn = (c + 1 < nch) ? c + 1 : nch - 1; GS_LOAD(fa1, uv1, fb1, gl1, cn); }
            GS_STEP(fa0, uv0, fb0, gl0, c);
            if (c + 1 < nch) {
                { const int cn = (c + 2 < nch) ? c + 2 : nch - 1; GS_LOAD(fa0, uv0, fb0, gl0, cn); }
                GS_STEP(fa1, uv1, fb1, gl1, c + 1);
            }
        }
#undef GS_LOAD
#undef GS_STEP
        if (role == 2 && !(dup_ && (MK_Y & 1))) { float* so = F.out + (smp ? O_GS : O_GP) + ((size_t)(b * GH + h) * GDK + 32 * rt) * GDV + dv0 + r;
#pragma unroll
            for (int q = 0; q < 16; ++q) so[(size_t)crow(q, hh) * GDV] = Sacc[q]; }
    }
}
__device__ __forceinline__ void gdn_out_phase(Frame& F, const Args& A) {
    const int lane = lane_fresh(); const bf16* P = WSP(bf16, WS_P); const float* OG = WSP(float, WS_OG); bf16* CAT = WSP(bf16, WS_CAT);
    const int gw = F.bx * NWAVES + F.wave, NGW = F.G * NWAVES;
    const f32x4 nw0 = *(const GAS f32x4*)(A.in[17] + 8 * (lane & 15)), nw1 = *(const GAS f32x4*)(A.in[17] + 8 * (lane & 15) + 4);
    for (int m0 = gw; m0 < M; m0 += 4 * NGW) {
        f32x4 o0[4], o1[4]; v4u zz[4];
#pragma unroll
        for (int k = 0; k < 4; ++k) { const int m = m0 + k * NGW; const int mm = m < M ? m : m0;
            o0[k] = *(const GAS f32x4*)(OG + (size_t)mm * 512 + 8 * lane); o1[k] = *(const GAS f32x4*)(OG + (size_t)mm * 512 + 8 * lane + 4); zz[k] = *(const GAS v4u*)(P + (size_t)mm * INWP + C_Z + 8 * lane); }
#pragma unroll
        for (int k = 0; k < 4; ++k) { const int m = m0 + k * NGW;
            if (m < M) {
                float ss = (o0[k].x * o0[k].x + o0[k].y * o0[k].y) + (o0[k].z * o0[k].z + o0[k].w * o0[k].w) + (o1[k].x * o1[k].x + o1[k].y * o1[k].y) + (o1[k].z * o1[k].z + o1[k].w * o1[k].w);
                ss += dpp_movf(ss, 0); ss += dpp_movf(ss, 1); ss += dpp_movf(ss, 2); ss += dpp_movf(ss, 3);
                const float rs = 1.f / sqrtf(ss * (1.f / 128.f) + NORM_EPS);
                float z[8] = {bflo(zz[k].x), bfhi(zz[k].x), bflo(zz[k].y), bfhi(zz[k].y), bflo(zz[k].z), bfhi(zz[k].z), bflo(zz[k].w), bfhi(zz[k].w)};
                const float ov[8] = {o0[k].x, o0[k].y, o0[k].z, o0[k].w, o1[k].x, o1[k].y, o1[k].z, o1[k].w}; const float nwv[8] = {nw0.x, nw0.y, nw0.z, nw0.w, nw1.x, nw1.y, nw1.z, nw1.w};
                float r[8];
#pragma unroll
                for (int e = 0; e < 8; ++e) r[e] = ov[e] * rs * nwv[e] * (z[e] / (1.f + __expf(-z[e])));
                v4u w; w.x = pk2(r[0], r[1]); w.y = pk2(r[2], r[3]); w.z = pk2(r[4], r[5]); w.w = pk2(r[6], r[7]);
                *(GAS v4u*)(CAT + (size_t)m * D + 512 + 8 * lane) = w; } }
    }
}
#define MFMA32H __builtin_amdgcn_mfma_f32_32x32x16_f16
__device__ __forceinline__ unsigned f2key(float x) { unsigned b = __builtin_bit_cast(unsigned, x); if ((b << 1) == 0u) b = 0u; return (b & 0x80000000u) ? ~b : (b | 0x80000000u); }
__device__ __forceinline__ float key2f(unsigned k) { const unsigned b = (k & 0x80000000u) ? (k & 0x7fffffffu) : ~k; return __builtin_bit_cast(float, b); }
template <class Get>
__device__ __forceinline__ void wave_topk_threshold(const Get& get, int n, int lane, LAS unsigned* hist, unsigned& thr_key, int& tie_cut) {
    const int niter = (n + 63) >> 6;
    unsigned kmin = 0xffffffffu, kmax = 0u;
#pragma unroll 4
    for (int it = 0; it < niter; ++it) { const int idx = 64 * it + lane; if (idx < n) { const unsigned uk = f2key(get(idx)); kmin = uk < kmin ? uk : kmin; kmax = uk > kmax ? uk : kmax; } }
#pragma unroll
    for (int o = 1; o < 64; o <<= 1) { const unsigned a = (unsigned)__shfl_xor((int)kmin, o), b = (unsigned)__shfl_xor((int)kmax, o); kmin = a < kmin ? a : kmin; kmax = b > kmax ? b : kmax; }
    thr_key = kmax; tie_cut = KSEL - 1;
    if (kmax == kmin) return;
    unsigned base = kmin; int bits = 32 - __builtin_clz(kmax - kmin), kk = KSEL; unsigned cnt = (unsigned)n;
#pragma unroll 1
    while (bits > 0 && cnt > 64u) {
        const int shift = bits > 8 ? bits - 8 : 0;
        *(LAS v4u*)(hist + 4 * lane) = (v4u){0u, 0u, 0u, 0u};
        LDS_WAIT(); asm volatile("" ::: "memory");
#pragma unroll 4
        for (int it = 0; it < niter; ++it) { const int idx = 64 * it + lane;
            if (idx < n) { const unsigned uk = f2key(get(idx)); const unsigned rel = uk - base; if (uk >= base && (bits >= 32 || (rel >> bits) == 0u)) __hip_atomic_fetch_add(hist + (rel >> shift), 1u, __ATOMIC_RELAXED, __HIP_MEMORY_SCOPE_WORKGROUP); } }
        LDS_WAIT(); asm volatile("" ::: "memory");
        const v4u h4 = *(const LAS v4u*)(hist + 4 * lane);
        const unsigned tot = h4.x + h4.y + h4.z + h4.w; unsigned incl = tot;
#pragma unroll
        for (int o = 1; o < 64; o <<= 1) { const unsigned t = __shfl_down(incl, o); if (lane + o < 64) incl += t; }
        const unsigned excl = incl - tot, c3 = excl + h4.w, c2 = c3 + h4.z, c1 = c2 + h4.y, c0 = c1 + h4.x; const unsigned k_ = (unsigned)kk;
        int dj = -1; unsigned above = 0u, cn = 0u;
        if (excl < k_ && k_ <= c3) { dj = 3; above = excl; cn = h4.w; } else if (c3 < k_ && k_ <= c2) { dj = 2; above = c3; cn = h4.z; } else if (c2 < k_ && k_ <= c1) { dj = 1; above = c2; cn = h4.y; } else if (c1 < k_ && k_ <= c0) { dj = 0; above = c1; cn = h4.x; }
        const unsigned long long bm = __ballot(dj >= 0); const int src = bm ? __builtin_ctzll(bm) : 0;
        const unsigned digit = (unsigned)__shfl(4 * lane + dj, src); above = (unsigned)__shfl((int)above, src); cn = (unsigned)__shfl((int)cn, src);
        base += digit << shift; kk -= (int)above; cnt = cn; bits = shift;
    }
    if (bits == 0) {
        thr_key = base; tie_cut = 0x7fffffff;
        if ((int)cnt > kk) { int run = 0;
#pragma unroll 1
            for (int it = 0; it < niter; ++it) { const int idx = 64 * it + lane; const bool eq = idx < n && f2key(get(idx)) == base;
                unsigned long long bm = __ballot(eq); const int c = __builtin_popcountll(bm);
                if (run + c >= kk) { int skip = kk - run - 1; while (skip-- > 0) bm &= bm - 1; tie_cut = 64 * it + __builtin_ctzll(bm); break; }
                run += c; } }
        return;
    }
    { int run = 0;
#pragma unroll 4
      for (int it = 0; it < niter; ++it) { const int idx = 64 * it + lane; bool in = false; unsigned uk = 0u;
          if (idx < n) { uk = f2key(get(idx)); in = uk >= base && ((uk - base) >> bits) == 0u; }
          const unsigned long long bm = __ballot(in);
          if (in) { const int pos = run + __builtin_popcountll(bm & ((1ull << lane) - 1ull)); hist[pos] = uk; hist[64 + pos] = (unsigned)idx; }
          run += __builtin_popcountll(bm); } }
    LDS_WAIT(); asm volatile("" ::: "memory");
    const bool have = lane < (int)cnt; const unsigned my = have ? hist[lane] : 0u; const int myi = have ? (int)hist[64 + lane] : 0x7fffffff;
    int rank = 0; bool later_tie = false;
#pragma unroll 1
    for (int j = 0; j < (int)cnt; ++j) { const unsigned kj = hist[j]; const int ij = (int)hist[64 + j]; rank += (kj > my || (kj == my && ij < myi)) ? 1 : 0; later_tie = later_tie || (kj == my && ij > myi); }
    const unsigned long long hit = __ballot(have && rank == kk - 1); const int src = hit ? __builtin_ctzll(hit) : 0;
    thr_key = (unsigned)__shfl((int)my, src); const int cut = __shfl(myi, src); const int lt = __shfl(later_tie ? 1 : 0, src);
    tie_cut = lt ? cut : 0x7fffffff;
}
template <int NIT>
__device__ __forceinline__ void wave_topk_reg(const LAS float* row, int n, int lane, LAS unsigned* hist, unsigned& thr_key, int& tie_cut) {
    unsigned key[NIT]; unsigned kmin = 0xffffffffu, kmax = 0u;
#pragma unroll
    for (int i = 0; i < NIT; ++i) { const float x = row[64 * i + lane]; const unsigned uk = f2key(x); const bool ok = 64 * i + lane < n; key[i] = ok ? uk : 0u;
        kmin = (ok && uk < kmin) ? uk : kmin; kmax = (ok && uk > kmax) ? uk : kmax; }
    WAVE_REDUCE_U32(kmin, umin_); WAVE_REDUCE_U32(kmax, umax_);
    thr_key = kmax; tie_cut = KSEL - 1;
    if (kmax == kmin) return;
    unsigned base = kmin, kcap = kmax; int kk = KSEL; unsigned cnt = (unsigned)n;
#define TK_SCAN(DIGIT, ABOVE, CN) do { \
        const v4u h4 = *(const LAS v4u*)(hist + 4 * lane); \
        const unsigned tot = h4.x + h4.y + h4.z + h4.w; const unsigned incl = wave_suffix_sum(tot, lane); \
        const unsigned excl = incl - tot, c3 = excl + h4.w, c2 = c3 + h4.z, c1 = c2 + h4.y, c0 = c1 + h4.x; const unsigned k_ = (unsigned)kk; \
        int dj = -1; unsigned ab_ = 0u, cn_ = 0u; \
        if (excl < k_ && k_ <= c3) { dj = 3; ab_ = excl; cn_ = h4.w; } else if (c3 < k_ && k_ <= c2) { dj = 2; ab_ = c3; cn_ = h4.z; } else if (c2 < k_ && k_ <= c1) { dj = 1; ab_ = c2; cn_ = h4.y; } else if (c1 < k_ && k_ <= c0) { dj = 0; ab_ = c1; cn_ = h4.x; } \
        const unsigned long long bm_ = __ballot(dj >= 0); const int src_ = bm_ ? __builtin_ctzll(bm_) : 0; \
        DIGIT = (unsigned)__builtin_amdgcn_readlane(4 * lane + dj, src_); ABOVE = (unsigned)__builtin_amdgcn_readlane((int)ab_, src_); CN = (unsigned)__builtin_amdgcn_readlane((int)cn_, src_); } while (0)
    bool uselin = false; float lxmin = 0.f, lscale = 0.f; int ldig = 0;
    { const float xmin = key2f(kmin), range = key2f(kmax) - xmin;
      if (range > 1e-30f && range < 1e30f) {
          const float scale = 255.99f / range;
          *(LAS v4u*)(hist + 4 * lane) = (v4u){0u, 0u, 0u, 0u};
          LDS_WAIT(); asm volatile("" ::: "memory");
#pragma unroll
          for (int i = 0; i < NIT; ++i) { int d = (int)((key2f(key[i]) - xmin) * scale); d = d > 255 ? 255 : d; if (key[i] != 0u) __hip_atomic_fetch_add(hist + d, 1u, __ATOMIC_RELAXED, __HIP_MEMORY_SCOPE_WORKGROUP); }
          LDS_WAIT(); asm volatile("" ::: "memory");
          unsigned digit, above, cn; TK_SCAN(digit, above, cn);
          kk -= (int)above; cnt = cn; uselin = true; lxmin = xmin; lscale = scale; ldig = (int)digit;
          if (cnt > 64u) {
              uselin = false;
              unsigned k2min = 0xffffffffu, k2max = 0u;
#pragma unroll
              for (int i = 0; i < NIT; ++i) { int d = (int)((key2f(key[i]) - xmin) * scale); d = d > 255 ? 255 : d; const bool in = key[i] != 0u && d == (int)digit; k2min = (in && key[i] < k2min) ? key[i] : k2min; k2max = (in && key[i] > k2max) ? key[i] : k2max; }
              WAVE_REDUCE_U32(k2min, umin_); WAVE_REDUCE_U32(k2max, umax_);
              base = k2min; kcap = k2max; }
      } }
    int bits = (kcap == base) ? 0 : 32 - __builtin_clz(kcap - base);
#pragma unroll 1
    while (bits > 0 && cnt > 64u) {
        const int shift = bits > 8 ? bits - 8 : 0; const unsigned lim = bits >= 32 ? 0xffffffffu : ((1u << bits) - 1u);
        *(LAS v4u*)(hist + 4 * lane) = (v4u){0u, 0u, 0u, 0u};
        LDS_WAIT(); asm volatile("" ::: "memory");
#pragma unroll
        for (int i = 0; i < NIT; ++i) { const unsigned rel = key[i] - base; if (key[i] >= base && key[i] <= kcap && rel <= lim) __hip_atomic_fetch_add(hist + (rel >> shift), 1u, __ATOMIC_RELAXED, __HIP_MEMORY_SCOPE_WORKGROUP); }
        LDS_WAIT(); asm volatile("" ::: "memory");
        unsigned digit, above, cn; TK_SCAN(digit, above, cn);
        base += digit << shift; kk -= (int)above; cnt = cn; bits = shift;
    }
#undef TK_SCAN
    if (bits == 0) {
        thr_key = base; tie_cut = 0x7fffffff;
        if ((int)cnt > kk) { int run = 0; bool done = false;
#pragma unroll
            for (int i = 0; i < NIT; ++i) { unsigned long long bm = __ballot(key[i] == base); const int c = __builtin_popcountll(bm);
                if (!done && run + c >= kk) { int skip = kk - run - 1; while (skip-- > 0) bm &= bm - 1; tie_cut = 64 * i + __builtin_ctzll(bm); done = true; }
                run += c; } }
        return;
    }
    const unsigned lim = bits >= 32 ? 0xffffffffu : ((1u << bits) - 1u);
    { int run = 0;
#pragma unroll
      for (int i = 0; i < NIT; ++i) { const unsigned rel = key[i] - base; bool in;
          if (uselin) { int d = (int)((key2f(key[i]) - lxmin) * lscale); d = d > 255 ? 255 : d; in = key[i] != 0u && d == ldig; } else in = key[i] >= base && key[i] <= kcap && rel <= lim;
          const unsigned long long bm = __ballot(in);
          if (in) { const int pos = run + __builtin_popcountll(bm & ((1ull << lane) - 1ull)); hist[pos] = key[i]; hist[64 + pos] = (unsigned)(64 * i + lane); }
          run += __builtin_popcountll(bm); } }
    LDS_WAIT(); asm volatile("" ::: "memory");
    const bool have = lane < (int)cnt; const unsigned my = have ? hist[lane] : 0u; const int myi = have ? (int)hist[64 + lane] : 0x7fffffff;
    int rank = 0; bool later_tie = false;
#pragma unroll 1
    for (int j = 0; j < (int)cnt; ++j) { const unsigned kj = (unsigned)__builtin_amdgcn_readlane((int)my, j); const int ij = __builtin_amdgcn_readlane(myi, j);
        rank += (kj > my || (kj == my && ij < myi)) ? 1 : 0; later_tie = later_tie || (kj == my && ij > myi); }
    const unsigned long long hit = __ballot(have && rank == kk - 1); const int src = hit ? __builtin_ctzll(hit) : 0;
    thr_key = (unsigned)__builtin_amdgcn_readlane((int)my, src); const int cut = __builtin_amdgcn_readlane(myi, src); const int lt = __builtin_amdgcn_readlane(later_tie ? 1 : 0, src);
    tie_cut = lt ? cut : 0x7fffffff;
}
__device__ __forceinline__ int idx_row_q(int i) { return 2 * ((i >> 2) & 1) + (i >> 4); }
__device__ __forceinline__ int idx_row_h(int i) { return 4 * ((i >> 3) & 1) + (i & 3); }

constexpr int SC_LD = 2052;
constexpr int DP_SC = 0, DP_WI = 131328, DP_THR = 131840, DP_TIE = 131904, DP_HIST = 132096, DP_END = 140288;
static_assert(DP_END <= RING_BYTES, "DSA prompt LDS");
constexpr float QK_SCALE = 0.125f * 1.4426950408889634f;
__device__ __forceinline__ void dsa_prompt_unit(Frame& F, int b, int qt) {
    const int wave = F.wave; const int lane = lane_dep(qt); const int c = lane & 31, hh = lane >> 5;
    LAS unsigned char* L = F.lds + RING_OFF;
    LAS float* SC = (LAS float*)(L + DP_SC); LAS float* WIs = (LAS float*)(L + DP_WI); LAS float* THR = (LAS float*)(L + DP_THR); LAS int* TIE = (LAS int*)(L + DP_TIE);
    const f16* QIh = WSP(f16, WS_QI); const f16* KIh = WSP(f16, WS_KI); const float* WI = WSP(float, WS_WI);
    const bf16* Qb = WSP(bf16, WS_QB); const bf16* Kb = WSP(bf16, WS_KB); const bf16* VT = WSP(bf16, WS_VT); bf16* CAT = WSP(bf16, WS_CAT);
    const int q0 = 16 * qt; const size_t mb = (size_t)b * SEQ; const int Lk = q0 + 16, nkt = (Lk + 31) >> 5;
#pragma unroll 1
    for (int rep_a = 0; rep_a < (MK_X == 1 ? 2 : 1); ++rep_a) {
    if (wave == 0 && lane < 32) *(LAS f32x4*)(WIs + 4 * lane) = *(const GAS f32x4*)(WI + (mb + q0) * 8 + 4 * lane);
    {
        f16x8 aq[4][4];
#pragma unroll
        for (int rt4 = 0; rt4 < 4; ++rt4)
#pragma unroll
            for (int s = 0; s < 4; ++s) aq[rt4][s] = *(const GAS f16x8*)(QIh + (mb + q0 + 4 * rt4 + idx_row_q(c)) * 512 + idx_row_h(c) * 64 + 16 * s + 8 * hh);
        LDS_WAIT(); __syncthreads();
#define DA_LOAD(BK, kt_) do { _Pragma("unroll") for (int s = 0; s < 4; ++s) BK[s] = *(const GAS f16x8*)(KIh + (mb + 32 * (kt_) + c) * 64 + 16 * s + 8 * hh); } while (0)
#define DA_STEP(BK, kt_) do { const int key = 32 * (kt_) + c; \
            _Pragma("unroll") for (int rt4 = 0; rt4 < 4; ++rt4) { \
                f32x16 acc = zero16(); \
                _Pragma("unroll") for (int s = 0; s < 4; ++s) acc = MFMA32H(aq[rt4][s], BK[s], acc, 0, 0, 0); \
                const int ql0 = 4 * rt4 + 2 * hh; \
                const f32x4 w0 = *(const LAS f32x4*)(WIs + ql0 * 8), w1 = *(const LAS f32x4*)(WIs + ql0 * 8 + 4), w2 = *(const LAS f32x4*)(WIs + ql0 * 8 + 8), w3 = *(const LAS f32x4*)(WIs + ql0 * 8 + 12); \
                float s0 = w0.x * fmaxf(acc[0], 0.f) + w0.y * fmaxf(acc[1], 0.f) + w0.z * fmaxf(acc[2], 0.f) + w0.w * fmaxf(acc[3], 0.f) + w1.x * fmaxf(acc[4], 0.f) + w1.y * fmaxf(acc[5], 0.f) + w1.z * fmaxf(acc[6], 0.f) + w1.w * fmaxf(acc[7], 0.f); \
                float s1 = w2.x * fmaxf(acc[8], 0.f) + w2.y * fmaxf(acc[9], 0.f) + w2.z * fmaxf(acc[10], 0.f) + w2.w * fmaxf(acc[11], 0.f) + w3.x * fmaxf(acc[12], 0.f) + w3.y * fmaxf(acc[13], 0.f) + w3.z * fmaxf(acc[14], 0.f) + w3.w * fmaxf(acc[15], 0.f); \
                SC[ql0 * SC_LD + key] = (key <= q0 + ql0) ? s0 : -INFINITY; SC[(ql0 + 1) * SC_LD + key] = (key <= q0 + ql0 + 1) ? s1 : -INFINITY; } } while (0)
        { f16x8 bkA[4], bkB[4];
          if (wave < nkt) DA_LOAD(bkA, wave);
#pragma unroll 1
          for (int kt = wave; kt < nkt; kt += 2 * NWAVES) {
              if (kt + NWAVES < nkt) DA_LOAD(bkB, kt + NWAVES);
              DA_STEP(bkA, kt);
              if (kt + NWAVES < nkt) {
                  if (kt + 2 * NWAVES < nkt) DA_LOAD(bkA, kt + 2 * NWAVES);
                  DA_STEP(bkB, kt + NWAVES);
              }
          } }
#undef DA_LOAD
#undef DA_STEP
    }
    LDS_WAIT(); __syncthreads();
    }
#pragma unroll 1
    for (int rep_b = 0; rep_b < (MK_X == 2 ? 2 : 1); ++rep_b)
#pragma unroll 1
    for (int e = 0; e < 2; ++e) { const int ql = 2 * wave + e, n = q0 + ql + 1; unsigned tk = 0u; int tc = 0x7fffffff; float thr = -3.0e38f;
        if (n > KSEL) { const LAS float* row = SC + ql * SC_LD; LAS unsigned* hist = (LAS unsigned*)(L + DP_HIST) + wave * 256;
            if (MK_X != 6 && n <= 1024) wave_topk_reg<16>(row, n, lane, hist, tk, tc); else wave_topk_reg<32>(row, n, lane, hist, tk, tc);
            thr = key2f(tk); }
        if (lane == 0) { THR[ql] = thr; TIE[ql] = tc; } }
    LDS_WAIT(); __syncthreads();
    const int rt = wave & 3, kh = wave >> 2, g = rt >> 1, ql = 8 * (rt & 1) + (c >> 2), head = 4 * g + (c & 3), qpos = q0 + ql;
    bf16x8 bq[4];
#pragma unroll
    for (int s = 0; s < 4; ++s) bq[s] = *(const GAS bf16x8*)(Qb + (mb + qpos) * 512 + head * 64 + 16 * s + 8 * hh);
    const float thr = THR[ql]; const int tie = TIE[ql];
    float m_run = -INFINITY, l_run = 0.f; f32x16 O0 = zero16(), O1 = zero16();
    const bf16* vtb = VT + (((size_t)(b * 2 + g) * (SEQ / 32)) * 64 + c) * 32 + 16 * hh;
#define DP_LOAD(AK, V8, kt_) do { \
        _Pragma("unroll") for (int s = 0; s < 4; ++s) AK[s] = *(const GAS bf16x8*)(Kb + (mb + 32 * (kt_) + c) * 128 + g * 64 + 16 * s + 8 * hh); \
        _Pragma("unroll") for (int dt = 0; dt < 2; ++dt) _Pragma("unroll") for (int s2 = 0; s2 < 2; ++s2) \
            V8[dt][s2] = *(const GAS bf16x8*)(vtb + ((size_t)(kt_) * 64 + 32 * dt) * 32 + 8 * s2); } while (0)
#define DP_STEP(AK, V8, kt_) do { asm volatile("; DPSTEP_BEGIN"); \
        f32x16 acc = zero16(); \
        _Pragma("unroll") for (int s = 0; s < 4; ++s) acc = MFMA32(AK[s], bq[s], acc, 0, 0, 0); \
        float p[16]; float mx = -INFINITY; \
        if (notie) { \
            _Pragma("unroll") for (int g4 = 0; g4 < 4; ++g4) { const f32x4 scv = *(const LAS f32x4*)(SC + ql * SC_LD + 32 * (kt_) + 8 * g4 + 4 * hh); \
                _Pragma("unroll") for (int e = 0; e < 4; ++e) { const float s = (scv[e] >= thr) ? acc[4 * g4 + e] : -INFINITY; p[4 * g4 + e] = s; mx = fmaxf(mx, s); } } \
        } else { \
            _Pragma("unroll") for (int g4 = 0; g4 < 4; ++g4) { const f32x4 scv = *(const LAS f32x4*)(SC + ql * SC_LD + 32 * (kt_) + 8 * g4 + 4 * hh); \
                _Pragma("unroll") for (int e = 0; e < 4; ++e) { const int key = 32 * (kt_) + 8 * g4 + 4 * hh + e; const float sv = scv[e]; \
                    const bool sel = sv > thr || (sv == thr && key <= tie); \
                    const float s = sel ? acc[4 * g4 + e] : -INFINITY; p[4 * g4 + e] = s; mx = fmaxf(mx, s); } } } \
        mx = fmaxf(mx, __shfl_xor(mx, 32)); \
        const float m_new = fmaxf(m_run, mx), m_safe = (m_new == -INFINITY) ? 0.f : m_new; \
        float ps = 0.f; \
        _Pragma("unroll") for (int r = 0; r < 16; ++r) { p[r] = __builtin_amdgcn_exp2f(p[r] - m_safe); ps += p[r]; } \
        if (__any(m_new != m_run)) { const float alpha = __builtin_amdgcn_exp2f(m_run - m_safe); l_run *= alpha; \
            _Pragma("unroll") for (int r = 0; r < 16; ++r) { O0[r] *= alpha; O1[r] *= alpha; } } \
        l_run += ps; m_run = m_new; \
        _Pragma("unroll") for (int s2 = 0; s2 < 2; ++s2) { \
            v4u pw; pw.x = pg8::cvt_pk_bf16(p[8 * s2], p[8 * s2 + 1]); pw.y = pg8::cvt_pk_bf16(p[8 * s2 + 2], p[8 * s2 + 3]); pw.z = pg8::cvt_pk_bf16(p[8 * s2 + 4], p[8 * s2 + 5]); pw.w = pg8::cvt_pk_bf16(p[8 * s2 + 6], p[8 * s2 + 7]); \
            const bf16x8 pb = __builtin_bit_cast(bf16x8, pw); \
            O0 = MFMA32(V8[0][s2], pb, O0, 0, 0, 0); O1 = MFMA32(V8[1][s2], pb, O1, 0, 0, 0); } } while (0)
    { bf16x8 akA[4], akB[4], akC[4]; bf16x8 v8A[2][2], v8B[2][2], v8C[2][2];
      const bool notie = __all(tie == 0x7fffffff);
      if (kh < nkt) DP_LOAD(akA, v8A, kh);
      if (kh + 2 < nkt) DP_LOAD(akB, v8B, kh + 2);
#pragma unroll 1
      for (int kt = kh; kt < nkt; kt += 6) {
          if (kt + 4 < nkt) DP_LOAD(akC, v8C, kt + 4);
          DP_STEP(akA, v8A, kt);
          if (kt + 2 < nkt) {
              if (kt + 6 < nkt) DP_LOAD(akA, v8A, kt + 6);
              DP_STEP(akB, v8B, kt + 2);
              if (kt + 4 < nkt) {
                  if (kt + 8 < nkt) DP_LOAD(akB, v8B, kt + 8);
                  DP_STEP(akC, v8C, kt + 4);
              }
          }
      } }
#undef DP_LOAD
#undef DP_STEP
    l_run += __shfl_xor(l_run, 32);
    __syncthreads();
    LAS float* CB = (LAS float*)(L + DP_SC) + rt * (34 * 64);
    if (kh == 1) { CB[lane] = m_run; CB[64 + lane] = l_run;
#pragma unroll
        for (int r = 0; r < 16; ++r) { CB[(2 + r) * 64 + lane] = O0[r]; CB[(18 + r) * 64 + lane] = O1[r]; } }
    LDS_WAIT(); __syncthreads();
    if (kh == 0) {
        const float m1 = CB[lane], l1 = CB[64 + lane]; const float m = fmaxf(m_run, m1), ms = (m == -INFINITY) ? 0.f : m;
        const float a0 = __builtin_amdgcn_exp2f(m_run - ms), a1 = __builtin_amdgcn_exp2f(m1 - ms); const float inv = 1.f / (l_run * a0 + l1 * a1);
        bf16* op = CAT + (mb + qpos) * D + head * 64 + 4 * hh;
#pragma unroll
        for (int g4 = 0; g4 < 4; ++g4) { float o[8];
#pragma unroll
            for (int e = 0; e < 4; ++e) { o[e] = (O0[4 * g4 + e] * a0 + CB[(2 + 4 * g4 + e) * 64 + lane] * a1) * inv; o[4 + e] = (O1[4 * g4 + e] * a0 + CB[(18 + 4 * g4 + e) * 64 + lane] * a1) * inv; }
            v2u w0; w0.x = pk2(o[0], o[1]); w0.y = pk2(o[2], o[3]); *(GAS v2u*)(op + 8 * g4) = w0;
            v2u w1; w1.x = pk2(o[4], o[5]); w1.y = pk2(o[6], o[7]); *(GAS v2u*)(op + 32 + 8 * g4) = w1; }
    }
    LDS_WAIT(); __syncthreads();
}
__device__ __forceinline__ void dsa_prompt_phase(Frame& F) {
    for (int w0 = F.bx; w0 < 256; w0 += F.G) { const int w = ((w0 & 7) << 5) | (w0 >> 3);
        const int b = w >> 4, sub = w & 15;
#pragma unroll 1
        for (int j = 0; j < 8; ++j) { const int qt = 32 * (j >> 1) + ((j & 1) ? 31 - sub : sub); dsa_prompt_unit(F, b, qt); } }
}
__device__ __forceinline__ void dsa_sample_scores_phase(Frame& F, const Args& A) {
    const int wave = F.wave;
    const f16* QIh = WSP(f16, WS_QI); const f16* KIh = WSP(f16, WS_KI); const float* WI = WSP(float, WS_WI); float* SCS = WSP(float, WS_SCS);
    const float* ckidx = A.in[4]; const int* ptab = (const int*)A.in[7];
    const int kt4 = wave & 3, rt2 = wave >> 2;
    { const int lane = lane_fresh(); const int c = lane & 31, hh = lane >> 5; const int NU = DECB * NPAGES;
      LAS unsigned char* L = F.lds + RING_OFF + wave * 4608;
      f32x4 xa[8], xb[8];
#define D1_GLOAD(X, u_) do { const int kk_ = ((u_) - u0 < per) ? (u_) - u0 : per - 1; const int phys = phl[kk_]; const GAS f32x4* src = (const GAS f32x4*)(ckidx + ((size_t)phys * PAGE + 32 * kt4) * 64); \
        _Pragma("unroll") for (int i = 0; i < 8; ++i) X[i] = src[lane + 64 * i]; } while (0)
#define D1_STEP(X, u_) do { \
        _Pragma("unroll") for (int i = 0; i < 8; ++i) { const int idx = lane + 64 * i, key = idx >> 4, d4 = idx & 15; \
            typedef _Float16 f16x4_ __attribute__((ext_vector_type(4))); f16x4_ h; h[0] = (f16)X[i].x; h[1] = (f16)X[i].y; h[2] = (f16)X[i].z; h[3] = (f16)X[i].w; \
            *(LAS f16x4_*)(L + key * 144 + d4 * 8) = h; } \
        LDS_WAIT(); asm volatile("" ::: "memory"); \
        const int bs = (u_) >> 6, j = (u_) & 63; const size_t ms = (size_t)MP + (size_t)bs * DECT; \
        f16x8 bk[4]; \
        _Pragma("unroll") for (int s = 0; s < 4; ++s) bk[s] = *(const LAS f16x8*)(L + c * 144 + (16 * s + 8 * hh) * 2); \
        LDS_WAIT(); asm volatile("" ::: "memory"); \
        const int ql0 = 4 * rt2 + 2 * hh; \
        if (bs != bs_cur) { bs_cur = bs; \
            _Pragma("unroll") for (int s = 0; s < 4; ++s) aq[s] = *(const GAS f16x8*)(QIh + (ms + 4 * rt2 + idx_row_q(c)) * 512 + idx_row_h(c) * 64 + 16 * s + 8 * hh); \
            const GAS f32x4* wp = (const GAS f32x4*)(WI + (ms + ql0) * 8); w0 = wp[0]; w1 = wp[1]; w2 = wp[2]; w3 = wp[3]; } \
        f32x16 acc = zero16(); \
        _Pragma("unroll") for (int s = 0; s < 4; ++s) acc = MFMA32H(aq[s], bk[s], acc, 0, 0, 0); \
        const float s0 = w0.x * fmaxf(acc[0], 0.f) + w0.y * fmaxf(acc[1], 0.f) + w0.z * fmaxf(acc[2], 0.f) + w0.w * fmaxf(acc[3], 0.f) + w1.x * fmaxf(acc[4], 0.f) + w1.y * fmaxf(acc[5], 0.f) + w1.z * fmaxf(acc[6], 0.f) + w1.w * fmaxf(acc[7], 0.f); \
        const float s1 = w2.x * fmaxf(acc[8], 0.f) + w2.y * fmaxf(acc[9], 0.f) + w2.z * fmaxf(acc[10], 0.f) + w2.w * fmaxf(acc[11], 0.f) + w3.x * fmaxf(acc[12], 0.f) + w3.y * fmaxf(acc[13], 0.f) + w3.z * fmaxf(acc[14], 0.f) + w3.w * fmaxf(acc[15], 0.f); \
        const int key = PAGE * j + 32 * kt4 + c; \
        SCS[((size_t)bs * DECT + ql0) * SCS_LD + key] = s0; SCS[((size_t)bs * DECT + ql0 + 1) * SCS_LD + key] = s1; } while (0)
      const int per = (NU + F.G - 1) / F.G, u0 = F.bx * per, u1 = (u0 + per < NU) ? u0 + per : NU;
      LAS int* phl = (LAS int*)(F.lds + RING_OFF + 8 * 4608);
      for (int k = wave * 64 + lane; k < per; k += NTHR) { const int uu = (u0 + k < NU) ? u0 + k : NU - 1; phl[k] = ptab[(uu >> 6) * NPAGES + (uu & 63)]; }
      LDS_WAIT(); __syncthreads();
      int bs_cur = -1; f16x8 aq[4]; f32x4 w0, w1, w2, w3; f32x4 xc[8], xd[8];
      D1_GLOAD(xa, u0); D1_GLOAD(xb, u0 + 1); D1_GLOAD(xc, u0 + 2); D1_GLOAD(xd, u0 + 3);
#pragma unroll 1
      for (int u = u0; u < u1; u += 4) {
          D1_STEP(xa, u); D1_GLOAD(xa, u + 4);
          if (u + 1 < u1) { D1_STEP(xb, u + 1); D1_GLOAD(xb, u + 5); }
          if (u + 2 < u1) { D1_STEP(xc, u + 2); D1_GLOAD(xc, u + 6); }
          if (u + 3 < u1) { D1_STEP(xd, u + 3); D1_GLOAD(xd, u + 7); }
      }
#undef D1_GLOAD
#undef D1_STEP
    }
    __syncthreads();
#pragma unroll 1
    for (int bs = F.bx * NWAVES + wave; bs < DECB; bs += F.G * NWAVES) {
        const int lane = lane_dep(bs); const int t = lane >> 3, t2 = lane & 7; const size_t ms = (size_t)MP + (size_t)bs * DECT;
        float sc = 0.f;
#pragma unroll 1
        for (int h = 0; h < 8; ++h) { float d = 0.f;
#pragma unroll 8
            for (int e = 0; e < 64; ++e) d += (float)QIh[(ms + t) * 512 + h * 64 + e] * (float)KIh[(ms + t2) * 64 + e];
            sc += WI[(ms + t) * 8 + h] * fmaxf(d, 0.f); }
        SCS[((size_t)bs * DECT + t) * SCS_LD + PAST + t2] = (t2 <= t) ? sc : -INFINITY;
    }
}
constexpr int DS_ROW = 0, DS_HIST = 32832, DS_LIST = 33856, DS_RID = 34880, DS_WAVE = 35904;
static_assert(4 * DS_WAVE <= RING_BYTES, "DSA sample LDS");
__device__ __forceinline__ void dsa_sample_attend_phase(Frame& F, const Args& A) {
    const int wave = F.wave;
    if (wave >= 4) return;
    LAS unsigned char* L = F.lds + RING_OFF + wave * DS_WAVE;
    LAS float* rowl = (LAS float*)(L + DS_ROW); LAS unsigned* hist = (LAS unsigned*)(L + DS_HIST); LAS int* list = (LAS int*)(L + DS_LIST); LAS int* rowid = (LAS int*)(L + DS_RID);
    LAS float* qv = rowl; LAS float* sc = rowl + 512;
    const float* SCS = WSP(float, WS_SCS); const bf16* Qb = WSP(bf16, WS_QB); bf16* CAT = WSP(bf16, WS_CAT);
    const float* ck = A.in[2]; const float* cv = A.in[3]; const int* ptab = (const int*)A.in[7];
#pragma unroll 1
    for (int qi = wave * F.G + F.bx; qi < MS; qi += 4 * F.G) {
        const int lane = lane_dep(qi);
        const int bs = qi >> 3, t = qi & 7, n = PAST + t + 1; const size_t m = (size_t)MP + qi;
        { const GAS f32x4* src = (const GAS f32x4*)(SCS + (size_t)qi * SCS_LD);
#pragma unroll 1
          for (int k0 = 0; k0 < 33; k0 += 11) { f32x4 tmp[11];
#pragma unroll
              for (int k = 0; k < 11; ++k) { const int i4 = lane + 64 * (k0 + k); tmp[k] = (i4 < SCS_LD / 4) ? src[i4] : (f32x4){0.f, 0.f, 0.f, 0.f}; }
#pragma unroll
              for (int k = 0; k < 11; ++k) { const int i4 = lane + 64 * (k0 + k); if (i4 < SCS_LD / 4) *(LAS f32x4*)(rowl + 4 * i4) = tmp[k]; } } }
        LDS_WAIT(); asm volatile("" ::: "memory");
        unsigned tk; int tc;
        wave_topk_reg<(LS + 63) / 64>(rowl, n, lane, hist, tk, tc);
        int cnt = 0;
#pragma unroll 1
        for (int it = 0; it < (n + 63) / 64; ++it) { const int idx = 64 * it + lane; bool sel = false;
            if (idx < n) { const unsigned uk = f2key(rowl[idx]); sel = uk > tk || (uk == tk && idx <= tc); }
            const unsigned long long bm = __ballot(sel); const int pos = cnt + __builtin_popcountll(bm & ((1ull << lane) - 1ull));
            if (sel && pos < KSEL) list[pos] = idx;
            cnt += __builtin_popcountll(bm); }
        LDS_WAIT(); asm volatile("" ::: "memory");
#pragma unroll
        for (int e = 0; e < 4; ++e) { const unsigned qq = *(const GAS unsigned*)(Qb + m * 512 + 128 * e + 2 * lane); qv[128 * e + 2 * lane] = bflo(qq); qv[128 * e + 2 * lane + 1] = bfhi(qq); }
        LDS_WAIT(); asm volatile("" ::: "memory");
        float mxh[8];
#pragma unroll
        for (int h = 0; h < 8; ++h) mxh[h] = -INFINITY;
#pragma unroll 1
        for (int p = 0; p < 4; ++p) { const int jj = 64 * p + lane; const int idx = list[jj];
            const float* kp; int rid;
            if (idx < PAST) { rid = ptab[bs * NPAGES + (idx >> 7)] * PAGE + (idx & 127); kp = ck + (size_t)rid * 128; }
            else { rid = -(idx - PAST) - 1; kp = F.out + O_KS + ((size_t)bs * DECT + (idx - PAST)) * 128; }
            rowid[jj] = rid;
            f32x4 kr[32];
#pragma unroll
            for (int e = 0; e < 32; ++e) kr[e] = *(const GAS f32x4*)(kp + 4 * e);
            float s[8];
#pragma unroll
            for (int h = 0; h < 8; ++h) s[h] = 0.f;
#pragma unroll
            for (int g = 0; g < 2; ++g)
#pragma unroll
                for (int d4 = 0; d4 < 16; ++d4) { const f32x4 kv = kr[16 * g + d4];
#pragma unroll
                    for (int hl = 0; hl < 4; ++hl) { const f32x4 q4 = *(const LAS f32x4*)(qv + (4 * g + hl) * 64 + 4 * d4); s[4 * g + hl] += kv.x * q4.x + kv.y * q4.y + kv.z * q4.z + kv.w * q4.w; } }
#pragma unroll
            for (int h = 0; h < 8; ++h) { const float v = s[h];   sc[h * 256 + jj] = v; mxh[h] = fmaxf(mxh[h], v); } }
        LDS_WAIT(); asm volatile("" ::: "memory");
        float invl[8];
#pragma unroll
        for (int h = 0; h < 8; ++h) { const float mm = wave_max(mxh[h]); float ps = 0.f;
#pragma unroll
            for (int p = 0; p < 4; ++p) { const float e = __builtin_amdgcn_exp2f(sc[h * 256 + 64 * p + lane] - mm); sc[h * 256 + 64 * p + lane] = e; ps += e; }
            invl[h] = 1.f / wave_sum(ps); }
        LDS_WAIT(); asm volatile("" ::: "memory");
        const int g = lane >> 5, dp = lane & 31; float o[4][2];
#pragma unroll
        for (int hl = 0; hl < 4; ++hl) { o[hl][0] = 0.f; o[hl][1] = 0.f; }
#pragma unroll 1
        for (int j0 = 0; j0 < KSEL; j0 += 32) { f32x2 vv[32];
#pragma unroll
            for (int e = 0; e < 32; ++e) { const int rid = __builtin_amdgcn_readfirstlane(rowid[j0 + e]);
                const float* vp = (rid >= 0) ? cv + (size_t)rid * 128 : F.out + O_VS + ((size_t)bs * DECT + (-rid - 1)) * 128;
                vv[e] = *(const GAS f32x2*)(vp + 64 * g + 2 * dp); }
#pragma unroll
            for (int e = 0; e < 32; ++e)
#pragma unroll
                for (int hl = 0; hl < 4; ++hl) { const float pp = sc[(4 * g + hl) * 256 + j0 + e]; o[hl][0] += pp * vv[e].x; o[hl][1] += pp * vv[e].y; } }
#pragma unroll
        for (int hl = 0; hl < 4; ++hl) { const float il = (g == 0) ? invl[hl] : invl[4 + hl];
            *(GAS unsigned*)(CAT + m * D + (4 * g + hl) * 64 + 2 * dp) = pk2(o[hl][0] * il, o[hl][1] * il); }
        LDS_WAIT(); asm volatile("" ::: "memory");
    }
}
#if MK_DIAG
constexpr int CW_DG = 2048;
__device__ __forceinline__ void dg_add(Frame& F, int k, float num, float den) {
    LAS float* red = (LAS float*)(F.lds + RING_OFF + 140000);
    __syncthreads(); if ((int)threadIdx.x < 2) red[(int)threadIdx.x] = 0.f; __syncthreads();
    atomicAdd((float*)&red[0], num); atomicAdd((float*)&red[1], den); __syncthreads();
    if ((int)threadIdx.x == 0) { atomicAdd((float*)(F.ctl + CW_DG + 2 * k), red[0]); atomicAdd((float*)(F.ctl + CW_DG + 2 * k + 1), red[1]); }
    __syncthreads();
}
__device__ __forceinline__ int dg_row(int i) { const int rows[8] = {0, 777, 2047, 2048, 20000, 32767, 32768, 33791}; int r = 0;
#pragma unroll
    for (int j = 0; j < 8; ++j) r = (i == j) ? rows[j] : r; return r; }
__device__ __forceinline__ void chk_ffn(Frame& F, const float* x0, const float* x1, int split, const float* Wg, const float* Wu, const float* Wd, const float* lg, const float* lb, const float* Xout, int ch) {
    if (F.bx >= 8) return;
    const int row = dg_row(F.bx), tid = (int)threadIdx.x;
    LAS float* xs = (LAS float*)(F.lds + RING_OFF); LAS float* hs = xs + 1024; LAS float* rs = hs + 2816;
    const float* xr = row < split ? x0 + (size_t)row * D : x1 + (size_t)(row - split) * D;
    for (int c = tid; c < D; c += NTHR) xs[c] = xr[c];
    __syncthreads();
    for (int j = tid; j < FF; j += NTHR) { float g = 0.f, u = 0.f; for (int k = 0; k < D; ++k) { g += xs[k] * Wg[(size_t)k * FF + j]; u += xs[k] * Wu[(size_t)k * FF + j]; } hs[j] = g / (1.f + expf(-g)) * u; }
    __syncthreads();
    for (int c = tid; c < D; c += NTHR) { float y = 0.f; for (int j = 0; j < FF; ++j) y += hs[j] * Wd[(size_t)j * D + c]; rs[c] = ALPHA * xs[c] + 0.5f * y; }
    __syncthreads();
    float mean = 0.f; for (int c = 0; c < D; ++c) mean += rs[c]; mean *= (1.f / D);
    float var = 0.f; for (int c = 0; c < D; ++c) { const float d = rs[c] - mean; var += d * d; } var *= (1.f / D);
    const float rstd = 1.f / sqrtf(var + LN_EPS);
    float num = 0.f, den = 0.f;
    for (int c = tid; c < D; c += NTHR) { const float ref = (rs[c] - mean) * rstd * lg[c] + lb[c]; const float d = Xout[(size_t)row * D + c] - ref; num += d * d; den += ref * ref; }
    dg_add(F, ch, num, den);
}
__device__ __forceinline__ void chk_proj(Frame& F, const float* X1, const float* Win, const bf16* P, int ch) {
    if (F.bx >= 8) return;
    const int row = dg_row(F.bx), tid = (int)threadIdx.x;
    LAS float* xs = (LAS float*)(F.lds + RING_OFF);
    for (int c = tid; c < D; c += NTHR) xs[c] = X1[(size_t)row * D + c];
    __syncthreads();
    float num = 0.f, den = 0.f;
    for (int c = tid; c < INW; c += NTHR) { float p = 0.f; for (int k = 0; k < D; ++k) p += xs[k] * Win[(size_t)k * INW + c]; const float d = bf2f(P[(size_t)row * INWP + c]) - p; num += d * d; den += p * p; }
    dg_add(F, ch, num, den);
}

__device__ __forceinline__ void chk_gdn(Frame& F, const Args& A, bool sample, int b, int h, int ch_o, int ch_s) {
    const int tid = (int)threadIdx.x;
    LAS float* S = (LAS float*)(F.lds + RING_OFF); LAS float* y = S + 16384; LAS float* qn = y + 384; LAS float* kn = qn + 128; LAS float* rv = kn + 128;
    const bf16* P = WSP(bf16, WS_P); const float* BG = WSP(float, WS_BG); const float* OG = WSP(float, WS_OG); const float* cw = A.in[14];
    const int T = sample ? DECT : SEQ; const size_t m0 = sample ? (size_t)MP + b * DECT : (size_t)b * SEQ;
    const float* st_in = A.in[5] + (size_t)(b * GH + h) * GDK * GDV; const float* st_out = F.out + (sample ? O_GS : O_GP) + (size_t)(b * GH + h) * GDK * GDV;
    for (int e = tid; e < 16384; e += NTHR) S[e] = sample ? st_in[e] : 0.f;
    float no = 0.f, dn = 0.f;
    __syncthreads();
    for (int t = 0; t < T; ++t) {
        const size_t m = m0 + t;
        if (tid < 384) { const int col = (tid < 128) ? h * 128 + tid : (tid < 256) ? 512 + h * 128 + (tid - 128) : 1024 + h * 128 + (tid - 256); float a = 0.f;
            for (int j = 0; j < 4; ++j) { const int rr = t + j; float x;
                if (rr < 3) x = sample ? A.in[6][((size_t)b * 3 + rr) * CONVC + col] : 0.f; else x = bf2f(P[(m0 + rr - 3) * INWP + C_QKV + col]);
                a += cw[j * CONVC + col] * x; }
            y[tid] = a / (1.f + expf(-a)); }
        __syncthreads();
        float sq = 0.f, sk = 0.f; for (int i = 0; i < 128; ++i) { sq += y[i] * y[i]; sk += y[128 + i] * y[128 + i]; }
        const float rq = 1.f / sqrtf(sq + NORM_EPS), rk = 1.f / sqrtf(sk + NORM_EPS);
        if (tid < 128) { qn[tid] = y[tid] * rq; kn[tid] = y[128 + tid] * rk; }
        __syncthreads();
        const float be = BG[m * 8 + h], a = expf(BG[m * 8 + 4 + h]);
        if (tid < 128) { float part = 0.f; for (int dk = 0; dk < 128; ++dk) part += a * S[dk * 128 + tid] * kn[dk]; rv[tid] = (y[256 + tid] - part) * be; }
        __syncthreads();
        for (int e = tid; e < 16384; e += NTHR) S[e] = a * S[e] + kn[e >> 7] * rv[e & 127];
        __syncthreads();
        if (tid < 128) { float o = 0.f; for (int dk = 0; dk < 128; ++dk) o += S[dk * 128 + tid] * qn[dk]; o *= 0.08838834764831845f;
            const float d = OG[m * 512 + h * 128 + tid] - o; no += d * d; dn += o * o; }
        __syncthreads();
    }
    float ns = 0.f, ds = 0.f;
    for (int e = tid; e < 16384; e += NTHR) { const float d = st_out[e] - S[e]; ns += d * d; ds += S[e] * S[e]; }
    dg_add(F, ch_o, no, dn); dg_add(F, ch_s, ns, ds);
}

__device__ __forceinline__ void chk_dsa(Frame& F, const Args& A, bool sample, int b, int t, int ch) {
    const int tid = (int)threadIdx.x;
    LAS float* sc = (LAS float*)(F.lds + RING_OFF); LAS unsigned char* sel = (LAS unsigned char*)(sc + 8208); LAS float* qs = (LAS float*)(sel + 8208);
    const f16* QIh = WSP(f16, WS_QI); const f16* KIh = WSP(f16, WS_KI); const float* WI = WSP(float, WS_WI); const bf16* Qb = WSP(bf16, WS_QB); const bf16* Kb = WSP(bf16, WS_KB); const bf16* P = WSP(bf16, WS_P); const bf16* CAT = WSP(bf16, WS_CAT);
    const int* ptab = (const int*)A.in[7];
    const size_t m = sample ? (size_t)MP + b * DECT + t : (size_t)b * SEQ + t; const int n = sample ? PAST + t + 1 : t + 1;
    for (int l = tid; l < n; l += NTHR) { float s = 0.f;
        for (int h = 0; h < 8; ++h) { float d = 0.f;
            for (int e = 0; e < 64; ++e) { float kv;
                if (sample) { if (l < PAST) kv = (float)(f16)A.in[4][((size_t)ptab[b * NPAGES + (l >> 7)] * PAGE + (l & 127)) * 64 + e]; else kv = (float)KIh[((size_t)MP + b * DECT + (l - PAST)) * 64 + e]; }
                else kv = (float)KIh[((size_t)b * SEQ + l) * 64 + e];
                d += (float)QIh[m * 512 + h * 64 + e] * kv; }
            s += WI[m * 8 + h] * fmaxf(d, 0.f); }
        if (s == 0.f) s = 0.f;
        sc[l] = s; }
    for (int e = tid; e < 512; e += NTHR) qs[e] = bf2f(Qb[m * 512 + e]);
    __syncthreads();
    for (int l = tid; l < n; l += NTHR) { const float x = sc[l]; int rank = 0; for (int l2 = 0; l2 < n; ++l2) { const float y = sc[l2]; rank += (y > x || (y == x && l2 < l)) ? 1 : 0; } sel[l] = rank < KSEL ? 1 : 0; }
    __syncthreads();
    const int h = tid >> 6, d = tid & 63, g = h >> 2; float mx = -INFINITY;
    for (int pass = 0; pass < 2; ++pass) { float lsum = 0.f, o = 0.f;
        for (int l = 0; l < n; ++l) { if (!sel[l]) continue; float dot = 0.f; float vv;
            if (sample) { const float* kp; const float* vp;
                if (l < PAST) { const size_t rid = (size_t)ptab[b * NPAGES + (l >> 7)] * PAGE + (l & 127); kp = A.in[2] + rid * 128; vp = A.in[3] + rid * 128; }
                else { kp = F.out + O_KS + ((size_t)b * DECT + (l - PAST)) * 128; vp = F.out + O_VS + ((size_t)b * DECT + (l - PAST)) * 128; }
                for (int e = 0; e < 64; ++e) dot += qs[h * 64 + e] * kp[g * 64 + e]; vv = vp[g * 64 + d];
            } else { const size_t mk = (size_t)b * SEQ + l; for (int e = 0; e < 64; ++e) dot += qs[h * 64 + e] * bf2f(Kb[mk * 128 + g * 64 + e]); vv = bf2f(P[mk * INWP + C_V + g * 64 + d]); }
            dot *= 0.6931471805599453f;
            if (pass == 0) mx = fmaxf(mx, dot); else { const float p = expf(dot - mx); lsum += p; o += p * vv; } }
        if (pass == 1) { const float ref = o / lsum; const float dd = bf2f(CAT[m * D + h * 64 + d]) - ref; dg_add(F, ch, dd * dd, ref * ref); } }
}
__device__ __forceinline__ void dg_report(Frame& F) {
    if (F.bx != 0 || (int)threadIdx.x >= 12) return;
    const size_t offs[12] = {O_YP, O_YS, O_KP, O_VP, O_IP, O_GP, O_CP, O_KS, O_VS, O_IS, O_GS, O_CS};
    size_t off = 0;
#pragma unroll
    for (int j = 0; j < 12; ++j) off = ((int)threadIdx.x == j) ? offs[j] : off;
    const float num = __hip_atomic_load((float*)(F.ctl + CW_DG + 2 * (int)threadIdx.x), RLX_AGENT), den = __hip_atomic_load((float*)(F.ctl + CW_DG + 2 * (int)threadIdx.x + 1), RLX_AGENT);
    int n = 99;
    if (den > 0.f) { const float e = sqrtf(num / den); const float L = -log10f(fmaxf(e, 1e-9f)); n = 1 + (int)(10.f * fmaxf(L, 0.f) + 0.5f); n = n > 98 ? 98 : n; if (!(e == e)) n = 1; }
    for (int i = 0; i < n; ++i) ((unsigned*)F.out)[off + i] = 0xAAAAAAAAu;
}
#endif

#if MK_DIAG == 2
constexpr int CW_TS = 3072;
__device__ __forceinline__ void ts_stamp(Frame& F, int k) { if (F.bx == 0 && F.wave == 0 && lane_fresh() == 0) { const unsigned long long t = __builtin_amdgcn_s_memrealtime(); F.ctl[CW_TS + 2 * k] = (unsigned)t; F.ctl[CW_TS + 2 * k + 1] = (unsigned)(t >> 32); } }
__device__ __forceinline__ void ts_report(Frame& F) {
    if (F.bx != 0 || F.wave != 0) return; const int lane = lane_fresh(); if (lane >= 12) return;
    const size_t offs[12] = {O_YP, O_YS, O_KP, O_VP, O_IP, O_GP, O_CP, O_KS, O_VS, O_IS, O_GS, O_CS};
    const int lo[12] = TS_LO; const int hi[12] = TS_HI;
    size_t off = 0; int a = 0, b = 0;
#pragma unroll
    for (int j = 0; j < 12; ++j) { off = (lane == j) ? offs[j] : off; a = (lane == j) ? lo[j] : a; b = (lane == j) ? hi[j] : b; }
    const unsigned long long t0 = (unsigned long long)F.ctl[CW_TS + 2 * a] | ((unsigned long long)F.ctl[CW_TS + 2 * a + 1] << 32), t1 = (unsigned long long)F.ctl[CW_TS + 2 * b] | ((unsigned long long)F.ctl[CW_TS + 2 * b + 1] << 32);
    int n = (int)((t1 - t0) / 100ull); n = n < 1 ? 1 : (n > 60000 ? 60000 : n);
    for (int i = 0; i < n; ++i) ((unsigned*)F.out)[off + i] = 0xAAAAAAAAu;
}
#endif
#ifndef MK_ONE_LAUNCH
#define MK_ONE_LAUNCH 0
#endif
constexpr int NPH = 14 + (MK_DIAG == 1 ? 2 : MK_DIAG == 2 ? 1 : 0);
__global__ void __launch_bounds__(NTHR, 2) mk_fwd(Args args) {
    extern __shared__ __attribute__((aligned(16))) unsigned char lds[];
    Frame F;
    F.lds = (LAS unsigned char*)lds; F.MISC = (volatile LAS unsigned*)(F.lds + MISC_OFF);
    F.wave = __builtin_amdgcn_readfirstlane(threadIdx.x >> 6); F.G = gridDim.x; F.bx = blockIdx.x;
    F.out = args.out; F.ws = args.ws; F.ctl = (gu32*)(args.ws + WS_CTL);
    for (int u = F.wave * 64 + lane_fresh(); u < (LDS_BYTES - LDSCTL_OFF) / 4; u += NTHR) ((LAS unsigned*)(F.lds + LDSCTL_OFF))[u] = 0u;
    __syncthreads();
    XcdBarrier bar; bar.wave = F.wave; bar.bar = (unsigned*)(F.ctl + CW_BAR); bar.x = 0; bar.st = nullptr;
    if (MK_ONE_LAUNCH) bar = xcd_barrier_post((unsigned*)(F.ctl + CW_BAR), F.MISC + 8, F.wave);
    const int lo = args.ph_lo, hi = args.ph_hi;
#define IN(k) (lo <= (k) && (k) < hi)
#define PHASE(k, ...) do { if (IN(k)) { __VA_ARGS__ } if (MK_DUP == (k)) { xcd_barrier(bar); __VA_ARGS__ } SEAM(k); } while (0)
#if MK_DIAG == 2
#define SEAM(k) do { if (IN(k) && IN((k) + 1)) xcd_barrier(bar); ts_stamp(F, (k) + 1); } while (0)
#else
#define SEAM(k) do { if (IN(k) && IN((k) + 1)) xcd_barrier(bar); } while (0)
#endif
    const float* xp = args.in[0]; const float* xs = args.in[1];
    bf16* XB = WSP(bf16, WS_XB); float* X1 = WSP(float, WS_X1); float* X2 = WSP(float, WS_X2); float* R = WSP(float, WS_R); bf16* RB = WSP(bf16, WS_R); bf16* H = WSP(bf16, WS_H); bf16* P = WSP(bf16, WS_P); bf16* CAT = WSP(bf16, WS_CAT);

#if MK_DIAG == 2
    ts_stamp(F, 0);
#endif
    PHASE(0,  p0_prologue(F, args); );
    PHASE(1,
        pg8::Gemm g{XB, WSP(bf16, WS_WGU1), M, NGU, D}; pg8::StaticOrder S; S.init(M, NGU, F.G, F.bx);
        pg8::EpiSwiGLU E{H, FF};
        pg8::gemm_phase<pg8::EpiSwiGLU, pg8::StaticOrder, true, true>(F.lds + RING_OFF, g, S, E, F.wave);
        { const int nwg = (M / 256) * (NGU / 256), rem = nwg % F.G;
          if (rem == 0) p0_convert_items(F, args, 2 * P0_I_GU, P0_NITEMS, F.bx, F.G); else if (F.bx >= rem) p0_convert_items(F, args, 2 * P0_I_GU, P0_NITEMS, F.bx - rem, F.G - rem); }
    );
    PHASE(2,
        pg8::Gemm g{H, WSP(bf16, WS_WD1), MP, D, FF}; pg8::StaticOrder S; S.init(MP, D, F.G, F.bx);
        pg8::EpiResBf16<true> E{xp, RB, D, ALPHA, 0.5f};
        pg8::gemm_phase<pg8::EpiResBf16<true>, pg8::StaticOrder, true, true>(F.lds + RING_OFF, g, S, E, F.wave);
        pg8::Gemm gs{H + (size_t)MP * FF, WSP(bf16, WS_WD1), MS, D, FF, 256}; pg8::SplitOrder SS; SS.init(MS, D, FF / 256, F.G, F.bx);
        pg8::EpiPartialF32 ES{WSP(float, WS_PART), D, (size_t)MS * D};
        pg8::gemm_phase<pg8::EpiPartialF32, pg8::SplitOrder, true, true>(F.lds + RING_OFF, gs, SS, ES, F.wave);
    );
    PHASE(3,  ln_phase(F, RB, args.in[11], args.in[12], nullptr, XB, WSP(float, WS_PART), FF / 256, xs, nullptr, 0.5f); );
    PHASE(4,
        pg8::Gemm g{XB, WSP(bf16, WS_WIN), M, INWP, D}; pg8::StaticOrder S; S.init(M, INWP, F.G, F.bx);
        pg8::EpiPlainBf16 E{P, INWP};
        pg8::gemm_phase<pg8::EpiPlainBf16, pg8::StaticOrder, true, true>(F.lds + RING_OFF, g, S, E, F.wave);
    );
    PHASE(5,  post_phase(F, args); );
    PHASE(6,  gdn_prep_phase(F, args); if (MK_DUP == 60) gdn_prep_phase(F, args, MK_Y); dsa_sample_scores_phase(F, args); if (MK_DUP == 61) dsa_sample_scores_phase(F, args); );
    PHASE(7,  gdn_scan_phase(F, args); if (MK_DUP == 70) gdn_scan_phase(F, args); dsa_sample_attend_phase(F, args); if (MK_DUP == 71) dsa_sample_attend_phase(F, args); dsa_prompt_phase(F); if (MK_DUP == 72) dsa_prompt_phase(F); );
    PHASE(8,  gdn_out_phase(F, args); );
#if MK_DIAG != 1
    PHASE(9,
        pg8::Gemm g{CAT, WSP(bf16, WS_WO), MP, D, D}; pg8::StaticOrder S; S.init(MP, D, F.G, F.bx);
        pg8::EpiResBf16<false> E{XB, RB, D, ALPHA, 1.0f};
        pg8::gemm_phase<pg8::EpiResBf16<false>, pg8::StaticOrder, true, true>(F.lds + RING_OFF, g, S, E, F.wave);
        pg8::Gemm gs{CAT + (size_t)MP * D, WSP(bf16, WS_WO), MS, D, D, 256}; pg8::SplitOrder SS; SS.init(MS, D, D / 256, F.G, F.bx);
        pg8::EpiPartialF32 ES{WSP(float, WS_PART), D, (size_t)MS * D};
        pg8::gemm_phase<pg8::EpiPartialF32, pg8::SplitOrder, true, true>(F.lds + RING_OFF, gs, SS, ES, F.wave);
    );
    PHASE(10,  ln_phase(F, RB, args.in[19], args.in[20], nullptr, XB, WSP(float, WS_PART), D / 256, nullptr, XB, 1.0f); );
    PHASE(11,
        pg8::Gemm g{XB, WSP(bf16, WS_WGU2), M, NGU, D}; pg8::StaticOrder S; S.init(M, NGU, F.G, F.bx);
        pg8::EpiSwiGLU E{H, FF};
        pg8::gemm_phase<pg8::EpiSwiGLU, pg8::StaticOrder, true, true>(F.lds + RING_OFF, g, S, E, F.wave);
    );
    PHASE(12,
        pg8::Gemm g{H, WSP(bf16, WS_WD2), MP, D, FF}; pg8::StaticOrder S; S.init(MP, D, F.G, F.bx);
        pg8::EpiResBf16<false> E{XB, RB, D, ALPHA, 0.5f};
        pg8::gemm_phase<pg8::EpiResBf16<false>, pg8::StaticOrder, true, true>(F.lds + RING_OFF, g, S, E, F.wave);
        pg8::Gemm gs{H + (size_t)MP * FF, WSP(bf16, WS_WD2), MS, D, FF, 256}; pg8::SplitOrder SS; SS.init(MS, D, FF / 256, F.G, F.bx);
        pg8::EpiPartialF32 ES{WSP(float, WS_PART), D, (size_t)MS * D};
        pg8::gemm_phase<pg8::EpiPartialF32, pg8::SplitOrder, true, true>(F.lds + RING_OFF, gs, SS, ES, F.wave);
    );
    PHASE(13,  ln_phase(F, RB, args.in[24], args.in[25], F.out + O_YP, nullptr, WSP(float, WS_PART), FF / 256, nullptr, XB, 0.5f); );
#endif
#if MK_DIAG == 1
    if (IN(14)) {
#if MK_DIAG_ALL
        chk_ffn(F, xp, xs, MP, args.in[8], args.in[9], args.in[10], args.in[11], args.in[12], X1, 0);
        chk_proj(F, X1, args.in[13], P, 1);
#endif
        if (F.bx >= 8 && F.bx < 12) { const int i = F.bx - 8; chk_gdn(F, args, false, 5 * i, i, 2, 3); }
        if (F.bx >= 16 && F.bx < 24) { const int i = F.bx - 16; chk_dsa(F, args, false, (3 * i + 1) & 15, i == 0 ? 5 : i == 1 ? 255 : i == 2 ? 256 : i == 3 ? 300 : i == 4 ? 777 : i == 5 ? 1500 : i == 6 ? 2046 : 2047, 6); }
        if (F.bx >= 24 && F.bx < 28) { const int i = F.bx - 24; chk_dsa(F, args, true, i == 0 ? 0 : i == 1 ? 50 : i == 2 ? 99 : 127, i == 0 ? 0 : i == 1 ? 3 : i == 2 ? 6 : 7, 7); }
        if (F.bx >= 12 && F.bx < 16) { const int i = F.bx - 12; chk_gdn(F, args, true, i == 0 ? 0 : i == 1 ? 37 : i == 2 ? 100 : 127, i, 4, 5); }
    }
#endif
#if MK_DIAG == 1
    if (IN(15)) dg_report(F);
#endif
#if MK_DIAG == 2
    if (IN(14)) ts_report(F);
#endif
#undef IN
#undef SEAM
}

extern "C" void kernel_launch(void* const* d_in, const int* in_sizes, int n_in, void* d_out, int out_size, void* d_ws, size_t ws_size, hipStream_t stream) {
    static int grid = 0;
    if (grid == 0) {
        if (n_in != 26 || out_size != (int)O_END || ws_size < WS_END) { fprintf(stderr, "kernel_launch: unexpected shapes (n_in %d out %d ws %zu)\n", n_in, out_size, ws_size); grid = -1; return; }
        int dev = 0, cus = 0, per_cu = 0;
        if (hipGetDevice(&dev) != hipSuccess || hipDeviceGetAttribute(&cus, hipDeviceAttributeMultiprocessorCount, dev) != hipSuccess) { grid = -1; return; }
        if (hipFuncSetAttribute((const void*)mk_fwd, hipFuncAttributeMaxDynamicSharedMemorySize, LDS_BYTES) != hipSuccess) { fprintf(stderr, "kernel_launch: hipFuncSetAttribute failed\n"); grid = -1; return; }
        if (hipOccupancyMaxActiveBlocksPerMultiprocessor(&per_cu, (const void*)mk_fwd, NTHR, LDS_BYTES) != hipSuccess || per_cu < 1) fprintf(stderr, "kernel_launch: occupancy query reports %d\n", per_cu);
        (void)hipGetLastError();
        grid = cus;
    }
    if (grid < 0) return;
    if (hipMemsetAsync((char*)d_ws + WS_CTL, 0, CTL_ZERO_BYTES, stream) != hipSuccess) return;
    Args a{};
    for (int i = 0; i < 26; ++i) a.in[i] = (const float*)d_in[i];
    a.out = (float*)d_out; a.ws = (unsigned char*)d_ws;
#if MK_ONE_LAUNCH
    a.ph_lo = 0; a.ph_hi = NPH;
    hipLaunchKernelGGL(mk_fwd, dim3(grid), dim3(NTHR), LDS_BYTES, stream, a);
#else
    for (int k = 0; k < NPH; ++k) { if (MK_DIAG == 1 && k >= 9 && k <= 13) continue; a.ph_lo = k; a.ph_hi = k + 1; hipLaunchKernelGGL(mk_fwd, dim3(grid), dim3(NTHR), LDS_BYTES, stream, a); }
#endif
}
```

```cpp
#define MK_DIAG 0
#define MK_DIAG_ALL 0
#define TS_LO {0,1,2,3,4,5,6,7,8,9,10,11}
#define TS_HI {1,2,3,4,5,6,7,8,9,10,11,14}
#define MK_ONE_LAUNCH 1
#define MK_DUP -1
#define MK_X 0
#define MK_Y 0
#include <hip/hip_runtime.h>
#include <cstdio>
#include <cstdint>
namespace pg8 {
#define PG8_LAS __attribute__((address_space(3)))
typedef unsigned short bf16_t;
typedef short bf16x8 __attribute__((ext_vector_type(8)));
typedef float f32x4 __attribute__((ext_vector_type(4)));
typedef unsigned u32x4 __attribute__((ext_vector_type(4)));
constexpr int BM = 256, BK = 64, HALF = 128, HTB = HALF * BK * 2  , STAGE_BYTES = 8 * HTB, NXCD = 8, WGM = 8;

__host__ __device__ __forceinline__ int lds_byte(int r, int c) { const int st = (r >> 4) * 2 + (c >> 5), rr = r & 15, cc = c & 31, ob = rr * 64 + cc * 2; return st * 1024 + (ob ^ (((ob >> 9) & 1) << 5)); }
__host__ __device__ __forceinline__ void stage_rc(int b, int& R, int& C) { const int st = b / 1024, sb = b % 1024, swz = sb ^ (((sb >> 9) & 1) << 5); R = (st >> 1) * 16 + swz / 64; C = (st & 1) * 32 + (swz % 64) / 2; }
__host__ __device__ __forceinline__ int perm32(int rho) { const int n = rho >> 4, i = rho & 15; return 8 * (i >> 2) + 4 * n + (i & 3); }

struct Unit { int pm, pn, kc; };
struct Gemm { const bf16_t* A; const bf16_t* Bt; int M, N, K; int klen = 0; };

struct StaticOrder {
    int nM, nN, nwg, G, c;
    __host__ __device__ void init(int M, int N, int G_, int c_) { nM = M / BM; nN = N / BM; nwg = nM * nN; G = G_; c = c_; }
    __host__ __device__ bool next(int i, Unit& u) const {
        const long L = (long)i * G + c; if (L >= nwg) return false;
        int wgid = (int)L; { const int q = nwg / NXCD, r = nwg % NXCD, xcd = wgid % NXCD, off = wgid / NXCD; wgid = (xcd < r ? xcd * (q + 1) : r * (q + 1) + (xcd - r) * q) + off; }
        const int nig = WGM * nN, gid = wgid / nig, fm = gid * WGM, gsz = (nM - fm) < WGM ? (nM - fm) : WGM;
        u.pm = fm + ((wgid % nig) % gsz); u.pn = (wgid % nig) / gsz; u.kc = 0; return true;
    }
    __device__ __forceinline__ void a_ready(const Unit&) const {}
    __device__ __forceinline__ void done(const Unit&) const {}
};

__device__ __forceinline__ unsigned cvt_pk_bf16(float lo, float hi) { unsigned r; asm volatile("v_cvt_pk_bf16_f32 %0, %1, %2" : "=v"(r) : "v"(lo), "v"(hi)); return r; }
typedef float f32x2 __attribute__((ext_vector_type(2)));
__device__ __forceinline__ float silu_f(float x) { return x * __builtin_amdgcn_rcpf(1.0f + __builtin_amdgcn_exp2f(-1.4426950408889634f * x)); }
struct EpiSwiGLU {
    static constexpr bool PERM = true, AFTER_DRAIN = false;
    bf16_t* O; int ldc;
    __device__ __forceinline__ void operator()(const f32x4 (&acc)[2][2][4][2], const Unit& u, int wr, int wc, int fr, int fq) const {
        const int row0 = u.pm * BM + wr * 64 + fr, col0 = u.pn * HALF + wc * 32 + 8 * fq;
#pragma unroll
        for (int ai = 0; ai < 2; ++ai)
#pragma unroll
            for (int m = 0; m < 4; ++m) { bf16_t* p = O + (size_t)(row0 + ai * HALF + m * 16) * ldc + col0;
                const f32x4 g0 = acc[ai][0][m][0], g1 = acc[ai][0][m][1], u0 = acc[ai][1][m][0], u1 = acc[ai][1][m][1];
                u32x4 w; w.x = cvt_pk_bf16(silu_f(g0[0]) * u0[0], silu_f(g0[1]) * u0[1]); w.y = cvt_pk_bf16(silu_f(g0[2]) * u0[2], silu_f(g0[3]) * u0[3]);
                w.z = cvt_pk_bf16(silu_f(g1[0]) * u1[0], silu_f(g1[1]) * u1[1]); w.w = cvt_pk_bf16(silu_f(g1[2]) * u1[2], silu_f(g1[3]) * u1[3]);
                *(u32x4*)p = w; }
    }
};
struct EpiResF32 {
    static constexpr bool PERM = false, AFTER_DRAIN = false;
    const float* res0; const float* res1; int split; float* out; int ldc; float alpha, s;
    __device__ __forceinline__ void operator()(const f32x4 (&acc)[2][2][4][2], const Unit& u, int wr, int wc, int fr, int fq) const {
        const int col0 = u.pn * BM + wc * 32 + 4 * fq;
#pragma unroll
        for (int ai = 0; ai < 2; ++ai)
#pragma unroll
            for (int m = 0; m < 4; ++m) { const int r = u.pm * BM + ai * HALF + wr * 64 + m * 16 + fr;
                const float* rp = (r < split) ? res0 + (size_t)r * ldc : res1 + (size_t)(r - split) * ldc; float* op = out + (size_t)r * ldc;
#pragma unroll
                for (int bj = 0; bj < 2; ++bj)
#pragma unroll
                    for (int n = 0; n < 2; ++n) { const int c = col0 + bj * HALF + n * 16; const f32x4 x = *(const f32x4*)(rp + c); *(f32x4*)(op + c) = x * alpha + acc[ai][bj][m][n] * s; }
                if (m & 1) asm volatile("" ::: "memory"); }
    }
};
struct EpiPlainBf16 {
    static constexpr bool PERM = true, AFTER_DRAIN = false;
    bf16_t* O; int ldc;
    __device__ __forceinline__ void operator()(const f32x4 (&acc)[2][2][4][2], const Unit& u, int wr, int wc, int fr, int fq) const {
        const int row0 = u.pm * BM + wr * 64 + fr, col0 = u.pn * BM + wc * 32 + 8 * fq;
#pragma unroll
        for (int ai = 0; ai < 2; ++ai)
#pragma unroll
            for (int m = 0; m < 4; ++m) { bf16_t* rowp = O + (size_t)(row0 + ai * HALF + m * 16) * ldc + col0;
#pragma unroll
                for (int bj = 0; bj < 2; ++bj) { const f32x4 v0 = acc[ai][bj][m][0], v1 = acc[ai][bj][m][1];
                    u32x4 w; w.x = cvt_pk_bf16(v0[0], v0[1]); w.y = cvt_pk_bf16(v0[2], v0[3]); w.z = cvt_pk_bf16(v1[0], v1[1]); w.w = cvt_pk_bf16(v1[2], v1[3]);
                    *(u32x4*)(rowp + bj * HALF) = w; } }
    }
};
struct SplitOrder {
    int nM, nN, ns, nwg, G, c;
    __host__ __device__ void init(int M, int N, int ns_, int G_, int c_) { nM = M / BM; nN = N / BM; ns = ns_; nwg = nM * nN * ns; G = G_; c = c_; }
    __host__ __device__ bool next(int i, Unit& u) const { const long L = (long)i * G + c; if (L >= nwg) return false; const int l = (int)L; u.kc = l % ns; u.pn = (l / ns) % nN; u.pm = l / (ns * nN); return true; }
    __device__ __forceinline__ void a_ready(const Unit&) const {}
    __device__ __forceinline__ void done(const Unit&) const {}
};
struct EpiPartialF32 {
    static constexpr bool PERM = false, AFTER_DRAIN = false;
    float* part; int ldc; size_t slice;
    __device__ __forceinline__ void operator()(const f32x4 (&acc)[2][2][4][2], const Unit& u, int wr, int wc, int fr, int fq) const {
        const int col0 = u.pn * BM + wc * 32 + 4 * fq; float* base = part + (size_t)u.kc * slice;
#pragma unroll
        for (int ai = 0; ai < 2; ++ai)
#pragma unroll
            for (int m = 0; m < 4; ++m) { const int r = u.pm * BM + ai * HALF + wr * 64 + m * 16 + fr; float* op = base + (size_t)r * ldc;
#pragma unroll
                for (int bj = 0; bj < 2; ++bj)
#pragma unroll
                    for (int n = 0; n < 2; ++n) *(f32x4*)(op + col0 + bj * HALF + n * 16) = acc[ai][bj][m][n]; }
    }
};
template <bool RESF32> struct EpiResBf16 {
    static constexpr bool PERM = true, AFTER_DRAIN = false;
    const void* res; bf16_t* out; int ldc; float alpha, s;
    __device__ __forceinline__ void operator()(const f32x4 (&acc)[2][2][4][2], const Unit& u, int wr, int wc, int fr, int fq) const {
        const int row0 = u.pm * BM + wr * 64 + fr, col0 = u.pn * BM + wc * 32 + 8 * fq;
#pragma unroll
        for (int ai = 0; ai < 2; ++ai)
#pragma unroll
            for (int m = 0; m < 4; ++m) { const size_t ro = (size_t)(row0 + ai * HALF + m * 16) * ldc + col0;
#pragma unroll
                for (int bj = 0; bj < 2; ++bj) { f32x4 r0, r1;
                    if (RESF32) { const float* rp = (const float*)res + ro + bj * HALF; r0 = *(const f32x4*)rp; r1 = *(const f32x4*)(rp + 4); }
                    else { const u32x4 rw = *(const u32x4*)((const bf16_t*)res + ro + bj * HALF);
                        r0 = (f32x4){__builtin_bit_cast(float, rw.x << 16), __builtin_bit_cast(float, rw.x & 0xffff0000u), __builtin_bit_cast(float, rw.y << 16), __builtin_bit_cast(float, rw.y & 0xffff0000u)};
                        r1 = (f32x4){__builtin_bit_cast(float, rw.z << 16), __builtin_bit_cast(float, rw.z & 0xffff0000u), __builtin_bit_cast(float, rw.w << 16), __builtin_bit_cast(float, rw.w & 0xffff0000u)}; }
                    const f32x4 v0 = r0 * alpha + acc[ai][bj][m][0] * s, v1 = r1 * alpha + acc[ai][bj][m][1] * s;
                    u32x4 w; w.x = cvt_pk_bf16(v0[0], v0[1]); w.y = cvt_pk_bf16(v0[2], v0[3]); w.z = cvt_pk_bf16(v1[0], v1[1]); w.w = cvt_pk_bf16(v1[2], v1[3]);
                    *(u32x4*)(out + ro + bj * HALF) = w; }
                if (m & 1) asm volatile("" ::: "memory"); }
    }
};
template <class Epi, class Sched, bool ALIGN_EPI = false, bool SP2 = false>
__device__ __forceinline__ void gemm_phase(PG8_LAS unsigned char* lds, const Gemm g, const Sched& S, const Epi& E, const int wid) {
    int lane_; asm volatile("v_mbcnt_lo_u32_b32 %0, -1, 0\n\tv_mbcnt_hi_u32_b32 %0, -1, %0" : "=v"(lane_));
    const int lane = lane_, tid = wid * 64 + lane, wr = wid >> 2, wc = wid & 3, fr = lane & 15, fq = lane >> 4;
    const int K = g.K, nt = (g.klen ? g.klen : K) / BK;
    const size_t kcstep = (size_t)g.klen * 2;
    unsigned voffA[2], voffB[2];
#pragma unroll
    for (int i = 0; i < 2; ++i) { int R, C; stage_rc(tid * 16 + i * 8192, R, C); const int Rb = Epi::PERM ? ((R & ~31) + perm32(R & 31)) : R;
        voffA[i] = (unsigned)(R * K + C) * 2u; voffB[i] = (unsigned)(Rb * K + C) * 2u; }
    const size_t kstep = (size_t)(BK * 2);
    const size_t hstep = (size_t)HALF * K * 2;
    const size_t tstep = 2 * hstep;
    const unsigned ldsw = (unsigned)wid * 1024u;
    const int aoff = lds_byte(wr * 64 + fr, fq * 8), boff = lds_byte(wc * 32 + fr, fq * 8);
#define PG8_SA(b, h) (((b) * 2 + (h)) * HTB)
#define PG8_SB(b, h) ((4 + (b) * 2 + (h)) * HTB)
#define PG8_STAGE(bufoff, gbase, voff) do { _Pragma("unroll") for (int _i = 0; _i < 2; ++_i) \
        __builtin_amdgcn_global_load_lds((const unsigned*)((const char*)(gbase) + (voff)[_i]), (PG8_LAS unsigned*)(lds + (bufoff) + ldsw + _i * 8192), 16, 0, 0); } while (0)
#define PG8_LDA(dst, b, h) do { _Pragma("unroll") for (int m = 0; m < 4; ++m) _Pragma("unroll") for (int k = 0; k < 2; ++k) dst[m][k] = *(const PG8_LAS bf16x8*)(lds + PG8_SA(b, h) + aoff + m * 2048 + k * 1024); } while (0)
#define PG8_LDB(dst, b, h) do { _Pragma("unroll") for (int n = 0; n < 2; ++n) _Pragma("unroll") for (int k = 0; k < 2; ++k) dst[n][k] = *(const PG8_LAS bf16x8*)(lds + PG8_SB(b, h) + boff + n * 2048 + k * 1024); } while (0)
#define PG8_MMA(ai, bj, At, Bt) do { __builtin_amdgcn_s_setprio(1); _Pragma("unroll") for (int m = 0; m < 4; ++m) _Pragma("unroll") for (int n = 0; n < 2; ++n) _Pragma("unroll") for (int k = 0; k < 2; ++k) \
        acc[ai][bj][m][n] = __builtin_amdgcn_mfma_f32_16x16x32_bf16(Bt[n][k], At[m][k], acc[ai][bj][m][n], 0, 0, 0); __builtin_amdgcn_s_setprio(0); } while (0)
#define PG8_WAIT_V(n) asm volatile("s_waitcnt vmcnt(" #n ")" ::: "memory")
#define PG8_WAIT_L(n) asm volatile("s_waitcnt lgkmcnt(" #n ")" ::: "memory")
#define PG8_BAR __builtin_amdgcn_s_barrier()
#define PG8_SCHED __builtin_amdgcn_sched_barrier(0)
    Unit cur, nxt; int ui = 0;
    if (!S.next(0, cur)) return;
    f32x4 acc[2][2][4][2];
#pragma unroll
    for (int a = 0; a < 2; ++a)
#pragma unroll
        for (int b = 0; b < 2; ++b)
#pragma unroll
            for (int m = 0; m < 4; ++m)
#pragma unroll
                for (int n = 0; n < 2; ++n) acc[a][b][m][n] = (f32x4){0.f, 0.f, 0.f, 0.f};
    bf16x8 At[4][2], B0[2][2], B1[2][2];
    const char* cA = (const char*)g.A + (size_t)cur.pm * tstep + (size_t)cur.kc * kcstep; const char* cB = (const char*)g.Bt + (size_t)cur.pn * tstep + (size_t)cur.kc * kcstep;
    S.a_ready(cur);
    if constexpr (SP2) {
        PG8_STAGE(PG8_SB(0, 0), cB, voffB); PG8_STAGE(PG8_SB(0, 1), cB + hstep, voffB); PG8_STAGE(PG8_SA(0, 0), cA, voffA); PG8_STAGE(PG8_SA(0, 1), cA + hstep, voffA);
        if (wr == 1) PG8_BAR;
        PG8_WAIT_V(2); PG8_BAR;
        PG8_STAGE(PG8_SB(1, 0), cB + kstep, voffB); PG8_STAGE(PG8_SA(1, 0), cA + kstep, voffA); PG8_STAGE(PG8_SB(1, 1), cB + hstep + kstep, voffB);
        PG8_WAIT_V(6); PG8_BAR;
    } else {
        PG8_STAGE(PG8_SB(0, 0), cB, voffB); PG8_STAGE(PG8_SA(0, 0), cA, voffA); PG8_STAGE(PG8_SB(0, 1), cB + hstep, voffB); PG8_STAGE(PG8_SA(0, 1), cA + hstep, voffA);
        if (wr == 1) PG8_BAR;
        PG8_WAIT_V(4); PG8_BAR;
        PG8_STAGE(PG8_SB(1, 0), cB + kstep, voffB); PG8_STAGE(PG8_SA(1, 0), cA + kstep, voffA); PG8_STAGE(PG8_SB(1, 1), cB + hstep + kstep, voffB);
        PG8_WAIT_V(6); PG8_BAR;
    }
    for (;;) {
        const bool has_next = S.next(ui + 1, nxt);
        const char* nA = has_next ? (const char*)g.A + (size_t)nxt.pm * tstep + (size_t)nxt.kc * kcstep : cA; const char* nB = has_next ? (const char*)g.Bt + (size_t)nxt.pn * tstep + (size_t)nxt.kc * kcstep : cB;
        for (int t = 0; t < nt; t += 2) {
            const bool last = (t == nt - 2);
            const char* a1 = cA + (size_t)(t + 1) * kstep;
            const char* a2 = last ? nA : cA + (size_t)(t + 2) * kstep; const char* b2 = last ? nB : cB + (size_t)(t + 2) * kstep;
            const char* a3 = a2 + kstep; const char* b3 = b2 + kstep;
            if (last && has_next) S.a_ready(nxt);
            if constexpr (SP2) {
            PG8_LDB(B0, 0, 0); PG8_LDB(B1, 0, 1); PG8_SCHED; PG8_LDA(At, 0, 0); PG8_STAGE(PG8_SA(1, 1), a1 + hstep, voffA);
            PG8_WAIT_V(8); PG8_WAIT_L(0); PG8_BAR; PG8_MMA(0, 0, At, B0); PG8_MMA(0, 1, At, B1); PG8_BAR; PG8_SCHED;
            PG8_LDA(At, 0, 1); PG8_STAGE(PG8_SB(0, 0), b2, voffB); PG8_STAGE(PG8_SB(0, 1), b2 + hstep, voffB); PG8_STAGE(PG8_SA(0, 0), a2, voffA);
            PG8_WAIT_V(8); PG8_WAIT_L(0); PG8_BAR; PG8_MMA(1, 0, At, B0); PG8_MMA(1, 1, At, B1); PG8_BAR; PG8_SCHED;
            PG8_LDB(B0, 1, 0); PG8_LDB(B1, 1, 1); PG8_SCHED; PG8_LDA(At, 1, 0); PG8_STAGE(PG8_SA(0, 1), a2 + hstep, voffA);
            PG8_WAIT_V(8); PG8_WAIT_L(0); PG8_BAR; PG8_MMA(0, 0, At, B0); PG8_MMA(0, 1, At, B1); PG8_BAR; PG8_SCHED;
            PG8_LDA(At, 1, 1); PG8_STAGE(PG8_SB(1, 0), b3, voffB); PG8_STAGE(PG8_SB(1, 1), b3 + hstep, voffB); PG8_STAGE(PG8_SA(1, 0), a3, voffA);
            PG8_WAIT_V(8); PG8_WAIT_L(0); PG8_BAR; PG8_MMA(1, 0, At, B0); PG8_MMA(1, 1, At, B1); PG8_BAR; PG8_SCHED;
            } else {
            PG8_LDB(B0, 0, 0); PG8_SCHED; PG8_LDA(At, 0, 0); PG8_STAGE(PG8_SA(1, 1), a1 + hstep, voffA);
            PG8_WAIT_L(8); PG8_BAR; PG8_WAIT_L(0); PG8_MMA(0, 0, At, B0); PG8_BAR; PG8_SCHED;
            PG8_LDB(B1, 0, 1); PG8_STAGE(PG8_SB(0, 0), b2, voffB);
            PG8_BAR; PG8_WAIT_L(0); PG8_MMA(0, 1, At, B1); PG8_BAR;
            PG8_LDA(At, 0, 1); PG8_STAGE(PG8_SA(0, 0), a2, voffA);
            PG8_BAR; PG8_WAIT_L(0); PG8_MMA(1, 0, At, B0); PG8_BAR; PG8_SCHED;
            PG8_STAGE(PG8_SB(0, 1), b2 + hstep, voffB);
            PG8_WAIT_V(6); PG8_BAR; PG8_MMA(1, 1, At, B1); PG8_BAR;
            PG8_LDB(B0, 1, 0); PG8_SCHED; PG8_LDA(At, 1, 0); PG8_STAGE(PG8_SA(0, 1), a2 + hstep, voffA);
            PG8_WAIT_L(8); PG8_BAR; PG8_WAIT_L(0); PG8_MMA(0, 0, At, B0); PG8_BAR; PG8_SCHED;
            PG8_LDB(B1, 1, 1); PG8_STAGE(PG8_SB(1, 0), b3, voffB);
            PG8_BAR; PG8_WAIT_L(0); PG8_MMA(0, 1, At, B1); PG8_BAR;
            PG8_LDA(At, 1, 1); PG8_STAGE(PG8_SA(1, 0), a3, voffA);
            PG8_BAR; PG8_WAIT_L(0); PG8_MMA(1, 0, At, B0); PG8_BAR; PG8_SCHED;
            PG8_STAGE(PG8_SB(1, 1), b3 + hstep, voffB);
            PG8_WAIT_V(6); PG8_BAR; PG8_MMA(1, 1, At, B1); PG8_BAR;
            }
        }
        if constexpr (ALIGN_EPI) { if (wr == 0) PG8_BAR; }
        if constexpr (!Epi::AFTER_DRAIN) { E(acc, cur, wr, wc, fr, fq); S.done(cur); }
        if (!has_next) break;
#pragma unroll
        for (int a = 0; a < 2; ++a)
#pragma unroll
            for (int b = 0; b < 2; ++b)
#pragma unroll
                for (int m = 0; m < 4; ++m)
#pragma unroll
                    for (int n = 0; n < 2; ++n) acc[a][b][m][n] = (f32x4){0.f, 0.f, 0.f, 0.f};
        cur = nxt; cA = nA; cB = nB; ++ui;
        if constexpr (ALIGN_EPI) { if (wr == 1) PG8_BAR; }
    }
    PG8_WAIT_V(0);
    if constexpr (!ALIGN_EPI) { if (wr == 0) PG8_BAR; }
    PG8_BAR;
    if constexpr (Epi::AFTER_DRAIN) { E.fused(acc, cur, wr, wc, fr, fq, lds, wid, lane); S.done(cur); }
#undef PG8_SA
#undef PG8_SB
#undef PG8_STAGE
#undef PG8_LDA
#undef PG8_LDB
#undef PG8_MMA
#undef PG8_WAIT_V
#undef PG8_WAIT_L
#undef PG8_BAR
#undef PG8_SCHED
}
}
constexpr int NWAVES = 8, NTHR = 512;
constexpr int D = 1024, BATCH = 16, SEQ = 2048, DECB = 128, DECT = 8, PAST = 8192, PAGE = 128, NPAGES = 64;
constexpr int MP = BATCH * SEQ, MS = DECB * DECT, M = MP + MS;
constexpr int FF = 2816, NGU = 2 * FF, INW = 3408, INWP = 3584;
constexpr int C_Q = 0, C_K = 512, C_V = 640, C_QI = 768, C_KI = 1280, C_WI = 1344, C_QKV = 1352, C_Z = 2888, C_BG = 3400, C_AG = 3404;
constexpr int GH = 4, GDK = 128, GDV = 128, CONVC = 1536, NCHUNK = SEQ / 64, GDN_UNITS = 2048 + DECB * GH;
constexpr int KSEL = 256, LS = PAST + DECT, SCS_LD = 8208;
constexpr float LN_EPS = 1e-5f, NORM_EPS = 1e-6f, ALPHA = 1.189207115002721f;
constexpr size_t O_YP = 0, O_YS = 33554432, O_KP = 34603008, O_VP = 38797312, O_IP = 42991616, O_GP = 45088768, O_CP = 46137344, O_KS = 46211072, O_VS = 46342144, O_IS = 46473216, O_GS = 46538752, O_CS = 54927360, O_END = 55517184;
constexpr size_t MiB = 1u << 20;
constexpr size_t WS_CTL = 0, CTL_ZERO_BYTES = 1 * MiB, WS_ROPE = 1 * MiB;
constexpr size_t WS_WGU1 = 2 * MiB, WS_WD1 = 13 * MiB, WS_WIN = 19 * MiB, WS_WO = 26 * MiB, WS_WGU2 = 28 * MiB, WS_WD2 = 39 * MiB;
constexpr size_t WS_XB = 48 * MiB, WS_X1 = 116 * MiB, WS_X2 = 248 * MiB, WS_R = 380 * MiB, WS_H = 512 * MiB, WS_P = 696 * MiB;
constexpr size_t WS_QB = 928 * MiB, WS_QI = 961 * MiB, WS_KB = 994 * MiB, WS_VT = 1003 * MiB, WS_KI = 1011 * MiB, WS_WI = 1016 * MiB, WS_BG = 1018 * MiB;
constexpr size_t WS_CAT = 1020 * MiB, WS_OG = 1086 * MiB, WS_GSC = 1152 * MiB, WS_GL = 1334 * MiB, WS_SCS = 1336 * MiB, WS_PART = 1370 * MiB, WS_END = 1418 * MiB;
constexpr size_t GSC_UNIT = 73728;
static_assert(WS_WGU1 + (size_t)NGU * D * 2 <= WS_WD1 && WS_WD1 + (size_t)D * FF * 2 <= WS_WIN && WS_WIN + (size_t)INWP * D * 2 <= WS_WO && WS_WO + (size_t)D * D * 2 <= WS_WGU2, "ws map 1");
static_assert(WS_XB + (size_t)M * D * 2 <= WS_X1 && WS_X1 + (size_t)M * D * 4 <= WS_X2 && WS_X2 + (size_t)M * D * 4 <= WS_R && WS_R + (size_t)M * D * 4 <= WS_H && WS_H + (size_t)M * FF * 2 <= WS_P && WS_P + (size_t)M * INWP * 2 <= WS_QB, "ws map 2");
static_assert(WS_QB + (size_t)M * 512 * 2 <= WS_QI && WS_QI + (size_t)M * 512 * 2 <= WS_KB && WS_KB + (size_t)M * 128 * 2 <= WS_VT && WS_VT + (size_t)MP * 128 * 2 <= WS_KI && WS_KI + (size_t)M * 64 * 2 <= WS_WI && WS_WI + (size_t)M * 8 * 4 <= WS_BG && WS_BG + (size_t)M * 8 * 4 <= WS_CAT, "ws map 3");
static_assert(WS_CAT + (size_t)M * D * 2 <= WS_OG && WS_OG + (size_t)M * 512 * 4 <= WS_GSC && WS_GSC + (size_t)GDN_UNITS * GSC_UNIT <= WS_GL && WS_SCS + (size_t)MS * SCS_LD * 4 <= WS_END, "ws map 4");
constexpr int CW_TMO = 0, CW_CODE = 1, CW_BAR = 4096;
constexpr int RING_OFF = 0, RING_BYTES = 151552;
constexpr int LDSCTL_OFF = RING_BYTES, MISC_OFF = LDSCTL_OFF + 320;
constexpr int LDS_BYTES = 152576;
static_assert(MISC_OFF + 128 <= LDS_BYTES, "LDS map");

#define GAS __attribute__((address_space(1)))
#define LAS __attribute__((address_space(3)))
typedef unsigned short bf16;
typedef _Float16 f16;
typedef unsigned v4u __attribute__((ext_vector_type(4)));
typedef unsigned v2u __attribute__((ext_vector_type(2)));
typedef float f32x4 __attribute__((ext_vector_type(4)));
typedef float f32x2 __attribute__((ext_vector_type(2)));
typedef float f32x16 __attribute__((ext_vector_type(16)));
typedef short bf16x8 __attribute__((ext_vector_type(8)));
typedef short s16x4 __attribute__((ext_vector_type(4)));
typedef _Float16 f16x8 __attribute__((ext_vector_type(8)));
typedef GAS unsigned gu32;
#define RLX_AGENT __ATOMIC_RELAXED, __HIP_MEMORY_SCOPE_AGENT
#define LDS_WAIT() asm volatile("s_waitcnt lgkmcnt(0)" ::: "memory")
#define VM_WAIT() asm volatile("s_waitcnt vmcnt(0)" ::: "memory")
__device__ __forceinline__ unsigned f2bf(float f) { unsigned u = __builtin_bit_cast(unsigned, f); return (u + 0x7fffu + ((u >> 16) & 1u)) >> 16; }
__device__ __forceinline__ unsigned pk2(float lo, float hi) { return f2bf(lo) | (f2bf(hi) << 16); }
__device__ __forceinline__ float bf2f(unsigned short b) { return __builtin_bit_cast(float, (unsigned)b << 16); }
__device__ __forceinline__ float bflo(unsigned w) { return __builtin_bit_cast(float, w << 16); }
__device__ __forceinline__ float bfhi(unsigned w) { return __builtin_bit_cast(float, w & 0xffff0000u); }
__device__ __forceinline__ float wave_sum(float v) {
#pragma unroll
    for (int o = 1; o < 64; o <<= 1) v += __shfl_xor(v, o);
    return v;
}
__device__ __forceinline__ float wave_max(float v) {
#pragma unroll
    for (int o = 1; o < 64; o <<= 1) v = fmaxf(v, __shfl_xor(v, o));
    return v;
}
__device__ __forceinline__ int lane_fresh() { int l; asm volatile("v_mbcnt_lo_u32_b32 %0, -1, 0\n\tv_mbcnt_hi_u32_b32 %0, -1, %0" : "=v"(l)); return l; }
__device__ __forceinline__ int lane_dep(int dep) { int l; asm volatile("v_mbcnt_lo_u32_b32 %0, -1, 0\n\tv_mbcnt_hi_u32_b32 %0, -1, %0" : "=v"(l) : "s"(dep)); return l; }
template <int CTRL> __device__ __forceinline__ int dpp_mov(int v) { return __builtin_amdgcn_update_dpp(0, v, CTRL, 0xf, 0xf, true); }
#define WAVE_REDUCE_U32(v, OP) do { unsigned t_; \
    t_ = (unsigned)dpp_mov<0xB1>((int)(v)); (v) = OP((v), t_); t_ = (unsigned)dpp_mov<0x4E>((int)(v)); (v) = OP((v), t_); \
    t_ = (unsigned)dpp_mov<0x141>((int)(v)); (v) = OP((v), t_); t_ = (unsigned)dpp_mov<0x140>((int)(v)); (v) = OP((v), t_); \
    const unsigned a_ = (unsigned)__builtin_amdgcn_readlane((int)(v), 0), b_ = (unsigned)__builtin_amdgcn_readlane((int)(v), 16), c_ = (unsigned)__builtin_amdgcn_readlane((int)(v), 32), d_ = (unsigned)__builtin_amdgcn_readlane((int)(v), 48); \
    (v) = OP(OP(a_, b_), OP(c_, d_)); } while (0)
__device__ __forceinline__ unsigned umin_(unsigned a, unsigned b) { return a < b ? a : b; }
__device__ __forceinline__ unsigned umax_(unsigned a, unsigned b) { return a > b ? a : b; }
__device__ __forceinline__ unsigned wave_suffix_sum(unsigned v, int lane) {
    unsigned s = v;
    s += (unsigned)dpp_mov<0x101>((int)s); s += (unsigned)dpp_mov<0x102>((int)s); s += (unsigned)dpp_mov<0x104>((int)s); s += (unsigned)dpp_mov<0x108>((int)s);
    const unsigned t1 = (unsigned)__builtin_amdgcn_readlane((int)s, 16), t2 = (unsigned)__builtin_amdgcn_readlane((int)s, 32), t3 = (unsigned)__builtin_amdgcn_readlane((int)s, 48);
    const int row = lane >> 4;
    return s + (row == 0 ? t1 + t2 + t3 : row == 1 ? t2 + t3 : row == 2 ? t3 : 0u);
}
__device__ __forceinline__ float dpp_movf(float v, const int which) { const int i = __builtin_bit_cast(int, v); int r;
    switch (which) { case 0: r = dpp_mov<0xB1>(i); break; case 1: r = dpp_mov<0x4E>(i); break; case 2: r = dpp_mov<0x141>(i); break; default: r = dpp_mov<0x140>(i); break; }
    return __builtin_bit_cast(float, r); }
__device__ __forceinline__ float wave_sum_fast(float v) {
    v += dpp_movf(v, 0); v += dpp_movf(v, 1); v += dpp_movf(v, 2); v += dpp_movf(v, 3);
    const int i = __builtin_bit_cast(int, v);
    const float a = __builtin_bit_cast(float, __builtin_amdgcn_readlane(i, 0)), b = __builtin_bit_cast(float, __builtin_amdgcn_readlane(i, 16)), c = __builtin_bit_cast(float, __builtin_amdgcn_readlane(i, 32)), d = __builtin_bit_cast(float, __builtin_amdgcn_readlane(i, 48));
    return (a + b) + (c + d);
}
#define XB_TMO      128
#define XB_XCNT(j)  (256  + 64 * (j))
#define XB_XSUB(j)  (1280 + 64 * (j))
#define XB_XGEN(j)  (2304 + 64 * (j))
#define XB_TOP      3328
#define XB_TOPGEN   3392
#define XCD_BAR_WORDS 3456
#define XB_SPIN_CAP (1u << 18)

__device__ __forceinline__ unsigned xb_ld(unsigned* p)              { return __hip_atomic_load(p, __ATOMIC_RELAXED, __HIP_MEMORY_SCOPE_AGENT); }
__device__ __forceinline__ unsigned xb_add(unsigned* p, unsigned v) { return __hip_atomic_fetch_add(p, v, __ATOMIC_RELAXED, __HIP_MEMORY_SCOPE_AGENT); }
__device__ __forceinline__ unsigned xb_xcc_id() { return (unsigned)__builtin_amdgcn_s_getreg((3 << 11) | 20) & 0xFu; }
#define XB_SPIN(cond, bar) do { unsigned _sp = 0; while (cond) { __builtin_amdgcn_s_sleep(1); \
    if ((++_sp & 255u) == 0u) { if (xb_ld(&(bar)[XB_TMO])) break; if (_sp > XB_SPIN_CAP) { atomicAdd(&(bar)[XB_TMO], 1u); break; } } } } while (0)

struct XcdBarrier {
    int wave; unsigned* bar; unsigned x;
    volatile LAS unsigned* st;
};

__device__ __forceinline__ XcdBarrier xcd_barrier_post(unsigned* bar, volatile LAS unsigned* st, int wave) {
    XcdBarrier b; b.wave = wave; b.bar = bar; b.x = xb_xcc_id(); b.st = st;
    if (wave == 0 && lane_fresh() == 0) (void)xb_add(&bar[XB_XCNT(b.x)], 1u);
    return b;
}
__device__ __forceinline__ void xcd_barrier_complete(unsigned* bar, unsigned x, unsigned& nloc, unsigned& nx) {
    const unsigned G = gridDim.x * gridDim.y * gridDim.z;
    unsigned sum, cnt, mine, sp = 0u;
    for (;;) {
        sum = 0u; cnt = 0u; mine = 0u;
#pragma unroll
        for (unsigned j = 0; j < 16; ++j) { const unsigned c = xb_ld(&bar[XB_XCNT(j)]); sum += c; cnt += (c > 0u) ? 1u : 0u; mine = (j == x) ? c : mine; }
        if (sum == G) break;
        __builtin_amdgcn_s_sleep(1);
        if ((++sp & 255u) == 0u) { if (xb_ld(&bar[XB_TMO])) break; if (sp > XB_SPIN_CAP) { atomicAdd(&bar[XB_TMO], 1u); break; } }
    }
    nloc = mine > 0u ? mine : 1u; nx = cnt > 0u ? cnt : 1u;
}

__device__ __forceinline__ void xcd_barrier(const XcdBarrier& b) {
    asm volatile("s_waitcnt vmcnt(0)" ::: "memory");
    __syncthreads();
    if (b.wave == 0 && lane_fresh() == 0) {
        unsigned* bar = b.bar;
        __builtin_amdgcn_s_waitcnt(0);
        unsigned nloc = b.st[0], nx = b.st[1];
        if (nloc == 0u) { xcd_barrier_complete(bar, b.x, nloc, nx); b.st[0] = nloc; b.st[1] = nx; }
        const unsigned old = xb_add(&bar[XB_XSUB(b.x)], 1u);
        const unsigned gen = old / nloc;
        if (old + 1u == (gen + 1u) * nloc) {
            __builtin_amdgcn_fence(__ATOMIC_RELEASE, "agent");
            asm volatile("s_waitcnt vmcnt(0)" ::: "memory");
            const unsigned og = xb_add(&bar[XB_TOP], 1u);
            const unsigned tg = og / nx;
            if (og + 1u == (tg + 1u) * nx) xb_add(&bar[XB_TOPGEN], 1u);
            else XB_SPIN(xb_ld(&bar[XB_TOPGEN]) == tg, bar);
            __builtin_amdgcn_fence(__ATOMIC_ACQUIRE, "agent");
            xb_add(&bar[XB_XGEN(b.x)], 1u);
            asm volatile("s_waitcnt vmcnt(0)" ::: "memory");
        } else {
            XB_SPIN(xb_ld(&bar[XB_XGEN(b.x)]) == gen, bar);
            __builtin_amdgcn_fence(__ATOMIC_ACQUIRE, "agent");
            asm volatile("s_waitcnt vmcnt(0)" ::: "memory");
        }
    }
    __syncthreads();
}
struct Frame {
    LAS unsigned char* lds;
    volatile LAS unsigned* MISC;
    gu32* ctl;
    int wave, G, bx;
    float* out; unsigned char* ws;
};
struct Args { const float* in[26]; float* out; unsigned char* ws; int ph_lo, ph_hi; };
#define WSP(T, off) ((T*)(F.ws + (off)))

__device__ __forceinline__ void p0_transpose_item(const float* W, int K, int N, bf16* WT, int drow0, int k0, int n0, LAS float* scr, int lane) {
    const int n4 = (lane & 7) * 4; const bool ok = n0 + n4 < N;
    f32x4 t[8];
#pragma unroll
    for (int i = 0; i < 8; ++i) t[i] = ok ? *(const GAS f32x4*)(W + (size_t)(k0 + 8 * i + (lane >> 3)) * N + n0 + n4) : (f32x4){0.f, 0.f, 0.f, 0.f};
#pragma unroll
    for (int i = 0; i < 8; ++i) { LAS float* d = scr + (8 * i + (lane >> 3)) * 33 + n4; d[0] = t[i].x; d[1] = t[i].y; d[2] = t[i].z; d[3] = t[i].w; }
    LDS_WAIT(); asm volatile("" ::: "memory");
    const int c = lane & 7;
#pragma unroll
    for (int j = 0; j < 4; ++j) { const int n = (lane >> 3) + 8 * j; const LAS float* s = scr + (8 * c) * 33 + n;
        v4u o; o.x = pk2(s[0 * 33], s[1 * 33]); o.y = pk2(s[2 * 33], s[3 * 33]); o.z = pk2(s[4 * 33], s[5 * 33]); o.w = pk2(s[6 * 33], s[7 * 33]);
        *(GAS v4u*)(WT + (size_t)(drow0 + n) * K + k0 + 8 * c) = o; }
    LDS_WAIT(); asm volatile("" ::: "memory");
}
__device__ __forceinline__ void p0_convert_items(Frame& F, const Args& A, int first, int last, int wi, int nw) {
    const int lane = lane_fresh();
    LAS float* scr = (LAS float*)(F.lds + RING_OFF + F.wave * 16384);
    constexpr int I_GU = (D / 64) * (FF / 32), I_D = (FF / 64) * (D / 32), I_IN = (D / 64) * (INWP / 32);
    for (int it = first + wi * NWAVES + F.wave; it < last; it += nw * NWAVES) {
        int r = it;
        if (r < 4 * I_GU) {
            const int which = r / I_GU; r -= which * I_GU; const int nblk = FF / 32, kb = r / nblk, nb = r % nblk, n0 = 32 * nb;
            const float* W = which == 0 ? A.in[8] : which == 1 ? A.in[9] : which == 2 ? A.in[21] : A.in[22];
            bf16* WT = WSP(bf16, (which < 2) ? WS_WGU1 : WS_WGU2);
            const int drow0 = 256 * (n0 >> 7) + (n0 & 127) + ((which & 1) ? 128 : 0);
            p0_transpose_item(W, D, FF, WT, drow0, 64 * kb, n0, scr, lane); continue; }
        r -= 4 * I_GU;
        if (r < 2 * I_D) { const int which = r / I_D; r -= which * I_D; const int nblk = D / 32, kb = r / nblk, nb = r % nblk;
            p0_transpose_item(which ? A.in[23] : A.in[10], FF, D, WSP(bf16, which ? WS_WD2 : WS_WD1), 32 * nb, 64 * kb, 32 * nb, scr, lane); continue; }
        r -= 2 * I_D;
        if (r < I_IN) { const int nblk = INWP / 32, kb = r / nblk, nb = r % nblk;
            p0_transpose_item(A.in[13], D, INW, WSP(bf16, WS_WIN), 32 * nb, 64 * kb, 32 * nb, scr, lane); continue; }
        r -= I_IN;
        { const int nblk = D / 32, kb = r / nblk, nb = r % nblk; p0_transpose_item(A.in[18], D, D, WSP(bf16, WS_WO), 32 * nb, 64 * kb, 32 * nb, scr, lane); }
    }
}
constexpr int P0_I_GU = (D / 64) * (FF / 32), P0_NITEMS = 4 * P0_I_GU + 2 * (FF / 64) * (D / 32) + (D / 64) * (INWP / 32) + (D / 64) * (D / 32);
__device__ __forceinline__ void p0_prologue(Frame& F, const Args& A) {
    const int lane = lane_fresh();
    const int gw = F.bx * NWAVES + F.wave, NGW = F.G * NWAVES;
    p0_convert_items(F, A, 0, 2 * P0_I_GU, F.bx, F.G);
    bf16* XB = WSP(bf16, WS_XB);
    for (int m0 = gw; m0 < M; m0 += 4 * NGW) {
        f32x4 v[4][4];
#pragma unroll
        for (int k = 0; k < 4; ++k) { const int m = m0 + k * NGW, mm = m < M ? m : m0;
            const float* xr = (mm < MP) ? A.in[0] + (size_t)mm * D : A.in[1] + (size_t)(mm - MP) * D; const GAS f32x4* x4 = (const GAS f32x4*)xr + lane;
#pragma unroll
            for (int j = 0; j < 4; ++j) v[k][j] = x4[64 * j]; }
#pragma unroll
        for (int k = 0; k < 4; ++k) { const int m = m0 + k * NGW;
            if (m < M) { GAS unsigned long long* o8 = (GAS unsigned long long*)(XB + (size_t)m * D) + lane;
#pragma unroll
                for (int j = 0; j < 4; ++j) o8[64 * j] = (unsigned long long)pk2(v[k][j].x, v[k][j].y) | ((unsigned long long)pk2(v[k][j].z, v[k][j].w) << 32); } }
    }
    float* rope = WSP(float, WS_ROPE);
    for (int i = gw * 64 + lane; i < (SEQ + DECT) * 8; i += NGW * 64) {
        const int pi = i >> 3, f = i & 7; const float pos = (float)(pi < SEQ ? pi : PAST + pi - SEQ);
        const float invf = powf(500000.0f, -(float)f / 8.0f); const float ang = pos * invf;
        rope[pi * 16 + f] = cosf(ang); rope[pi * 16 + 8 + f] = sinf(ang);
    }
}
__device__ __forceinline__ void ln_phase(Frame& F, const bf16* RB, const float* g, const float* b, float* dstf, bf16* dstb, const float* part, int nsplit, const float* resf, const bf16* resb, float pscale) {
    const int lane = lane_fresh();
    const int gw = F.bx * NWAVES + F.wave, NGW = F.G * NWAVES;
    f32x4 gv[4], bv[4];
#pragma unroll
    for (int j = 0; j < 2; ++j) { gv[2 * j] = *(const GAS f32x4*)(g + 512 * j + 8 * lane); gv[2 * j + 1] = *(const GAS f32x4*)(g + 512 * j + 8 * lane + 4); bv[2 * j] = *(const GAS f32x4*)(b + 512 * j + 8 * lane); bv[2 * j + 1] = *(const GAS f32x4*)(b + 512 * j + 8 * lane + 4); }
#define LN_UNPK(W, A0, A1) do { A0 = (f32x4){bflo(W.x), bfhi(W.x), bflo(W.y), bfhi(W.y)}; A1 = (f32x4){bflo(W.z), bfhi(W.z), bflo(W.w), bfhi(W.w)}; } while (0)
#define LN_FINISH(v, m) do { float s = 0.f; \
        _Pragma("unroll") for (int j = 0; j < 4; ++j) s += (v[j].x + v[j].y) + (v[j].z + v[j].w); \
        const float mean = wave_sum_fast(s) * (1.f / D); float s2 = 0.f; \
        _Pragma("unroll") for (int j = 0; j < 4; ++j) { v[j] = v[j] - mean; s2 += (v[j].x * v[j].x + v[j].y * v[j].y) + (v[j].z * v[j].z + v[j].w * v[j].w); } \
        const float rstd = 1.f / sqrtf(wave_sum_fast(s2) * (1.f / D) + LN_EPS); \
        _Pragma("unroll") for (int j = 0; j < 4; ++j) { v[j] = v[j] * rstd * gv[j] + bv[j]; } \
        if (dstf) { _Pragma("unroll") for (int j = 0; j < 2; ++j) { *(GAS f32x4*)(dstf + (size_t)(m) * D + 512 * j + 8 * lane) = v[2 * j]; *(GAS f32x4*)(dstf + (size_t)(m) * D + 512 * j + 8 * lane + 4) = v[2 * j + 1]; } } \
        if (dstb) { _Pragma("unroll") for (int j = 0; j < 2; ++j) { v4u w; w.x = pk2(v[2 * j].x, v[2 * j].y); w.y = pk2(v[2 * j].z, v[2 * j].w); w.z = pk2(v[2 * j + 1].x, v[2 * j + 1].y); w.w = pk2(v[2 * j + 1].z, v[2 * j + 1].w); \
                *(GAS v4u*)(dstb + (size_t)(m) * D + 512 * j + 8 * lane) = w; } } } while (0)
    for (int m0 = gw; m0 < MP; m0 += 4 * NGW) {
        v4u raw[4][2];
#pragma unroll
        for (int k = 0; k < 4; ++k) { const int m = m0 + k * NGW; const int mm = m < MP ? m : m0;
#pragma unroll
            for (int j = 0; j < 2; ++j) raw[k][j] = *(const GAS v4u*)(RB + (size_t)mm * D + 512 * j + 8 * lane); }
#pragma unroll
        for (int k = 0; k < 4; ++k) { const int m = m0 + k * NGW;
            if (m < MP) { f32x4 v[4];
#pragma unroll
                for (int j = 0; j < 2; ++j) LN_UNPK(raw[k][j], v[2 * j], v[2 * j + 1]);
                LN_FINISH(v, m); } }
    }
    for (int m = MP + gw; m < M; m += NGW) {
        f32x4 v[4];
        {
            const int ms = m - MP;
#pragma unroll
            for (int j = 0; j < 4; ++j) v[j] = (f32x4){0.f, 0.f, 0.f, 0.f};
#pragma unroll 1
            for (int k = 0; k < nsplit; ++k) { const float* pp = part + ((size_t)k * MS + ms) * D + 8 * lane;
#pragma unroll
                for (int j = 0; j < 2; ++j) { v[2 * j] = v[2 * j] + *(const GAS f32x4*)(pp + 512 * j); v[2 * j + 1] = v[2 * j + 1] + *(const GAS f32x4*)(pp + 512 * j + 4); } }
#pragma unroll
            for (int j = 0; j < 2; ++j) { f32x4 r0, r1;
                if (resf) { r0 = *(const GAS f32x4*)(resf + (size_t)ms * D + 512 * j + 8 * lane); r1 = *(const GAS f32x4*)(resf + (size_t)ms * D + 512 * j + 8 * lane + 4); }
                else { const v4u w = *(const GAS v4u*)(resb + (size_t)m * D + 512 * j + 8 * lane); LN_UNPK(w, r0, r1); }
                v[2 * j] = r0 * ALPHA + v[2 * j] * pscale; v[2 * j + 1] = r1 * ALPHA + v[2 * j + 1] * pscale; }
        }
        LN_FINISH(v, m);
    }
#undef LN_FINISH
#undef LN_UNPK
}
__device__ __forceinline__ void post_phase(Frame& F, const Args& A) {
    const int lane = lane_fresh();
    const int gw = F.bx * NWAVES + F.wave, NGW = F.G * NWAVES;
    const bf16* P = WSP(bf16, WS_P); const float* rope = WSP(float, WS_ROPE);
    bf16* Qb = WSP(bf16, WS_QB); f16* QIh = WSP(f16, WS_QI); bf16* Kb = WSP(bf16, WS_KB); f16* KIh = WSP(f16, WS_KI); float* WI = WSP(float, WS_WI); float* BG = WSP(float, WS_BG);
    const f32x4 alog = *(const GAS f32x4*)A.in[15], dtb4 = *(const GAS f32x4*)A.in[16];
    const float a_exp[4] = {expf(alog.x), expf(alog.y), expf(alog.z), expf(alog.w)}; const float dtb[4] = {dtb4.x, dtb4.y, dtb4.z, dtb4.w};
    const int j8 = lane & 7; const bool rot = j8 < 2; const float sgn = (j8 == 0) ? -1.f : 1.f;
    for (int m = gw; m < M; m += NGW) {
        const bool prm = m < MP; const int ms = m - MP; const int b = prm ? (m >> 11) : (ms >> 3), t = prm ? (m & 2047) : (ms & 7), pi = prm ? t : SEQ + t;
        const bf16* p = P + (size_t)m * INWP;
        const int c3 = lane < 32 ? C_K + 8 * lane : (lane < 41 ? C_KI + 8 * (lane - 32) : C_BG);
        const v4u rq = *(const GAS v4u*)(p + C_Q + 8 * lane), ri = *(const GAS v4u*)(p + C_QI + 8 * lane);
        v4u r3 = (v4u){0u, 0u, 0u, 0u}; if (lane < 42) r3 = *(const GAS v4u*)(p + c3);
        const f32x4 c0 = *(const GAS f32x4*)(rope + pi * 16), c1 = *(const GAS f32x4*)(rope + pi * 16 + 4), s0 = *(const GAS f32x4*)(rope + pi * 16 + 8), s1 = *(const GAS f32x4*)(rope + pi * 16 + 12);
        const float cs[8] = {c0.x, c0.y, c0.z, c0.w, c1.x, c1.y, c1.z, c1.w}; const float sn[8] = {s0.x, s0.y, s0.z, s0.w, s1.x, s1.y, s1.z, s1.w};
        float xq[8], xi[8], x3[8];
#pragma unroll
        for (int e = 0; e < 4; ++e) { xq[2 * e] = bflo(rq[e]); xq[2 * e + 1] = bfhi(rq[e]); xi[2 * e] = bflo(ri[e]); xi[2 * e + 1] = bfhi(ri[e]); x3[2 * e] = bflo(r3[e]); x3[2 * e + 1] = bfhi(r3[e]); }
        const bool rot3 = rot && (lane < 16 || (lane >= 32 && lane < 40));
#pragma unroll
        for (int e = 0; e < 8; ++e) { const float pq = __shfl_xor(xq[e], 1), pi_ = __shfl_xor(xi[e], 1), p3 = __shfl_xor(x3[e], 1);
            if (rot) { xq[e] = xq[e] * cs[e] + sgn * pq * sn[e]; xi[e] = xi[e] * cs[e] + sgn * pi_ * sn[e]; }
            if (rot3) x3[e] = x3[e] * cs[e] + sgn * p3 * sn[e]; }
        { v4u w; const float qs = 0.125f * 1.4426950408889634f;
#pragma unroll
          for (int e = 0; e < 4; ++e) w[e] = pk2(xq[2 * e] * qs, xq[2 * e + 1] * qs);
          *(GAS v4u*)(Qb + (size_t)m * 512 + 8 * lane) = w;
          f16x8 h;
#pragma unroll
          for (int e = 0; e < 8; ++e) h[e] = (f16)xi[e];
          *(GAS f16x8*)(QIh + (size_t)m * 512 + 8 * lane) = h; }
        if (lane < 32) {
            float* o = F.out + (lane < 16 ? (prm ? O_KP + (size_t)m * 128 : O_KS + (size_t)ms * 128) + 8 * lane : (prm ? O_VP + (size_t)m * 128 : O_VS + (size_t)ms * 128) + 8 * (lane - 16));
            *(GAS f32x4*)o = (f32x4){x3[0], x3[1], x3[2], x3[3]}; *(GAS f32x4*)(o + 4) = (f32x4){x3[4], x3[5], x3[6], x3[7]};
            if (lane < 16) { v4u w;
#pragma unroll
                for (int e = 0; e < 4; ++e) w[e] = pk2(x3[2 * e], x3[2 * e + 1]);
                *(GAS v4u*)(Kb + (size_t)m * 128 + 8 * lane) = w; }
        } else if (lane < 40) {
            float* o = F.out + (prm ? O_IP + (size_t)m * 64 : O_IS + (size_t)ms * 64) + 8 * (lane - 32);
            *(GAS f32x4*)o = (f32x4){x3[0], x3[1], x3[2], x3[3]}; *(GAS f32x4*)(o + 4) = (f32x4){x3[4], x3[5], x3[6], x3[7]};
            f16x8 h;
#pragma unroll
            for (int e = 0; e < 8; ++e) h[e] = (f16)x3[e];
            *(GAS f16x8*)(KIh + (size_t)m * 64 + 8 * (lane - 32)) = h;
        } else if (lane == 40) {
            const float ws = 0.35355339059327373f * 0.125f;
            *(GAS f32x4*)(WI + (size_t)m * 8) = (f32x4){x3[0] * ws, x3[1] * ws, x3[2] * ws, x3[3] * ws}; *(GAS f32x4*)(WI + (size_t)m * 8 + 4) = (f32x4){x3[4] * ws, x3[5] * ws, x3[6] * ws, x3[7] * ws};
        } else if (lane == 41) {
            float be[4], gg[4];
#pragma unroll
            for (int e = 0; e < 4; ++e) { be[e] = 1.f / (1.f + expf(-x3[e])); const float ag = x3[4 + e] + dtb[e]; gg[e] = -a_exp[e] * (ag > 20.f ? ag : log1pf(expf(ag))); }
            *(GAS f32x4*)(BG + (size_t)m * 8) = (f32x4){be[0], be[1], be[2], be[3]}; *(GAS f32x4*)(BG + (size_t)m * 8 + 4) = (f32x4){gg[0], gg[1], gg[2], gg[3]};
        }
        const int trow = prm ? t - (SEQ - 3) : t - (DECT - 3);
        if (trow >= 0) { float* co = F.out + (prm ? O_CP : O_CS) + ((size_t)b * 3 + trow) * CONVC;
#pragma unroll
            for (int k = 0; k < 3; ++k) { const v4u rc = *(const GAS v4u*)(p + C_QKV + 512 * k + 8 * lane);
                *(GAS f32x4*)(co + 512 * k + 8 * lane) = (f32x4){bflo(rc[0]), bfhi(rc[0]), bflo(rc[1]), bfhi(rc[1])}; *(GAS f32x4*)(co + 512 * k + 8 * lane + 4) = (f32x4){bflo(rc[2]), bfhi(rc[2]), bflo(rc[3]), bfhi(rc[3])}; } }
    }
    LAS bf16* tile = (LAS bf16*)(F.lds + RING_OFF + F.wave * 16384);
    bf16* VT = WSP(bf16, WS_VT);
    for (int it = gw; it < BATCH * 2 * (SEQ / 64); it += NGW) {
        const int tb = it % (SEQ / 64), g = (it / (SEQ / 64)) & 1, b = it / (2 * (SEQ / 64));
        for (int tt = 0; tt < 64; ++tt) tile[tt * 66 + lane] = P[(size_t)(b * SEQ + tb * 64 + tt) * INWP + C_V + g * 64 + lane];
        LDS_WAIT(); asm volatile("" ::: "memory");
        { const int kk = lane & 31, pos = ((kk >> 2) & 1) * 16 + ((kk >> 4) * 2 + ((kk >> 3) & 1)) * 4 + (kk & 3); bf16* vt = VT + (((size_t)(b * 2 + g) * (SEQ / 32) + 2 * tb + (lane >> 5)) * 64) * 32 + pos;
          for (int d = 0; d < 64; ++d) vt[d * 32] = tile[lane * 66 + d]; }
        LDS_WAIT(); asm volatile("" ::: "memory");
    }
}
#define MFMA32 __builtin_amdgcn_mfma_f32_32x32x16_bf16
__device__ __forceinline__ int crow(int r, int hh) { return (r & 3) + 8 * (r >> 2) + 4 * hh; }
__device__ __forceinline__ f32x16 zero16() { f32x16 z; for (int i = 0; i < 16; ++i) z[i] = 0.f; return z; }
constexpr int GT_LD = 272;
constexpr int GP_HALF = 72704;
constexpr int GP_Q = 0, GP_K = 17408, GP_V = 34816, GP_A = 52224, GP_G = 69632, GP_B = 69888, GP_EG = 70144;
__device__ __forceinline__ void gdn_prep_phase(Frame& F, const Args& A, const int abl = 0) {
    const int half = F.wave >> 2, hw = F.wave & 3;
    LAS unsigned char* L = F.lds + RING_OFF + half * GP_HALF;
    const bf16* P = WSP(bf16, WS_P); const float* BG = WSP(float, WS_BG); const float* cw = A.in[14];
    const float* sconv = A.in[6];
    const int nit = (GDN_UNITS + 2 * F.G - 1) / (2 * F.G);
    for (int it = 0; it < nit; ++it) {
        const int lane = lane_fresh();
        const int ht = (hw << 6) | lane;
        const int u = (it * F.G + F.bx) * 2 + half; const bool live = u < GDN_UNITS;
        const bool smp = u >= 2048; const int us = u - 2048;
        const int c = smp ? 0 : (u & 31), h = smp ? (us & 3) : ((u >> 5) & 3), b = smp ? (us >> 2) : (u >> 7);
        const size_t mrow0 = smp ? (size_t)MP + (size_t)b * DECT : (size_t)b * SEQ;
        const int nreal = smp ? DECT : 64;
        unsigned char* gs = F.ws + WS_GSC + (size_t)u * GSC_UNIT;
        if (live) {
            LAS float* wl = (LAS float*)(L + GP_A);
#pragma unroll
            for (int k = 0; k < 6; ++k) { const int idx = ht + 256 * k, p = idx >> 9, j = (idx >> 7) & 3, ch = idx & 127; wl[idx] = cw[j * CONVC + p * 512 + h * 128 + ch]; }
        }
        LDS_WAIT(); __syncthreads();
        if (live) {
            const LAS float* wl = (const LAS float*)(L + GP_A);
            const int ti = lane >> 2, qq = lane & 3, row = hw * 16 + ti, tt = c * 64 + row; const bool real = row < nreal;
#pragma unroll 1
            for (int p = 0; p < ((abl & 1) ? 0 : 3); ++p) {
                float y[32];
                v4u xv[4][4]; f32x4 sv[4][2]; bool isrow[4], iscv[4];
#pragma unroll
                for (int j = 0; j < 4; ++j) { const int rr = tt - 3 + j; isrow[j] = rr >= 0 && (!smp || rr < nreal); iscv[j] = smp && rr < 0; }
#pragma unroll
                for (int ch4 = 0; ch4 < 4; ++ch4) { const int col = p * 512 + h * 128 + 32 * qq + 8 * ch4;
#pragma unroll
                    for (int j = 0; j < 4; ++j) { const int rr = tt - 3 + j; xv[ch4][j] = isrow[j] ? *(const GAS v4u*)(P + (mrow0 + rr) * INWP + C_QKV + col) : (v4u){0u, 0u, 0u, 0u}; } }
#pragma unroll
                for (int ch4 = 0; ch4 < 4; ++ch4) { const int col = p * 512 + h * 128 + 32 * qq + 8 * ch4;
                    float a[8];
#pragma unroll
                    for (int e = 0; e < 8; ++e) a[e] = 0.f;
#pragma unroll
                    for (int j = 0; j < 4; ++j) { const int rr = tt - 3 + j; float x[8];
#pragma unroll
                        for (int e = 0; e < 4; ++e) { x[2 * e] = bflo(xv[ch4][j][e]); x[2 * e + 1] = bfhi(xv[ch4][j][e]); }
                        if (iscv[j]) { const f32x4 s0 = *(const GAS f32x4*)(sconv + ((size_t)b * 3 + (3 + rr)) * CONVC + col), s1 = *(const GAS f32x4*)(sconv + ((size_t)b * 3 + (3 + rr)) * CONVC + col + 4);
                            x[0] = s0.x; x[1] = s0.y; x[2] = s0.z; x[3] = s0.w; x[4] = s1.x; x[5] = s1.y; x[6] = s1.z; x[7] = s1.w; }
                        const f32x4 w0 = *(const LAS f32x4*)(wl + (p * 4 + j) * 128 + 32 * qq + 8 * ch4), w1 = *(const LAS f32x4*)(wl + (p * 4 + j) * 128 + 32 * qq + 8 * ch4 + 4);
                        a[0] += w0.x * x[0]; a[1] += w0.y * x[1]; a[2] += w0.z * x[2]; a[3] += w0.w * x[3]; a[4] += w1.x * x[4]; a[5] += w1.y * x[5]; a[6] += w1.z * x[6]; a[7] += w1.w * x[7]; }
#pragma unroll
                    for (int e = 0; e < 8; ++e) { y[8 * ch4 + e] = a[e] / (1.f + __expf(-a[e])); asm volatile("" : "+v"(y[8 * ch4 + e])); }
                    asm volatile("" ::: "memory"); __builtin_amdgcn_sched_barrier(0); }
                if (p < 2) { float ss = 0.f;
#pragma unroll
                    for (int e = 0; e < 32; ++e) ss += y[e] * y[e];
                    ss += __shfl_xor(ss, 1); ss += __shfl_xor(ss, 2);
                    const float rn = 1.f / sqrtf(ss + NORM_EPS);
#pragma unroll
                    for (int e = 0; e < 32; ++e) y[e] *= rn; }
#pragma unroll
                for (int k = 0; k < 4; ++k) { v4u w4;
#pragma unroll
                    for (int e = 0; e < 4; ++e) w4[e] = real ? pk2(y[8 * k + 2 * e], y[8 * k + 2 * e + 1]) : 0u;
                    *(LAS v4u*)(L + p * 17408 + row * GT_LD + 64 * qq + 16 * k) = w4; }
            }
            if (hw == 0) { const size_t m = mrow0 + c * 64 + lane; const bool rl = lane < nreal; float g = rl ? BG[m * 8 + 4 + h] : 0.f; const float be = rl ? BG[m * 8 + h] : 0.f;
#pragma unroll
                for (int o = 1; o < 64; o <<= 1) { const float t = __shfl_up(g, o); if (lane >= o) g += t; }
                ((LAS float*)(L + GP_G))[lane] = g; ((LAS float*)(L + GP_B))[lane] = be;
                const float g63 = __shfl(g, 63); ((LAS float*)(L + GP_EG))[lane] = __expf(g); ((LAS float*)(L + GP_EG))[64 + lane] = __expf(g63 - g); }
        }
        LDS_WAIT(); __syncthreads();
        if (live && !(abl & 2)) {
            const LAS float* Gs = (const LAS float*)(L + GP_G); const LAS float* Bs = (const LAS float*)(L + GP_B);
            bf16* QKg = (bf16*)(gs + 65536);
            const int r = lane & 31, hh = lane >> 5;
            if (hw < 3) {
                const int ti = hw > 0 ? 1 : 0, tj = hw > 1 ? 1 : 0;
                f32x16 akk = zero16(), aqk = zero16();
#pragma unroll
                for (int s = 0; s < 8; ++s) {
                    const bf16x8 bk = *(const LAS bf16x8*)(L + GP_K + (32 * tj + r) * GT_LD + (16 * s + 8 * hh) * 2);
                    const bf16x8 ak = *(const LAS bf16x8*)(L + GP_K + (32 * ti + r) * GT_LD + (16 * s + 8 * hh) * 2);
                    const bf16x8 aq = *(const LAS bf16x8*)(L + GP_Q + (32 * ti + r) * GT_LD + (16 * s + 8 * hh) * 2);
                    akk = MFMA32(ak, bk, akk, 0, 0, 0); aqk = MFMA32(aq, bk, aqk, 0, 0, 0);
                }
                const int j = 32 * tj + r; const float Gj = Gs[j];
#pragma unroll
                for (int q = 0; q < 16; ++q) { const int i = 32 * ti + crow(q, hh); const float dec = __expf(Gs[i] - Gj);
                    ((LAS float*)(L + GP_A))[i * 68 + j] = (i > j) ? Bs[i] * akk[q] * dec : 0.f;
                    QKg[(((i >> 5) * 4 + (j >> 4)) * 64 + ((j >> 3) & 1) * 32 + (i & 31)) * 8 + (j & 7)] = (bf16)f2bf((i >= j) ? aqk[q] * dec * 0.08838834764831845f : 0.f); }
            } else {
#pragma unroll
                for (int q = 0; q < 16; ++q) { const int i = crow(q, hh), j = 32 + r; QKg[(((i >> 5) * 4 + (j >> 4)) * 64 + ((j >> 3) & 1) * 32 + (i & 31)) * 8 + (j & 7)] = 0; }
            }
        }
        LDS_WAIT(); __syncthreads();
        if (live) {
            const LAS float* Gs = (const LAS float*)(L + GP_G); const LAS float* Bs = (const LAS float*)(L + GP_B); const LAS float* As = (const LAS float*)(L + GP_A);
            const bool isu = ht < 128; const int cc = ht & 127; const LAS float* EGs = (const LAS float*)(L + GP_EG);
            const LAS unsigned char* src = L + (isu ? GP_V : GP_K) + cc * 2;
            float X[64];
#pragma unroll 1
            for (int rep_s4 = 0; rep_s4 < ((abl & 4) ? 0 : (MK_X == 5 ? 2 : 1)); ++rep_s4) {
#pragma unroll
            for (int i = 0; i < 64; ++i) X[i] = 0.f;
#pragma unroll
            for (int i = 0; i < 64; ++i) {
                float acc = bf2f(*(const LAS bf16*)(src + i * GT_LD)) * Bs[i] * (isu ? 1.f : EGs[i]);
                float a1_ = 0.f, a2_ = 0.f, a3_ = 0.f;
#pragma unroll
                for (int j4 = 0; j4 < (i + 3) / 4; ++j4) { const f32x4 a = *(const LAS f32x4*)(As + i * 68 + 4 * j4);
                    acc -= a.x * X[4 * j4]; a1_ -= a.y * X[4 * j4 + 1]; a2_ -= a.z * X[4 * j4 + 2]; a3_ -= a.w * X[4 * j4 + 3]; }
                acc = (acc + a1_) + (a2_ + a3_);
                X[i] = acc; asm volatile("" : "+v"(X[i]) :: "memory"); __builtin_amdgcn_sched_barrier(0);
            }
            }
            if (!(abl & 8) && isu) {
#pragma unroll
                for (int q = 0; q < 16; ++q) { const int rt_ = q >> 3, g_ = (q >> 1) & 3, hh_ = q & 1, i0 = 32 * rt_ + 8 * g_ + 4 * hh_;
                    v2u w2; w2.x = pk2(X[i0], X[i0 + 1]); w2.y = pk2(X[i0 + 2], X[i0 + 3]);
                    *(GAS v2u*)(gs + (size_t)((((cc >> 5) * 2 + rt_) * 4 + g_) * 64 + hh_ * 32 + (cc & 31)) * 8) = w2; }
            }
            LDS_WAIT(); __builtin_amdgcn_s_barrier(); asm volatile("" ::: "memory");
            if (!isu) {
#pragma unroll
                for (int i = 0; i < 64; ++i) *(LAS bf16*)(L + GP_V + i * GT_LD + cc * 2) = (bf16)f2bf(X[i]); }
            if (!(abl & 8)) {
#pragma unroll
            for (int k = 0; k < 4; ++k) { const int q_ = ht + 256 * k, ln_ = q_ & 63, s_ = (q_ >> 6) & 7, rt_ = q_ >> 9, i = 32 * rt_ + (ln_ & 31);
                const v4u qv = *(const LAS v4u*)(L + GP_Q + i * GT_LD + (16 * s_ + 8 * (ln_ >> 5)) * 2); const float sc = EGs[i] * 0.08838834764831845f;
                v4u w4; w4.x = pk2(bflo(qv.x) * sc, bfhi(qv.x) * sc); w4.y = pk2(bflo(qv.y) * sc, bfhi(qv.y) * sc); w4.z = pk2(bflo(qv.z) * sc, bfhi(qv.z) * sc); w4.w = pk2(bflo(qv.w) * sc, bfhi(qv.w) * sc);
                *(GAS v4u*)(gs + 32768 + (size_t)q_ * 16) = w4; }
            if (!isu) {
#pragma unroll
                for (int q = 0; q < 8; ++q) { float kv[8];
#pragma unroll
                    for (int e = 0; e < 8; ++e) { const int i = 8 * q + e; kv[e] = bf2f(*(const LAS bf16*)(L + GP_K + i * GT_LD + cc * 2)) * EGs[64 + i]; }
                    v4u w4; w4.x = pk2(kv[0], kv[1]); w4.y = pk2(kv[2], kv[3]); w4.z = pk2(kv[4], kv[5]); w4.w = pk2(kv[6], kv[7]);
                    *(GAS v4u*)(gs + 49152 + (size_t)((((cc >> 5) * 4 + (q >> 1)) * 64 + (q & 1) * 32 + (cc & 31)) * 16)) = w4; } }
            if (ht == 0) WSP(float, WS_GL)[u] = EGs[63];
            }
            LDS_WAIT(); __builtin_amdgcn_s_barrier(); asm volatile("" ::: "memory");
            if (!(abl & 8)) {
#pragma unroll
            for (int k = 0; k < 4; ++k) { const int q_ = ht + 256 * k, ln_ = q_ & 63, s_ = (q_ >> 6) & 7, rt_ = q_ >> 9, i = 32 * rt_ + (ln_ & 31);
                *(GAS v4u*)(gs + 16384 + (size_t)q_ * 16) = *(const LAS v4u*)(L + GP_V + i * GT_LD + (16 * s_ + 8 * (ln_ >> 5)) * 2); }
            }
        } else { __builtin_amdgcn_s_barrier(); __builtin_amdgcn_s_barrier(); }
        LDS_WAIT(); __syncthreads();
    }
}
constexpr int GS_SB = 0, GS_SB_LD = 272, GS_VN = 8704, GS_VN_LD = 144, GS_OB = 13312;
__device__ __forceinline__ void gdn_scan_phase(Frame& F, const Args& A) {
    const int wave = F.wave;
    LAS unsigned char* L = F.lds + RING_OFF;
    float* OG = WSP(float, WS_OG); const float* GL = WSP(float, WS_GL);
    for (int uu0 = F.bx; uu0 < (BATCH * GH * 4 + DECB * GH * 4) * (MK_X == 3 || MK_X == 4 ? 2 : 1); uu0 += F.G) {
        const bool dup_ = uu0 >= BATCH * GH * 4 + DECB * GH * 4;
        int uu = uu0; if (MK_X == 3 && uu0 >= BATCH * GH * 4 + DECB * GH * 4) { uu = uu0 - (BATCH * GH * 4 + DECB * GH * 4); if (uu >= BATCH * GH * 4) continue; }
        if (MK_X == 4 && uu0 >= BATCH * GH * 4 + DECB * GH * 4) { uu = uu0 - (BATCH * GH * 4 + DECB * GH * 4); if (uu < BATCH * GH * 4) continue; }
        const int lane = lane_fresh(); const int r = lane & 31, hh = lane >> 5;
        const bool smp = uu >= BATCH * GH * 4; const int u0_ = smp ? uu - BATCH * GH * 4 : uu;
        const int nseq_ = smp ? DECB * GH : BATCH * GH;
        const int x_ = u0_ & 7, i_ = u0_ >> 3, sl = i_ & 3, seq_ = x_ * (nseq_ >> 3) + (i_ >> 2);
        const int h = seq_ & 3, b = seq_ >> 2, dv0 = sl * 32;
        const int role = wave < 2 ? 0 : (wave < 4 ? 1 : 2), rt = wave < 2 ? wave : (wave < 4 ? wave - 2 : wave - 4);
        const int nch = smp ? 1 : NCHUNK, un0 = smp ? 2048 + b * GH + h : (b * GH + h) * NCHUNK;
        const size_t mrow0 = smp ? (size_t)MP + (size_t)b * DECT : (size_t)b * SEQ;
        f32x16 Sacc = zero16();
        __syncthreads();
        if (!smp) { for (int i = wave * 64 + lane; i < (GS_VN + 32 * GS_VN_LD) / 4; i += NTHR) ((LAS unsigned*)L)[i] = 0u; }
        else if (role == 2) {
            const GAS float* sp = (const GAS float*)(A.in[5] + ((size_t)(b * GH + h) * GDK + 32 * rt) * GDV + dv0 + r);
#pragma unroll
            for (int q = 0; q < 16; ++q) Sacc[q] = sp[(size_t)crow(q, hh) * GDV];
#pragma unroll
            for (int g = 0; g < 4; ++g) { v2u w2; w2.x = pk2(Sacc[4 * g], Sacc[4 * g + 1]); w2.y = pk2(Sacc[4 * g + 2], Sacc[4 * g + 3]); *(LAS v2u*)(L + GS_SB + r * GS_SB_LD + (32 * rt + 8 * g + 4 * hh) * 2) = w2; }
        }
        LDS_WAIT(); __syncthreads();
        const size_t offA = (role == 2) ? (size_t)lane * 16 : (role == 1 ? 32768 : 16384) + (size_t)((rt * 8) * 64 + lane) * 16;
        const size_t strA = (role == 2) ? 0 : 1024;
        const size_t offB = (role == 0) ? (size_t)lane * 16 : (role == 2 ? 49152 : 65536) + (size_t)((rt * 4) * 64 + lane) * 16;
        const size_t strB = (role == 0) ? 0 : 1024;
        const size_t offU = (role == 0) ? (size_t)(((sl * 2 + rt) * 4) * 64 + lane) * 8 : (size_t)lane * 8;
        const size_t strU = (role == 0) ? 512 : 0;
#define GS_LOAD(FA, UV, FB, GLV, cc) do { const int un_ = un0 + (cc); const unsigned char* gs = F.ws + WS_GSC + (size_t)un_ * GSC_UNIT; \
            _Pragma("unroll") for (int s = 0; s < 8; ++s) FA[s] = *(const GAS bf16x8*)(gs + offA + (size_t)s * strA); \
            _Pragma("unroll") for (int s = 0; s < 4; ++s) FB[s] = *(const GAS bf16x8*)(gs + offB + (size_t)s * strB); \
            _Pragma("unroll") for (int g = 0; g < 4; ++g) UV[g] = *(const GAS s16x4*)(gs + offU + (size_t)g * strU); \
            GLV = GL[un_]; } while (0)
#define GS_STEP(FA, UV, FB, GLV, cc) do { asm volatile("; SCAN_STEP_BEGIN"); \
            f32x16 acc = zero16(); \
            if (role < 2) { \
                _Pragma("unroll") for (int s = 0; s < 8; ++s) { const bf16x8 sb = *(const LAS bf16x8*)(L + GS_SB + r * GS_SB_LD + (16 * s + 8 * hh) * 2); acc = MFMA32(FA[s], sb, acc, 0, 0, 0); } } \
            if (role == 0) { \
                _Pragma("unroll") for (int g = 0; g < 4; ++g) { const float v0 = bf2f((unsigned short)UV[g][0]) - acc[4 * g], v1 = bf2f((unsigned short)UV[g][1]) - acc[4 * g + 1], v2 = bf2f((unsigned short)UV[g][2]) - acc[4 * g + 2], v3 = bf2f((unsigned short)UV[g][3]) - acc[4 * g + 3]; \
                    v2u w2; w2.x = pk2(v0, v1); w2.y = pk2(v2, v3); *(LAS v2u*)(L + GS_VN + r * GS_VN_LD + (32 * rt + 8 * g + 4 * hh) * 2) = w2; } } \
            LDS_WAIT(); if (!(dup_ && (MK_Y & 2))) __builtin_amdgcn_s_barrier(); asm volatile("" ::: "memory"); \
            if (role == 1) { \
                _Pragma("unroll") for (int s = 0; s < 4; ++s) { const bf16x8 vn = *(const LAS bf16x8*)(L + GS_VN + r * GS_VN_LD + (16 * s + 8 * hh) * 2); acc = MFMA32(FB[s], vn, acc, 0, 0, 0); } \
                float* op = OG + (mrow0 + (cc) * 64 + 32 * rt) * 512 + h * 128 + dv0 + r; \
                const int nreal = smp ? DECT : 64; \
                if (!(dup_ && (MK_Y & 1))) { _Pragma("unroll") for (int q = 0; q < 16; ++q) if (32 * rt + crow(q, hh) < nreal) op[(size_t)crow(q, hh) * 512] = acc[q]; } \
            } else if (role == 2) { \
                _Pragma("unroll") for (int q = 0; q < 16; ++q) Sacc[q] *= GLV; \
                _Pragma("unroll") for (int s = 0; s < 4; ++s) { const bf16x8 vn = *(const LAS bf16x8*)(L + GS_VN + r * GS_VN_LD + (16 * s + 8 * hh) * 2); Sacc = MFMA32(FB[s], vn, Sacc, 0, 0, 0); } \
                _Pragma("unroll") for (int g = 0; g < 4; ++g) { v2u w2; w2.x = pk2(Sacc[4 * g], Sacc[4 * g + 1]); w2.y = pk2(Sacc[4 * g + 2], Sacc[4 * g + 3]); *(LAS v2u*)(L + GS_SB + r * GS_SB_LD + (32 * rt + 8 * g + 4 * hh) * 2) = w2; } } \
            LDS_WAIT(); if (!(dup_ && (MK_Y & 2))) __builtin_amdgcn_s_barrier(); asm volatile("" ::: "memory"); } while (0)
        bf16x8 fa0[8], fa1[8], fb0[4], fb1[4]; s16x4 uv0[4], uv1[4]; float gl0 = 1.f, gl1 = 1.f;
        GS_LOAD(fa0, uv0, fb0, gl0, 0);
#pragma unroll 1
        for (int c = 0; c < nch; c += 2) {
            { const int cn = (c + 1 < nch) ? c + 1 : nch - 1; GS_LOAD(fa1, uv1, fb1, gl1, cn); }
            GS_STEP(fa0, uv0, fb0, gl0, c);
            if (c + 1 < nch) {
                { const int cn = (c + 2 < nch) ? c + 2 : nch - 1; GS_LOAD(fa0, uv0, fb0, gl0, cn); }
                GS_STEP(fa1, uv1, fb1, gl1, c + 1);
            }
        }
#undef GS_LOAD
#undef GS_STEP
        if (role == 2 && !(dup_ && (MK_Y & 1))) { float* so = F.out + (smp ? O_GS : O_GP) + ((size_t)(b * GH + h) * GDK + 32 * rt) * GDV + dv0 + r;
#pragma unroll
            for (int q = 0; q < 16; ++q) so[(size_t)crow(q, hh) * GDV] = Sacc[q]; }
    }
}
__device__ __forceinline__ void gdn_out_phase(Frame& F, const Args& A) {
    const int lane = lane_fresh(); const bf16* P = WSP(bf16, WS_P); const float* OG = WSP(float, WS_OG); bf16* CAT = WSP(bf16, WS_CAT);
    const int gw = F.bx * NWAVES + F.wave, NGW = F.G * NWAVES;
    const f32x4 nw0 = *(const GAS f32x4*)(A.in[17] + 8 * (lane & 15)), nw1 = *(const GAS f32x4*)(A.in[17] + 8 * (lane & 15) + 4);
    for (int m0 = gw; m0 < M; m0 += 4 * NGW) {
        f32x4 o0[4], o1[4]; v4u zz[4];
#pragma unroll
        for (int k = 0; k < 4; ++k) { const int m = m0 + k * NGW; const int mm = m < M ? m : m0;
            o0[k] = *(const GAS f32x4*)(OG + (size_t)mm * 512 + 8 * lane); o1[k] = *(const GAS f32x4*)(OG + (size_t)mm * 512 + 8 * lane + 4); zz[k] = *(const GAS v4u*)(P + (size_t)mm * INWP + C_Z + 8 * lane); }
#pragma unroll
        for (int k = 0; k < 4; ++k) { const int m = m0 + k * NGW;
            if (m < M) {
                float ss = (o0[k].x * o0[k].x + o0[k].y * o0[k].y) + (o0[k].z * o0[k].z + o0[k].w * o0[k].w) + (o1[k].x * o1[k].x + o1[k].y * o1[k].y) + (o1[k].z * o1[k].z + o1[k].w * o1[k].w);
                ss += dpp_movf(ss, 0); ss += dpp_movf(ss, 1); ss += dpp_movf(ss, 2); ss += dpp_movf(ss, 3);
                const float rs = 1.f / sqrtf(ss * (1.f / 128.f) + NORM_EPS);
                float z[8] = {bflo(zz[k].x), bfhi(zz[k].x), bflo(zz[k].y), bfhi(zz[k].y), bflo(zz[k].z), bfhi(zz[k].z), bflo(zz[k].w), bfhi(zz[k].w)};
                const float ov[8] = {o0[k].x, o0[k].y, o0[k].z, o0[k].w, o1[k].x, o1[k].y, o1[k].z, o1[k].w}; const float nwv[8] = {nw0.x, nw0.y, nw0.z, nw0.w, nw1.x, nw1.y, nw1.z, nw1.w};
                float r[8];
#pragma unroll
                for (int e = 0; e < 8; ++e) r[e] = ov[e] * rs * nwv[e] * (z[e] / (1.f + __expf(-z[e])));
                v4u w; w.x = pk2(r[0], r[1]); w.y = pk2(r[2], r[3]); w.z = pk2(r[4], r[5]); w.w = pk2(r[6], r[7]);
                *(GAS v4u*)(CAT + (size_t)m * D + 512 + 8 * lane) = w; } }
    }
}
#define MFMA32H __builtin_amdgcn_mfma_f32_32x32x16_f16
__device__ __forceinline__ unsigned f2key(float x) { unsigned b = __builtin_bit_cast(unsigned, x); if ((b << 1) == 0u) b = 0u; return (b & 0x80000000u) ? ~b : (b | 0x80000000u); }
__device__ __forceinline__ float key2f(unsigned k) { const unsigned b = (k & 0x80000000u) ? (k & 0x7fffffffu) : ~k; return __builtin_bit_cast(float, b); }
template <class Get>
__device__ __forceinline__ void wave_topk_threshold(const Get& get, int n, int lane, LAS unsigned* hist, unsigned& thr_key, int& tie_cut) {
    const int niter = (n + 63) >> 6;
    unsigned kmin = 0xffffffffu, kmax = 0u;
#pragma unroll 4
    for (int it = 0; it < niter; ++it) { const int idx = 64 * it + lane; if (idx < n) { const unsigned uk = f2key(get(idx)); kmin = uk < kmin ? uk : kmin; kmax = uk > kmax ? uk : kmax; } }
#pragma unroll
    for (int o = 1; o < 64; o <<= 1) { const unsigned a = (unsigned)__shfl_xor((int)kmin, o), b = (unsigned)__shfl_xor((int)kmax, o); kmin = a < kmin ? a : kmin; kmax = b > kmax ? b : kmax; }
    thr_key = kmax; tie_cut = KSEL - 1;
    if (kmax == kmin) return;
    unsigned base = kmin; int bits = 32 - __builtin_clz(kmax - kmin), kk = KSEL; unsigned cnt = (unsigned)n;
#pragma unroll 1
    while (bits > 0 && cnt > 64u) {
        const int shift = bits > 8 ? bits - 8 : 0;
        *(LAS v4u*)(hist + 4 * lane) = (v4u){0u, 0u, 0u, 0u};
        LDS_WAIT(); asm volatile("" ::: "memory");
#pragma unroll 4
        for (int it = 0; it < niter; ++it) { const int idx = 64 * it + lane;
            if (idx < n) { const unsigned uk = f2key(get(idx)); const unsigned rel = uk - base; if (uk >= base && (bits >= 32 || (rel >> bits) == 0u)) __hip_atomic_fetch_add(hist + (rel >> shift), 1u, __ATOMIC_RELAXED, __HIP_MEMORY_SCOPE_WORKGROUP); } }
        LDS_WAIT(); asm volatile("" ::: "memory");
        const v4u h4 = *(const LAS v4u*)(hist + 4 * lane);
        const unsigned tot = h4.x + h4.y + h4.z + h4.w; unsigned incl = tot;
#pragma unroll
        for (int o = 1; o < 64; o <<= 1) { const unsigned t = __shfl_down(incl, o); if (lane + o < 64) incl += t; }
        const unsigned excl = incl - tot, c3 = excl + h4.w, c2 = c3 + h4.z, c1 = c2 + h4.y, c0 = c1 + h4.x; const unsigned k_ = (unsigned)kk;
        int dj = -1; unsigned above = 0u, cn = 0u;
        if (excl < k_ && k_ <= c3) { dj = 3; above = excl; cn = h4.w; } else if (c3 < k_ && k_ <= c2) { dj = 2; above = c3; cn = h4.z; } else if (c2 < k_ && k_ <= c1) { dj = 1; above = c2; cn = h4.y; } else if (c1 < k_ && k_ <= c0) { dj = 0; above = c1; cn = h4.x; }
        const unsigned long long bm = __ballot(dj >= 0); const int src = bm ? __builtin_ctzll(bm) : 0;
        const unsigned digit = (unsigned)__shfl(4 * lane + dj, src); above = (unsigned)__shfl((int)above, src); cn = (unsigned)__shfl((int)cn, src);
        base += digit << shift; kk -= (int)above; cnt = cn; bits = shift;
    }
    if (bits == 0) {
        thr_key = base; tie_cut = 0x7fffffff;
        if ((int)cnt > kk) { int run = 0;
#pragma unroll 1
            for (int it = 0; it < niter; ++it) { const int idx = 64 * it + lane; const bool eq = idx < n && f2key(get(idx)) == base;
                unsigned long long bm = __ballot(eq); const int c = __builtin_popcountll(bm);
                if (run + c >= kk) { int skip = kk - run - 1; while (skip-- > 0) bm &= bm - 1; tie_cut = 64 * it + __builtin_ctzll(bm); break; }
                run += c; } }
        return;
    }
    { int run = 0;
#pragma unroll 4
      for (int it = 0; it < niter; ++it) { const int idx = 64 * it + lane; bool in = false; unsigned uk = 0u;
          if (idx < n) { uk = f2key(get(idx)); in = uk >= base && ((uk - base) >> bits) == 0u; }
          const unsigned long long bm = __ballot(in);
          if (in) { const int pos = run + __builtin_popcountll(bm & ((1ull << lane) - 1ull)); hist[pos] = uk; hist[64 + pos] = (unsigned)idx; }
          run += __builtin_popcountll(bm); } }
    LDS_WAIT(); asm volatile("" ::: "memory");
    const bool have = lane < (int)cnt; const unsigned my = have ? hist[lane] : 0u; const int myi = have ? (int)hist[64 + lane] : 0x7fffffff;
    int rank = 0; bool later_tie = false;
#pragma unroll 1
    for (int j = 0; j < (int)cnt; ++j) { const unsigned kj = hist[j]; const int ij = (int)hist[64 + j]; rank += (kj > my || (kj == my && ij < myi)) ? 1 : 0; later_tie = later_tie || (kj == my && ij > myi); }
    const unsigned long long hit = __ballot(have && rank == kk - 1); const int src = hit ? __builtin_ctzll(hit) : 0;
    thr_key = (unsigned)__shfl((int)my, src); const int cut = __shfl(myi, src); const int lt = __shfl(later_tie ? 1 : 0, src);
    tie_cut = lt ? cut : 0x7fffffff;
}
template <int NIT>
__device__ __forceinline__ void wave_topk_reg(const LAS float* row, int n, int lane, LAS unsigned* hist, unsigned& thr_key, int& tie_cut) {
    unsigned key[NIT]; unsigned kmin = 0xffffffffu, kmax = 0u;
#pragma unroll
    for (int i = 0; i < NIT; ++i) { const float x = row[64 * i + lane]; const unsigned uk = f2key(x); const bool ok = 64 * i + lane < n; key[i] = ok ? uk : 0u;
        kmin = (ok && uk < kmin) ? uk : kmin; kmax = (ok && uk > kmax) ? uk : kmax; }
    WAVE_REDUCE_U32(kmin, umin_); WAVE_REDUCE_U32(kmax, umax_);
    thr_key = kmax; tie_cut = KSEL - 1;
    if (kmax == kmin) return;
    unsigned base = kmin, kcap = kmax; int kk = KSEL; unsigned cnt = (unsigned)n;
#define TK_SCAN(DIGIT, ABOVE, CN) do { \
        const v4u h4 = *(const LAS v4u*)(hist + 4 * lane); \
        const unsigned tot = h4.x + h4.y + h4.z + h4.w; const unsigned incl = wave_suffix_sum(tot, lane); \
        const unsigned excl = incl - tot, c3 = excl + h4.w, c2 = c3 + h4.z, c1 = c2 + h4.y, c0 = c1 + h4.x; const unsigned k_ = (unsigned)kk; \
        int dj = -1; unsigned ab_ = 0u, cn_ = 0u; \
        if (excl < k_ && k_ <= c3) { dj = 3; ab_ = excl; cn_ = h4.w; } else if (c3 < k_ && k_ <= c2) { dj = 2; ab_ = c3; cn_ = h4.z; } else if (c2 < k_ && k_ <= c1) { dj = 1; ab_ = c2; cn_ = h4.y; } else if (c1 < k_ && k_ <= c0) { dj = 0; ab_ = c1; cn_ = h4.x; } \
        const unsigned long long bm_ = __ballot(dj >= 0); const int src_ = bm_ ? __builtin_ctzll(bm_) : 0; \
        DIGIT = (unsigned)__builtin_amdgcn_readlane(4 * lane + dj, src_); ABOVE = (unsigned)__builtin_amdgcn_readlane((int)ab_, src_); CN = (unsigned)__builtin_amdgcn_readlane((int)cn_, src_); } while (0)
    bool uselin = false; float lxmin = 0.f, lscale = 0.f; int ldig = 0;
    { const float xmin = key2f(kmin), range = key2f(kmax) - xmin;
      if (range > 1e-30f && range < 1e30f) {
          const float scale = 255.99f / range;
          *(LAS v4u*)(hist + 4 * lane) = (v4u){0u, 0u, 0u, 0u};
          LDS_WAIT(); asm volatile("" ::: "memory");
#pragma unroll
          for (int i = 0; i < NIT; ++i) { int d = (int)((key2f(key[i]) - xmin) * scale); d = d > 255 ? 255 : d; if (key[i] != 0u) __hip_atomic_fetch_add(hist + d, 1u, __ATOMIC_RELAXED, __HIP_MEMORY_SCOPE_WORKGROUP); }
          LDS_WAIT(); asm volatile("" ::: "memory");
          unsigned digit, above, cn; TK_SCAN(digit, above, cn);
          kk -= (int)above; cnt = cn; uselin = true; lxmin = xmin; lscale = scale; ldig = (int)digit;
          if (cnt > 64u) {
              uselin = false;
              unsigned k2min = 0xffffffffu, k2max = 0u;
#pragma unroll
              for (int i = 0; i < NIT; ++i) { int d = (int)((key2f(key[i]) - xmin) * scale); d = d > 255 ? 255 : d; const bool in = key[i] != 0u && d == (int)digit; k2min = (in && key[i] < k2min) ? key[i] : k2min; k2max = (in && key[i] > k2max) ? key[i] : k2max; }
              WAVE_REDUCE_U32(k2min, umin_); WAVE_REDUCE_U32(k2max, umax_);
              base = k2min; kcap = k2max; }
      } }
    int bits = (kcap == base) ? 0 : 32 - __builtin_clz(kcap - base);
#pragma unroll 1
    while (bits > 0 && cnt > 64u) {
        const int shift = bits > 8 ? bits - 8 : 0; const unsigned lim = bits >= 32 ? 0xffffffffu : ((1u << bits) - 1u);
        *(LAS v4u*)(hist + 4 * lane) = (v4u){0u, 0u, 0u, 0u};
        LDS_WAIT(); asm volatile("" ::: "memory");
#pragma unroll
        for (int i = 0; i < NIT; ++i) { const unsigned rel = key[i] - base; if (key[i] >= base && key[i] <= kcap && rel <= lim) __hip_atomic_fetch_add(hist + (rel >> shift), 1u, __ATOMIC_RELAXED, __HIP_MEMORY_SCOPE_WORKGROUP); }
        LDS_WAIT(); asm volatile("" ::: "memory");
        unsigned digit, above, cn; TK_SCAN(digit, above, cn);
        base += digit << shift; kk -= (int)above; cnt = cn; bits = shift;
    }
#undef TK_SCAN
    if (bits == 0) {
        thr_key = base; tie_cut = 0x7fffffff;
        if ((int)cnt > kk) { int run = 0; bool done = false;
#pragma unroll
            for (int i = 0; i < NIT; ++i) { unsigned long long bm = __ballot(key[i] == base); const int c = __builtin_popcountll(bm);
                if (!done && run + c >= kk) { int skip = kk - run - 1; while (skip-- > 0) bm &= bm - 1; tie_cut = 64 * i + __builtin_ctzll(bm); done = true; }
                run += c; } }
        return;
    }
    const unsigned lim = bits >= 32 ? 0xffffffffu : ((1u << bits) - 1u);
    { int run = 0;
#pragma unroll
      for (int i = 0; i < NIT; ++i) { const unsigned rel = key[i] - base; bool in;
          if (uselin) { int d = (int)((key2f(key[i]) - lxmin) * lscale); d = d > 255 ? 255 : d; in = key[i] != 0u && d == ldig; } else in = key[i] >= base && key[i] <= kcap && rel <= lim;
          const unsigned long long bm = __ballot(in);
          if (in) { const int pos = run + __builtin_popcountll(bm & ((1ull << lane) - 1ull)); hist[pos] = key[i]; hist[64 + pos] = (unsigned)(64 * i + lane); }
          run += __builtin_popcountll(bm); } }
    LDS_WAIT(); asm volatile("" ::: "memory");
    const bool have = lane < (int)cnt; const unsigned my = have ? hist[lane] : 0u; const int myi = have ? (int)hist[64 + lane] : 0x7fffffff;
    int rank = 0; bool later_tie = false;
#pragma unroll 1
    for (int j = 0; j < (int)cnt; ++j) { const unsigned kj = (unsigned)__builtin_amdgcn_readlane((int)my, j); const int ij = __builtin_amdgcn_readlane(myi, j);
        rank += (kj > my || (kj == my && ij < myi)) ? 1 : 0; later_tie = later_tie || (kj == my && ij > myi); }
    const unsigned long long hit = __ballot(have && rank == kk - 1); const int src = hit ? __builtin_ctzll(hit) : 0;
    thr_key = (unsigned)__builtin_amdgcn_readlane((int)my, src); const int cut = __builtin_amdgcn_readlane(myi, src); const int lt = __builtin_amdgcn_readlane(later_tie ? 1 : 0, src);
    tie_cut = lt ? cut : 0x7fffffff;
}
__device__ __forceinline__ int idx_row_q(int i) { return 2 * ((i >> 2) & 1) + (i >> 4); }
__device__ __forceinline__ int idx_row_h(int i) { return 4 * ((i >> 3) & 1) + (i & 3); }

constexpr int SC_LD = 2052;
constexpr int DP_SC = 0, DP_WI = 131328, DP_THR = 131840, DP_TIE = 131904, DP_HIST = 132096, DP_END = 140288;
static_assert(DP_END <= RING_BYTES, "DSA prompt LDS");
constexpr float QK_SCALE = 0.125f * 1.4426950408889634f;
__device__ __forceinline__ void dsa_prompt_unit(Frame& F, int b, int qt) {
    const int wave = F.wave; const int lane = lane_dep(qt); const int c = lane & 31, hh = lane >> 5;
    LAS unsigned char* L = F.lds + RING_OFF;
    LAS float* SC = (LAS float*)(L + DP_SC); LAS float* WIs = (LAS float*)(L + DP_WI); LAS float* THR = (LAS float*)(L + DP_THR); LAS int* TIE = (LAS int*)(L + DP_TIE);
    const f16* QIh = WSP(f16, WS_QI); const f16* KIh = WSP(f16, WS_KI); const float* WI = WSP(float, WS_WI);
    const bf16* Qb = WSP(bf16, WS_QB); const bf16* Kb = WSP(bf16, WS_KB); const bf16* VT = WSP(bf16, WS_VT); bf16* CAT = WSP(bf16, WS_CAT);
    const int q0 = 16 * qt; const size_t mb = (size_t)b * SEQ; const int Lk = q0 + 16, nkt = (Lk + 31) >> 5;
#pragma unroll 1
    for (int rep_a = 0; rep_a < (MK_X == 1 ? 2 : 1); ++rep_a) {
    if (wave == 0 && lane < 32) *(LAS f32x4*)(WIs + 4 * lane) = *(const GAS f32x4*)(WI + (mb + q0) * 8 + 4 * lane);
    {
        f16x8 aq[4][4];
#pragma unroll
        for (int rt4 = 0; rt4 < 4; ++rt4)
#pragma unroll
            for (int s = 0; s < 4; ++s) aq[rt4][s] = *(const GAS f16x8*)(QIh + (mb + q0 + 4 * rt4 + idx_row_q(c)) * 512 + idx_row_h(c) * 64 + 16 * s + 8 * hh);
        LDS_WAIT(); __syncthreads();
#define DA_LOAD(BK, kt_) do { _Pragma("unroll") for (int s = 0; s < 4; ++s) BK[s] = *(const GAS f16x8*)(KIh + (mb + 32 * (kt_) + c) * 64 + 16 * s + 8 * hh); } while (0)
#define DA_STEP(BK, kt_) do { const int key = 32 * (kt_) + c; \
            _Pragma("unroll") for (int rt4 = 0; rt4 < 4; ++rt4) { \
                f32x16 acc = zero16(); \
                _Pragma("unroll") for (int s = 0; s < 4; ++s) acc = MFMA32H(aq[rt4][s], BK[s], acc, 0, 0, 0); \
                const int ql0 = 4 * rt4 + 2 * hh; \
                const f32x4 w0 = *(const LAS f32x4*)(WIs + ql0 * 8), w1 = *(const LAS f32x4*)(WIs + ql0 * 8 + 4), w2 = *(const LAS f32x4*)(WIs + ql0 * 8 + 8), w3 = *(const LAS f32x4*)(WIs + ql0 * 8 + 12); \
                float s0 = w0.x * fmaxf(acc[0], 0.f) + w0.y * fmaxf(acc[1], 0.f) + w0.z * fmaxf(acc[2], 0.f) + w0.w * fmaxf(acc[3], 0.f) + w1.x * fmaxf(acc[4], 0.f) + w1.y * fmaxf(acc[5], 0.f) + w1.z * fmaxf(acc[6], 0.f) + w1.w * fmaxf(acc[7], 0.f); \
                float s1 = w2.x * fmaxf(acc[8], 0.f) + w2.y * fmaxf(acc[9], 0.f) + w2.z * fmaxf(acc[10], 0.f) + w2.w * fmaxf(acc[11], 0.f) + w3.x * fmaxf(acc[12], 0.f) + w3.y * fmaxf(acc[13], 0.f) + w3.z * fmaxf(acc[14], 0.f) + w3.w * fmaxf(acc[15], 0.f); \
                SC[ql0 * SC_LD + key] = (key <= q0 + ql0) ? s0 : -INFINITY; SC[(ql0 + 1) * SC_LD + key] = (key <= q0 + ql0 + 1) ? s1 : -INFINITY; } } while (0)
        { f16x8 bkA[4], bkB[4];
          DA_LOAD(bkA, (wave < nkt ? wave : nkt - 1));
#pragma unroll 1
          for (int kt = wave; kt < nkt; kt += 2 * NWAVES) {
              DA_LOAD(bkB, (kt + NWAVES < nkt ? kt + NWAVES : nkt - 1));
              DA_STEP(bkA, kt);
              if (kt + NWAVES < nkt) {
                  DA_LOAD(bkA, (kt + 2 * NWAVES < nkt ? kt + 2 * NWAVES : nkt - 1));
                  DA_STEP(bkB, kt + NWAVES);
              }
          } }
#undef DA_LOAD
#undef DA_STEP
    }
    LDS_WAIT(); __syncthreads();
    }
#pragma unroll 1
    for (int rep_b = 0; rep_b < (MK_X == 2 ? 2 : 1); ++rep_b)
#pragma unroll 1
    for (int e = 0; e < 2; ++e) { const int ql = 2 * wave + e, n = q0 + ql + 1; unsigned tk = 0u; int tc = 0x7fffffff; float thr = -3.0e38f;
        if (n > KSEL) { const LAS float* row = SC + ql * SC_LD; LAS unsigned* hist = (LAS unsigned*)(L + DP_HIST) + wave * 256;
            if (MK_X != 6 && n <= 1024) wave_topk_reg<16>(row, n, lane, hist, tk, tc); else wave_topk_reg<32>(row, n, lane, hist, tk, tc);
            thr = key2f(tk); }
        if (lane == 0) { THR[ql] = thr; TIE[ql] = tc; } }
    LDS_WAIT(); __syncthreads();
    const int rt = wave & 3, kh = wave >> 2, g = rt >> 1, ql = 8 * (rt & 1) + (c >> 2), head = 4 * g + (c & 3), qpos = q0 + ql;
    bf16x8 bq[4];
#pragma unroll
    for (int s = 0; s < 4; ++s) bq[s] = *(const GAS bf16x8*)(Qb + (mb + qpos) * 512 + head * 64 + 16 * s + 8 * hh);
    const float thr = THR[ql]; const int tie = TIE[ql];
    float m_run = -INFINITY, l_run = 0.f; f32x16 O0 = zero16(), O1 = zero16();
    const bf16* vtb = VT + (((size_t)(b * 2 + g) * (SEQ / 32)) * 64 + c) * 32 + 16 * hh;
#define DP_LOAD(AK, V8, kt_) do { \
        _Pragma("unroll") for (int s = 0; s < 4; ++s) AK[s] = *(const GAS bf16x8*)(Kb + (mb + 32 * (kt_) + c) * 128 + g * 64 + 16 * s + 8 * hh); \
        _Pragma("unroll") for (int dt = 0; dt < 2; ++dt) _Pragma("unroll") for (int s2 = 0; s2 < 2; ++s2) \
            V8[dt][s2] = *(const GAS bf16x8*)(vtb + ((size_t)(kt_) * 64 + 32 * dt) * 32 + 8 * s2); } while (0)
#define DP_STEP(AK, V8, kt_) do { asm volatile("; DPSTEP_BEGIN"); \
        f32x16 acc = zero16(); \
        _Pragma("unroll") for (int s = 0; s < 4; ++s) acc = MFMA32(AK[s], bq[s], acc, 0, 0, 0); \
        float p[16]; float mx = -INFINITY; \
        if (notie) { \
            _Pragma("unroll") for (int g4 = 0; g4 < 4; ++g4) { const f32x4 scv = *(const LAS f32x4*)(SC + ql * SC_LD + 32 * (kt_) + 8 * g4 + 4 * hh); \
                _Pragma("unroll") for (int e = 0; e < 4; ++e) { const float s = (scv[e] >= thr) ? acc[4 * g4 + e] : -INFINITY; p[4 * g4 + e] = s; mx = fmaxf(mx, s); } } \
        } else { \
            _Pragma("unroll") for (int g4 = 0; g4 < 4; ++g4) { const f32x4 scv = *(const LAS f32x4*)(SC + ql * SC_LD + 32 * (kt_) + 8 * g4 + 4 * hh); \
                _Pragma("unroll") for (int e = 0; e < 4; ++e) { const int key = 32 * (kt_) + 8 * g4 + 4 * hh + e; const float sv = scv[e]; \
                    const bool sel = sv > thr || (sv == thr && key <= tie); \
                    const float s = sel ? acc[4 * g4 + e] : -INFINITY; p[4 * g4 + e] = s; mx = fmaxf(mx, s); } } } \
        mx = fmaxf(mx, __shfl_xor(mx, 32)); \
        const float m_new = fmaxf(m_run, mx), m_safe = (m_new == -INFINITY) ? 0.f : m_new; \
        float ps = 0.f; \
        _Pragma("unroll") for (int r = 0; r < 16; ++r) { p[r] = __builtin_amdgcn_exp2f(p[r] - m_safe); ps += p[r]; } \
        if (__any(m_new != m_run)) { const float alpha = __builtin_amdgcn_exp2f(m_run - m_safe); l_run *= alpha; \
            _Pragma("unroll") for (int r = 0; r < 16; ++r) { O0[r] *= alpha; O1[r] *= alpha; } } \
        l_run += ps; m_run = m_new; \
        _Pragma("unroll") for (int s2 = 0; s2 < 2; ++s2) { \
            v4u pw; pw.x = pg8::cvt_pk_bf16(p[8 * s2], p[8 * s2 + 1]); pw.y = pg8::cvt_pk_bf16(p[8 * s2 + 2], p[8 * s2 + 3]); pw.z = pg8::cvt_pk_bf16(p[8 * s2 + 4], p[8 * s2 + 5]); pw.w = pg8::cvt_pk_bf16(p[8 * s2 + 6], p[8 * s2 + 7]); \
            const bf16x8 pb = __builtin_bit_cast(bf16x8, pw); \
            O0 = MFMA32(V8[0][s2], pb, O0, 0, 0, 0); O1 = MFMA32(V8[1][s2], pb, O1, 0, 0, 0); } } while (0)
    { bf16x8 akA[4], akB[4], akC[4]; bf16x8 v8A[2][2], v8B[2][2], v8C[2][2];
      const bool notie = __all(tie == 0x7fffffff);
#define DP_CL(k_) ((k_) < nkt ? (k_) : nkt - 1)
      DP_LOAD(akA, v8A, DP_CL(kh)); DP_LOAD(akB, v8B, DP_CL(kh + 2));
#pragma unroll 1
      for (int kt = kh; kt < nkt; kt += 6) {
          DP_LOAD(akC, v8C, DP_CL(kt + 4));
          DP_STEP(akA, v8A, kt);
          if (kt + 2 < nkt) {
              DP_LOAD(akA, v8A, DP_CL(kt + 6));
              DP_STEP(akB, v8B, kt + 2);
              if (kt + 4 < nkt) {
                  DP_LOAD(akB, v8B, DP_CL(kt + 8));
                  DP_STEP(akC, v8C, kt + 4);
              }
          }
      } }
#undef DP_CL
#undef DP_LOAD
#undef DP_STEP
    l_run += __shfl_xor(l_run, 32);
    __syncthreads();
    LAS float* CB = (LAS float*)(L + DP_SC) + rt * (34 * 64);
    if (kh == 1) { CB[lane] = m_run; CB[64 + lane] = l_run;
#pragma unroll
        for (int r = 0; r < 16; ++r) { CB[(2 + r) * 64 + lane] = O0[r]; CB[(18 + r) * 64 + lane] = O1[r]; } }
    LDS_WAIT(); __syncthreads();
    if (kh == 0) {
        const float m1 = CB[lane], l1 = CB[64 + lane]; const float m = fmaxf(m_run, m1), ms = (m == -INFINITY) ? 0.f : m;
        const float a0 = __builtin_amdgcn_exp2f(m_run - ms), a1 = __builtin_amdgcn_exp2f(m1 - ms); const float inv = 1.f / (l_run * a0 + l1 * a1);
        bf16* op = CAT + (mb + qpos) * D + head * 64 + 4 * hh;
#pragma unroll
        for (int g4 = 0; g4 < 4; ++g4) { float o[8];
#pragma unroll
            for (int e = 0; e < 4; ++e) { o[e] = (O0[4 * g4 + e] * a0 + CB[(2 + 4 * g4 + e) * 64 + lane] * a1) * inv; o[4 + e] = (O1[4 * g4 + e] * a0 + CB[(18 + 4 * g4 + e) * 64 + lane] * a1) * inv; }
            v2u w0; w0.x = pk2(o[0], o[1]); w0.y = pk2(o[2], o[3]); *(GAS v2u*)(op + 8 * g4) = w0;
            v2u w1; w1.x = pk2(o[4], o[5]); w1.y = pk2(o[6], o[7]); *(GAS v2u*)(op + 32 + 8 * g4) = w1; }
    }
    LDS_WAIT(); __syncthreads();
}
__device__ __forceinline__ void dsa_prompt_phase(Frame& F) {
    for (int w0 = F.bx; w0 < 256; w0 += F.G) { const int w = ((w0 & 7) << 5) | (w0 >> 3);
        const int b = w >> 4, sub = w & 15;
#pragma unroll 1
        for (int j = 0; j < 8; ++j) { const int qt = 32 * (j >> 1) + ((j & 1) ? 31 - sub : sub); dsa_prompt_unit(F, b, qt); } }
}
__device__ __forceinline__ void dsa_sample_scores_phase(Frame& F, const Args& A) {
    const int wave = F.wave;
    const f16* QIh = WSP(f16, WS_QI); const f16* KIh = WSP(f16, WS_KI); const float* WI = WSP(float, WS_WI); float* SCS = WSP(float, WS_SCS);
    const float* ckidx = A.in[4]; const int* ptab = (const int*)A.in[7];
    const int kt4 = wave & 3, rt2 = wave >> 2;
    { const int lane = lane_fresh(); const int c = lane & 31, hh = lane >> 5; const int NU = DECB * NPAGES;
      LAS unsigned char* L = F.lds + RING_OFF + wave * 4608;
      f32x4 xa[8], xb[8];
#define D1_GLOAD(X, u_) do { const int kk_ = ((u_) - u0 < per) ? (u_) - u0 : per - 1; const int phys = phl[kk_]; const GAS f32x4* src = (const GAS f32x4*)(ckidx + ((size_t)phys * PAGE + 32 * kt4) * 64); \
        _Pragma("unroll") for (int i = 0; i < 8; ++i) X[i] = src[lane + 64 * i]; } while (0)
#define D1_STEP(X, u_) do { \
        _Pragma("unroll") for (int i = 0; i < 8; ++i) { const int idx = lane + 64 * i, key = idx >> 4, d4 = idx & 15; \
            typedef _Float16 f16x4_ __attribute__((ext_vector_type(4))); f16x4_ h; h[0] = (f16)X[i].x; h[1] = (f16)X[i].y; h[2] = (f16)X[i].z; h[3] = (f16)X[i].w; \
            *(LAS f16x4_*)(L + key * 144 + d4 * 8) = h; } \
        LDS_WAIT(); asm volatile("" ::: "memory"); \
        const int bs = (u_) >> 6, j = (u_) & 63; const size_t ms = (size_t)MP + (size_t)bs * DECT; \
        f16x8 bk[4]; \
        _Pragma("unroll") for (int s = 0; s < 4; ++s) bk[s] = *(const LAS f16x8*)(L + c * 144 + (16 * s + 8 * hh) * 2); \
        LDS_WAIT(); asm volatile("" ::: "memory"); \
        const int ql0 = 4 * rt2 + 2 * hh; \
        if (bs != bs_cur) { bs_cur = bs; \
            _Pragma("unroll") for (int s = 0; s < 4; ++s) aq[s] = *(const GAS f16x8*)(QIh + (ms + 4 * rt2 + idx_row_q(c)) * 512 + idx_row_h(c) * 64 + 16 * s + 8 * hh); \
            const GAS f32x4* wp = (const GAS f32x4*)(WI + (ms + ql0) * 8); w0 = wp[0]; w1 = wp[1]; w2 = wp[2]; w3 = wp[3]; } \
        f32x16 acc = zero16(); \
        _Pragma("unroll") for (int s = 0; s < 4; ++s) acc = MFMA32H(aq[s], bk[s], acc, 0, 0, 0); \
        const float s0 = w0.x * fmaxf(acc[0], 0.f) + w0.y * fmaxf(acc[1], 0.f) + w0.z * fmaxf(acc[2], 0.f) + w0.w * fmaxf(acc[3], 0.f) + w1.x * fmaxf(acc[4], 0.f) + w1.y * fmaxf(acc[5], 0.f) + w1.z * fmaxf(acc[6], 0.f) + w1.w * fmaxf(acc[7], 0.f); \
        const float s1 = w2.x * fmaxf(acc[8], 0.f) + w2.y * fmaxf(acc[9], 0.f) + w2.z * fmaxf(acc[10], 0.f) + w2.w * fmaxf(acc[11], 0.f) + w3.x * fmaxf(acc[12], 0.f) + w3.y * fmaxf(acc[13], 0.f) + w3.z * fmaxf(acc[14], 0.f) + w3.w * fmaxf(acc[15], 0.f); \
        const int key = PAGE * j + 32 * kt4 + c; \
        SCS[((size_t)bs * DECT + ql0) * SCS_LD + key] = s0; SCS[((size_t)bs * DECT + ql0 + 1) * SCS_LD + key] = s1; } while (0)
      const int per = (NU + F.G - 1) / F.G, u0 = F.bx * per, u1 = (u0 + per < NU) ? u0 + per : NU;
      LAS int* phl = (LAS int*)(F.lds + RING_OFF + 8 * 4608);
      for (int k = wave * 64 + lane; k < per; k += NTHR) { const int uu = (u0 + k < NU) ? u0 + k : NU - 1; phl[k] = ptab[(uu >> 6) * NPAGES + (uu & 63)]; }
      LDS_WAIT(); __syncthreads();
      int bs_cur = -1; f16x8 aq[4]; f32x4 w0, w1, w2, w3; f32x4 xc[8], xd[8];
      D1_GLOAD(xa, u0); D1_GLOAD(xb, u0 + 1); D1_GLOAD(xc, u0 + 2); D1_GLOAD(xd, u0 + 3);
#pragma unroll 1
      for (int u = u0; u < u1; u += 4) {
          D1_STEP(xa, u); D1_GLOAD(xa, u + 4);
          if (u + 1 < u1) { D1_STEP(xb, u + 1); D1_GLOAD(xb, u + 5); }
          if (u + 2 < u1) { D1_STEP(xc, u + 2); D1_GLOAD(xc, u + 6); }
          if (u + 3 < u1) { D1_STEP(xd, u + 3); D1_GLOAD(xd, u + 7); }
      }
#undef D1_GLOAD
#undef D1_STEP
    }
    __syncthreads();
#pragma unroll 1
    for (int bs = F.bx * NWAVES + wave; bs < DECB; bs += F.G * NWAVES) {
        const int lane = lane_dep(bs); const int t = lane >> 3, t2 = lane & 7; const size_t ms = (size_t)MP + (size_t)bs * DECT;
        float sc = 0.f;
#pragma unroll 1
        for (int h = 0; h < 8; ++h) { float d = 0.f;
#pragma unroll 8
            for (int e = 0; e < 64; ++e) d += (float)QIh[(ms + t) * 512 + h * 64 + e] * (float)KIh[(ms + t2) * 64 + e];
            sc += WI[(ms + t) * 8 + h] * fmaxf(d, 0.f); }
        SCS[((size_t)bs * DECT + t) * SCS_LD + PAST + t2] = (t2 <= t) ? sc : -INFINITY;
    }
}
constexpr int DS_ROW = 0, DS_HIST = 32832, DS_LIST = 33856, DS_RID = 34880, DS_WAVE = 35904;
static_assert(4 * DS_WAVE <= RING_BYTES, "DSA sample LDS");
__device__ __forceinline__ void dsa_sample_attend_phase(Frame& F, const Args& A) {
    const int wave = F.wave;
    if (wave >= 4) return;
    LAS unsigned char* L = F.lds + RING_OFF + wave * DS_WAVE;
    LAS float* rowl = (LAS float*)(L + DS_ROW); LAS unsigned* hist = (LAS unsigned*)(L + DS_HIST); LAS int* list = (LAS int*)(L + DS_LIST); LAS int* rowid = (LAS int*)(L + DS_RID);
    LAS float* qv = rowl; LAS float* sc = rowl + 512;
    const float* SCS = WSP(float, WS_SCS); const bf16* Qb = WSP(bf16, WS_QB); bf16* CAT = WSP(bf16, WS_CAT);
    const float* ck = A.in[2]; const float* cv = A.in[3]; const int* ptab = (const int*)A.in[7];
#pragma unroll 1
    for (int qi = wave * F.G + F.bx; qi < MS; qi += 4 * F.G) {
        const int lane = lane_dep(qi);
        const int bs = qi >> 3, t = qi & 7, n = PAST + t + 1; const size_t m = (size_t)MP + qi;
        { const GAS f32x4* src = (const GAS f32x4*)(SCS + (size_t)qi * SCS_LD);
#pragma unroll 1
          for (int k0 = 0; k0 < 33; k0 += 11) { f32x4 tmp[11];
#pragma unroll
              for (int k = 0; k < 11; ++k) { const int i4 = lane + 64 * (k0 + k); tmp[k] = (i4 < SCS_LD / 4) ? src[i4] : (f32x4){0.f, 0.f, 0.f, 0.f}; }
#pragma unroll
              for (int k = 0; k < 11; ++k) { const int i4 = lane + 64 * (k0 + k); if (i4 < SCS_LD / 4) *(LAS f32x4*)(rowl + 4 * i4) = tmp[k]; } } }
        LDS_WAIT(); asm volatile("" ::: "memory");
        unsigned tk; int tc;
        wave_topk_reg<(LS + 63) / 64>(rowl, n, lane, hist, tk, tc);
        int cnt = 0;
#pragma unroll 1
        for (int it = 0; it < (n + 63) / 64; ++it) { const int idx = 64 * it + lane; bool sel = false;
            if (idx < n) { const unsigned uk = f2key(rowl[idx]); sel = uk > tk || (uk == tk && idx <= tc); }
            const unsigned long long bm = __ballot(sel); const int pos = cnt + __builtin_popcountll(bm & ((1ull << lane) - 1ull));
            if (sel && pos < KSEL) list[pos] = idx;
            cnt += __builtin_popcountll(bm); }
        LDS_WAIT(); asm volatile("" ::: "memory");
#pragma unroll
        for (int e = 0; e < 4; ++e) { const unsigned qq = *(const GAS unsigned*)(Qb + m * 512 + 128 * e + 2 * lane); qv[128 * e + 2 * lane] = bflo(qq); qv[128 * e + 2 * lane + 1] = bfhi(qq); }
        LDS_WAIT(); asm volatile("" ::: "memory");
        float mxh[8];
#pragma unroll
        for (int h = 0; h < 8; ++h) mxh[h] = -INFINITY;
#pragma unroll 1
        for (int p = 0; p < 4; ++p) { const int jj = 64 * p + lane; const int idx = list[jj];
            const float* kp; int rid;
            if (idx < PAST) { rid = ptab[bs * NPAGES + (idx >> 7)] * PAGE + (idx & 127); kp = ck + (size_t)rid * 128; }
            else { rid = -(idx - PAST) - 1; kp = F.out + O_KS + ((size_t)bs * DECT + (idx - PAST)) * 128; }
            rowid[jj] = rid;
            f32x4 kr[32];
#pragma unroll
            for (int e = 0; e < 32; ++e) kr[e] = *(const GAS f32x4*)(kp + 4 * e);
            float s[8];
#pragma unroll
            for (int h = 0; h < 8; ++h) s[h] = 0.f;
#pragma unroll
            for (int g = 0; g < 2; ++g)
#pragma unroll
                for (int d4 = 0; d4 < 16; ++d4) { const f32x4 kv = kr[16 * g + d4];
#pragma unroll
                    for (int hl = 0; hl < 4; ++hl) { const f32x4 q4 = *(const LAS f32x4*)(qv + (4 * g + hl) * 64 + 4 * d4); s[4 * g + hl] += kv.x * q4.x + kv.y * q4.y + kv.z * q4.z + kv.w * q4.w; } }
#pragma unroll
            for (int h = 0; h < 8; ++h) { const float v = s[h];   sc[h * 256 + jj] = v; mxh[h] = fmaxf(mxh[h], v); } }
        LDS_WAIT(); asm volatile("" ::: "memory");
        float invl[8];
#pragma unroll
        for (int h = 0; h < 8; ++h) { const float mm = wave_max(mxh[h]); float ps = 0.f;
#pragma unroll
            for (int p = 0; p < 4; ++p) { const float e = __builtin_amdgcn_exp2f(sc[h * 256 + 64 * p + lane] - mm); sc[h * 256 + 64 * p + lane] = e; ps += e; }
            invl[h] = 1.f / wave_sum(ps); }
        LDS_WAIT(); asm volatile("" ::: "memory");
        const int g = lane >> 5, dp = lane & 31; float o[4][2];
#pragma unroll
        for (int hl = 0; hl < 4; ++hl) { o[hl][0] = 0.f; o[hl][1] = 0.f; }
#pragma unroll 1
        for (int j0 = 0; j0 < KSEL; j0 += 32) { f32x2 vv[32];
#pragma unroll
            for (int e = 0; e < 32; ++e) { const int rid = __builtin_amdgcn_readfirstlane(rowid[j0 + e]);
                const float* vp = (rid >= 0) ? cv + (size_t)rid * 128 : F.out + O_VS + ((size_t)bs * DECT + (-rid - 1)) * 128;
                vv[e] = *(const GAS f32x2*)(vp + 64 * g + 2 * dp); }
#pragma unroll
            for (int e = 0; e < 32; ++e)
#pragma unroll
                for (int hl = 0; hl < 4; ++hl) { const float pp = sc[(4 * g + hl) * 256 + j0 + e]; o[hl][0] += pp * vv[e].x; o[hl][1] += pp * vv[e].y; } }
#pragma unroll
        for (int hl = 0; hl < 4; ++hl) { const float il = (g == 0) ? invl[hl] : invl[4 + hl];
            *(GAS unsigned*)(CAT + m * D + (4 * g + hl) * 64 + 2 * dp) = pk2(o[hl][0] * il, o[hl][1] * il); }
        LDS_WAIT(); asm volatile("" ::: "memory");
    }
}
#if MK_DIAG
constexpr int CW_DG = 2048;
__device__ __forceinline__ void dg_add(Frame& F, int k, float num, float den) {
    LAS float* red = (LAS float*)(F.lds + RING_OFF + 140000);
    __syncthreads(); if ((int)threadIdx.x < 2) red[(int)threadIdx.x] = 0.f; __syncthreads();
    atomicAdd((float*)&red[0], num); atomicAdd((float*)&red[1], den); __syncthreads();
    if ((int)threadIdx.x == 0) { atomicAdd((float*)(F.ctl + CW_DG + 2 * k), red[0]); atomicAdd((float*)(F.ctl + CW_DG + 2 * k + 1), red[1]); }
    __syncthreads();
}
__device__ __forceinline__ int dg_row(int i) { const int rows[8] = {0, 777, 2047, 2048, 20000, 32767, 32768, 33791}; int r = 0;
#pragma unroll
    for (int j = 0; j < 8; ++j) r = (i == j) ? rows[j] : r; return r; }
__device__ __forceinline__ void chk_ffn(Frame& F, const float* x0, const float* x1, int split, const float* Wg, const float* Wu, const float* Wd, const float* lg, const float* lb, const float* Xout, int ch) {
    if (F.bx >= 8) return;
    const int row = dg_row(F.bx), tid = (int)threadIdx.x;
    LAS float* xs = (LAS float*)(F.lds + RING_OFF); LAS float* hs = xs + 1024; LAS float* rs = hs + 2816;
    const float* xr = row < split ? x0 + (size_t)row * D : x1 + (size_t)(row - split) * D;
    for (int c = tid; c < D; c += NTHR) xs[c] = xr[c];
    __syncthreads();
    for (int j = tid; j < FF; j += NTHR) { float g = 0.f, u = 0.f; for (int k = 0; k < D; ++k) { g += xs[k] * Wg[(size_t)k * FF + j]; u += xs[k] * Wu[(size_t)k * FF + j]; } hs[j] = g / (1.f + expf(-g)) * u; }
    __syncthreads();
    for (int c = tid; c < D; c += NTHR) { float y = 0.f; for (int j = 0; j < FF; ++j) y += hs[j] * Wd[(size_t)j * D + c]; rs[c] = ALPHA * xs[c] + 0.5f * y; }
    __syncthreads();
    float mean = 0.f; for (int c = 0; c < D; ++c) mean += rs[c]; mean *= (1.f / D);
    float var = 0.f; for (int c = 0; c < D; ++c) { const float d = rs[c] - mean; var += d * d; } var *= (1.f / D);
    const float rstd = 1.f / sqrtf(var + LN_EPS);
    float num = 0.f, den = 0.f;
    for (int c = tid; c < D; c += NTHR) { const float ref = (rs[c] - mean) * rstd * lg[c] + lb[c]; const float d = Xout[(size_t)row * D + c] - ref; num += d * d; den += ref * ref; }
    dg_add(F, ch, num, den);
}
__device__ __forceinline__ void chk_proj(Frame& F, const float* X1, const float* Win, const bf16* P, int ch) {
    if (F.bx >= 8) return;
    const int row = dg_row(F.bx), tid = (int)threadIdx.x;
    LAS float* xs = (LAS float*)(F.lds + RING_OFF);
    for (int c = tid; c < D; c += NTHR) xs[c] = X1[(size_t)row * D + c];
    __syncthreads();
    float num = 0.f, den = 0.f;
    for (int c = tid; c < INW; c += NTHR) { float p = 0.f; for (int k = 0; k < D; ++k) p += xs[k] * Win[(size_t)k * INW + c]; const float d = bf2f(P[(size_t)row * INWP + c]) - p; num += d * d; den += p * p; }
    dg_add(F, ch, num, den);
}

__device__ __forceinline__ void chk_gdn(Frame& F, const Args& A, bool sample, int b, int h, int ch_o, int ch_s) {
    const int tid = (int)threadIdx.x;
    LAS float* S = (LAS float*)(F.lds + RING_OFF); LAS float* y = S + 16384; LAS float* qn = y + 384; LAS float* kn = qn + 128; LAS float* rv = kn + 128;
    const bf16* P = WSP(bf16, WS_P); const float* BG = WSP(float, WS_BG); const float* OG = WSP(float, WS_OG); const float* cw = A.in[14];
    const int T = sample ? DECT : SEQ; const size_t m0 = sample ? (size_t)MP + b * DECT : (size_t)b * SEQ;
    const float* st_in = A.in[5] + (size_t)(b * GH + h) * GDK * GDV; const float* st_out = F.out + (sample ? O_GS : O_GP) + (size_t)(b * GH + h) * GDK * GDV;
    for (int e = tid; e < 16384; e += NTHR) S[e] = sample ? st_in[e] : 0.f;
    float no = 0.f, dn = 0.f;
    __syncthreads();
    for (int t = 0; t < T; ++t) {
        const size_t m = m0 + t;
        if (tid < 384) { const int col = (tid < 128) ? h * 128 + tid : (tid < 256) ? 512 + h * 128 + (tid - 128) : 1024 + h * 128 + (tid - 256); float a = 0.f;
            for (int j = 0; j < 4; ++j) { const int rr = t + j; float x;
                if (rr < 3) x = sample ? A.in[6][((size_t)b * 3 + rr) * CONVC + col] : 0.f; else x = bf2f(P[(m0 + rr - 3) * INWP + C_QKV + col]);
                a += cw[j * CONVC + col] * x; }
            y[tid] = a / (1.f + expf(-a)); }
        __syncthreads();
        float sq = 0.f, sk = 0.f; for (int i = 0; i < 128; ++i) { sq += y[i] * y[i]; sk += y[128 + i] * y[128 + i]; }
        const float rq = 1.f / sqrtf(sq + NORM_EPS), rk = 1.f / sqrtf(sk + NORM_EPS);
        if (tid < 128) { qn[tid] = y[tid] * rq; kn[tid] = y[128 + tid] * rk; }
        __syncthreads();
        const float be = BG[m * 8 + h], a = expf(BG[m * 8 + 4 + h]);
        if (tid < 128) { float part = 0.f; for (int dk = 0; dk < 128; ++dk) part += a * S[dk * 128 + tid] * kn[dk]; rv[tid] = (y[256 + tid] - part) * be; }
        __syncthreads();
        for (int e = tid; e < 16384; e += NTHR) S[e] = a * S[e] + kn[e >> 7] * rv[e & 127];
        __syncthreads();
        if (tid < 128) { float o = 0.f; for (int dk = 0; dk < 128; ++dk) o += S[dk * 128 + tid] * qn[dk]; o *= 0.08838834764831845f;
            const float d = OG[m * 512 + h * 128 + tid] - o; no += d * d; dn += o * o; }
        __syncthreads();
    }
    float ns = 0.f, ds = 0.f;
    for (int e = tid; e < 16384; e += NTHR) { const float d = st_out[e] - S[e]; ns += d * d; ds += S[e] * S[e]; }
    dg_add(F, ch_o, no, dn); dg_add(F, ch_s, ns, ds);
}

__device__ __forceinline__ void chk_dsa(Frame& F, const Args& A, bool sample, int b, int t, int ch) {
    const int tid = (int)threadIdx.x;
    LAS float* sc = (LAS float*)(F.lds + RING_OFF); LAS unsigned char* sel = (LAS unsigned char*)(sc + 8208); LAS float* qs = (LAS float*)(sel + 8208);
    const f16* QIh = WSP(f16, WS_QI); const f16* KIh = WSP(f16, WS_KI); const float* WI = WSP(float, WS_WI); const bf16* Qb = WSP(bf16, WS_QB); const bf16* Kb = WSP(bf16, WS_KB); const bf16* P = WSP(bf16, WS_P); const bf16* CAT = WSP(bf16, WS_CAT);
    const int* ptab = (const int*)A.in[7];
    const size_t m = sample ? (size_t)MP + b * DECT + t : (size_t)b * SEQ + t; const int n = sample ? PAST + t + 1 : t + 1;
    for (int l = tid; l < n; l += NTHR) { float s = 0.f;
        for (int h = 0; h < 8; ++h) { float d = 0.f;
            for (int e = 0; e < 64; ++e) { float kv;
                if (sample) { if (l < PAST) kv = (float)(f16)A.in[4][((size_t)ptab[b * NPAGES + (l >> 7)] * PAGE + (l & 127)) * 64 + e]; else kv = (float)KIh[((size_t)MP + b * DECT + (l - PAST)) * 64 + e]; }
                else kv = (float)KIh[((size_t)b * SEQ + l) * 64 + e];
                d += (float)QIh[m * 512 + h * 64 + e] * kv; }
            s += WI[m * 8 + h] * fmaxf(d, 0.f); }
        if (s == 0.f) s = 0.f;
        sc[l] = s; }
    for (int e = tid; e < 512; e += NTHR) qs[e] = bf2f(Qb[m * 512 + e]);
    __syncthreads();
    for (int l = tid; l < n; l += NTHR) { const float x = sc[l]; int rank = 0; for (int l2 = 0; l2 < n; ++l2) { const float y = sc[l2]; rank += (y > x || (y == x && l2 < l)) ? 1 : 0; } sel[l] = rank < KSEL ? 1 : 0; }
    __syncthreads();
    const int h = tid >> 6, d = tid & 63, g = h >> 2; float mx = -INFINITY;
    for (int pass = 0; pass < 2; ++pass) { float lsum = 0.f, o = 0.f;
        for (int l = 0; l < n; ++l) { if (!sel[l]) continue; float dot = 0.f; float vv;
            if (sample) { const float* kp; const float* vp;
                if (l < PAST) { const size_t rid = (size_t)ptab[b * NPAGES + (l >> 7)] * PAGE + (l & 127); kp = A.in[2] + rid * 128; vp = A.in[3] + rid * 128; }
                else { kp = F.out + O_KS + ((size_t)b * DECT + (l - PAST)) * 128; vp = F.out + O_VS + ((size_t)b * DECT + (l - PAST)) * 128; }
                for (int e = 0; e < 64; ++e) dot += qs[h * 64 + e] * kp[g * 64 + e]; vv = vp[g * 64 + d];
            } else { const size_t mk = (size_t)b * SEQ + l; for (int e = 0; e < 64; ++e) dot += qs[h * 64 + e] * bf2f(Kb[mk * 128 + g * 64 + e]); vv = bf2f(P[mk * INWP + C_V + g * 64 + d]); }
            dot *= 0.6931471805599453f;
            if (pass == 0) mx = fmaxf(mx, dot); else { const float p = expf(dot - mx); lsum += p; o += p * vv; } }
        if (pass == 1) { const float ref = o / lsum; const float dd = bf2f(CAT[m * D + h * 64 + d]) - ref; dg_add(F, ch, dd * dd, ref * ref); } }
}
__device__ __forceinline__ void dg_report(Frame& F) {
    if (F.bx != 0 || (int)threadIdx.x >= 12) return;
    const size_t offs[12] = {O_YP, O_YS, O_KP, O_VP, O_IP, O_GP, O_CP, O_KS, O_VS, O_IS, O_GS, O_CS};
    size_t off = 0;
#pragma unroll
    for (int j = 0; j < 12; ++j) off = ((int)threadIdx.x == j) ? offs[j] : off;
    const float num = __hip_atomic_load((float*)(F.ctl + CW_DG + 2 * (int)threadIdx.x), RLX_AGENT), den = __hip_atomic_load((float*)(F.ctl + CW_DG + 2 * (int)threadIdx.x + 1), RLX_AGENT);
    int n = 99;
    if (den > 0.f) { const float e = sqrtf(num / den); const float L = -log10f(fmaxf(e, 1e-9f)); n = 1 + (int)(10.f * fmaxf(L, 0.f) + 0.5f); n = n > 98 ? 98 : n; if (!(e == e)) n = 1; }
    for (int i = 0; i < n; ++i) ((unsigned*)F.out)[off + i] = 0xAAAAAAAAu;
}
#endif

#if MK_DIAG == 2
constexpr int CW_TS = 3072;
__device__ __forceinline__ void ts_stamp(Frame& F, int k) { if (F.bx == 0 && F.wave == 0 && lane_fresh() == 0) { const unsigned long long t = __builtin_amdgcn_s_memrealtime(); F.ctl[CW_TS + 2 * k] = (unsigned)t; F.ctl[CW_TS + 2 * k + 1] = (unsigned)(t >> 32); } }
__device__ __forceinline__ void ts_report(Frame& F) {
    if (F.bx != 0 || F.wave != 0) return; const int lane = lane_fresh(); if (lane >= 12) return;
    const size_t offs[12] = {O_YP, O_YS, O_KP, O_VP, O_IP, O_GP, O_CP, O_KS, O_VS, O_IS, O_GS, O_CS};
    const int lo[12] = TS_LO; const int hi[12] = TS_HI;
    size_t off = 0; int a = 0, b = 0;
#pragma unroll
    for (int j = 0; j < 12; ++j) { off = (lane == j) ? offs[j] : off; a = (lane == j) ? lo[j] : a; b = (lane == j) ? hi[j] : b; }
    const unsigned long long t0 = (unsigned long long)F.ctl[CW_TS + 2 * a] | ((unsigned long long)F.ctl[CW_TS + 2 * a + 1] << 32), t1 = (unsigned long long)F.ctl[CW_TS + 2 * b] | ((unsigned long long)F.ctl[CW_TS + 2 * b + 1] << 32);
    int n = (int)((t1 - t0) / 100ull); n = n < 1 ? 1 : (n > 60000 ? 60000 : n);
    for (int i = 0; i < n; ++i) ((unsigned*)F.out)[off + i] = 0xAAAAAAAAu;
}
#endif
#ifndef MK_ONE_LAUNCH
#define MK_ONE_LAUNCH 0
#endif
constexpr int NPH = 14 + (MK_DIAG == 1 ? 2 : MK_DIAG == 2 ? 1 : 0);
__global__ void __launch_bounds__(NTHR, 2) mk_fwd(Args args) {
    extern __shared__ __attribute__((aligned(16))) unsigned char lds[];
    Frame F;
    F.lds = (LAS unsigned char*)lds; F.MISC = (volatile LAS unsigned*)(F.lds + MISC_OFF);
    F.wave = __builtin_amdgcn_readfirstlane(threadIdx.x >> 6); F.G = gridDim.x; F.bx = blockIdx.x;
    F.out = args.out; F.ws = args.ws; F.ctl = (gu32*)(args.ws + WS_CTL);
    for (int u = F.wave * 64 + lane_fresh(); u < (LDS_BYTES - LDSCTL_OFF) / 4; u += NTHR) ((LAS unsigned*)(F.lds + LDSCTL_OFF))[u] = 0u;
    __syncthreads();
    XcdBarrier bar; bar.wave = F.wave; bar.bar = (unsigned*)(F.ctl + CW_BAR); bar.x = 0; bar.st = nullptr;
    if (MK_ONE_LAUNCH) bar = xcd_barrier_post((unsigned*)(F.ctl + CW_BAR), F.MISC + 8, F.wave);
    const int lo = args.ph_lo, hi = args.ph_hi;
#define IN(k) (lo <= (k) && (k) < hi)
#define PHASE(k, ...) do { if (IN(k)) { __VA_ARGS__ } if (MK_DUP == (k)) { xcd_barrier(bar); __VA_ARGS__ } SEAM(k); } while (0)
#if MK_DIAG == 2
#define SEAM(k) do { if (IN(k) && IN((k) + 1)) xcd_barrier(bar); ts_stamp(F, (k) + 1); } while (0)
#else
#define SEAM(k) do { if (IN(k) && IN((k) + 1)) xcd_barrier(bar); } while (0)
#endif
    const float* xp = args.in[0]; const float* xs = args.in[1];
    bf16* XB = WSP(bf16, WS_XB); float* X1 = WSP(float, WS_X1); float* X2 = WSP(float, WS_X2); float* R = WSP(float, WS_R); bf16* RB = WSP(bf16, WS_R); bf16* H = WSP(bf16, WS_H); bf16* P = WSP(bf16, WS_P); bf16* CAT = WSP(bf16, WS_CAT);

#if MK_DIAG == 2
    ts_stamp(F, 0);
#endif
    PHASE(0,  p0_prologue(F, args); );
    PHASE(1,
        pg8::Gemm g{XB, WSP(bf16, WS_WGU1), M, NGU, D}; pg8::StaticOrder S; S.init(M, NGU, F.G, F.bx);
        pg8::EpiSwiGLU E{H, FF};
        pg8::gemm_phase<pg8::EpiSwiGLU, pg8::StaticOrder, true, true>(F.lds + RING_OFF, g, S, E, F.wave);
        { const int nwg = (M / 256) * (NGU / 256), rem = nwg % F.G;
          if (rem == 0) p0_convert_items(F, args, 2 * P0_I_GU, P0_NITEMS, F.bx, F.G); else if (F.bx >= rem) p0_convert_items(F, args, 2 * P0_I_GU, P0_NITEMS, F.bx - rem, F.G - rem); }
    );
    PHASE(2,
        pg8::Gemm g{H, WSP(bf16, WS_WD1), MP, D, FF}; pg8::StaticOrder S; S.init(MP, D, F.G, F.bx);
        pg8::EpiResBf16<true> E{xp, RB, D, ALPHA, 0.5f};
        pg8::gemm_phase<pg8::EpiResBf16<true>, pg8::StaticOrder, true, true>(F.lds + RING_OFF, g, S, E, F.wave);
        pg8::Gemm gs{H + (size_t)MP * FF, WSP(bf16, WS_WD1), MS, D, FF, 256}; pg8::SplitOrder SS; SS.init(MS, D, FF / 256, F.G, F.bx);
        pg8::EpiPartialF32 ES{WSP(float, WS_PART), D, (size_t)MS * D};
        pg8::gemm_phase<pg8::EpiPartialF32, pg8::SplitOrder, true, true>(F.lds + RING_OFF, gs, SS, ES, F.wave);
    );
    PHASE(3,  ln_phase(F, RB, args.in[11], args.in[12], nullptr, XB, WSP(float, WS_PART), FF / 256, xs, nullptr, 0.5f); );
    PHASE(4,
        pg8::Gemm g{XB, WSP(bf16, WS_WIN), M, INWP, D}; pg8::StaticOrder S; S.init(M, INWP, F.G, F.bx);
        pg8::EpiPlainBf16 E{P, INWP};
        pg8::gemm_phase<pg8::EpiPlainBf16, pg8::StaticOrder, true, true>(F.lds + RING_OFF, g, S, E, F.wave);
    );
    PHASE(5,  post_phase(F, args); );
    PHASE(6,  gdn_prep_phase(F, args); if (MK_DUP == 60) gdn_prep_phase(F, args, MK_Y); dsa_sample_scores_phase(F, args); if (MK_DUP == 61) dsa_sample_scores_phase(F, args); );
    PHASE(7,  gdn_scan_phase(F, args); if (MK_DUP == 70) gdn_scan_phase(F, args); dsa_sample_attend_phase(F, args); if (MK_DUP == 71) dsa_sample_attend_phase(F, args); dsa_prompt_phase(F); if (MK_DUP == 72) dsa_prompt_phase(F); );
    PHASE(8,  gdn_out_phase(F, args); );
#if MK_DIAG != 1
    PHASE(9,
        pg8::Gemm g{CAT, WSP(bf16, WS_WO), MP, D, D}; pg8::StaticOrder S; S.init(MP, D, F.G, F.bx);
        pg8::EpiResBf16<false> E{XB, RB, D, ALPHA, 1.0f};
        pg8::gemm_phase<pg8::EpiResBf16<false>, pg8::StaticOrder, true, true>(F.lds + RING_OFF, g, S, E, F.wave);
        pg8::Gemm gs{CAT + (size_t)MP * D, WSP(bf16, WS_WO), MS, D, D, 256}; pg8::SplitOrder SS; SS.init(MS, D, D / 256, F.G, F.bx);
        pg8::EpiPartialF32 ES{WSP(float, WS_PART), D, (size_t)MS * D};
        pg8::gemm_phase<pg8::EpiPartialF32, pg8::SplitOrder, true, true>(F.lds + RING_OFF, gs, SS, ES, F.wave);
    );
    PHASE(10,  ln_phase(F, RB, args.in[19], args.in[20], nullptr, XB, WSP(float, WS_PART), D / 256, nullptr, XB, 1.0f); );
    PHASE(11,
        pg8::Gemm g{XB, WSP(bf16, WS_WGU2), M, NGU, D}; pg8::StaticOrder S; S.init(M, NGU, F.G, F.bx);
        pg8::EpiSwiGLU E{H, FF};
        pg8::gemm_phase<pg8::EpiSwiGLU, pg8::StaticOrder, true, true>(F.lds + RING_OFF, g, S, E, F.wave);
    );
    PHASE(12,
        pg8::Gemm g{H, WSP(bf16, WS_WD2), MP, D, FF}; pg8::StaticOrder S; S.init(MP, D, F.G, F.bx);
        pg8::EpiResBf16<false> E{XB, RB, D, ALPHA, 0.5f};
        pg8::gemm_phase<pg8::EpiResBf16<false>, pg8::StaticOrder, true, true>(F.lds + RING_OFF, g, S, E, F.wave);
        pg8::Gemm gs{H + (size_t)MP * FF, WSP(bf16, WS_WD2), MS, D, FF, 256}; pg8::SplitOrder SS; SS.init(MS, D, FF / 256, F.G, F.bx);
        pg8::EpiPartialF32 ES{WSP(float, WS_PART), D, (size_t)MS * D};
        pg8::gemm_phase<pg8::EpiPartialF32, pg8::SplitOrder, true, true>(F.lds + RING_OFF, gs, SS, ES, F.wave);
    );
    PHASE(13,  ln_phase(F, RB, args.in[24], args.in[25], F.out + O_YP, nullptr, WSP(float, WS_PART), FF / 256, nullptr, XB, 0.5f); );
#endif
#if MK_DIAG == 1
    if (IN(14)) {
#if MK_DIAG_ALL
        chk_ffn(F, xp, xs, MP, args.in[8], args.in[9], args.in[10], args.in[11], args.in[12], X1, 0);
        chk_proj(F, X1, args.in[13], P, 1);
#endif
        if (F.bx >= 8 && F.bx < 12) { const int i = F.bx - 8; chk_gdn(F, args, false, 5 * i, i, 2, 3); }
        if (F.bx >= 16 && F.bx < 24) { const int i = F.bx - 16; chk_dsa(F, args, false, (3 * i + 1) & 15, i == 0 ? 5 : i == 1 ? 255 : i == 2 ? 256 : i == 3 ? 300 : i == 4 ? 777 : i == 5 ? 1500 : i == 6 ? 2046 : 2047, 6); }
        if (F.bx >= 24 && F.bx < 28) { const int i = F.bx - 24; chk_dsa(F, args, true, i == 0 ? 0 : i == 1 ? 50 : i == 2 ? 99 : 127, i == 0 ? 0 : i == 1 ? 3 : i == 2 ? 6 : 7, 7); }
        if (F.bx >= 12 && F.bx < 16) { const int i = F.bx - 12; chk_gdn(F, args, true, i == 0 ? 0 : i == 1 ? 37 : i == 2 ? 100 : 127, i, 4, 5); }
    }
#endif
#if MK_DIAG == 1
    if (IN(15)) dg_report(F);
#endif
#if MK_DIAG == 2
    if (IN(14)) ts_report(F);
#endif
#undef IN
#undef SEAM
}

extern "C" void kernel_launch(void* const* d_in, const int* in_sizes, int n_in, void* d_out, int out_size, void* d_ws, size_t ws_size, hipStream_t stream) {
    static int grid = 0;
    if (grid == 0) {
        if (n_in != 26 || out_size != (int)O_END || ws_size < WS_END) { fprintf(stderr, "kernel_launch: unexpected shapes (n_in %d out %d ws %zu)\n", n_in, out_size, ws_size); grid = -1; return; }
        int dev = 0, cus = 0, per_cu = 0;
        if (hipGetDevice(&dev) != hipSuccess || hipDeviceGetAttribute(&cus, hipDeviceAttributeMultiprocessorCount, dev) != hipSuccess) { grid = -1; return; }
        if (hipFuncSetAttribute((const void*)mk_fwd, hipFuncAttributeMaxDynamicSharedMemorySize, LDS_BYTES) != hipSuccess) { fprintf(stderr, "kernel_launch: hipFuncSetAttribute failed\n"); grid = -1; return; }
        if (hipOccupancyMaxActiveBlocksPerMultiprocessor(&per_cu, (const void*)mk_fwd, NTHR, LDS_BYTES) != hipSuccess || per_cu < 1) fprintf(stderr, "kernel_launch: occupancy query reports %d\n", per_cu);
        (void)hipGetLastError();
        grid = cus;
    }
    if (grid < 0) return;
    if (hipMemsetAsync((char*)d_ws + WS_CTL, 0, CTL_ZERO_BYTES, stream) != hipSuccess) return;
    Args a{};
    for (int i = 0; i < 26; ++i) a.in[i] = (const float*)d_in[i];
    a.out = (float*)d_out; a.ws = (unsigned char*)d_ws;
#if MK_ONE_LAUNCH
    a.ph_lo = 0; a.ph_hi = NPH;
    hipLaunchKernelGGL(mk_fwd, dim3(grid), dim3(NTHR), LDS_BYTES, stream, a);
#else
    for (int k = 0; k < NPH; ++k) { if (MK_DIAG == 1 && k >= 9 && k <= 13) continue; a.ph_lo = k; a.ph_hi = k + 1; hipLaunchKernelGGL(mk_fwd, dim3(grid), dim3(NTHR), LDS_BYTES, stream, a); }
#endif
}
```
